# Optimizing an MI355X kernel written in HIP

```python
import jax
import jax.numpy as jnp
from jax import lax
import numpy as np


D_MODEL = 2048
BATCH = 1
SEQ = 8192
DEPTH = 4

GRID_W = 64
CTX_LEN = 256
N_EVEN = (DEPTH + 1) // 2
N_ODD = DEPTH // 2

CONV_DIM = D_MODEL // 2
CONV_WIDTH = 3
RET_HEADS = 8
RET_HEAD_DIM = (D_MODEL // 2) // RET_HEADS
RET_DIM = RET_HEADS * RET_HEAD_DIM
RET_CHUNK = 128
ROPE_BASE = 10000.0
AB_SPLITS = (CONV_DIM, 2 * CONV_DIM, 3 * CONV_DIM, 3 * CONV_DIM + RET_DIM, 3 * CONV_DIM + 2 * RET_DIM, 3 * CONV_DIM + 3 * RET_DIM)
AB_IN = 3 * CONV_DIM + 4 * RET_DIM
NA_HEADS = 16
NA_HEAD_DIM = D_MODEL // NA_HEADS
NA_KR = 8
NA_KC = 16
FFN_HIDDEN = -(-8 * D_MODEL // (3 * 256)) * 256
N_MOD = 6
EPS = 1e-6

kernel_name = 'hybrid_conv_retention_natten_dit'


def rms_norm(x, g):
    xf = x.astype(jnp.float32)
    y = xf * lax.rsqrt(jnp.mean(xf * xf, axis=-1, keepdims=True) + EPS)
    return (y * g.astype(jnp.float32)).astype(x.dtype)


def modulate(h, shift, scale):
    return h * (1 + scale) + shift


def short_conv(u, w):
    L = u.shape[1]
    half = CONV_WIDTH // 2
    up = jnp.pad(u, ((0, 0), (half, half), (0, 0)))
    return sum(up[:, j:j + L] * w[j] for j in range(CONV_WIDTH))


def axial_rope(n_tok, head_dim):
    pos = jnp.arange(n_tok)
    quarter = head_dim // 4
    inv_freq = ROPE_BASE ** (-jnp.arange(quarter, dtype=jnp.float32) / quarter)
    row = (pos // GRID_W).astype(jnp.float32)[:, None] * inv_freq
    col = (pos % GRID_W).astype(jnp.float32)[:, None] * inv_freq
    ang = jnp.concatenate([row, col], axis=-1)[None, :, None, :]
    return jnp.cos(ang), jnp.sin(ang)


def apply_rope(t, cos, sin):
    t1, t2 = t[..., 0::2], t[..., 1::2]
    return jnp.stack([t1 * cos - t2 * sin, t1 * sin + t2 * cos], axis=-1).reshape(t.shape)


def retention_chunks(q, k, v, log_gamma, state0):
    b, L, H, dh = k.shape
    dv = v.shape[-1]
    n = L // RET_CHUNK
    kc = k.reshape(b, n, RET_CHUNK, H, dh)
    vc = v.reshape(b, n, RET_CHUNK, H, dv)
    pos = jnp.arange(RET_CHUNK, dtype=jnp.float32)
    lg = log_gamma[:, None]
    kv_decay = jnp.exp((RET_CHUNK - 1 - pos)[None, :] * lg)
    chunk_decay = jnp.exp(RET_CHUNK * log_gamma)[None, :, None, None]
    kv = jnp.einsum('bnkhd,hk,bnkhv->nbhdv', kc, kv_decay, vc)

    def step(state, kv_n):
        return state * chunk_decay + kv_n, state

    state_final, state_prev = lax.scan(step, state0, kv)
    if q is None:
        return None, state_final
    qc = q.reshape(b, n, RET_CHUNK, H, dh)
    diff = pos[:, None] - pos[None, :]
    intra_decay = jnp.where(diff >= 0, jnp.exp(jnp.maximum(diff, 0.0)[None] * log_gamma[:, None, None]), 0.0)
    q_decay = jnp.exp((pos + 1.0)[None, :] * lg)
    scores = jnp.einsum('bnqhd,bnkhd->bnhqk', qc, kc) * intra_decay
    out = (jnp.einsum('bnhqk,bnkhv->bnqhv', scores, vc)
           + jnp.einsum('bnqhd,hq,nbhdv->bnqhv', qc, q_decay, state_prev))
    return out.reshape(b, L, H, dv), state_final


def bidirectional_retention(q, k, v, q_ctx, k_ctx, v_ctx, log_gamma):
    flip = lambda t: None if t is None else t[:, ::-1]
    b, _, H, dh = k.shape
    zero = jnp.zeros((b, H, dh, v.shape[-1]), jnp.float32)
    o_ctx_f, s_f = retention_chunks(q_ctx, k_ctx, v_ctx, log_gamma[0], zero)
    o_ctx_b, s_b = retention_chunks(flip(q_ctx), flip(k_ctx), flip(v_ctx), log_gamma[1], zero)
    o_f, _ = retention_chunks(q, k, v, log_gamma[0], s_f)
    o_b, _ = retention_chunks(flip(q), flip(k), flip(v), log_gamma[1], s_b)
    o = o_f + flip(o_b)
    o_ctx = None if q_ctx is None else o_ctx_f + flip(o_ctx_b)
    return o, o_ctx


def head_rms(o):
    return o * lax.rsqrt(jnp.mean(o * o, axis=-1, keepdims=True) + EPS)


def conv_retention_mixer(h, hc, w_in, conv_w, decay_exp, w_out, with_ctx_out):
    b, S, _ = h.shape
    n_ctx = hc.shape[1]
    f32 = jnp.float32
    log_gamma = jnp.log1p(-jnp.exp2(-decay_exp.astype(f32)))
    cos, sin = axial_rope(S, RET_HEAD_DIM)
    heads = lambda t: t.astype(f32).reshape(t.shape[0], t.shape[1], RET_HEADS, RET_HEAD_DIM)
    bg, cg, u, q, k, v, g = jnp.split(h @ w_in, AB_SPLITS, axis=-1)
    q = apply_rope(heads(q), cos, sin)
    k = apply_rope(heads(k), cos, sin) * RET_HEAD_DIM ** -0.5
    if with_ctx_out:
        bgc, cgc, uc, qc, kc, vc, gc = jnp.split(hc @ w_in, AB_SPLITS, axis=-1)
        qc = heads(qc)
    else:
        kc, vc = jnp.split(hc @ w_in[:, AB_SPLITS[3]:AB_SPLITS[5]], 2, axis=-1)
        qc = None
    kc = heads(kc) * RET_HEAD_DIM ** -0.5
    o, oc = bidirectional_retention(q, k, heads(v), qc, kc, heads(vc), log_gamma)
    y_a = bg * short_conv(cg * u, conv_w)
    y_b = jax.nn.silu(g) * head_rms(o).reshape(b, S, RET_DIM).astype(g.dtype)
    y = jnp.concatenate([y_a, y_b], axis=-1) @ w_out
    if not with_ctx_out:
        return y, None
    yc_a = bgc * short_conv(cgc * uc, conv_w)
    yc_b = jax.nn.silu(gc) * head_rms(oc).reshape(b, n_ctx, RET_DIM).astype(gc.dtype)
    return y, jnp.concatenate([yc_a, yc_b], axis=-1) @ w_out


def neighbourhood_attention_mixer(h, hc, w_qkv, rpb, w_out, with_ctx_out):
    b, S, _ = h.shape
    n_ctx = hc.shape[1]
    rows = S // GRID_W
    kr = min(NA_KR, rows)
    scale = NA_HEAD_DIM ** -0.5
    to_grid = lambda t: t.reshape(b, rows, GRID_W, NA_HEADS, NA_HEAD_DIM)
    q, k, v = [to_grid(t) for t in jnp.split(h @ w_qkv, 3, axis=-1)]
    k_ctx, v_ctx = [t.reshape(b, n_ctx, NA_HEADS, NA_HEAD_DIM) for t in jnp.split(hc @ w_qkv[:, D_MODEL:], 2, axis=-1)]
    row_start = jnp.clip(jnp.arange(rows) - kr // 2, 0, rows - kr)
    col_start = jnp.clip(jnp.arange(GRID_W) - NA_KC // 2, 0, GRID_W - NA_KC)
    col_idx = col_start[:, None] + jnp.arange(NA_KC)[None, :]
    rpb_cols = rpb[:, :, col_idx - jnp.arange(GRID_W)[:, None] + NA_KC - 1]

    def row_block(args):
        r, q_r = args
        sr = row_start[r]
        k_win = lax.dynamic_slice_in_dim(k, sr, kr, axis=1)[:, :, col_idx]
        v_win = lax.dynamic_slice_in_dim(v, sr, kr, axis=1)[:, :, col_idx]
        bias = rpb_cols[:, sr + jnp.arange(kr) - r + NA_KR - 1]
        s_win = (jnp.einsum('bqhd,biqjhd->bqhij', q_r, k_win).astype(jnp.float32) * scale
                 + jnp.transpose(bias, (2, 0, 1, 3)).astype(jnp.float32))
        s_ctx = jnp.einsum('bqhd,bchd->bqhc', q_r, k_ctx).astype(jnp.float32) * scale
        logits = jnp.concatenate([s_win.reshape(b, GRID_W, NA_HEADS, kr * NA_KC), s_ctx], axis=-1)
        p = jax.nn.softmax(logits, axis=-1).astype(v.dtype)
        p_win = p[..., :kr * NA_KC].reshape(b, GRID_W, NA_HEADS, kr, NA_KC)
        p_ctx = p[..., kr * NA_KC:]
        return (jnp.einsum('bqhij,biqjhd->bqhd', p_win, v_win)
                + jnp.einsum('bqhc,bchd->bqhd', p_ctx, v_ctx))

    o = lax.map(row_block, (jnp.arange(rows), jnp.moveaxis(q, 1, 0)))
    y = jnp.moveaxis(o, 0, 1).reshape(b, S, D_MODEL) @ w_out
    if not with_ctx_out:
        return y, None
    q_ctx = (hc @ w_qkv[:, :D_MODEL]).reshape(b, n_ctx, NA_HEADS, NA_HEAD_DIM)
    s = jnp.einsum('bqhd,bkhd->bhqk', q_ctx, k_ctx).astype(jnp.float32) * scale
    p = jax.nn.softmax(s, axis=-1).astype(v_ctx.dtype)
    oc = jnp.einsum('bhqk,bkhd->bqhd', p, v_ctx).reshape(b, n_ctx, D_MODEL)
    return y, oc @ w_out


def swiglu(h, w_in, w_out):
    gate, up = jnp.split(h @ w_in, 2, axis=-1)
    return (jax.nn.silu(gate) * up) @ w_out


def setup_inputs(seed: int = 0) -> dict:
    key = jax.random.key(seed)
    ks = jax.random.split(key, 16)
    f32 = jnp.float32
    nrm = lambda k, shape, s: jax.random.normal(k, shape, f32) * s
    return {
        'x': nrm(ks[0], (BATCH, SEQ, D_MODEL), 1.0),
        'c': nrm(ks[1], (BATCH, D_MODEL), 1.0),
        'ctx': nrm(ks[2], (BATCH, CTX_LEN, D_MODEL), 1.0),
        'c_ctx': nrm(ks[3], (D_MODEL,), 1.0),
        'ada_w': nrm(ks[4], (DEPTH, D_MODEL, N_MOD * D_MODEL), 0.5 * D_MODEL ** -0.5),
        'ada_b': nrm(ks[5], (DEPTH, N_MOD * D_MODEL), 0.02),
        'norm_g': 1.0 + nrm(ks[6], (DEPTH, 4, D_MODEL), 0.05),
        'ab_w_in': nrm(ks[7], (N_EVEN, D_MODEL, AB_IN), D_MODEL ** -0.5),
        'ab_conv_w': nrm(ks[8], (N_EVEN, CONV_WIDTH, CONV_DIM), CONV_WIDTH ** -0.5),
        'ab_decay_exp': 5.0 + jnp.arange(RET_HEADS, dtype=f32) + nrm(ks[9], (N_EVEN, 2, RET_HEADS), 0.1),
        'ab_w_out': nrm(ks[10], (N_EVEN, CONV_DIM + RET_DIM, D_MODEL), (CONV_DIM + RET_DIM) ** -0.5),
        'na_w_qkv': nrm(ks[11], (N_ODD, D_MODEL, 3 * D_MODEL), D_MODEL ** -0.5),
        'na_rpb': nrm(ks[12], (N_ODD, NA_HEADS, 2 * NA_KR - 1, 2 * NA_KC - 1), 0.5),
        'na_w_out': nrm(ks[13], (N_ODD, D_MODEL, D_MODEL), D_MODEL ** -0.5),
        'ffn_w_in': nrm(ks[14], (DEPTH, D_MODEL, 2 * FFN_HIDDEN), D_MODEL ** -0.5),
        'ffn_w_out': nrm(ks[15], (DEPTH, FFN_HIDDEN, D_MODEL), FFN_HIDDEN ** -0.5),
    }


def reference(x, c, ctx, c_ctx, ada_w, ada_b, norm_g, ab_w_in, ab_conv_w, ab_decay_exp, ab_w_out,
              na_w_qkv, na_rpb, na_w_out, ffn_w_in, ffn_w_out):
    xc = ctx
    s_lat = jax.nn.silu(c)
    s_ctx = jax.nn.silu(c_ctx)
    for layer in range(DEPTH):
        last = layer == DEPTH - 1
        mod = jnp.split((s_lat @ ada_w[layer] + ada_b[layer])[:, None, :], N_MOD, axis=-1)
        mod_c = jnp.split(s_ctx @ ada_w[layer] + ada_b[layer], N_MOD, axis=-1)
        h = modulate(rms_norm(x, norm_g[layer, 0]), mod[0], mod[1])
        hc = modulate(rms_norm(xc, norm_g[layer, 0]), mod_c[0], mod_c[1])
        if layer % 2 == 0:
            i = layer // 2
            y, yc = conv_retention_mixer(h, hc, ab_w_in[i], ab_conv_w[i], ab_decay_exp[i], ab_w_out[i], not last)
        else:
            i = layer // 2
            y, yc = neighbourhood_attention_mixer(h, hc, na_w_qkv[i], na_rpb[i], na_w_out[i], not last)
        x = x + mod[2] * rms_norm(y, norm_g[layer, 1])
        h = modulate(rms_norm(x, norm_g[layer, 2]), mod[3], mod[4])
        x = x + mod[5] * rms_norm(swiglu(h, ffn_w_in[layer], ffn_w_out[layer]), norm_g[layer, 3])
        if not last:
            xc = xc + mod_c[2] * rms_norm(yc, norm_g[layer, 1])
            hc = modulate(rms_norm(xc, norm_g[layer, 2]), mod_c[3], mod_c[4])
            xc = xc + mod_c[5] * rms_norm(swiglu(hc, ffn_w_in[layer], ffn_w_out[layer]), norm_g[layer, 3])
    return x
```

```cpp
#ifndef HOST_EMU
#include <hip/hip_runtime.h>
#include <cstdio>
#include <cstdint>
#define DEV __device__ __forceinline__
#define HDEV __host__ __device__ __forceinline__
#define LAS __attribute__((address_space(3)))
#endif

typedef unsigned short bf16_t;
typedef short bf16x8 __attribute__((ext_vector_type(8)));
typedef float f32x4 __attribute__((ext_vector_type(4)));
typedef float f32x2 __attribute__((ext_vector_type(2)));
typedef unsigned u32x4 __attribute__((ext_vector_type(4)));
typedef unsigned u32x2 __attribute__((ext_vector_type(2)));

#ifndef HOST_EMU
DEV f32x4 mfma16(bf16x8 a, bf16x8 b, f32x4 c) { return __builtin_amdgcn_mfma_f32_16x16x32_bf16(a, b, c, 0, 0, 0); }
DEV float shfl_xor_f(float v, int m) { return __shfl_xor(v, m); }
DEV unsigned cvt_pk_bf16(float lo, float hi) { unsigned r; asm("v_cvt_pk_bf16_f32 %0, %1, %2" : "=v"(r) : "v"(lo), "v"(hi)); return r; }
DEV float ex2(float x) { return __builtin_amdgcn_exp2f(x); }
DEV float rcp_f(float x) { return __builtin_amdgcn_rcpf(x); }
DEV float rsq_f(float x) { return 1.0f / sqrtf(x); }
DEV void atomic_add_f(float* p, float v) { (void)__hip_atomic_fetch_add(p, v, __ATOMIC_RELAXED, __HIP_MEMORY_SCOPE_AGENT); }
#endif

namespace cfg {
constexpr int D = 2048, S = 8192, NCTX = 256, MTOK = 8448, DEPTH = 4;
constexpr int ABIN = 7168, FFH = 5632, FF2 = 11264, QKV = 6144;
constexpr int NCHUNK = 66;
constexpr float EPS = 1e-6f;
constexpr float HSCALE = 0.08838834764831845f;
constexpr float LOG2E = 1.4426950408889634f;
}
using namespace cfg;

DEV float bf_lo(unsigned w) { return __builtin_bit_cast(float, w << 16); }
DEV float bf_hi(unsigned w) { return __builtin_bit_cast(float, w & 0xffff0000u); }
DEV float wave_sum(float v) {
#pragma unroll
    for (int o = 1; o < 64; o <<= 1) v += shfl_xor_f(v, o);
    return v;
}
DEV float silu_f(float x) { return x * rcp_f(1.0f + ex2(-x * LOG2E)); }
DEV float lg2gamma(const float* decay_exp, int iab, int dir, int head) {
    const float e = decay_exp[(iab * 2 + dir) * 8 + head];
    return log1pf(-exp2f(-e)) * LOG2E;
}
DEV bf16x8 extract8(const u32x4 (&vd)[8], int mt) {
    u32x4 w;
#pragma unroll
    for (int q = 0; q < 4; ++q) {
        const unsigned X = vd[2 * q][mt >> 1], Y = vd[2 * q + 1][mt >> 1];
        w[q] = (mt & 1) ? ((X >> 16) | (Y & 0xffff0000u)) : ((X & 0xffffu) | (Y << 16));
    }
    return __builtin_bit_cast(bf16x8, w);
}

struct RowopArgs {
    const float* y;
    const float* xin_lat; const float* xin_ctx;
    float* xout_lat; float* xout_ctx;
    bf16_t* h;
    const float* modacc; const float* ada_b; const float* norm_g;
    int ly, jg_y, jgate, lh, jg_h, jshift, jscale, nctx;
};
DEV f32x4 ld4(const float* p) { return *(const f32x4*)p; }
constexpr int MODPART = 4 * 2 * 6 * 2048;
DEV f32x4 modvec(const RowopArgs& a, int l, int s, int j, int col) {
    const float* q = a.modacc + (size_t)((l * 2 + s) * 6 + j) * D + col;
    return ((ld4(q) + ld4(q + MODPART)) + (ld4(q + 2 * MODPART) + ld4(q + 3 * MODPART))) + ld4(a.ada_b + (size_t)l * 6 * D + j * D + col);
}
template <class CP>
DEV void rowop_coefs(const RowopArgs& a, const int s, CP coef, const int tid) {
    const int col = 4 * tid;
    f32x4 A = (f32x4){0.f, 0.f, 0.f, 0.f}, B = A, SH = A;
    if (a.ly >= 0) A = modvec(a, a.ly, s, a.jgate, col) * ld4(a.norm_g + (size_t)(a.ly * 4 + a.jg_y) * D + col);
    if (a.lh >= 0) { B = ld4(a.norm_g + (size_t)(a.lh * 4 + a.jg_h) * D + col) * (modvec(a, a.lh, s, a.jscale, col) + 1.0f); SH = modvec(a, a.lh, s, a.jshift, col); }
    *(f32x4*)(coef + col) = A; *(f32x4*)(coef + D + col) = B; *(f32x4*)(coef + 2 * D + col) = SH;
}
template <class CP>
DEV void rowop_stream(const RowopArgs& a, const int s, CP coef, const int row_begin, const int row_end, const int gw, const int NGW, const int lane) {
    const bool hasy = a.ly >= 0, hash = a.lh >= 0;
    for (int m = row_begin + gw; m < row_end; m += NGW) {
        const float* xr = (s == 0) ? a.xin_lat + (size_t)m * D : a.xin_ctx + (size_t)(m - S) * D;
        f32x4 x[8];
#pragma unroll
        for (int j = 0; j < 8; ++j) x[j] = ld4(xr + 4 * lane + 256 * j);
        if (hasy) {
            const float* yr = a.y + (size_t)m * D;
            f32x4 y[8]; float ss = 0.f;
#pragma unroll
            for (int j = 0; j < 8; ++j) { y[j] = ld4(yr + 4 * lane + 256 * j); ss += (y[j][0] * y[j][0] + y[j][1] * y[j][1]) + (y[j][2] * y[j][2] + y[j][3] * y[j][3]); }
            const float r1 = rsq_f(wave_sum(ss) * (1.0f / D) + EPS);
#pragma unroll
            for (int j = 0; j < 8; ++j) x[j] = x[j] + *(const f32x4*)(coef + 4 * lane + 256 * j) * (y[j] * r1);
        }
        float* xo = (s == 0) ? (a.xout_lat ? a.xout_lat + (size_t)m * D : nullptr) : (a.xout_ctx ? a.xout_ctx + (size_t)(m - S) * D : nullptr);
        if (xo) {
#pragma unroll
            for (int j = 0; j < 8; ++j) *(f32x4*)(xo + 4 * lane + 256 * j) = x[j];
        }
        if (hash) {
            float ss = 0.f;
#pragma unroll
            for (int j = 0; j < 8; ++j) ss += (x[j][0] * x[j][0] + x[j][1] * x[j][1]) + (x[j][2] * x[j][2] + x[j][3] * x[j][3]);
            const float r2 = rsq_f(wave_sum(ss) * (1.0f / D) + EPS);
            bf16_t* hr = a.h + (size_t)m * D;
#pragma unroll
            for (int j = 0; j < 8; ++j) { const f32x4 v = (x[j] * r2) * *(const f32x4*)(coef + D + 4 * lane + 256 * j) + *(const f32x4*)(coef + 2 * D + 4 * lane + 256 * j);
                u32x2 w; w[0] = cvt_pk_bf16(v[0], v[1]); w[1] = cvt_pk_bf16(v[2], v[3]); *(u32x2*)(hr + 4 * lane + 256 * j) = w; }
        }
    }
}

DEV void conv_loadz(const bf16_t* P, int t, int c, float (&z)[8]) {
    const u32x4 cg = *(const u32x4*)(P + (size_t)t * ABIN + 1024 + c), u = *(const u32x4*)(P + (size_t)t * ABIN + 2048 + c);
#pragma unroll
    for (int e = 0; e < 4; ++e) { z[2 * e] = bf_lo(cg[e]) * bf_lo(u[e]); z[2 * e + 1] = bf_hi(cg[e]) * bf_hi(u[e]); }
}
DEV void conv_task(const bf16_t* P, bf16_t* YAB, const float* convw, int task, int lane) {
    const int half = task & 1, t0 = (task >> 1) * 8, c = half * 512 + lane * 8;
    float w0[8], w1[8], w2[8], zp[8], zc[8], zn[8];
#pragma unroll
    for (int e = 0; e < 8; ++e) { w0[e] = convw[c + e]; w1[e] = convw[1024 + c + e]; w2[e] = convw[2048 + c + e]; zp[e] = 0.f; zn[e] = 0.f; }
    if (t0 != 0 && t0 != S) conv_loadz(P, t0 - 1, c, zp);
    conv_loadz(P, t0, c, zc);
    for (int i = 0; i < 8; ++i) {
        const int t = t0 + i;
        if (t != S - 1 && t != MTOK - 1) conv_loadz(P, t + 1, c, zn);
        else {
#pragma unroll
            for (int e = 0; e < 8; ++e) zn[e] = 0.f;
        }
        const u32x4 bg = *(const u32x4*)(P + (size_t)t * ABIN + c);
        float o[8];
#pragma unroll
        for (int e = 0; e < 8; ++e) { const float b = (e & 1) ? bf_hi(bg[e >> 1]) : bf_lo(bg[e >> 1]); o[e] = b * (w0[e] * zp[e] + w1[e] * zc[e] + w2[e] * zn[e]); }
        u32x4 w; w[0] = cvt_pk_bf16(o[0], o[1]); w[1] = cvt_pk_bf16(o[2], o[3]); w[2] = cvt_pk_bf16(o[4], o[5]); w[3] = cvt_pk_bf16(o[6], o[7]);
        *(u32x4*)(YAB + (size_t)t * D + c) = w;
#pragma unroll
        for (int e = 0; e < 8; ++e) { zp[e] = zc[e]; zc[e] = zn[e]; }
    }
}

DEV int chunk_row(int cidx) { return cidx < 2 ? S + 128 * cidx : 128 * (cidx - 2); }
DEV void r1_task(const bf16_t* P, float* KVt, float lg2, int cidx, int head, int dir, int quad, int lane) {
    const int i = lane & 15, g = lane >> 4;
    const int dk0 = 64 * (quad >> 1), dv0 = 64 * (quad & 1);
    const bf16_t* Kp = P + (size_t)chunk_row(cidx) * ABIN + 4096 + head * 128 + dk0 + 4 * i;
    const bf16_t* Vp = P + (size_t)chunk_row(cidx) * ABIN + 5120 + head * 128 + dv0 + 4 * i;
    f32x4 acc[4][4];
#pragma unroll
    for (int a = 0; a < 4; ++a)
#pragma unroll
        for (int b = 0; b < 4; ++b) acc[a][b] = (f32x4){0.f, 0.f, 0.f, 0.f};
    for (int s = 0; s < 4; ++s) {
        u32x2 kd[8], vd[8]; float w[8];
#pragma unroll
        for (int jj = 0; jj < 8; ++jj) {
            const int tj = 32 * s + 8 * g + jj;
            kd[jj] = *(const u32x2*)(Kp + (size_t)tj * ABIN); vd[jj] = *(const u32x2*)(Vp + (size_t)tj * ABIN);
            w[jj] = ex2(lg2 * (float)(dir == 0 ? 127 - tj : tj));
        }
        bf16x8 af[4], bfr[4];
#pragma unroll
        for (int mt = 0; mt < 4; ++mt) {
            u32x4 wd;
#pragma unroll
            for (int q = 0; q < 4; ++q) {
                const unsigned X = kd[2 * q][mt >> 1], Y = kd[2 * q + 1][mt >> 1];
                const float lo = ((mt & 1) ? bf_hi(X) : bf_lo(X)) * w[2 * q], hi = ((mt & 1) ? bf_hi(Y) : bf_lo(Y)) * w[2 * q + 1];
                wd[q] = cvt_pk_bf16(lo, hi);
            }
            af[mt] = __builtin_bit_cast(bf16x8, wd);
        }
#pragma unroll
        for (int nt = 0; nt < 4; ++nt) {
            u32x4 wd;
#pragma unroll
            for (int q = 0; q < 4; ++q) {
                const unsigned X = vd[2 * q][nt >> 1], Y = vd[2 * q + 1][nt >> 1];
                wd[q] = (nt & 1) ? ((X >> 16) | (Y & 0xffff0000u)) : ((X & 0xffffu) | (Y << 16));
            }
            bfr[nt] = __builtin_bit_cast(bf16x8, wd);
        }
#pragma unroll
        for (int mt = 0; mt < 4; ++mt)
#pragma unroll
            for (int nt = 0; nt < 4; ++nt) acc[mt][nt] = mfma16(af[mt], bfr[nt], acc[mt][nt]);
    }
    float* out = KVt + ((((size_t)cidx * 8 + head) * 2 + dir) * 128) * 128;
#pragma unroll
    for (int nt = 0; nt < 4; ++nt)
#pragma unroll
        for (int reg = 0; reg < 4; ++reg) {
            const int dv = dv0 + 4 * i + nt, dk = dk0 + 16 * g + 4 * reg;
            *(f32x4*)(out + (size_t)dv * 128 + dk) = (f32x4){acc[0][nt][reg], acc[1][nt][reg], acc[2][nt][reg], acc[3][nt][reg]};
        }
}
DEV void r2_item(const float* KVt, bf16_t* St, const float* decay_exp, int iab, int item) {
    const int hd = item >> 13, e = (item & 8191) * 2, head = hd >> 1, dir = hd & 1;
    const float cd = exp2f(128.0f * lg2gamma(decay_exp, iab, dir, head));
    float s0 = 0.f, s1 = 0.f;
#pragma unroll 6
    for (int step = 0; step < NCHUNK; ++step) {
        const int c = dir == 0 ? step : (step < 2 ? 1 - step : 67 - step);
        const size_t off = (((size_t)c * 8 + head) * 2 + dir) * 16384 + e;
        *(unsigned*)(St + off) = cvt_pk_bf16(s0, s1);
        const f32x2 kv = *(const f32x2*)(KVt + off);
        s0 = s0 * cd + kv[0]; s1 = s1 * cd + kv[1];
    }
}
DEV void r3_task(const bf16_t* P, const bf16_t* St, bf16_t* YAB, float lg2f, float lg2b, int cidx, int head, int qb, int lane) {
    const int i = lane & 15, g = lane >> 4, qi = 16 * qb + i, rowbase = chunk_row(cidx);
    const bf16_t* Prow = P + (size_t)rowbase * ABIN;
    bf16x8 qf[4];
#pragma unroll
    for (int s = 0; s < 4; ++s) qf[s] = *(const bf16x8*)(Prow + (size_t)qi * ABIN + 3072 + head * 128 + 32 * s + 8 * g);
    f32x4 sacc[8];
#pragma unroll
    for (int mt = 0; mt < 8; ++mt) {
        f32x4 a = (f32x4){0.f, 0.f, 0.f, 0.f};
#pragma unroll
        for (int s = 0; s < 4; ++s) { const bf16x8 kf = *(const bf16x8*)(Prow + (size_t)(16 * mt + i) * ABIN + 4096 + head * 128 + 32 * s + 8 * g); a = mfma16(kf, qf[s], a); }
        sacc[mt] = a;
    }
#pragma unroll
    for (int mt = 0; mt < 8; ++mt)
#pragma unroll
        for (int reg = 0; reg < 4; ++reg) {
            const int diff = qi - (16 * mt + 4 * g + reg);
            const float d = diff > 0 ? ex2((float)diff * lg2f) : (diff < 0 ? ex2((float)(-diff) * lg2b) : 2.0f);
            sacc[mt][reg] *= d;
        }
    bf16x8 pf[4];
#pragma unroll
    for (int s = 0; s < 4; ++s) {
        u32x4 w; w[0] = cvt_pk_bf16(sacc[2 * s][0], sacc[2 * s][1]); w[1] = cvt_pk_bf16(sacc[2 * s][2], sacc[2 * s][3]);
        w[2] = cvt_pk_bf16(sacc[2 * s + 1][0], sacc[2 * s + 1][1]); w[3] = cvt_pk_bf16(sacc[2 * s + 1][2], sacc[2 * s + 1][3]);
        pf[s] = __builtin_bit_cast(bf16x8, w);
    }
    f32x4 oacc[8];
#pragma unroll
    for (int mt = 0; mt < 8; ++mt) oacc[mt] = (f32x4){0.f, 0.f, 0.f, 0.f};
#pragma unroll
    for (int s = 0; s < 4; ++s) {
        u32x4 vd[8];
#pragma unroll
        for (int jj = 0; jj < 8; ++jj) { const int key = 32 * s + (jj < 4 ? 4 * g + jj : 16 + 4 * g + jj - 4); vd[jj] = *(const u32x4*)(Prow + (size_t)key * ABIN + 5120 + head * 128 + 8 * i); }
#pragma unroll
        for (int mt = 0; mt < 8; ++mt) oacc[mt] = mfma16(extract8(vd, mt), pf[s], oacc[mt]);
    }
#pragma unroll
    for (int dir = 0; dir < 2; ++dir) {
        f32x4 tacc[8];
#pragma unroll
        for (int mt = 0; mt < 8; ++mt) tacc[mt] = (f32x4){0.f, 0.f, 0.f, 0.f};
        const bf16_t* Sp = St + ((((size_t)cidx * 8 + head) * 2 + dir) * 128) * 128;
#pragma unroll
        for (int s = 0; s < 4; ++s)
#pragma unroll
            for (int mt = 0; mt < 8; ++mt) { const bf16x8 sf = *(const bf16x8*)(Sp + (size_t)(8 * i + mt) * 128 + 32 * s + 8 * g); tacc[mt] = mfma16(sf, qf[s], tacc[mt]); }
        const float qd = dir == 0 ? ex2((float)(qi + 1) * lg2f) : ex2((float)(128 - qi) * lg2b);
#pragma unroll
        for (int mt = 0; mt < 8; ++mt) oacc[mt] = oacc[mt] + tacc[mt] * qd;
    }
    float ss = 0.f;
#pragma unroll
    for (int mt = 0; mt < 8; ++mt) ss += (oacc[mt][0] * oacc[mt][0] + oacc[mt][1] * oacc[mt][1]) + (oacc[mt][2] * oacc[mt][2] + oacc[mt][3] * oacc[mt][3]);
    ss += shfl_xor_f(ss, 16); ss += shfl_xor_f(ss, 32);
    const float rinv = rsq_f(ss * (1.0f / 128.0f) + EPS);
#pragma unroll
    for (int reg = 0; reg < 4; ++reg) {
        const int dvb = 32 * g + 8 * reg;
        const u32x4 gt = *(const u32x4*)(Prow + (size_t)qi * ABIN + 6144 + head * 128 + dvb);
        float o[8];
#pragma unroll
        for (int mt = 0; mt < 8; ++mt) { const float gv = (mt & 1) ? bf_hi(gt[mt >> 1]) : bf_lo(gt[mt >> 1]); o[mt] = silu_f(gv) * (oacc[mt][reg] * rinv); }
        u32x4 w; w[0] = cvt_pk_bf16(o[0], o[1]); w[1] = cvt_pk_bf16(o[2], o[3]); w[2] = cvt_pk_bf16(o[4], o[5]); w[3] = cvt_pk_bf16(o[6], o[7]);
        *(u32x4*)(YAB + (size_t)(rowbase + qi) * D + 1024 + head * 128 + dvb) = w;
    }
}

template <bool WIN>
DEV void attn_task(const bf16_t* P, bf16_t* YAB, const float* rpb, int h, int qtok0, int r, int c0, int kc0, int lane) {
    const int i = lane & 15, g = lane >> 4, qtok = qtok0 + i;
    bf16x8 qf[4];
#pragma unroll
    for (int s = 0; s < 4; ++s) qf[s] = *(const bf16x8*)(P + (size_t)qtok * QKV + h * 128 + 32 * s + 8 * g);
    const int c = c0 + i;
    const int sr = r - 4 < 0 ? 0 : (r - 4 > 120 ? 120 : r - 4);
    const int sc = c - 8 < 0 ? 0 : (c - 8 > 48 ? 48 : c - 8);
    float m_run = -1e30f, l_run = 0.f;
    f32x4 oacc[8];
#pragma unroll
    for (int mt = 0; mt < 8; ++mt) oacc[mt] = (f32x4){0.f, 0.f, 0.f, 0.f};
    for (int b = WIN ? 0 : 8; b < 16; ++b) {
        const int kb = b < 8 ? (sr + b) * 64 + kc0 : S + 32 * (b - 8);
        f32x4 sa[2];
#pragma unroll
        for (int mt = 0; mt < 2; ++mt) {
            f32x4 a = (f32x4){0.f, 0.f, 0.f, 0.f};
#pragma unroll
            for (int s = 0; s < 4; ++s) { const bf16x8 kf = *(const bf16x8*)(P + (size_t)(kb + 16 * mt + i) * QKV + 2048 + h * 128 + 32 * s + 8 * g); a = mfma16(kf, qf[s], a); }
            sa[mt] = a;
        }
        float bm = -1e30f;
#pragma unroll
        for (int mt = 0; mt < 2; ++mt)
#pragma unroll
            for (int reg = 0; reg < 4; ++reg) {
                float v = sa[mt][reg] * HSCALE;
                if (WIN && b < 8) {
                    const int kcol = kc0 + 16 * mt + 4 * g + reg;
                    const bool valid = kcol >= sc && kcol < sc + 16;
                    const int dc = valid ? kcol - c + 15 : 0;
                    const float bias = rpb[(h * 15 + (sr + b - r + 7)) * 31 + dc];
                    v = valid ? v + bias : -1e30f;
                }
                sa[mt][reg] = v; bm = fmaxf(bm, v);
            }
        bm = fmaxf(bm, shfl_xor_f(bm, 16)); bm = fmaxf(bm, shfl_xor_f(bm, 32));
        const float m_new = fmaxf(m_run, bm);
        const float alpha = ex2((m_run - m_new) * LOG2E);
        m_run = m_new;
        float ps = 0.f;
#pragma unroll
        for (int mt = 0; mt < 2; ++mt)
#pragma unroll
            for (int reg = 0; reg < 4; ++reg) { const float pv = ex2((sa[mt][reg] - m_new) * LOG2E); sa[mt][reg] = pv; ps += pv; }
        l_run = l_run * alpha + ps;
#pragma unroll
        for (int mt = 0; mt < 8; ++mt) oacc[mt] = oacc[mt] * alpha;
        u32x4 pw; pw[0] = cvt_pk_bf16(sa[0][0], sa[0][1]); pw[1] = cvt_pk_bf16(sa[0][2], sa[0][3]); pw[2] = cvt_pk_bf16(sa[1][0], sa[1][1]); pw[3] = cvt_pk_bf16(sa[1][2], sa[1][3]);
        const bf16x8 pf = __builtin_bit_cast(bf16x8, pw);
        u32x4 vd[8];
#pragma unroll
        for (int jj = 0; jj < 8; ++jj) { const int key = kb + (jj < 4 ? 4 * g + jj : 16 + 4 * g + jj - 4); vd[jj] = *(const u32x4*)(P + (size_t)key * QKV + 4096 + h * 128 + 8 * i); }
#pragma unroll
        for (int mt = 0; mt < 8; ++mt) oacc[mt] = mfma16(extract8(vd, mt), pf, oacc[mt]);
    }
    l_run += shfl_xor_f(l_run, 16); l_run += shfl_xor_f(l_run, 32);
    const float inv = 1.0f / l_run;
#pragma unroll
    for (int reg = 0; reg < 4; ++reg) {
        const int dvb = 32 * g + 8 * reg;
        u32x4 w;
#pragma unroll
        for (int q = 0; q < 4; ++q) w[q] = cvt_pk_bf16(oacc[2 * q][reg] * inv, oacc[2 * q + 1][reg] * inv);
        *(u32x4*)(YAB + (size_t)qtok * D + h * 128 + dvb) = w;
    }
}

struct Unit { int pm, pn; };
struct EpiF32 {
    static constexpr bool PERM = false, AFTER_DRAIN = false;
    float* C; int ldc;
    DEV void operator()(const f32x4 (&acc)[2][2][4][2], const Unit& u, int wr, int wc, int fr, int fq) const {
        const int row0 = u.pm * 256 + wr * 64 + fr, col0 = u.pn * 256 + wc * 32 + 4 * fq;
#pragma unroll
        for (int ai = 0; ai < 2; ++ai)
#pragma unroll
            for (int m = 0; m < 4; ++m) { float* rowp = C + (size_t)(row0 + ai * 128 + m * 16) * ldc + col0;
#pragma unroll
                for (int bj = 0; bj < 2; ++bj)
#pragma unroll
                    for (int n = 0; n < 2; ++n) *(f32x4*)(rowp + bj * 128 + n * 16) = acc[ai][bj][m][n]; }
    }
};
struct EpiBf16 {
    static constexpr bool PERM = true, AFTER_DRAIN = false;
    bf16_t* O; int ldc;
    DEV void operator()(const f32x4 (&acc)[2][2][4][2], const Unit& u, int wr, int wc, int fr, int fq) const {
        const int row0 = u.pm * 256 + wr * 64 + fr, col0 = u.pn * 256 + wc * 32 + 8 * fq;
#pragma unroll
        for (int ai = 0; ai < 2; ++ai)
#pragma unroll
            for (int m = 0; m < 4; ++m) { bf16_t* rowp = O + (size_t)(row0 + ai * 128 + m * 16) * ldc + col0;
#pragma unroll
                for (int bj = 0; bj < 2; ++bj) { const f32x4 v0 = acc[ai][bj][m][0], v1 = acc[ai][bj][m][1];
                    u32x4 w; w[0] = cvt_pk_bf16(v0[0], v0[1]); w[1] = cvt_pk_bf16(v0[2], v0[3]); w[2] = cvt_pk_bf16(v1[0], v1[1]); w[3] = cvt_pk_bf16(v1[2], v1[3]);
                    *(u32x4*)(rowp + bj * 128) = w; } }
    }
};
struct EpiInProj {
    static constexpr bool PERM = true, AFTER_DRAIN = false;
    bf16_t* O; const f32x2* rope;
    DEV void operator()(const f32x4 (&acc)[2][2][4][2], const Unit& u, int wr, int wc, int fr, int fq) const {
        const int row0 = u.pm * 256 + wr * 64 + fr, col0 = u.pn * 256 + wc * 32 + 8 * fq;
        const bool isk = u.pn >= 16 && u.pn < 20, isq = u.pn >= 12 && u.pn < 16, dorope = (isq || isk) && u.pm < 32;
        const float sc = isk ? HSCALE : 1.0f;
#pragma unroll
        for (int ai = 0; ai < 2; ++ai)
#pragma unroll
            for (int m = 0; m < 4; ++m) { const int row = row0 + ai * 128 + m * 16; bf16_t* rowp = O + (size_t)row * ABIN + col0;
                f32x4 cs01 = (f32x4){1.f, 0.f, 1.f, 0.f}, cs23 = cs01, cs45 = cs01, cs67 = cs01;
                if (dorope) { const int pidx = (wc < 2) ? (row >> 6) : 128 + (row & 63); const f32x2* tp = rope + pidx * 32 + 16 * (wc & 1) + 4 * fq;
                    const f32x4 t0 = *(const f32x4*)tp, t1 = *(const f32x4*)(tp + 2); cs01 = t0; cs23 = t0; cs45 = t1; cs67 = t1; }
#pragma unroll
                for (int bj = 0; bj < 2; ++bj) { f32x4 v0 = acc[ai][bj][m][0], v1 = acc[ai][bj][m][1];
                    if (dorope) {
                        const f32x4 a0 = v0, a1 = v1;
                        v0[0] = a0[0] * cs01[0] - a0[1] * cs01[1]; v0[1] = a0[0] * cs01[1] + a0[1] * cs01[0];
                        v0[2] = a0[2] * cs23[2] - a0[3] * cs23[3]; v0[3] = a0[2] * cs23[3] + a0[3] * cs23[2];
                        v1[0] = a1[0] * cs45[0] - a1[1] * cs45[1]; v1[1] = a1[0] * cs45[1] + a1[1] * cs45[0];
                        v1[2] = a1[2] * cs67[2] - a1[3] * cs67[3]; v1[3] = a1[2] * cs67[3] + a1[3] * cs67[2];
                    }
                    v0 = v0 * sc; v1 = v1 * sc;
                    u32x4 w; w[0] = cvt_pk_bf16(v0[0], v0[1]); w[1] = cvt_pk_bf16(v0[2], v0[3]); w[2] = cvt_pk_bf16(v1[0], v1[1]); w[3] = cvt_pk_bf16(v1[2], v1[3]);
                    *(u32x4*)(rowp + bj * 128) = w; } }
    }
};
struct EpiSwiglu {
    static constexpr bool PERM = true, AFTER_DRAIN = false;
    bf16_t* O;
    DEV void operator()(const f32x4 (&acc)[2][2][4][2], const Unit& u, int wr, int wc, int fr, int fq) const {
        const int row0 = u.pm * 256 + wr * 64 + fr, col0 = u.pn * 128 + wc * 32 + 8 * fq;
#pragma unroll
        for (int ai = 0; ai < 2; ++ai)
#pragma unroll
            for (int m = 0; m < 4; ++m) { bf16_t* rowp = O + (size_t)(row0 + ai * 128 + m * 16) * FFH + col0;
                const f32x4 g0 = acc[ai][0][m][0], g1 = acc[ai][0][m][1], u0 = acc[ai][1][m][0], u1 = acc[ai][1][m][1];
                u32x4 w; w[0] = cvt_pk_bf16(silu_f(g0[0]) * u0[0], silu_f(g0[1]) * u0[1]); w[1] = cvt_pk_bf16(silu_f(g0[2]) * u0[2], silu_f(g0[3]) * u0[3]);
                w[2] = cvt_pk_bf16(silu_f(g1[0]) * u1[0], silu_f(g1[1]) * u1[1]); w[3] = cvt_pk_bf16(silu_f(g1[2]) * u1[2], silu_f(g1[3]) * u1[3]);
                *(u32x4*)rowp = w; }
    }
};

#ifndef HOST_EMU
namespace pg8 {
#define PG8_LAS __attribute__((address_space(3)))
constexpr int BM = 256, BK = 64, HALF = 128, HTB = HALF * BK * 2, STAGE_BYTES = 8 * HTB, NXCD = 8, WGM = 8;
__host__ __device__ __forceinline__ int lds_byte(int r, int c) { const int st = (r >> 4) * 2 + (c >> 5), rr = r & 15, cc = c & 31, ob = rr * 64 + cc * 2; return st * 1024 + (ob ^ (((ob >> 9) & 1) << 5)); }
__host__ __device__ __forceinline__ void stage_rc(int b, int& R, int& C) { const int st = b / 1024, sb = b % 1024, swz = sb ^ (((sb >> 9) & 1) << 5); R = (st >> 1) * 16 + swz / 64; C = (st & 1) * 32 + (swz % 64) / 2; }
__host__ __device__ __forceinline__ int perm32(int rho) { const int n = rho >> 4, i = rho & 15; return 8 * (i >> 2) + 4 * n + (i & 3); }
struct Gemm { const bf16_t* A; const bf16_t* Bt; int M, N, K; };
struct StaticOrder {
    int nM, nN, nwg, G, c;
    __host__ __device__ void init(int M, int N, int G_, int c_) { nM = M / BM; nN = N / BM; nwg = nM * nN; G = G_; c = c_; }
    __host__ __device__ bool next(int i, Unit& u) const {
        const long L = (long)i * G + c; if (L >= nwg) return false;
        int wgid = (int)L; { const int q = nwg / NXCD, r = nwg % NXCD, xcd = wgid % NXCD, off = wgid / NXCD; wgid = (xcd < r ? xcd * (q + 1) : r * (q + 1) + (xcd - r) * q) + off; }
        const int nig = WGM * nN, gid = wgid / nig, fm = gid * WGM, gsz = (nM - fm) < WGM ? (nM - fm) : WGM;
        u.pm = fm + ((wgid % nig) % gsz); u.pn = (wgid % nig) / gsz; return true;
    }
    __device__ __forceinline__ void a_ready(const Unit&) const {}
    __device__ __forceinline__ void done(const Unit&) const {}
};
template <class Epi, class Sched, bool ALIGN_EPI = false, bool SP2 = false>
__device__ __forceinline__ void gemm_phase(PG8_LAS unsigned char* lds, const Gemm g, const Sched& S, const Epi& E, const int tid) {
    const int wid = __builtin_amdgcn_readfirstlane(tid >> 6), lane = tid & 63, wr = wid >> 2, wc = wid & 3, fr = lane & 15, fq = lane >> 4;
    const int K = g.K, nt = K / BK;
    unsigned voffA[2], voffB[2];
#pragma unroll
    for (int i = 0; i < 2; ++i) { int R, C; stage_rc(tid * 16 + i * 8192, R, C); const int Rb = Epi::PERM ? ((R & ~31) + perm32(R & 31)) : R;
        voffA[i] = (unsigned)(R * K + C) * 2u; voffB[i] = (unsigned)(Rb * K + C) * 2u; }
    const size_t kstep = (size_t)(BK * 2);
    const size_t hstep = (size_t)HALF * K * 2;
    const size_t tstep = 2 * hstep;
    const unsigned ldsw = (unsigned)wid * 1024u;
    const int aoff = lds_byte(wr * 64 + fr, fq * 8), boff = lds_byte(wc * 32 + fr, fq * 8);
#define PG8_SA(b, h) (((b) * 2 + (h)) * HTB)
#define PG8_SB(b, h) ((4 + (b) * 2 + (h)) * HTB)
#define PG8_STAGE(bufoff, gbase, voff) do { _Pragma("unroll") for (int _i = 0; _i < 2; ++_i) \
        __builtin_amdgcn_global_load_lds((const unsigned*)((const char*)(gbase) + (voff)[_i]), (PG8_LAS unsigned*)(lds + (bufoff) + ldsw + _i * 8192), 16, 0, 0); } while (0)
#define PG8_LDA(dst, b, h) do { _Pragma("unroll") for (int m = 0; m < 4; ++m) _Pragma("unroll") for (int k = 0; k < 2; ++k) dst[m][k] = *(const PG8_LAS bf16x8*)(lds + PG8_SA(b, h) + aoff + m * 2048 + k * 1024); } while (0)
#define PG8_LDB(dst, b, h) do { _Pragma("unroll") for (int n = 0; n < 2; ++n) _Pragma("unroll") for (int k = 0; k < 2; ++k) dst[n][k] = *(const PG8_LAS bf16x8*)(lds + PG8_SB(b, h) + boff + n * 2048 + k * 1024); } while (0)
#define PG8_MMA(ai, bj, At, Bt) do { __builtin_amdgcn_s_setprio(1); _Pragma("unroll") for (int m = 0; m < 4; ++m) _Pragma("unroll") for (int n = 0; n < 2; ++n) _Pragma("unroll") for (int k = 0; k < 2; ++k) \
        acc[ai][bj][m][n] = __builtin_amdgcn_mfma_f32_16x16x32_bf16(Bt[n][k], At[m][k], acc[ai][bj][m][n], 0, 0, 0); __builtin_amdgcn_s_setprio(0); } while (0)
#define PG8_WAIT_V(n) asm volatile("s_waitcnt vmcnt(" #n ")" ::: "memory")
#define PG8_WAIT_L(n) asm volatile("s_waitcnt lgkmcnt(" #n ")" ::: "memory")
#define PG8_BAR __builtin_amdgcn_s_barrier()
#define PG8_SCHED __builtin_amdgcn_sched_barrier(0)
    Unit cur, nxt; int ui = 0;
    if (!S.next(0, cur)) return;
    f32x4 acc[2][2][4][2];
#pragma unroll
    for (int a = 0; a < 2; ++a)
#pragma unroll
        for (int b = 0; b < 2; ++b)
#pragma unroll
            for (int m = 0; m < 4; ++m)
#pragma unroll
                for (int n = 0; n < 2; ++n) acc[a][b][m][n] = (f32x4){0.f, 0.f, 0.f, 0.f};
    bf16x8 At[4][2], B0[2][2], B1[2][2];
    const char* cA = (const char*)g.A + (size_t)cur.pm * tstep; const char* cB = (const char*)g.Bt + (size_t)cur.pn * tstep;
    S.a_ready(cur);
    if constexpr (SP2) {
        PG8_STAGE(PG8_SB(0, 0), cB, voffB); PG8_STAGE(PG8_SB(0, 1), cB + hstep, voffB); PG8_STAGE(PG8_SA(0, 0), cA, voffA); PG8_STAGE(PG8_SA(0, 1), cA + hstep, voffA);
        if (wr == 1) PG8_BAR;
        PG8_WAIT_V(2); PG8_BAR;
        PG8_STAGE(PG8_SB(1, 0), cB + kstep, voffB); PG8_STAGE(PG8_SA(1, 0), cA + kstep, voffA); PG8_STAGE(PG8_SB(1, 1), cB + hstep + kstep, voffB);
        PG8_WAIT_V(6); PG8_BAR;
    } else {
        PG8_STAGE(PG8_SB(0, 0), cB, voffB); PG8_STAGE(PG8_SA(0, 0), cA, voffA); PG8_STAGE(PG8_SB(0, 1), cB + hstep, voffB); PG8_STAGE(PG8_SA(0, 1), cA + hstep, voffA);
        if (wr == 1) PG8_BAR;
        PG8_WAIT_V(4); PG8_BAR;
        PG8_STAGE(PG8_SB(1, 0), cB + kstep, voffB); PG8_STAGE(PG8_SA(1, 0), cA + kstep, voffA); PG8_STAGE(PG8_SB(1, 1), cB + hstep + kstep, voffB);
        PG8_WAIT_V(6); PG8_BAR;
    }
    for (;;) {
        const bool has_next = S.next(ui + 1, nxt);
        const char* nA = has_next ? (const char*)g.A + (size_t)nxt.pm * tstep : cA; const char* nB = has_next ? (const char*)g.Bt + (size_t)nxt.pn * tstep : cB;
        for (int t = 0; t < nt; t += 2) {
            const bool last = (t == nt - 2);
            const char* a1 = cA + (size_t)(t + 1) * kstep;
            const char* a2 = last ? nA : cA + (size_t)(t + 2) * kstep; const char* b2 = last ? nB : cB + (size_t)(t + 2) * kstep;
            const char* a3 = a2 + kstep; const char* b3 = b2 + kstep;
            if (last && has_next) S.a_ready(nxt);
            if constexpr (SP2) {
            PG8_LDB(B0, 0, 0); PG8_LDB(B1, 0, 1); PG8_SCHED; PG8_LDA(At, 0, 0); PG8_STAGE(PG8_SA(1, 1), a1 + hstep, voffA);
            PG8_WAIT_V(8); PG8_WAIT_L(0); PG8_BAR; PG8_MMA(0, 0, At, B0); PG8_MMA(0, 1, At, B1); PG8_BAR; PG8_SCHED;
            PG8_LDA(At, 0, 1); PG8_STAGE(PG8_SB(0, 0), b2, voffB); PG8_STAGE(PG8_SB(0, 1), b2 + hstep, voffB); PG8_STAGE(PG8_SA(0, 0), a2, voffA);
            PG8_WAIT_V(8); PG8_WAIT_L(0); PG8_BAR; PG8_MMA(1, 0, At, B0); PG8_MMA(1, 1, At, B1); PG8_BAR; PG8_SCHED;
            PG8_LDB(B0, 1, 0); PG8_LDB(B1, 1, 1); PG8_SCHED; PG8_LDA(At, 1, 0); PG8_STAGE(PG8_SA(0, 1), a2 + hstep, voffA);
            PG8_WAIT_V(8); PG8_WAIT_L(0); PG8_BAR; PG8_MMA(0, 0, At, B0); PG8_MMA(0, 1, At, B1); PG8_BAR; PG8_SCHED;
            PG8_LDA(At, 1, 1); PG8_STAGE(PG8_SB(1, 0), b3, voffB); PG8_STAGE(PG8_SB(1, 1), b3 + hstep, voffB); PG8_STAGE(PG8_SA(1, 0), a3, voffA);
            PG8_WAIT_V(8); PG8_WAIT_L(0); PG8_BAR; PG8_MMA(1, 0, At, B0); PG8_MMA(1, 1, At, B1); PG8_BAR; PG8_SCHED;
            } else {
            PG8_LDB(B0, 0, 0); PG8_SCHED; PG8_LDA(At, 0, 0); PG8_STAGE(PG8_SA(1, 1), a1 + hstep, voffA);
            PG8_WAIT_L(8); PG8_BAR; PG8_WAIT_L(0); PG8_MMA(0, 0, At, B0); PG8_BAR; PG8_SCHED;
            PG8_LDB(B1, 0, 1); PG8_STAGE(PG8_SB(0, 0), b2, voffB);
            PG8_BAR; PG8_WAIT_L(0); PG8_MMA(0, 1, At, B1); PG8_BAR;
            PG8_LDA(At, 0, 1); PG8_STAGE(PG8_SA(0, 0), a2, voffA);
            PG8_BAR; PG8_WAIT_L(0); PG8_MMA(1, 0, At, B0); PG8_BAR; PG8_SCHED;
            PG8_STAGE(PG8_SB(0, 1), b2 + hstep, voffB);
            PG8_WAIT_V(6); PG8_BAR; PG8_MMA(1, 1, At, B1); PG8_BAR;
            PG8_LDB(B0, 1, 0); PG8_SCHED; PG8_LDA(At, 1, 0); PG8_STAGE(PG8_SA(0, 1), a2 + hstep, voffA);
            PG8_WAIT_L(8); PG8_BAR; PG8_WAIT_L(0); PG8_MMA(0, 0, At, B0); PG8_BAR; PG8_SCHED;
            PG8_LDB(B1, 1, 1); PG8_STAGE(PG8_SB(1, 0), b3, voffB);
            PG8_BAR; PG8_WAIT_L(0); PG8_MMA(0, 1, At, B1); PG8_BAR;
            PG8_LDA(At, 1, 1); PG8_STAGE(PG8_SA(1, 0), a3, voffA);
            PG8_BAR; PG8_WAIT_L(0); PG8_MMA(1, 0, At, B0); PG8_BAR; PG8_SCHED;
            PG8_STAGE(PG8_SB(1, 1), b3 + hstep, voffB);
            PG8_WAIT_V(6); PG8_BAR; PG8_MMA(1, 1, At, B1); PG8_BAR;
            }
        }
        if constexpr (ALIGN_EPI) { if (wr == 0) PG8_BAR; }
        if constexpr (!Epi::AFTER_DRAIN) { E(acc, cur, wr, wc, fr, fq); S.done(cur); }
        if (!has_next) break;
#pragma unroll
        for (int a = 0; a < 2; ++a)
#pragma unroll
            for (int b = 0; b < 2; ++b)
#pragma unroll
                for (int m = 0; m < 4; ++m)
#pragma unroll
                    for (int n = 0; n < 2; ++n) acc[a][b][m][n] = (f32x4){0.f, 0.f, 0.f, 0.f};
        cur = nxt; cA = nA; cB = nB; ++ui;
        if constexpr (ALIGN_EPI) { if (wr == 1) PG8_BAR; }
    }
    PG8_WAIT_V(0);
    if constexpr (!ALIGN_EPI) { if (wr == 0) PG8_BAR; }
    PG8_BAR;
#undef PG8_SA
#undef PG8_SB
#undef PG8_STAGE
#undef PG8_LDA
#undef PG8_LDB
#undef PG8_MMA
#undef PG8_WAIT_V
#undef PG8_WAIT_L
#undef PG8_BAR
#undef PG8_SCHED
}
}
#ifndef PG8_SP2
#define PG8_SP2 true
#endif
#ifndef PG8_ALIGN
#define PG8_ALIGN true
#endif

#define XB_TMO      128
#define XB_XCNT(j)  (256  + 64 * (j))
#define XB_XSUB(j)  (1280 + 64 * (j))
#define XB_XGEN(j)  (2304 + 64 * (j))
#define XB_TOP      3328
#define XB_TOPGEN   3392
#define XCD_BAR_WORDS 3456
#define XB_SPIN_CAP (1u << 18)
__device__ __forceinline__ unsigned xb_ld(unsigned* p)              { return __hip_atomic_load(p, __ATOMIC_RELAXED, __HIP_MEMORY_SCOPE_AGENT); }
__device__ __forceinline__ unsigned xb_add(unsigned* p, unsigned v) { return __hip_atomic_fetch_add(p, v, __ATOMIC_RELAXED, __HIP_MEMORY_SCOPE_AGENT); }
__device__ __forceinline__ unsigned xb_xcc_id() { return (unsigned)__builtin_amdgcn_s_getreg((3 << 11) | 20) & 0xFu; }
#define XB_SPIN(cond, bar) do { unsigned _sp = 0; while (cond) { __builtin_amdgcn_s_sleep(1); \
    if ((++_sp & 255u) == 0u) { if (xb_ld(&(bar)[XB_TMO])) break; if (_sp > XB_SPIN_CAP) { atomicAdd(&(bar)[XB_TMO], 1u); break; } } } } while (0)
struct XcdBarrier { unsigned* bar; unsigned x; volatile LAS unsigned* st; };
__device__ __forceinline__ XcdBarrier xcd_barrier_post(unsigned* bar, volatile LAS unsigned* st) {
    XcdBarrier b; b.bar = bar; b.x = xb_xcc_id(); b.st = st;
    if (threadIdx.x == 0) (void)xb_add(&bar[XB_XCNT(b.x)], 1u);
    return b;
}
__device__ __forceinline__ void xcd_barrier_complete(unsigned* bar, unsigned x, unsigned& nloc, unsigned& nx) {
    const unsigned G = gridDim.x * gridDim.y * gridDim.z;
    unsigned sum, cnt, mine, sp = 0u;
    for (;;) {
        sum = 0u; cnt = 0u; mine = 0u;
#pragma unroll
        for (unsigned j = 0; j < 16; ++j) { const unsigned c = xb_ld(&bar[XB_XCNT(j)]); sum += c; cnt += (c > 0u) ? 1u : 0u; mine = (j == x) ? c : mine; }
        if (sum == G) break;
        __builtin_amdgcn_s_sleep(1);
        if ((++sp & 255u) == 0u) { if (xb_ld(&bar[XB_TMO])) break; if (sp > XB_SPIN_CAP) { atomicAdd(&bar[XB_TMO], 1u); break; } }
    }
    nloc = mine > 0u ? mine : 1u; nx = cnt > 0u ? cnt : 1u;
}
__device__ __forceinline__ void xcd_barrier(const XcdBarrier& b) {
    asm volatile("s_waitcnt vmcnt(0)" ::: "memory");
    __syncthreads();
    if (threadIdx.x == 0) {
        unsigned* bar = b.bar;
        __builtin_amdgcn_s_waitcnt(0);
        unsigned nloc = b.st[0], nx = b.st[1];
        if (nloc == 0u) { xcd_barrier_complete(bar, b.x, nloc, nx); b.st[0] = nloc; b.st[1] = nx; }
        const unsigned old = xb_add(&bar[XB_XSUB(b.x)], 1u);
        const unsigned gen = old / nloc;
        if (old + 1u == (gen + 1u) * nloc) {
            __builtin_amdgcn_fence(__ATOMIC_RELEASE, "agent");
            asm volatile("s_waitcnt vmcnt(0)" ::: "memory");
            const unsigned og = xb_add(&bar[XB_TOP], 1u);
            const unsigned tg = og / nx;
            if (og + 1u == (tg + 1u) * nx) xb_add(&bar[XB_TOPGEN], 1u);
            else XB_SPIN(xb_ld(&bar[XB_TOPGEN]) == tg, bar);
            __builtin_amdgcn_fence(__ATOMIC_ACQUIRE, "agent");
            xb_add(&bar[XB_XGEN(b.x)], 1u);
            asm volatile("s_waitcnt vmcnt(0)" ::: "memory");
        } else {
            XB_SPIN(xb_ld(&bar[XB_XGEN(b.x)]) == gen, bar);
            __builtin_amdgcn_fence(__ATOMIC_ACQUIRE, "agent");
            asm volatile("s_waitcnt vmcnt(0)" ::: "memory");
        }
    }
    __syncthreads();
}

constexpr size_t al256(size_t x) { return (x + 255) & ~(size_t)255; }
constexpr size_t WS_CTL = 0;
constexpr size_t CTL_ZERO_BYTES = 65536;
constexpr size_t WS_MODACC = 4u << 20;
constexpr size_t WS_ROPE = 1u << 20;
constexpr size_t WS_WABIN = 8u << 20;
constexpr size_t SZ_WABIN = (size_t)ABIN * D * 2;
constexpr size_t WS_WABOUT = WS_WABIN + 2 * SZ_WABIN;
constexpr size_t SZ_WSQ = (size_t)D * D * 2;
constexpr size_t WS_WQKV = WS_WABOUT + 2 * SZ_WSQ;
constexpr size_t SZ_WQKV = (size_t)QKV * D * 2;
constexpr size_t WS_WNAOUT = WS_WQKV + 2 * SZ_WQKV;
constexpr size_t WS_WFFIN = WS_WNAOUT + 2 * SZ_WSQ;
constexpr size_t SZ_WFFIN = (size_t)FF2 * D * 2;
constexpr size_t WS_WFFOUT = WS_WFFIN + 4 * SZ_WFFIN;
constexpr size_t SZ_WFFOUT = (size_t)D * FFH * 2;
constexpr size_t WS_X = WS_WFFOUT + 4 * SZ_WFFOUT;
constexpr size_t WS_H = WS_X + (size_t)MTOK * D * 4;
constexpr size_t WS_P = WS_H + (size_t)MTOK * D * 2;
constexpr size_t WS_YAB = WS_P + (size_t)MTOK * ABIN * 2;
constexpr size_t WS_Y = WS_YAB + (size_t)MTOK * D * 2;
constexpr size_t WS_HID = WS_Y + (size_t)MTOK * D * 4;
constexpr size_t WS_KVT = WS_HID + (size_t)MTOK * FFH * 2;
constexpr size_t WS_ST = WS_KVT + (size_t)NCHUNK * 16 * 16384 * 4;
constexpr size_t WS_END = WS_ST + (size_t)NCHUNK * 16 * 16384 * 2;
static_assert(WS_WABIN % 256 == 0 && WS_X % 256 == 0 && WS_P % 256 == 0 && WS_KVT % 256 == 0 && WS_ST % 256 == 0, "ws alignment");

constexpr int RING_BYTES = 131072, LDSCTL_OFF = RING_BYTES, MISC_OFF = LDSCTL_OFF + 320, LDS_BYTES = 147456;
constexpr int NPHASE = 2 + 9 * DEPTH;

struct Params { const float* in[16]; float* out; unsigned char* ws; int ph_lo, ph_hi, li, pad; };

__device__ __forceinline__ void transpose_item(const float* W, int ldw, int K, bf16_t* Wt, int k0, int n0s, int n0d, LAS float* scr, int lane) {
#pragma unroll 8
    for (int i = 0; i < 32; ++i) { const int kk = 2 * i + (lane >> 5); scr[kk * 33 + (lane & 31)] = W[(size_t)(k0 + kk) * ldw + n0s + (lane & 31)]; }
    asm volatile("s_waitcnt lgkmcnt(0)" ::: "memory");
    const int c = lane & 7;
#pragma unroll
    for (int j = 0; j < 4; ++j) { const int n = (lane >> 3) + 8 * j; const LAS float* s = scr + (8 * c) * 33 + n;
        u32x4 o; o[0] = cvt_pk_bf16(s[0 * 33], s[1 * 33]); o[1] = cvt_pk_bf16(s[2 * 33], s[3 * 33]); o[2] = cvt_pk_bf16(s[4 * 33], s[5 * 33]); o[3] = cvt_pk_bf16(s[6 * 33], s[7 * 33]);
        *(u32x4*)(Wt + (size_t)(n0d + n) * K + k0 + 8 * c) = o; }
    asm volatile("s_waitcnt lgkmcnt(0)" ::: "memory");
}
__device__ __forceinline__ void transpose_matrix_item(const float* W, int K, int N, bf16_t* Wt, bool ffperm, int item, LAS float* scr, int lane) {
    const int nblk = N / 32, kb = item / nblk, nb = item % nblk, n0d = 32 * nb;
    int n0s = n0d;
    if (ffperm) { const int t = n0d >> 8, j = n0d & 255; n0s = j < 128 ? 128 * t + j : FFH + 128 * t + (j - 128); }
    transpose_item(W, N, K, Wt, 64 * kb, n0s, n0d, scr, lane);
}

__global__ void __launch_bounds__(512, 2) mega_fwd(Params p) {
    extern __shared__ __attribute__((aligned(16))) unsigned char lds_raw[];
    LAS unsigned char* lds = (LAS unsigned char*)lds_raw;
    const int G = gridDim.x, bx = blockIdx.x, NGW = G * 8;
#define SITE_COORDS int tid = threadIdx.x; asm volatile("" : "+v"(tid)); const int lane = tid & 63, wave = __builtin_amdgcn_readfirstlane(tid >> 6); \
    const int vcu = (G % 8 == 0) ? (bx % 8) * (G / 8) + bx / 8 : bx; const int gw = vcu * 8 + wave; (void)lane; (void)gw; (void)vcu
    unsigned char* ws = p.ws;
    volatile LAS unsigned* MISC = (volatile LAS unsigned*)(lds + MISC_OFF);
    { const int tid = threadIdx.x; for (int u = tid; u < (LDS_BYTES - LDSCTL_OFF) / 4; u += 512) ((LAS unsigned*)(lds + LDSCTL_OFF))[u] = 0u; }
    __syncthreads();
    const int lo = p.ph_lo, hi = p.ph_hi;
    const bool multi = (hi - lo) > 1;
    XcdBarrier bar; bar.bar = (unsigned*)(ws + WS_CTL) + p.li * 4096; bar.x = 0; bar.st = nullptr;
    if (multi) bar = xcd_barrier_post((unsigned*)(ws + WS_CTL) + p.li * 4096, MISC + 8);
#ifndef SITE_MASK
#define SITE_MASK 0xffff
#endif
#define EN(i) (((SITE_MASK) >> (i)) & 1)
#define IN(k) (lo <= (k) && (k) < hi)
#define ROWOP_RUN(a) do { LAS float* cf0 = (LAS float*)lds; LAS float* cf1 = (LAS float*)(lds + 24576); \
        rowop_coefs(a, 0, cf0, tid); if ((a).nctx) rowop_coefs(a, 1, cf1, tid); __syncthreads(); \
        rowop_stream(a, 0, cf0, 0, S, gw, NGW, lane); if ((a).nctx) rowop_stream(a, 1, cf1, S, S + (a).nctx, gw, NGW, lane); __syncthreads(); } while (0)
#define SEAM(k, knext) do { if (IN(k) && IN(knext)) xcd_barrier(bar); } while (0)

    const float* x_in = p.in[0]; const float* c_in = p.in[1]; const float* ctx_in = p.in[2]; const float* cctx_in = p.in[3];
    const float* ada_w = p.in[4]; const float* ada_b = p.in[5]; const float* norm_g = p.in[6];
    const float* ab_w_in = p.in[7]; const float* ab_conv_w = p.in[8]; const float* ab_decay = p.in[9]; const float* ab_w_out = p.in[10];
    const float* na_w_qkv = p.in[11]; const float* na_rpb = p.in[12]; const float* na_w_out = p.in[13];
    const float* ffn_w_in = p.in[14]; const float* ffn_w_out = p.in[15];
    float* modacc = (float*)(ws + WS_MODACC);
    f32x2* rope = (f32x2*)(ws + WS_ROPE);
    float* X = (float*)(ws + WS_X); bf16_t* H = (bf16_t*)(ws + WS_H); bf16_t* P = (bf16_t*)(ws + WS_P); bf16_t* YAB = (bf16_t*)(ws + WS_YAB);
    float* Y = (float*)(ws + WS_Y); bf16_t* HID = (bf16_t*)(ws + WS_HID); float* KVT = (float*)(ws + WS_KVT); bf16_t* ST = (bf16_t*)(ws + WS_ST);

    if (EN(0) && IN(0)) {
        SITE_COORDS;
        LAS float* scr = (LAS float*)(lds + wave * 16384);
        constexpr int I_ABIN = (D / 64) * (ABIN / 32), I_SQ = (D / 64) * (D / 32), I_QKV = (D / 64) * (QKV / 32), I_FFIN = (D / 64) * (FF2 / 32), I_FFOUT = (FFH / 64) * (D / 32);
        constexpr int NITEMS = 2 * (I_ABIN + I_SQ + I_QKV + I_SQ) + 4 * (I_FFIN + I_FFOUT);
        for (int it = gw; it < NITEMS; it += NGW) {
            int r = it;
            if (r < 2 * I_ABIN) { const int i = r / I_ABIN; transpose_matrix_item(ab_w_in + (size_t)i * D * ABIN, D, ABIN, (bf16_t*)(ws + WS_WABIN + i * SZ_WABIN), false, r % I_ABIN, scr, lane); continue; } r -= 2 * I_ABIN;
            if (r < 2 * I_SQ) { const int i = r / I_SQ; transpose_matrix_item(ab_w_out + (size_t)i * D * D, D, D, (bf16_t*)(ws + WS_WABOUT + i * SZ_WSQ), false, r % I_SQ, scr, lane); continue; } r -= 2 * I_SQ;
            if (r < 2 * I_QKV) { const int i = r / I_QKV; transpose_matrix_item(na_w_qkv + (size_t)i * D * QKV, D, QKV, (bf16_t*)(ws + WS_WQKV + i * SZ_WQKV), false, r % I_QKV, scr, lane); continue; } r -= 2 * I_QKV;
            if (r < 2 * I_SQ) { const int i = r / I_SQ; transpose_matrix_item(na_w_out + (size_t)i * D * D, D, D, (bf16_t*)(ws + WS_WNAOUT + i * SZ_WSQ), false, r % I_SQ, scr, lane); continue; } r -= 2 * I_SQ;
            if (r < 4 * I_FFIN) { const int i = r / I_FFIN; transpose_matrix_item(ffn_w_in + (size_t)i * D * FF2, D, FF2, (bf16_t*)(ws + WS_WFFIN + i * SZ_WFFIN), true, r % I_FFIN, scr, lane); continue; } r -= 4 * I_FFIN;
            { const int i = r / I_FFOUT; transpose_matrix_item(ffn_w_out + (size_t)i * FFH * D, FFH, D, (bf16_t*)(ws + WS_WFFOUT + i * SZ_WFFOUT), false, r % I_FFOUT, scr, lane); }
        }
        for (int it = vcu; it < 4 * 4 * 6; it += G) {
            const int l = it / 24, kp = (it % 24) / 6, nc = it % 6, n = nc * 2048 + 4 * tid;
            f32x4 aL = (f32x4){0.f, 0.f, 0.f, 0.f}, aC = aL;
            const float* wp = ada_w + ((size_t)l * D + kp * 512) * (6 * D) + n;
#pragma unroll 8
            for (int k = 0; k < 512; ++k) { const f32x4 w = *(const f32x4*)(wp + (size_t)k * (6 * D)); const float cl = c_in[kp * 512 + k], cc = cctx_in[kp * 512 + k];
                const float sl = cl / (1.0f + __expf(-cl)), sc = cc / (1.0f + __expf(-cc)); aL = aL + w * sl; aC = aC + w * sc; }
            *(f32x4*)(modacc + (size_t)kp * MODPART + (size_t)(l * 2 + 0) * 6 * D + n) = aL;
            *(f32x4*)(modacc + (size_t)kp * MODPART + (size_t)(l * 2 + 1) * 6 * D + n) = aC;
        }
        for (int idx = bx * 512 + tid; idx < 192 * 32; idx += G * 512) {
            const int pi = idx >> 5, f = idx & 31; const float pos = (float)(pi < 128 ? pi : pi - 128);
            const float ang = pos * powf(10000.0f, -(float)f / 32.0f);
            rope[idx] = (f32x2){cosf(ang), sinf(ang)};
        }
    }
    SEAM(0, 1);
    if (EN(1) && IN(1)) {
        SITE_COORDS;
        RowopArgs a; a.y = nullptr; a.xin_lat = x_in; a.xin_ctx = ctx_in; a.xout_lat = X; a.xout_ctx = X + (size_t)S * D; a.h = H; a.modacc = modacc; a.ada_b = ada_b; a.norm_g = norm_g;
        a.ly = -1; a.jg_y = 0; a.jgate = 0; a.lh = 0; a.jg_h = 0; a.jshift = 0; a.jscale = 1; a.nctx = NCTX;
        ROWOP_RUN(a);
    }
    SEAM(1, 2);
    for (int layer = 0; layer < DEPTH; ++layer) {
        const int pb = 2 + 9 * layer, iab = layer >> 1;
        const bool even = (layer & 1) == 0, last = layer == DEPTH - 1;
        const int Mrows = last ? S : MTOK;
        if (even) {
            if (EN(2) && IN(pb + 0)) {
                SITE_COORDS;
                pg8::Gemm g{H, (const bf16_t*)(ws + WS_WABIN + iab * SZ_WABIN), MTOK, ABIN, D}; pg8::StaticOrder So; So.init(MTOK, ABIN, G, bx);
                EpiInProj E{P, rope};
                pg8::gemm_phase<EpiInProj, pg8::StaticOrder, PG8_ALIGN, PG8_SP2>(lds, g, So, E, tid);
            }
            SEAM(pb + 0, pb + 1);
            if (EN(3) && IN(pb + 1)) {
                SITE_COORDS;
                for (int bt = vcu; bt < NCHUNK * 8; bt += G) {
                    const int cidx = bt >> 3, head = bt & 7, dir = wave >> 2, quad = wave & 3;
                    r1_task(P, KVT, lg2gamma(ab_decay, iab, dir, head), cidx, head, dir, quad, lane);
                }
                for (int t = gw; t < (MTOK / 8) * 2; t += NGW) conv_task(P, YAB, ab_conv_w + (size_t)iab * 3 * 1024, t, lane);
            }
            SEAM(pb + 1, pb + 2);
            if (EN(4) && IN(pb + 2)) {
                SITE_COORDS;
                for (int it = vcu * 512 + tid; it < 131072; it += G * 512) r2_item(KVT, ST, ab_decay, iab, it);
            }
            SEAM(pb + 2, pb + 3);
            if (EN(5) && IN(pb + 3)) {
                SITE_COORDS;
                for (int bt = vcu; bt < NCHUNK * 8; bt += G) {
                    const int cidx = bt >> 3, head = bt & 7;
                    r3_task(P, ST, YAB, lg2gamma(ab_decay, iab, 0, head), lg2gamma(ab_decay, iab, 1, head), cidx, head, wave, lane);
                }
            }
            SEAM(pb + 3, pb + 4);
        } else {
            if (EN(6) && IN(pb + 0)) {
                SITE_COORDS;
                pg8::Gemm g{H, (const bf16_t*)(ws + WS_WQKV + iab * SZ_WQKV), MTOK, QKV, D}; pg8::StaticOrder So; So.init(MTOK, QKV, G, bx);
                EpiBf16 E{P, QKV};
                pg8::gemm_phase<EpiBf16, pg8::StaticOrder, PG8_ALIGN, PG8_SP2>(lds, g, So, E, tid);
            }
            SEAM(pb + 0, pb + 1);
            if (EN(7) && IN(pb + 1)) {
                SITE_COORDS;
                const float* rpb = na_rpb + (size_t)iab * 16 * 15 * 31;
                const int per = (1024 + G - 1) / G;
                for (int bt = vcu * per; bt < (vcu + 1) * per && bt < 1024; ++bt) {
                    const int h = bt >> 6, rp = bt & 63, r = 2 * rp + (wave >> 2), cgp = wave & 3;
                    const int kc0 = cgp == 0 ? 0 : (cgp == 1 ? 8 : (cgp == 2 ? 24 : 32));
                    attn_task<true>(P, YAB, rpb, h, r * 64 + 16 * cgp, r, 16 * cgp, kc0, lane);
                }
                if (!last) for (int t = gw; t < 256; t += NGW) attn_task<false>(P, YAB, rpb, t >> 4, S + 16 * (t & 15), 0, 0, 0, lane);
            }
            SEAM(pb + 1, pb + 4);
        }
        if (EN(8) && IN(pb + 4)) {
            SITE_COORDS;
            const bf16_t* wt = even ? (const bf16_t*)(ws + WS_WABOUT + iab * SZ_WSQ) : (const bf16_t*)(ws + WS_WNAOUT + iab * SZ_WSQ);
            pg8::Gemm g{YAB, wt, Mrows, D, D}; pg8::StaticOrder So; So.init(Mrows, D, G, bx);
            EpiF32 E{Y, D};
            pg8::gemm_phase<EpiF32, pg8::StaticOrder, PG8_ALIGN, PG8_SP2>(lds, g, So, E, tid);
        }
        SEAM(pb + 4, pb + 5);
        if (EN(9) && IN(pb + 5)) {
            SITE_COORDS;
            RowopArgs a; a.y = Y; a.xin_lat = X; a.xin_ctx = X + (size_t)S * D; a.xout_lat = X; a.xout_ctx = X + (size_t)S * D; a.h = H; a.modacc = modacc; a.ada_b = ada_b; a.norm_g = norm_g;
            a.ly = layer; a.jg_y = 1; a.jgate = 2; a.lh = layer; a.jg_h = 2; a.jshift = 3; a.jscale = 4; a.nctx = last ? 0 : NCTX;
            ROWOP_RUN(a);
        }
        SEAM(pb + 5, pb + 6);
        if (EN(10) && IN(pb + 6)) {
            SITE_COORDS;
            pg8::Gemm g{H, (const bf16_t*)(ws + WS_WFFIN + layer * SZ_WFFIN), Mrows, FF2, D}; pg8::StaticOrder So; So.init(Mrows, FF2, G, bx);
            EpiSwiglu E{HID};
            pg8::gemm_phase<EpiSwiglu, pg8::StaticOrder, PG8_ALIGN, PG8_SP2>(lds, g, So, E, tid);
        }
        SEAM(pb + 6, pb + 7);
        if (EN(11) && IN(pb + 7)) {
            SITE_COORDS;
            pg8::Gemm g{HID, (const bf16_t*)(ws + WS_WFFOUT + layer * SZ_WFFOUT), Mrows, D, FFH}; pg8::StaticOrder So; So.init(Mrows, D, G, bx);
            EpiF32 E{Y, D};
            pg8::gemm_phase<EpiF32, pg8::StaticOrder, PG8_ALIGN, PG8_SP2>(lds, g, So, E, tid);
        }
        SEAM(pb + 7, pb + 8);
        if (EN(12) && IN(pb + 8)) {
            SITE_COORDS;
            RowopArgs a; a.y = Y; a.xin_lat = X; a.xin_ctx = X + (size_t)S * D; a.xout_lat = last ? p.out : X; a.xout_ctx = last ? nullptr : X + (size_t)S * D; a.h = H; a.modacc = modacc; a.ada_b = ada_b; a.norm_g = norm_g;
            a.ly = layer; a.jg_y = 3; a.jgate = 5; a.lh = last ? -1 : layer + 1; a.jg_h = 0; a.jshift = 0; a.jscale = 1; a.nctx = last ? 0 : NCTX;
            ROWOP_RUN(a);
        }
        if (!last) SEAM(pb + 8, pb + 9);
    }
#undef IN
#undef SEAM
}

#ifndef MK_MODE
#define MK_MODE 0
#endif
extern "C" void kernel_launch(void* const* d_in, const int* in_sizes, int n_in, void* d_out, int out_size, void* d_ws, size_t ws_size, hipStream_t stream) {
    static int grid = 0;
    if (grid == 0) {
        if (n_in != 16 || out_size != S * D || ws_size < WS_END) { fprintf(stderr, "kernel_launch: unexpected shapes (n_in %d out %d ws %zu need %zu)\n", n_in, out_size, ws_size, (size_t)WS_END); grid = -1; return; }
        int dev = 0, cus = 0, per_cu = 0;
        if (hipGetDevice(&dev) != hipSuccess || hipDeviceGetAttribute(&cus, hipDeviceAttributeMultiprocessorCount, dev) != hipSuccess) { grid = -1; return; }
        if (hipFuncSetAttribute((const void*)mega_fwd, hipFuncAttributeMaxDynamicSharedMemorySize, LDS_BYTES) != hipSuccess) { fprintf(stderr, "kernel_launch: hipFuncSetAttribute failed\n"); grid = -1; return; }
        if (hipOccupancyMaxActiveBlocksPerMultiprocessor(&per_cu, (const void*)mega_fwd, 512, LDS_BYTES) != hipSuccess || per_cu < 1) fprintf(stderr, "kernel_launch: occupancy query says %d\n", per_cu);
        (void)hipGetLastError();
        grid = cus;
    }
    if (grid < 0) return;
    if (hipMemsetAsync((char*)d_ws + WS_CTL, 0, CTL_ZERO_BYTES, stream) != hipSuccess) { fprintf(stderr, "kernel_launch: memset failed\n"); return; }
    Params a{};
    for (int i = 0; i < 16; ++i) a.in[i] = (const float*)d_in[i];
    a.out = (float*)d_out; a.ws = (unsigned char*)d_ws; a.pad = 0;
#if MK_MODE == 1
    a.ph_lo = 0; a.ph_hi = NPHASE; a.li = 0;
    hipLaunchKernelGGL(mega_fwd, dim3(grid), dim3(512), LDS_BYTES, stream, a);
#else
    for (int ph = 0; ph < NPHASE; ++ph) {
        if (ph >= 2) { const int layer = (ph - 2) / 9, slot = (ph - 2) % 9; if ((layer & 1) && (slot == 2 || slot == 3)) continue; }
        a.ph_lo = ph; a.ph_hi = ph + 1; a.li = 0;
        hipLaunchKernelGGL(mega_fwd, dim3(grid), dim3(512), LDS_BYTES, stream, a);
    }
#endif
    const hipError_t le = hipPeekAtLastError();
    if (le != hipSuccess) fprintf(stderr, "kernel_launch: launch failed: %s\n", hipGetErrorName(le));
}
#endif
```

```cpp
#ifndef HOST_EMU
#include <hip/hip_runtime.h>
#include <cstdio>
#include <cstdint>
#define DEV __device__ __forceinline__
#define HDEV __host__ __device__ __forceinline__
#define LAS __attribute__((address_space(3)))
#endif

typedef unsigned short bf16_t;
typedef short bf16x8 __attribute__((ext_vector_type(8)));
typedef float f32x4 __attribute__((ext_vector_type(4)));
typedef float f32x2 __attribute__((ext_vector_type(2)));
typedef unsigned u32x4 __attribute__((ext_vector_type(4)));
typedef unsigned u32x2 __attribute__((ext_vector_type(2)));

#ifndef HOST_EMU
DEV f32x4 mfma16(bf16x8 a, bf16x8 b, f32x4 c) { return __builtin_amdgcn_mfma_f32_16x16x32_bf16(a, b, c, 0, 0, 0); }
DEV float shfl_xor_f(float v, int m) { return __shfl_xor(v, m); }
DEV unsigned cvt_pk_bf16(float lo, float hi) { unsigned r; asm("v_cvt_pk_bf16_f32 %0, %1, %2" : "=v"(r) : "v"(lo), "v"(hi)); return r; }
DEV float ex2(float x) { return __builtin_amdgcn_exp2f(x); }
DEV float rcp_f(float x) { return __builtin_amdgcn_rcpf(x); }
DEV float rsq_f(float x) { return 1.0f / sqrtf(x); }
DEV void atomic_add_f(float* p, float v) { (void)__hip_atomic_fetch_add(p, v, __ATOMIC_RELAXED, __HIP_MEMORY_SCOPE_AGENT); }
#endif

namespace cfg {
constexpr int D = 2048, S = 8192, NCTX = 256, MTOK = 8448, DEPTH = 4;
constexpr int ABIN = 7168, FFH = 5632, FF2 = 11264, QKV = 6144;
constexpr int NCHUNK = 66;
constexpr float EPS = 1e-6f;
constexpr float HSCALE = 0.08838834764831845f;
constexpr float LOG2E = 1.4426950408889634f;
}
using namespace cfg;

DEV float bf_lo(unsigned w) { return __builtin_bit_cast(float, w << 16); }
DEV float bf_hi(unsigned w) { return __builtin_bit_cast(float, w & 0xffff0000u); }
DEV float wave_sum(float v) {
#pragma unroll
    for (int o = 1; o < 64; o <<= 1) v += shfl_xor_f(v, o);
    return v;
}
DEV float silu_f(float x) { return x * rcp_f(1.0f + ex2(-x * LOG2E)); }
DEV float lg2gamma(const float* decay_exp, int iab, int dir, int head) {
    const float e = decay_exp[(iab * 2 + dir) * 8 + head];
    return log1pf(-exp2f(-e)) * LOG2E;
}
DEV bf16x8 extract8(const u32x4 (&vd)[8], int mt) {
    u32x4 w;
#pragma unroll
    for (int q = 0; q < 4; ++q) {
        const unsigned X = vd[2 * q][mt >> 1], Y = vd[2 * q + 1][mt >> 1];
        w[q] = (mt & 1) ? ((X >> 16) | (Y & 0xffff0000u)) : ((X & 0xffffu) | (Y << 16));
    }
    return __builtin_bit_cast(bf16x8, w);
}

struct RowopArgs {
    const float* y;
    const float* xin_lat; const float* xin_ctx;
    float* xout_lat; float* xout_ctx;
    bf16_t* h;
    const float* modacc; const float* ada_b; const float* norm_g;
    int ly, jg_y, jgate, lh, jg_h, jshift, jscale, nctx;
};
DEV f32x4 ld4(const float* p) { return *(const f32x4*)p; }
constexpr int MODPART = 4 * 2 * 6 * 2048;
DEV f32x4 modvec(const RowopArgs& a, int l, int s, int j, int col) {
    const float* q = a.modacc + (size_t)((l * 2 + s) * 6 + j) * D + col;
    return ((ld4(q) + ld4(q + MODPART)) + (ld4(q + 2 * MODPART) + ld4(q + 3 * MODPART))) + ld4(a.ada_b + (size_t)l * 6 * D + j * D + col);
}
template <class CP>
DEV void rowop_coefs(const RowopArgs& a, const int s, CP coef, const int tid) {
    const int col = 4 * tid;
    f32x4 A = (f32x4){0.f, 0.f, 0.f, 0.f}, B = A, SH = A;
    if (a.ly >= 0) A = modvec(a, a.ly, s, a.jgate, col) * ld4(a.norm_g + (size_t)(a.ly * 4 + a.jg_y) * D + col);
    if (a.lh >= 0) { B = ld4(a.norm_g + (size_t)(a.lh * 4 + a.jg_h) * D + col) * (modvec(a, a.lh, s, a.jscale, col) + 1.0f); SH = modvec(a, a.lh, s, a.jshift, col); }
    *(f32x4*)(coef + col) = A; *(f32x4*)(coef + D + col) = B; *(f32x4*)(coef + 2 * D + col) = SH;
}
template <class CP>
DEV void rowop_stream(const RowopArgs& a, const int s, CP coef, const int row_begin, const int row_end, const int gw, const int NGW, const int lane) {
    const bool hasy = a.ly >= 0, hash = a.lh >= 0;
    for (int m = row_begin + gw; m < row_end; m += NGW) {
        const float* xr = (s == 0) ? a.xin_lat + (size_t)m * D : a.xin_ctx + (size_t)(m - S) * D;
        f32x4 x[8];
#pragma unroll
        for (int j = 0; j < 8; ++j) x[j] = ld4(xr + 4 * lane + 256 * j);
        if (hasy) {
            const float* yr = a.y + (size_t)m * D;
            f32x4 y[8]; float ss = 0.f;
#pragma unroll
            for (int j = 0; j < 8; ++j) { y[j] = ld4(yr + 4 * lane + 256 * j); ss += (y[j][0] * y[j][0] + y[j][1] * y[j][1]) + (y[j][2] * y[j][2] + y[j][3] * y[j][3]); }
            const float r1 = rsq_f(wave_sum(ss) * (1.0f / D) + EPS);
#pragma unroll
            for (int j = 0; j < 8; ++j) x[j] = x[j] + *(const f32x4*)(coef + 4 * lane + 256 * j) * (y[j] * r1);
        }
        float* xo = (s == 0) ? (a.xout_lat ? a.xout_lat + (size_t)m * D : nullptr) : (a.xout_ctx ? a.xout_ctx + (size_t)(m - S) * D : nullptr);
        if (xo) {
#pragma unroll
            for (int j = 0; j < 8; ++j) *(f32x4*)(xo + 4 * lane + 256 * j) = x[j];
        }
        if (hash) {
            float ss = 0.f;
#pragma unroll
            for (int j = 0; j < 8; ++j) ss += (x[j][0] * x[j][0] + x[j][1] * x[j][1]) + (x[j][2] * x[j][2] + x[j][3] * x[j][3]);
            const float r2 = rsq_f(wave_sum(ss) * (1.0f / D) + EPS);
            bf16_t* hr = a.h + (size_t)m * D;
#pragma unroll
            for (int j = 0; j < 8; ++j) { const f32x4 v = (x[j] * r2) * *(const f32x4*)(coef + D + 4 * lane + 256 * j) + *(const f32x4*)(coef + 2 * D + 4 * lane + 256 * j);
                u32x2 w; w[0] = cvt_pk_bf16(v[0], v[1]); w[1] = cvt_pk_bf16(v[2], v[3]); *(u32x2*)(hr + 4 * lane + 256 * j) = w; }
        }
    }
}

DEV void conv_loadz(const bf16_t* P, int t, int c, float (&z)[8]) {
    const u32x4 cg = *(const u32x4*)(P + (size_t)t * ABIN + 1024 + c), u = *(const u32x4*)(P + (size_t)t * ABIN + 2048 + c);
#pragma unroll
    for (int e = 0; e < 4; ++e) { z[2 * e] = bf_lo(cg[e]) * bf_lo(u[e]); z[2 * e + 1] = bf_hi(cg[e]) * bf_hi(u[e]); }
}
DEV void conv_task(const bf16_t* P, bf16_t* YAB, const float* convw, int task, int lane) {
    const int half = task & 1, t0 = (task >> 1) * 8, c = half * 512 + lane * 8;
    float w0[8], w1[8], w2[8], zp[8], zc[8], zn[8];
#pragma unroll
    for (int e = 0; e < 8; ++e) { w0[e] = convw[c + e]; w1[e] = convw[1024 + c + e]; w2[e] = convw[2048 + c + e]; zp[e] = 0.f; zn[e] = 0.f; }
    if (t0 != 0 && t0 != S) conv_loadz(P, t0 - 1, c, zp);
    conv_loadz(P, t0, c, zc);
    for (int i = 0; i < 8; ++i) {
        const int t = t0 + i;
        if (t != S - 1 && t != MTOK - 1) conv_loadz(P, t + 1, c, zn);
        else {
#pragma unroll
            for (int e = 0; e < 8; ++e) zn[e] = 0.f;
        }
        const u32x4 bg = *(const u32x4*)(P + (size_t)t * ABIN + c);
        float o[8];
#pragma unroll
        for (int e = 0; e < 8; ++e) { const float b = (e & 1) ? bf_hi(bg[e >> 1]) : bf_lo(bg[e >> 1]); o[e] = b * (w0[e] * zp[e] + w1[e] * zc[e] + w2[e] * zn[e]); }
        u32x4 w; w[0] = cvt_pk_bf16(o[0], o[1]); w[1] = cvt_pk_bf16(o[2], o[3]); w[2] = cvt_pk_bf16(o[4], o[5]); w[3] = cvt_pk_bf16(o[6], o[7]);
        *(u32x4*)(YAB + (size_t)t * D + c) = w;
#pragma unroll
        for (int e = 0; e < 8; ++e) { zp[e] = zc[e]; zc[e] = zn[e]; }
    }
}

DEV int chunk_row(int cidx) { return cidx < 2 ? S + 128 * cidx : 128 * (cidx - 2); }
DEV void r1_task(const bf16_t* P, float* KVt, float lg2, int cidx, int head, int dir, int quad, int lane) {
    const int i = lane & 15, g = lane >> 4;
    const int dk0 = 64 * (quad >> 1), dv0 = 64 * (quad & 1);
    const bf16_t* Kp = P + (size_t)chunk_row(cidx) * ABIN + 4096 + head * 128 + dk0 + 4 * i;
    const bf16_t* Vp = P + (size_t)chunk_row(cidx) * ABIN + 5120 + head * 128 + dv0 + 4 * i;
    f32x4 acc[4][4];
#pragma unroll
    for (int a = 0; a < 4; ++a)
#pragma unroll
        for (int b = 0; b < 4; ++b) acc[a][b] = (f32x4){0.f, 0.f, 0.f, 0.f};
    for (int s = 0; s < 4; ++s) {
        u32x2 kd[8], vd[8]; float w[8];
#pragma unroll
        for (int jj = 0; jj < 8; ++jj) {
            const int tj = 32 * s + 8 * g + jj;
            kd[jj] = *(const u32x2*)(Kp + (size_t)tj * ABIN); vd[jj] = *(const u32x2*)(Vp + (size_t)tj * ABIN);
            w[jj] = ex2(lg2 * (float)(dir == 0 ? 127 - tj : tj));
        }
        bf16x8 af[4], bfr[4];
#pragma unroll
        for (int mt = 0; mt < 4; ++mt) {
            u32x4 wd;
#pragma unroll
            for (int q = 0; q < 4; ++q) {
                const unsigned X = kd[2 * q][mt >> 1], Y = kd[2 * q + 1][mt >> 1];
                const float lo = ((mt & 1) ? bf_hi(X) : bf_lo(X)) * w[2 * q], hi = ((mt & 1) ? bf_hi(Y) : bf_lo(Y)) * w[2 * q + 1];
                wd[q] = cvt_pk_bf16(lo, hi);
            }
            af[mt] = __builtin_bit_cast(bf16x8, wd);
        }
#pragma unroll
        for (int nt = 0; nt < 4; ++nt) {
            u32x4 wd;
#pragma unroll
            for (int q = 0; q < 4; ++q) {
                const unsigned X = vd[2 * q][nt >> 1], Y = vd[2 * q + 1][nt >> 1];
                wd[q] = (nt & 1) ? ((X >> 16) | (Y & 0xffff0000u)) : ((X & 0xffffu) | (Y << 16));
            }
            bfr[nt] = __builtin_bit_cast(bf16x8, wd);
        }
#pragma unroll
        for (int mt = 0; mt < 4; ++mt)
#pragma unroll
            for (int nt = 0; nt < 4; ++nt) acc[mt][nt] = mfma16(af[mt], bfr[nt], acc[mt][nt]);
    }
    float* out = KVt + ((((size_t)cidx * 8 + head) * 2 + dir) * 128) * 128;
#pragma unroll
    for (int nt = 0; nt < 4; ++nt)
#pragma unroll
        for (int reg = 0; reg < 4; ++reg) {
            const int dv = dv0 + 4 * i + nt, dk = dk0 + 16 * g + 4 * reg;
            *(f32x4*)(out + (size_t)dv * 128 + dk) = (f32x4){acc[0][nt][reg], acc[1][nt][reg], acc[2][nt][reg], acc[3][nt][reg]};
        }
}
DEV void r2_item(const float* KVt, bf16_t* St, const float* decay_exp, int iab, int item) {
    const int hd = item >> 13, e = (item & 8191) * 2, head = hd >> 1, dir = hd & 1;
    const float cd = exp2f(128.0f * lg2gamma(decay_exp, iab, dir, head));
    float s0 = 0.f, s1 = 0.f;
#pragma unroll 6
    for (int step = 0; step < NCHUNK; ++step) {
        const int c = dir == 0 ? step : (step < 2 ? 1 - step : 67 - step);
        const size_t off = (((size_t)c * 8 + head) * 2 + dir) * 16384 + e;
        *(unsigned*)(St + off) = cvt_pk_bf16(s0, s1);
        const f32x2 kv = *(const f32x2*)(KVt + off);
        s0 = s0 * cd + kv[0]; s1 = s1 * cd + kv[1];
    }
}
DEV void r3_task(const bf16_t* P, const bf16_t* St, bf16_t* YAB, float lg2f, float lg2b, int cidx, int head, int qb, int lane) {
    const int i = lane & 15, g = lane >> 4, qi = 16 * qb + i, rowbase = chunk_row(cidx);
    const bf16_t* Prow = P + (size_t)rowbase * ABIN;
    bf16x8 qf[4];
#pragma unroll
    for (int s = 0; s < 4; ++s) qf[s] = *(const bf16x8*)(Prow + (size_t)qi * ABIN + 3072 + head * 128 + 32 * s + 8 * g);
    f32x4 sacc[8];
#pragma unroll
    for (int mt = 0; mt < 8; ++mt) {
        f32x4 a = (f32x4){0.f, 0.f, 0.f, 0.f};
#pragma unroll
        for (int s = 0; s < 4; ++s) { const bf16x8 kf = *(const bf16x8*)(Prow + (size_t)(16 * mt + i) * ABIN + 4096 + head * 128 + 32 * s + 8 * g); a = mfma16(kf, qf[s], a); }
        sacc[mt] = a;
    }
#pragma unroll
    for (int mt = 0; mt < 8; ++mt)
#pragma unroll
        for (int reg = 0; reg < 4; ++reg) {
            const int diff = qi - (16 * mt + 4 * g + reg);
            const float d = diff > 0 ? ex2((float)diff * lg2f) : (diff < 0 ? ex2((float)(-diff) * lg2b) : 2.0f);
            sacc[mt][reg] *= d;
        }
    bf16x8 pf[4];
#pragma unroll
    for (int s = 0; s < 4; ++s) {
        u32x4 w; w[0] = cvt_pk_bf16(sacc[2 * s][0], sacc[2 * s][1]); w[1] = cvt_pk_bf16(sacc[2 * s][2], sacc[2 * s][3]);
        w[2] = cvt_pk_bf16(sacc[2 * s + 1][0], sacc[2 * s + 1][1]); w[3] = cvt_pk_bf16(sacc[2 * s + 1][2], sacc[2 * s + 1][3]);
        pf[s] = __builtin_bit_cast(bf16x8, w);
    }
    f32x4 oacc[8];
#pragma unroll
    for (int mt = 0; mt < 8; ++mt) oacc[mt] = (f32x4){0.f, 0.f, 0.f, 0.f};
#pragma unroll
    for (int s = 0; s < 4; ++s) {
        u32x4 vd[8];
#pragma unroll
        for (int jj = 0; jj < 8; ++jj) { const int key = 32 * s + (jj < 4 ? 4 * g + jj : 16 + 4 * g + jj - 4); vd[jj] = *(const u32x4*)(Prow + (size_t)key * ABIN + 5120 + head * 128 + 8 * i); }
#pragma unroll
        for (int mt = 0; mt < 8; ++mt) oacc[mt] = mfma16(extract8(vd, mt), pf[s], oacc[mt]);
    }
#pragma unroll
    for (int dir = 0; dir < 2; ++dir) {
        f32x4 tacc[8];
#pragma unroll
        for (int mt = 0; mt < 8; ++mt) tacc[mt] = (f32x4){0.f, 0.f, 0.f, 0.f};
        const bf16_t* Sp = St + ((((size_t)cidx * 8 + head) * 2 + dir) * 128) * 128;
#pragma unroll
        for (int s = 0; s < 4; ++s)
#pragma unroll
            for (int mt = 0; mt < 8; ++mt) { const bf16x8 sf = *(const bf16x8*)(Sp + (size_t)(8 * i + mt) * 128 + 32 * s + 8 * g); tacc[mt] = mfma16(sf, qf[s], tacc[mt]); }
        const float qd = dir == 0 ? ex2((float)(qi + 1) * lg2f) : ex2((float)(128 - qi) * lg2b);
#pragma unroll
        for (int mt = 0; mt < 8; ++mt) oacc[mt] = oacc[mt] + tacc[mt] * qd;
    }
    float ss = 0.f;
#pragma unroll
    for (int mt = 0; mt < 8; ++mt) ss += (oacc[mt][0] * oacc[mt][0] + oacc[mt][1] * oacc[mt][1]) + (oacc[mt][2] * oacc[mt][2] + oacc[mt][3] * oacc[mt][3]);
    ss += shfl_xor_f(ss, 16); ss += shfl_xor_f(ss, 32);
    const float rinv = rsq_f(ss * (1.0f / 128.0f) + EPS);
#pragma unroll
    for (int reg = 0; reg < 4; ++reg) {
        const int dvb = 32 * g + 8 * reg;
        const u32x4 gt = *(const u32x4*)(Prow + (size_t)qi * ABIN + 6144 + head * 128 + dvb);
        float o[8];
#pragma unroll
        for (int mt = 0; mt < 8; ++mt) { const float gv = (mt & 1) ? bf_hi(gt[mt >> 1]) : bf_lo(gt[mt >> 1]); o[mt] = silu_f(gv) * (oacc[mt][reg] * rinv); }
        u32x4 w; w[0] = cvt_pk_bf16(o[0], o[1]); w[1] = cvt_pk_bf16(o[2], o[3]); w[2] = cvt_pk_bf16(o[4], o[5]); w[3] = cvt_pk_bf16(o[6], o[7]);
        *(u32x4*)(YAB + (size_t)(rowbase + qi) * D + 1024 + head * 128 + dvb) = w;
    }
}

template <bool WIN>
DEV void attn_task(const bf16_t* P, bf16_t* YAB, const float* rpb, int h, int qtok0, int r, int c0, int kc0, int lane) {
    const int i = lane & 15, g = lane >> 4, qtok = qtok0 + i;
    bf16x8 qf[4];
#pragma unroll
    for (int s = 0; s < 4; ++s) qf[s] = *(const bf16x8*)(P + (size_t)qtok * QKV + h * 128 + 32 * s + 8 * g);
    const int c = c0 + i;
    const int sr = r - 4 < 0 ? 0 : (r - 4 > 120 ? 120 : r - 4);
    const int sc = c - 8 < 0 ? 0 : (c - 8 > 48 ? 48 : c - 8);
    float m_run = -1e30f, l_run = 0.f;
    f32x4 oacc[8];
#pragma unroll
    for (int mt = 0; mt < 8; ++mt) oacc[mt] = (f32x4){0.f, 0.f, 0.f, 0.f};
    for (int b = WIN ? 0 : 8; b < 16; ++b) {
        const int kb = b < 8 ? (sr + b) * 64 + kc0 : S + 32 * (b - 8);
        f32x4 sa[2];
#pragma unroll
        for (int mt = 0; mt < 2; ++mt) {
            f32x4 a = (f32x4){0.f, 0.f, 0.f, 0.f};
#pragma unroll
            for (int s = 0; s < 4; ++s) { const bf16x8 kf = *(const bf16x8*)(P + (size_t)(kb + 16 * mt + i) * QKV + 2048 + h * 128 + 32 * s + 8 * g); a = mfma16(kf, qf[s], a); }
            sa[mt] = a;
        }
        float bm = -1e30f;
#pragma unroll
        for (int mt = 0; mt < 2; ++mt)
#pragma unroll
            for (int reg = 0; reg < 4; ++reg) {
                float v = sa[mt][reg] * HSCALE;
                if (WIN && b < 8) {
                    const int kcol = kc0 + 16 * mt + 4 * g + reg;
                    const bool valid = kcol >= sc && kcol < sc + 16;
                    const int dc = valid ? kcol - c + 15 : 0;
                    const float bias = rpb[(h * 15 + (sr + b - r + 7)) * 31 + dc];
                    v = valid ? v + bias : -1e30f;
                }
                sa[mt][reg] = v; bm = fmaxf(bm, v);
            }
        bm = fmaxf(bm, shfl_xor_f(bm, 16)); bm = fmaxf(bm, shfl_xor_f(bm, 32));
        const float m_new = fmaxf(m_run, bm);
        const float alpha = ex2((m_run - m_new) * LOG2E);
        m_run = m_new;
        float ps = 0.f;
#pragma unroll
        for (int mt = 0; mt < 2; ++mt)
#pragma unroll
            for (int reg = 0; reg < 4; ++reg) { const float pv = ex2((sa[mt][reg] - m_new) * LOG2E); sa[mt][reg] = pv; ps += pv; }
        l_run = l_run * alpha + ps;
#pragma unroll
        for (int mt = 0; mt < 8; ++mt) oacc[mt] = oacc[mt] * alpha;
        u32x4 pw; pw[0] = cvt_pk_bf16(sa[0][0], sa[0][1]); pw[1] = cvt_pk_bf16(sa[0][2], sa[0][3]); pw[2] = cvt_pk_bf16(sa[1][0], sa[1][1]); pw[3] = cvt_pk_bf16(sa[1][2], sa[1][3]);
        const bf16x8 pf = __builtin_bit_cast(bf16x8, pw);
        u32x4 vd[8];
#pragma unroll
        for (int jj = 0; jj < 8; ++jj) { const int key = kb + (jj < 4 ? 4 * g + jj : 16 + 4 * g + jj - 4); vd[jj] = *(const u32x4*)(P + (size_t)key * QKV + 4096 + h * 128 + 8 * i); }
#pragma unroll
        for (int mt = 0; mt < 8; ++mt) oacc[mt] = mfma16(extract8(vd, mt), pf, oacc[mt]);
    }
    l_run += shfl_xor_f(l_run, 16); l_run += shfl_xor_f(l_run, 32);
    const float inv = 1.0f / l_run;
#pragma unroll
    for (int reg = 0; reg < 4; ++reg) {
        const int dvb = 32 * g + 8 * reg;
        u32x4 w;
#pragma unroll
        for (int q = 0; q < 4; ++q) w[q] = cvt_pk_bf16(oacc[2 * q][reg] * inv, oacc[2 * q + 1][reg] * inv);
        *(u32x4*)(YAB + (size_t)qtok * D + h * 128 + dvb) = w;
    }
}

struct Unit { int pm, pn; };
struct EpiF32 {
    static constexpr bool PERM = false, AFTER_DRAIN = false;
    float* C; int ldc;
    DEV void operator()(const f32x4 (&acc)[2][2][4][2], const Unit& u, int wr, int wc, int fr, int fq) const {
        const int row0 = u.pm * 256 + wr * 64 + fr, col0 = u.pn * 256 + wc * 32 + 4 * fq;
#pragma unroll
        for (int ai = 0; ai < 2; ++ai)
#pragma unroll
            for (int m = 0; m < 4; ++m) { float* rowp = C + (size_t)(row0 + ai * 128 + m * 16) * ldc + col0;
#pragma unroll
                for (int bj = 0; bj < 2; ++bj)
#pragma unroll
                    for (int n = 0; n < 2; ++n) *(f32x4*)(rowp + bj * 128 + n * 16) = acc[ai][bj][m][n]; }
    }
};
struct EpiBf16 {
    static constexpr bool PERM = true, AFTER_DRAIN = false;
    bf16_t* O; int ldc;
    DEV void operator()(const f32x4 (&acc)[2][2][4][2], const Unit& u, int wr, int wc, int fr, int fq) const {
        const int row0 = u.pm * 256 + wr * 64 + fr, col0 = u.pn * 256 + wc * 32 + 8 * fq;
#pragma unroll
        for (int ai = 0; ai < 2; ++ai)
#pragma unroll
            for (int m = 0; m < 4; ++m) { bf16_t* rowp = O + (size_t)(row0 + ai * 128 + m * 16) * ldc + col0;
#pragma unroll
                for (int bj = 0; bj < 2; ++bj) { const f32x4 v0 = acc[ai][bj][m][0], v1 = acc[ai][bj][m][1];
                    u32x4 w; w[0] = cvt_pk_bf16(v0[0], v0[1]); w[1] = cvt_pk_bf16(v0[2], v0[3]); w[2] = cvt_pk_bf16(v1[0], v1[1]); w[3] = cvt_pk_bf16(v1[2], v1[3]);
                    *(u32x4*)(rowp + bj * 128) = w; } }
    }
};
struct EpiInProj {
    static constexpr bool PERM = true, AFTER_DRAIN = false;
    bf16_t* O; const f32x2* rope;
    DEV void operator()(const f32x4 (&acc)[2][2][4][2], const Unit& u, int wr, int wc, int fr, int fq) const {
        const int row0 = u.pm * 256 + wr * 64 + fr, col0 = u.pn * 256 + wc * 32 + 8 * fq;
        const bool isk = u.pn >= 16 && u.pn < 20, isq = u.pn >= 12 && u.pn < 16, dorope = (isq || isk) && u.pm < 32;
        const float sc = isk ? HSCALE : 1.0f;
#pragma unroll
        for (int ai = 0; ai < 2; ++ai)
#pragma unroll
            for (int m = 0; m < 4; ++m) { const int row = row0 + ai * 128 + m * 16; bf16_t* rowp = O + (size_t)row * ABIN + col0;
                f32x4 cs01 = (f32x4){1.f, 0.f, 1.f, 0.f}, cs23 = cs01, cs45 = cs01, cs67 = cs01;
                if (dorope) { const int pidx = (wc < 2) ? (row >> 6) : 128 + (row & 63); const f32x2* tp = rope + pidx * 32 + 16 * (wc & 1) + 4 * fq;
                    const f32x4 t0 = *(const f32x4*)tp, t1 = *(const f32x4*)(tp + 2); cs01 = t0; cs23 = t0; cs45 = t1; cs67 = t1; }
#pragma unroll
                for (int bj = 0; bj < 2; ++bj) { f32x4 v0 = acc[ai][bj][m][0], v1 = acc[ai][bj][m][1];
                    if (dorope) {
                        const f32x4 a0 = v0, a1 = v1;
                        v0[0] = a0[0] * cs01[0] - a0[1] * cs01[1]; v0[1] = a0[0] * cs01[1] + a0[1] * cs01[0];
                        v0[2] = a0[2] * cs23[2] - a0[3] * cs23[3]; v0[3] = a0[2] * cs23[3] + a0[3] * cs23[2];
                        v1[0] = a1[0] * cs45[0] - a1[1] * cs45[1]; v1[1] = a1[0] * cs45[1] + a1[1] * cs45[0];
                        v1[2] = a1[2] * cs67[2] - a1[3] * cs67[3]; v1[3] = a1[2] * cs67[3] + a1[3] * cs67[2];
                    }
                    v0 = v0 * sc; v1 = v1 * sc;
                    u32x4 w; w[0] = cvt_pk_bf16(v0[0], v0[1]); w[1] = cvt_pk_bf16(v0[2], v0[3]); w[2] = cvt_pk_bf16(v1[0], v1[1]); w[3] = cvt_pk_bf16(v1[2], v1[3]);
                    *(u32x4*)(rowp + bj * 128) = w; } }
    }
};
struct EpiSwiglu {
    static constexpr bool PERM = true, AFTER_DRAIN = false;
    bf16_t* O;
    DEV void operator()(const f32x4 (&acc)[2][2][4][2], const Unit& u, int wr, int wc, int fr, int fq) const {
        const int row0 = u.pm * 256 + wr * 64 + fr, col0 = u.pn * 128 + wc * 32 + 8 * fq;
#pragma unroll
        for (int ai = 0; ai < 2; ++ai)
#pragma unroll
            for (int m = 0; m < 4; ++m) { bf16_t* rowp = O + (size_t)(row0 + ai * 128 + m * 16) * FFH + col0;
                const f32x4 g0 = acc[ai][0][m][0], g1 = acc[ai][0][m][1], u0 = acc[ai][1][m][0], u1 = acc[ai][1][m][1];
                u32x4 w; w[0] = cvt_pk_bf16(silu_f(g0[0]) * u0[0], silu_f(g0[1]) * u0[1]); w[1] = cvt_pk_bf16(silu_f(g0[2]) * u0[2], silu_f(g0[3]) * u0[3]);
                w[2] = cvt_pk_bf16(silu_f(g1[0]) * u1[0], silu_f(g1[1]) * u1[1]); w[3] = cvt_pk_bf16(silu_f(g1[2]) * u1[2], silu_f(g1[3]) * u1[3]);
                *(u32x4*)rowp = w; }
    }
};

#ifndef HOST_EMU
namespace pg8 {
#define PG8_LAS __attribute__((address_space(3)))
constexpr int BM = 256, BK = 64, HALF = 128, HTB = HALF * BK * 2, STAGE_BYTES = 8 * HTB, NXCD = 8, WGM = 8;
__host__ __device__ __forceinline__ int lds_byte(int r, int c) { const int st = (r >> 4) * 2 + (c >> 5), rr = r & 15, cc = c & 31, ob = rr * 64 + cc * 2; return st * 1024 + (ob ^ (((ob >> 9) & 1) << 5)); }
__host__ __device__ __forceinline__ void stage_rc(int b, int& R, int& C) { const int st = b / 1024, sb = b % 1024, swz = sb ^ (((sb >> 9) & 1) << 5); R = (st >> 1) * 16 + swz / 64; C = (st & 1) * 32 + (swz % 64) / 2; }
__host__ __device__ __forceinline__ int perm32(int rho) { const int n = rho >> 4, i = rho & 15; return 8 * (i >> 2) + 4 * n + (i & 3); }
struct Gemm { const bf16_t* A; const bf16_t* Bt; int M, N, K; };
struct StaticOrder {
    int nM, nN, nwg, G, c;
    __host__ __device__ void init(int M, int N, int G_, int c_) { nM = M / BM; nN = N / BM; nwg = nM * nN; G = G_; c = c_; }
    __host__ __device__ bool next(int i, Unit& u) const {
        const long L = (long)i * G + c; if (L >= nwg) return false;
        int wgid = (int)L; { const int q = nwg / NXCD, r = nwg % NXCD, xcd = wgid % NXCD, off = wgid / NXCD; wgid = (xcd < r ? xcd * (q + 1) : r * (q + 1) + (xcd - r) * q) + off; }
        const int nig = WGM * nN, gid = wgid / nig, fm = gid * WGM, gsz = (nM - fm) < WGM ? (nM - fm) : WGM;
        u.pm = fm + ((wgid % nig) % gsz); u.pn = (wgid % nig) / gsz; return true;
    }
    __device__ __forceinline__ void a_ready(const Unit&) const {}
    __device__ __forceinline__ void done(const Unit&) const {}
};
template <class Epi, class Sched, bool ALIGN_EPI = false, bool SP2 = false>
__device__ __forceinline__ void gemm_phase(PG8_LAS unsigned char* lds, const Gemm g, const Sched& S, const Epi& E, const int tid) {
    const int wid = __builtin_amdgcn_readfirstlane(tid >> 6), lane = tid & 63, wr = wid >> 2, wc = wid & 3, fr = lane & 15, fq = lane >> 4;
    const int K = g.K, nt = K / BK;
    unsigned voffA[2], voffB[2];
#pragma unroll
    for (int i = 0; i < 2; ++i) { int R, C; stage_rc(tid * 16 + i * 8192, R, C); const int Rb = Epi::PERM ? ((R & ~31) + perm32(R & 31)) : R;
        voffA[i] = (unsigned)(R * K + C) * 2u; voffB[i] = (unsigned)(Rb * K + C) * 2u; }
    const size_t kstep = (size_t)(BK * 2);
    const size_t hstep = (size_t)HALF * K * 2;
    const size_t tstep = 2 * hstep;
    const unsigned ldsw = (unsigned)wid * 1024u;
    const int aoff = lds_byte(wr * 64 + fr, fq * 8), boff = lds_byte(wc * 32 + fr, fq * 8);
#define PG8_SA(b, h) (((b) * 2 + (h)) * HTB)
#define PG8_SB(b, h) ((4 + (b) * 2 + (h)) * HTB)
#define PG8_STAGE(bufoff, gbase, voff) do { _Pragma("unroll") for (int _i = 0; _i < 2; ++_i) \
        __builtin_amdgcn_global_load_lds((const unsigned*)((const char*)(gbase) + (voff)[_i]), (PG8_LAS unsigned*)(lds + (bufoff) + ldsw + _i * 8192), 16, 0, 0); } while (0)
#define PG8_LDA(dst, b, h) do { _Pragma("unroll") for (int m = 0; m < 4; ++m) _Pragma("unroll") for (int k = 0; k < 2; ++k) dst[m][k] = *(const PG8_LAS bf16x8*)(lds + PG8_SA(b, h) + aoff + m * 2048 + k * 1024); } while (0)
#define PG8_LDB(dst, b, h) do { _Pragma("unroll") for (int n = 0; n < 2; ++n) _Pragma("unroll") for (int k = 0; k < 2; ++k) dst[n][k] = *(const PG8_LAS bf16x8*)(lds + PG8_SB(b, h) + boff + n * 2048 + k * 1024); } while (0)
#define PG8_MMA(ai, bj, At, Bt) do { __builtin_amdgcn_s_setprio(1); _Pragma("unroll") for (int m = 0; m < 4; ++m) _Pragma("unroll") for (int n = 0; n < 2; ++n) _Pragma("unroll") for (int k = 0; k < 2; ++k) \
        acc[ai][bj][m][n] = __builtin_amdgcn_mfma_f32_16x16x32_bf16(Bt[n][k], At[m][k], acc[ai][bj][m][n], 0, 0, 0); __builtin_amdgcn_s_setprio(0); } while (0)
#define PG8_WAIT_V(n) asm volatile("s_waitcnt vmcnt(" #n ")" ::: "memory")
#define PG8_WAIT_L(n) asm volatile("s_waitcnt lgkmcnt(" #n ")" ::: "memory")
#define PG8_BAR __builtin_amdgcn_s_barrier()
#define PG8_SCHED __builtin_amdgcn_sched_barrier(0)
    Unit cur, nxt; int ui = 0;
    if (!S.next(0, cur)) return;
    f32x4 acc[2][2][4][2];
#pragma unroll
    for (int a = 0; a < 2; ++a)
#pragma unroll
        for (int b = 0; b < 2; ++b)
#pragma unroll
            for (int m = 0; m < 4; ++m)
#pragma unroll
                for (int n = 0; n < 2; ++n) acc[a][b][m][n] = (f32x4){0.f, 0.f, 0.f, 0.f};
    bf16x8 At[4][2], B0[2][2], B1[2][2];
    const char* cA = (const char*)g.A + (size_t)cur.pm * tstep; const char* cB = (const char*)g.Bt + (size_t)cur.pn * tstep;
    S.a_ready(cur);
    if constexpr (SP2) {
        PG8_STAGE(PG8_SB(0, 0), cB, voffB); PG8_STAGE(PG8_SB(0, 1), cB + hstep, voffB); PG8_STAGE(PG8_SA(0, 0), cA, voffA); PG8_STAGE(PG8_SA(0, 1), cA + hstep, voffA);
        if (wr == 1) PG8_BAR;
        PG8_WAIT_V(2); PG8_BAR;
        PG8_STAGE(PG8_SB(1, 0), cB + kstep, voffB); PG8_STAGE(PG8_SA(1, 0), cA + kstep, voffA); PG8_STAGE(PG8_SB(1, 1), cB + hstep + kstep, voffB);
        PG8_WAIT_V(6); PG8_BAR;
    } else {
        PG8_STAGE(PG8_SB(0, 0), cB, voffB); PG8_STAGE(PG8_SA(0, 0), cA, voffA); PG8_STAGE(PG8_SB(0, 1), cB + hstep, voffB); PG8_STAGE(PG8_SA(0, 1), cA + hstep, voffA);
        if (wr == 1) PG8_BAR;
        PG8_WAIT_V(4); PG8_BAR;
        PG8_STAGE(PG8_SB(1, 0), cB + kstep, voffB); PG8_STAGE(PG8_SA(1, 0), cA + kstep, voffA); PG8_STAGE(PG8_SB(1, 1), cB + hstep + kstep, voffB);
        PG8_WAIT_V(6); PG8_BAR;
    }
    for (;;) {
        const bool has_next = S.next(ui + 1, nxt);
        const char* nA = has_next ? (const char*)g.A + (size_t)nxt.pm * tstep : cA; const char* nB = has_next ? (const char*)g.Bt + (size_t)nxt.pn * tstep : cB;
        for (int t = 0; t < nt; t += 2) {
            const bool last = (t == nt - 2);
            const char* a1 = cA + (size_t)(t + 1) * kstep;
            const char* a2 = last ? nA : cA + (size_t)(t + 2) * kstep; const char* b2 = last ? nB : cB + (size_t)(t + 2) * kstep;
            const char* a3 = a2 + kstep; const char* b3 = b2 + kstep;
            if (last && has_next) S.a_ready(nxt);
            if constexpr (SP2) {
            PG8_LDB(B0, 0, 0); PG8_LDB(B1, 0, 1); PG8_SCHED; PG8_LDA(At, 0, 0); PG8_STAGE(PG8_SA(1, 1), a1 + hstep, voffA);
            PG8_WAIT_V(8); PG8_WAIT_L(0); PG8_BAR; PG8_MMA(0, 0, At, B0); PG8_MMA(0, 1, At, B1); PG8_BAR; PG8_SCHED;
            PG8_LDA(At, 0, 1); PG8_STAGE(PG8_SB(0, 0), b2, voffB); PG8_STAGE(PG8_SB(0, 1), b2 + hstep, voffB); PG8_STAGE(PG8_SA(0, 0), a2, voffA);
            PG8_WAIT_V(8); PG8_WAIT_L(0); PG8_BAR; PG8_MMA(1, 0, At, B0); PG8_MMA(1, 1, At, B1); PG8_BAR; PG8_SCHED;
            PG8_LDB(B0, 1, 0); PG8_LDB(B1, 1, 1); PG8_SCHED; PG8_LDA(At, 1, 0); PG8_STAGE(PG8_SA(0, 1), a2 + hstep, voffA);
            PG8_WAIT_V(8); PG8_WAIT_L(0); PG8_BAR; PG8_MMA(0, 0, At, B0); PG8_MMA(0, 1, At, B1); PG8_BAR; PG8_SCHED;
            PG8_LDA(At, 1, 1); PG8_STAGE(PG8_SB(1, 0), b3, voffB); PG8_STAGE(PG8_SB(1, 1), b3 + hstep, voffB); PG8_STAGE(PG8_SA(1, 0), a3, voffA);
            PG8_WAIT_V(8); PG8_WAIT_L(0); PG8_BAR; PG8_MMA(1, 0, At, B0); PG8_MMA(1, 1, At, B1); PG8_BAR; PG8_SCHED;
            } else {
            PG8_LDB(B0, 0, 0); PG8_SCHED; PG8_LDA(At, 0, 0); PG8_STAGE(PG8_SA(1, 1), a1 + hstep, voffA);
            PG8_WAIT_L(8); PG8_BAR; PG8_WAIT_L(0); PG8_MMA(0, 0, At, B0); PG8_BAR; PG8_SCHED;
            PG8_LDB(B1, 0, 1); PG8_STAGE(PG8_SB(0, 0), b2, voffB);
            PG8_BAR; PG8_WAIT_L(0); PG8_MMA(0, 1, At, B1); PG8_BAR;
            PG8_LDA(At, 0, 1); PG8_STAGE(PG8_SA(0, 0), a2, voffA);
            PG8_BAR; PG8_WAIT_L(0); PG8_MMA(1, 0, At, B0); PG8_BAR; PG8_SCHED;
            PG8_STAGE(PG8_SB(0, 1), b2 + hstep, voffB);
            PG8_WAIT_V(6); PG8_BAR; PG8_MMA(1, 1, At, B1); PG8_BAR;
            PG8_LDB(B0, 1, 0); PG8_SCHED; PG8_LDA(At, 1, 0); PG8_STAGE(PG8_SA(0, 1), a2 + hstep, voffA);
            PG8_WAIT_L(8); PG8_BAR; PG8_WAIT_L(0); PG8_MMA(0, 0, At, B0); PG8_BAR; PG8_SCHED;
            PG8_LDB(B1, 1, 1); PG8_STAGE(PG8_SB(1, 0), b3, voffB);
            PG8_BAR; PG8_WAIT_L(0); PG8_MMA(0, 1, At, B1); PG8_BAR;
            PG8_LDA(At, 1, 1); PG8_STAGE(PG8_SA(1, 0), a3, voffA);
            PG8_BAR; PG8_WAIT_L(0); PG8_MMA(1, 0, At, B0); PG8_BAR; PG8_SCHED;
            PG8_STAGE(PG8_SB(1, 1), b3 + hstep, voffB);
            PG8_WAIT_V(6); PG8_BAR; PG8_MMA(1, 1, At, B1); PG8_BAR;
            }
        }
        if constexpr (ALIGN_EPI) { if (wr == 0) PG8_BAR; }
        if constexpr (!Epi::AFTER_DRAIN) { E(acc, cur, wr, wc, fr, fq); S.done(cur); }
        if (!has_next) break;
#pragma unroll
        for (int a = 0; a < 2; ++a)
#pragma unroll
            for (int b = 0; b < 2; ++b)
#pragma unroll
                for (int m = 0; m < 4; ++m)
#pragma unroll
                    for (int n = 0; n < 2; ++n) acc[a][b][m][n] = (f32x4){0.f, 0.f, 0.f, 0.f};
        cur = nxt; cA = nA; cB = nB; ++ui;
        if constexpr (ALIGN_EPI) { if (wr == 1) PG8_BAR; }
    }
    PG8_WAIT_V(0);
    if constexpr (!ALIGN_EPI) { if (wr == 0) PG8_BAR; }
    PG8_BAR;
#undef PG8_SA
#undef PG8_SB
#undef PG8_STAGE
#undef PG8_LDA
#undef PG8_LDB
#undef PG8_MMA
#undef PG8_WAIT_V
#undef PG8_WAIT_L
#undef PG8_BAR
#undef PG8_SCHED
}
}
#ifndef PG8_SP2
#define PG8_SP2 true
#endif
#ifndef PG8_ALIGN
#define PG8_ALIGN true
#endif

#define XB_TMO      128
#define XB_XCNT(j)  (256  + 64 * (j))
#define XB_XSUB(j)  (1280 + 64 * (j))
#define XB_XGEN(j)  (2304 + 64 * (j))
#define XB_TOP      3328
#define XB_TOPGEN   3392
#define XCD_BAR_WORDS 3456
#define XB_SPIN_CAP (1u << 18)
__device__ __forceinline__ unsigned xb_ld(unsigned* p)              { return __hip_atomic_load(p, __ATOMIC_RELAXED, __HIP_MEMORY_SCOPE_AGENT); }
__device__ __forceinline__ unsigned xb_add(unsigned* p, unsigned v) { return __hip_atomic_fetch_add(p, v, __ATOMIC_RELAXED, __HIP_MEMORY_SCOPE_AGENT); }
__device__ __forceinline__ unsigned xb_xcc_id() { return (unsigned)__builtin_amdgcn_s_getreg((3 << 11) | 20) & 0xFu; }
#define XB_SPIN(cond, bar) do { unsigned _sp = 0; while (cond) { __builtin_amdgcn_s_sleep(1); \
    if ((++_sp & 255u) == 0u) { if (xb_ld(&(bar)[XB_TMO])) break; if (_sp > XB_SPIN_CAP) { atomicAdd(&(bar)[XB_TMO], 1u); break; } } } } while (0)
struct XcdBarrier { unsigned* bar; unsigned x; volatile LAS unsigned* st; };
__device__ __forceinline__ XcdBarrier xcd_barrier_post(unsigned* bar, volatile LAS unsigned* st) {
    XcdBarrier b; b.bar = bar; b.x = xb_xcc_id(); b.st = st;
    if (threadIdx.x == 0) (void)xb_add(&bar[XB_XCNT(b.x)], 1u);
    return b;
}
__device__ __forceinline__ void xcd_barrier_complete(unsigned* bar, unsigned x, unsigned& nloc, unsigned& nx) {
    const unsigned G = gridDim.x * gridDim.y * gridDim.z;
    unsigned sum, cnt, mine, sp = 0u;
    for (;;) {
        sum = 0u; cnt = 0u; mine = 0u;
#pragma unroll
        for (unsigned j = 0; j < 16; ++j) { const unsigned c = xb_ld(&bar[XB_XCNT(j)]); sum += c; cnt += (c > 0u) ? 1u : 0u; mine = (j == x) ? c : mine; }
        if (sum == G) break;
        __builtin_amdgcn_s_sleep(1);
        if ((++sp & 255u) == 0u) { if (xb_ld(&bar[XB_TMO])) break; if (sp > XB_SPIN_CAP) { atomicAdd(&bar[XB_TMO], 1u); break; } }
    }
    nloc = mine > 0u ? mine : 1u; nx = cnt > 0u ? cnt : 1u;
}
__device__ __forceinline__ void xcd_barrier(const XcdBarrier& b) {
    asm volatile("s_waitcnt vmcnt(0)" ::: "memory");
    __syncthreads();
    if (threadIdx.x == 0) {
        unsigned* bar = b.bar;
        __builtin_amdgcn_s_waitcnt(0);
        unsigned nloc = b.st[0], nx = b.st[1];
        if (nloc == 0u) { xcd_barrier_complete(bar, b.x, nloc, nx); b.st[0] = nloc; b.st[1] = nx; }
        const unsigned old = xb_add(&bar[XB_XSUB(b.x)], 1u);
        const unsigned gen = old / nloc;
        if (old + 1u == (gen + 1u) * nloc) {
            __builtin_amdgcn_fence(__ATOMIC_RELEASE, "agent");
            asm volatile("s_waitcnt vmcnt(0)" ::: "memory");
            const unsigned og = xb_add(&bar[XB_TOP], 1u);
            const unsigned tg = og / nx;
            if (og + 1u == (tg + 1u) * nx) xb_add(&bar[XB_TOPGEN], 1u);
            else XB_SPIN(xb_ld(&bar[XB_TOPGEN]) == tg, bar);
            __builtin_amdgcn_fence(__ATOMIC_ACQUIRE, "agent");
            xb_add(&bar[XB_XGEN(b.x)], 1u);
            asm volatile("s_waitcnt vmcnt(0)" ::: "memory");
        } else {
            XB_SPIN(xb_ld(&bar[XB_XGEN(b.x)]) == gen, bar);
            __builtin_amdgcn_fence(__ATOMIC_ACQUIRE, "agent");
            asm volatile("s_waitcnt vmcnt(0)" ::: "memory");
        }
    }
    __syncthreads();
}

constexpr size_t al256(size_t x) { return (x + 255) & ~(size_t)255; }
constexpr size_t WS_CTL = 0;
constexpr size_t CTL_ZERO_BYTES = 65536;
constexpr size_t WS_MODACC = 4u << 20;
constexpr size_t WS_ROPE = 1u << 20;
constexpr size_t WS_WABIN = 8u << 20;
constexpr size_t SZ_WABIN = (size_t)ABIN * D * 2;
constexpr size_t WS_WABOUT = WS_WABIN + 2 * SZ_WABIN;
constexpr size_t SZ_WSQ = (size_t)D * D * 2;
constexpr size_t WS_WQKV = WS_WABOUT + 2 * SZ_WSQ;
constexpr size_t SZ_WQKV = (size_t)QKV * D * 2;
constexpr size_t WS_WNAOUT = WS_WQKV + 2 * SZ_WQKV;
constexpr size_t WS_WFFIN = WS_WNAOUT + 2 * SZ_WSQ;
constexpr size_t SZ_WFFIN = (size_t)FF2 * D * 2;
constexpr size_t WS_WFFOUT = WS_WFFIN + 4 * SZ_WFFIN;
constexpr size_t SZ_WFFOUT = (size_t)D * FFH * 2;
constexpr size_t WS_X = WS_WFFOUT + 4 * SZ_WFFOUT;
constexpr size_t WS_H = WS_X + (size_t)MTOK * D * 4;
constexpr size_t WS_P = WS_H + (size_t)MTOK * D * 2;
constexpr size_t WS_YAB = WS_P + (size_t)MTOK * ABIN * 2;
constexpr size_t WS_Y = WS_YAB + (size_t)MTOK * D * 2;
constexpr size_t WS_HID = WS_Y + (size_t)MTOK * D * 4;
constexpr size_t WS_KVT = WS_HID + (size_t)MTOK * FFH * 2;
constexpr size_t WS_ST = WS_KVT + (size_t)NCHUNK * 16 * 16384 * 4;
constexpr size_t WS_END = WS_ST + (size_t)NCHUNK * 16 * 16384 * 2;
static_assert(WS_WABIN % 256 == 0 && WS_X % 256 == 0 && WS_P % 256 == 0 && WS_KVT % 256 == 0 && WS_ST % 256 == 0, "ws alignment");

constexpr int RING_BYTES = 131072, LDSCTL_OFF = RING_BYTES, MISC_OFF = LDSCTL_OFF + 320, LDS_BYTES = 147456;
constexpr int NPHASE = 2 + 9 * DEPTH;

struct Params { const float* in[16]; float* out; unsigned char* ws; int ph_lo, ph_hi, li, pad; };

__device__ __forceinline__ void transpose_item(const float* W, int ldw, int K, bf16_t* Wt, int k0, int n0s, int n0d, LAS float* scr, int lane) {
#pragma unroll 8
    for (int i = 0; i < 32; ++i) { const int kk = 2 * i + (lane >> 5); scr[kk * 33 + (lane & 31)] = W[(size_t)(k0 + kk) * ldw + n0s + (lane & 31)]; }
    asm volatile("s_waitcnt lgkmcnt(0)" ::: "memory");
    const int c = lane & 7;
#pragma unroll
    for (int j = 0; j < 4; ++j) { const int n = (lane >> 3) + 8 * j; const LAS float* s = scr + (8 * c) * 33 + n;
        u32x4 o; o[0] = cvt_pk_bf16(s[0 * 33], s[1 * 33]); o[1] = cvt_pk_bf16(s[2 * 33], s[3 * 33]); o[2] = cvt_pk_bf16(s[4 * 33], s[5 * 33]); o[3] = cvt_pk_bf16(s[6 * 33], s[7 * 33]);
        *(u32x4*)(Wt + (size_t)(n0d + n) * K + k0 + 8 * c) = o; }
    asm volatile("s_waitcnt lgkmcnt(0)" ::: "memory");
}
__device__ __forceinline__ void transpose_matrix_item(const float* W, int K, int N, bf16_t* Wt, bool ffperm, int item, LAS float* scr, int lane) {
    const int nblk = N / 32, kb = item / nblk, nb = item % nblk, n0d = 32 * nb;
    int n0s = n0d;
    if (ffperm) { const int t = n0d >> 8, j = n0d & 255; n0s = j < 128 ? 128 * t + j : FFH + 128 * t + (j - 128); }
    transpose_item(W, N, K, Wt, 64 * kb, n0s, n0d, scr, lane);
}

__global__ void __launch_bounds__(512, 2) mega_fwd(Params p) {
    extern __shared__ __attribute__((aligned(16))) unsigned char lds_raw[];
    LAS unsigned char* lds = (LAS unsigned char*)lds_raw;
    const int G = gridDim.x, bx = blockIdx.x, NGW = G * 8;
#define SITE_COORDS int tid = threadIdx.x; asm volatile("" : "+v"(tid)); const int lane = tid & 63, wave = __builtin_amdgcn_readfirstlane(tid >> 6); \
    const int vcu = (G % 8 == 0) ? (bx % 8) * (G / 8) + bx / 8 : bx; const int gw = vcu * 8 + wave; (void)lane; (void)gw; (void)vcu
    unsigned char* ws = p.ws;
    volatile LAS unsigned* MISC = (volatile LAS unsigned*)(lds + MISC_OFF);
    { const int tid = threadIdx.x; for (int u = tid; u < (LDS_BYTES - LDSCTL_OFF) / 4; u += 512) ((LAS unsigned*)(lds + LDSCTL_OFF))[u] = 0u; }
    __syncthreads();
    const int lo = p.ph_lo, hi = p.ph_hi;
    const bool multi = (hi - lo) > 1;
    XcdBarrier bar; bar.bar = (unsigned*)(ws + WS_CTL) + p.li * 4096; bar.x = 0; bar.st = nullptr;
    if (multi) bar = xcd_barrier_post((unsigned*)(ws + WS_CTL) + p.li * 4096, MISC + 8);
#ifndef SITE_MASK
#define SITE_MASK 0xffff
#endif
#define EN(i) (((SITE_MASK) >> (i)) & 1)
#define IN(k) (lo <= (k) && (k) < hi)
#define ROWOP_RUN(a) do { LAS float* cf0 = (LAS float*)lds; LAS float* cf1 = (LAS float*)(lds + 24576); \
        rowop_coefs(a, 0, cf0, tid); if ((a).nctx) rowop_coefs(a, 1, cf1, tid); __syncthreads(); \
        rowop_stream(a, 0, cf0, 0, S, gw, NGW, lane); if ((a).nctx) rowop_stream(a, 1, cf1, S, S + (a).nctx, gw, NGW, lane); __syncthreads(); } while (0)
#define SEAM(k, knext) do { if (IN(k) && IN(knext)) xcd_barrier(bar); } while (0)

    const float* x_in = p.in[0]; const float* c_in = p.in[1]; const float* ctx_in = p.in[2]; const float* cctx_in = p.in[3];
    const float* ada_w = p.in[4]; const float* ada_b = p.in[5]; const float* norm_g = p.in[6];
    const float* ab_w_in = p.in[7]; const float* ab_conv_w = p.in[8]; const float* ab_decay = p.in[9]; const float* ab_w_out = p.in[10];
    const float* na_w_qkv = p.in[11]; const float* na_rpb = p.in[12]; const float* na_w_out = p.in[13];
    const float* ffn_w_in = p.in[14]; const float* ffn_w_out = p.in[15];
    float* modacc = (float*)(ws + WS_MODACC);
    f32x2* rope = (f32x2*)(ws + WS_ROPE);
    float* X = (float*)(ws + WS_X); bf16_t* H = (bf16_t*)(ws + WS_H); bf16_t* P = (bf16_t*)(ws + WS_P); bf16_t* YAB = (bf16_t*)(ws + WS_YAB);
    float* Y = (float*)(ws + WS_Y); bf16_t* HID = (bf16_t*)(ws + WS_HID); float* KVT = (float*)(ws + WS_KVT); bf16_t* ST = (bf16_t*)(ws + WS_ST);

    if (EN(0) && IN(0)) {
        SITE_COORDS;
        LAS float* scr = (LAS float*)(lds + wave * 16384);
        constexpr int I_ABIN = (D / 64) * (ABIN / 32), I_SQ = (D / 64) * (D / 32), I_QKV = (D / 64) * (QKV / 32), I_FFIN = (D / 64) * (FF2 / 32), I_FFOUT = (FFH / 64) * (D / 32);
        constexpr int NITEMS = 2 * (I_ABIN + I_SQ + I_QKV + I_SQ) + 4 * (I_FFIN + I_FFOUT);
        for (int it = gw; it < NITEMS; it += NGW) {
            int r = it;
            if (r < 2 * I_ABIN) { const int i = r / I_ABIN; transpose_matrix_item(ab_w_in + (size_t)i * D * ABIN, D, ABIN, (bf16_t*)(ws + WS_WABIN + i * SZ_WABIN), false, r % I_ABIN, scr, lane); continue; } r -= 2 * I_ABIN;
            if (r < 2 * I_SQ) { const int i = r / I_SQ; transpose_matrix_item(ab_w_out + (size_t)i * D * D, D, D, (bf16_t*)(ws + WS_WABOUT + i * SZ_WSQ), false, r % I_SQ, scr, lane); continue; } r -= 2 * I_SQ;
            if (r < 2 * I_QKV) { const int i = r / I_QKV; transpose_matrix_item(na_w_qkv + (size_t)i * D * QKV, D, QKV, (bf16_t*)(ws + WS_WQKV + i * SZ_WQKV), false, r % I_QKV, scr, lane); continue; } r -= 2 * I_QKV;
            if (r < 2 * I_SQ) { const int i = r / I_SQ; transpose_matrix_item(na_w_out + (size_t)i * D * D, D, D, (bf16_t*)(ws + WS_WNAOUT + i * SZ_WSQ), false, r % I_SQ, scr, lane); continue; } r -= 2 * I_SQ;
            if (r < 4 * I_FFIN) { const int i = r / I_FFIN; transpose_matrix_item(ffn_w_in + (size_t)i * D * FF2, D, FF2, (bf16_t*)(ws + WS_WFFIN + i * SZ_WFFIN), true, r % I_FFIN, scr, lane); continue; } r -= 4 * I_FFIN;
            { const int i = r / I_FFOUT; transpose_matrix_item(ffn_w_out + (size_t)i * FFH * D, FFH, D, (bf16_t*)(ws + WS_WFFOUT + i * SZ_WFFOUT), false, r % I_FFOUT, scr, lane); }
        }
        for (int it = vcu; it < 4 * 4 * 6; it += G) {
            const int l = it / 24, kp = (it % 24) / 6, nc = it % 6, n = nc * 2048 + 4 * tid;
            f32x4 aL = (f32x4){0.f, 0.f, 0.f, 0.f}, aC = aL;
            const float* wp = ada_w + ((size_t)l * D + kp * 512) * (6 * D) + n;
#pragma unroll 8
            for (int k = 0; k < 512; ++k) { const f32x4 w = *(const f32x4*)(wp + (size_t)k * (6 * D)); const float cl = c_in[kp * 512 + k], cc = cctx_in[kp * 512 + k];
                const float sl = cl / (1.0f + __expf(-cl)), sc = cc / (1.0f + __expf(-cc)); aL = aL + w * sl; aC = aC + w * sc; }
            *(f32x4*)(modacc + (size_t)kp * MODPART + (size_t)(l * 2 + 0) * 6 * D + n) = aL;
            *(f32x4*)(modacc + (size_t)kp * MODPART + (size_t)(l * 2 + 1) * 6 * D + n) = aC;
        }
        for (int idx = bx * 512 + tid; idx < 192 * 32; idx += G * 512) {
            const int pi = idx >> 5, f = idx & 31; const float pos = (float)(pi < 128 ? pi : pi - 128);
            const float ang = pos * powf(10000.0f, -(float)f / 32.0f);
            rope[idx] = (f32x2){cosf(ang), sinf(ang)};
        }
    }
    SEAM(0, 1);
    if (EN(1) && IN(1)) {
        SITE_COORDS;
        RowopArgs a; a.y = nullptr; a.xin_lat = x_in; a.xin_ctx = ctx_in; a.xout_lat = X; a.xout_ctx = X + (size_t)S * D; a.h = H; a.modacc = modacc; a.ada_b = ada_b; a.norm_g = norm_g;
        a.ly = -1; a.jg_y = 0; a.jgate = 0; a.lh = 0; a.jg_h = 0; a.jshift = 0; a.jscale = 1; a.nctx = NCTX;
        ROWOP_RUN(a);
    }
    SEAM(1, 2);
    for (int layer = 0; layer < DEPTH; ++layer) {
        const int pb = 2 + 9 * layer, iab = layer >> 1;
        const bool even = (layer & 1) == 0, last = layer == DEPTH - 1;
        const int Mrows = last ? S : MTOK;
        if (even) {
            if (EN(2) && IN(pb + 0)) {
                SITE_COORDS;
                pg8::Gemm g{H, (const bf16_t*)(ws + WS_WABIN + iab * SZ_WABIN), MTOK, ABIN, D}; pg8::StaticOrder So; So.init(MTOK, ABIN, G, bx);
                EpiInProj E{P, rope};
                pg8::gemm_phase<EpiInProj, pg8::StaticOrder, PG8_ALIGN, PG8_SP2>(lds, g, So, E, tid);
            }
            SEAM(pb + 0, pb + 1);
            if (EN(3) && IN(pb + 1)) {
                SITE_COORDS;
                for (int bt = vcu; bt < NCHUNK * 8; bt += G) {
                    const int cidx = bt >> 3, head = bt & 7, dir = wave >> 2, quad = wave & 3;
                    r1_task(P, KVT, lg2gamma(ab_decay, iab, dir, head), cidx, head, dir, quad, lane);
                }
                for (int t = gw; t < (MTOK / 8) * 2; t += NGW) conv_task(P, YAB, ab_conv_w + (size_t)iab * 3 * 1024, t, lane);
            }
            SEAM(pb + 1, pb + 2);
            if (EN(4) && IN(pb + 2)) {
                SITE_COORDS;
                for (int it = vcu * 512 + tid; it < 131072; it += G * 512) r2_item(KVT, ST, ab_decay, iab, it);
            }
            SEAM(pb + 2, pb + 3);
            if (EN(5) && IN(pb + 3)) {
                SITE_COORDS;
                for (int bt = vcu; bt < NCHUNK * 8; bt += G) {
                    const int cidx = bt >> 3, head = bt & 7;
                    r3_task(P, ST, YAB, lg2gamma(ab_decay, iab, 0, head), lg2gamma(ab_decay, iab, 1, head), cidx, head, wave, lane);
                }
            }
            SEAM(pb + 3, pb + 4);
        } else {
            if (EN(6) && IN(pb + 0)) {
                SITE_COORDS;
                pg8::Gemm g{H, (const bf16_t*)(ws + WS_WQKV + iab * SZ_WQKV), MTOK, QKV, D}; pg8::StaticOrder So; So.init(MTOK, QKV, G, bx);
                EpiBf16 E{P, QKV};
                pg8::gemm_phase<EpiBf16, pg8::StaticOrder, PG8_ALIGN, PG8_SP2>(lds, g, So, E, tid);
            }
            SEAM(pb + 0, pb + 1);
            if (EN(7) && IN(pb + 1)) {
                SITE_COORDS;
                const float* rpb = na_rpb + (size_t)iab * 16 * 15 * 31;
                const int per = (1024 + G - 1) / G;
                for (int bt = vcu * per; bt < (vcu + 1) * per && bt < 1024; ++bt) {
                    const int h = bt >> 6, rp = bt & 63, r = 2 * rp + (wave >> 2), cgp = wave & 3;
                    const int kc0 = cgp == 0 ? 0 : (cgp == 1 ? 8 : (cgp == 2 ? 24 : 32));
                    attn_task<true>(P, YAB, rpb, h, r * 64 + 16 * cgp, r, 16 * cgp, kc0, lane);
                }
                if (!last) for (int t = gw; t < 256; t += NGW) attn_task<false>(P, YAB, rpb, t >> 4, S + 16 * (t & 15), 0, 0, 0, lane);
            }
            SEAM(pb + 1, pb + 4);
        }
        if (EN(8) && IN(pb + 4)) {
            SITE_COORDS;
            const bf16_t* wt = even ? (const bf16_t*)(ws + WS_WABOUT + iab * SZ_WSQ) : (const bf16_t*)(ws + WS_WNAOUT + iab * SZ_WSQ);
            pg8::Gemm g{YAB, wt, Mrows, D, D}; pg8::StaticOrder So; So.init(Mrows, D, G, bx);
            EpiF32 E{Y, D};
            pg8::gemm_phase<EpiF32, pg8::StaticOrder, PG8_ALIGN, PG8_SP2>(lds, g, So, E, tid);
        }
        SEAM(pb + 4, pb + 5);
        if (EN(9) && IN(pb + 5)) {
            SITE_COORDS;
            RowopArgs a; a.y = Y; a.xin_lat = X; a.xin_ctx = X + (size_t)S * D; a.xout_lat = X; a.xout_ctx = X + (size_t)S * D; a.h = H; a.modacc = modacc; a.ada_b = ada_b; a.norm_g = norm_g;
            a.ly = layer; a.jg_y = 1; a.jgate = 2; a.lh = layer; a.jg_h = 2; a.jshift = 3; a.jscale = 4; a.nctx = last ? 0 : NCTX;
            ROWOP_RUN(a);
        }
        SEAM(pb + 5, pb + 6);
        if (EN(10) && IN(pb + 6)) {
            SITE_COORDS;
            pg8::Gemm g{H, (const bf16_t*)(ws + WS_WFFIN + layer * SZ_WFFIN), Mrows, FF2, D}; pg8::StaticOrder So; So.init(Mrows, FF2, G, bx);
            EpiSwiglu E{HID};
            pg8::gemm_phase<EpiSwiglu, pg8::StaticOrder, PG8_ALIGN, PG8_SP2>(lds, g, So, E, tid);
        }
        SEAM(pb + 6, pb + 7);
        if (EN(11) && IN(pb + 7)) {
            SITE_COORDS;
            pg8::Gemm g{HID, (const bf16_t*)(ws + WS_WFFOUT + layer * SZ_WFFOUT), Mrows, D, FFH}; pg8::StaticOrder So; So.init(Mrows, D, G, bx);
            EpiF32 E{Y, D};
            pg8::gemm_phase<EpiF32, pg8::StaticOrder, PG8_ALIGN, PG8_SP2>(lds, g, So, E, tid);
        }
        SEAM(pb + 7, pb + 8);
        if (EN(12) && IN(pb + 8)) {
            SITE_COORDS;
            RowopArgs a; a.y = Y; a.xin_lat = X; a.xin_ctx = X + (size_t)S * D; a.xout_lat = last ? p.out : X; a.xout_ctx = last ? nullptr : X + (size_t)S * D; a.h = H; a.modacc = modacc; a.ada_b = ada_b; a.norm_g = norm_g;
            a.ly = layer; a.jg_y = 3; a.jgate = 5; a.lh = last ? -1 : layer + 1; a.jg_h = 0; a.jshift = 0; a.jscale = 1; a.nctx = last ? 0 : NCTX;
            ROWOP_RUN(a);
        }
        if (!last) SEAM(pb + 8, pb + 9);
    }
#undef IN
#undef SEAM
}

#ifndef MK_MODE
#define MK_MODE 1
#endif
extern "C" void kernel_launch(void* const* d_in, const int* in_sizes, int n_in, void* d_out, int out_size, void* d_ws, size_t ws_size, hipStream_t stream) {
    static int grid = 0;
    if (grid == 0) {
        if (n_in != 16 || out_size != S * D || ws_size < WS_END) { fprintf(stderr, "kernel_launch: unexpected shapes (n_in %d out %d ws %zu need %zu)\n", n_in, out_size, ws_size, (size_t)WS_END); grid = -1; return; }
        int dev = 0, cus = 0, per_cu = 0;
        if (hipGetDevice(&dev) != hipSuccess || hipDeviceGetAttribute(&cus, hipDeviceAttributeMultiprocessorCount, dev) != hipSuccess) { grid = -1; return; }
        if (hipFuncSetAttribute((const void*)mega_fwd, hipFuncAttributeMaxDynamicSharedMemorySize, LDS_BYTES) != hipSuccess) { fprintf(stderr, "kernel_launch: hipFuncSetAttribute failed\n"); grid = -1; return; }
        if (hipOccupancyMaxActiveBlocksPerMultiprocessor(&per_cu, (const void*)mega_fwd, 512, LDS_BYTES) != hipSuccess || per_cu < 1) fprintf(stderr, "kernel_launch: occupancy query says %d\n", per_cu);
        (void)hipGetLastError();
        grid = cus;
    }
    if (grid < 0) return;
    if (hipMemsetAsync((char*)d_ws + WS_CTL, 0, CTL_ZERO_BYTES, stream) != hipSuccess) { fprintf(stderr, "kernel_launch: memset failed\n"); return; }
    Params a{};
    for (int i = 0; i < 16; ++i) a.in[i] = (const float*)d_in[i];
    a.out = (float*)d_out; a.ws = (unsigned char*)d_ws; a.pad = 0;
#if MK_MODE == 1
    a.ph_lo = 0; a.ph_hi = NPHASE; a.li = 0;
    hipLaunchKernelGGL(mega_fwd, dim3(grid), dim3(512), LDS_BYTES, stream, a);
#else
    for (int ph = 0; ph < NPHASE; ++ph) {
        if (ph >= 2) { const int layer = (ph - 2) / 9, slot = (ph - 2) % 9; if ((layer & 1) && (slot == 2 || slot == 3)) continue; }
        a.ph_lo = ph; a.ph_hi = ph + 1; a.li = 0;
        hipLaunchKernelGGL(mega_fwd, dim3(grid), dim3(512), LDS_BYTES, stream, a);
    }
#endif
    const hipError_t le = hipPeekAtLastError();
    if (le != hipSuccess) fprintf(stderr, "kernel_launch: launch failed: %s\n", hipGetErrorName(le));
}
#endif
```

```cpp
#ifndef HOST_EMU
#include <hip/hip_runtime.h>
#include <cstdio>
#include <cstdint>
#define DEV __device__ __forceinline__
#define HDEV __host__ __device__ __forceinline__
#define LAS __attribute__((address_space(3)))
#endif

typedef unsigned short bf16_t;
typedef short bf16x8 __attribute__((ext_vector_type(8)));
typedef float f32x4 __attribute__((ext_vector_type(4)));
typedef float f32x2 __attribute__((ext_vector_type(2)));
typedef unsigned u32x4 __attribute__((ext_vector_type(4)));
typedef unsigned u32x2 __attribute__((ext_vector_type(2)));

#ifndef HOST_EMU
DEV f32x4 mfma16(bf16x8 a, bf16x8 b, f32x4 c) { return __builtin_amdgcn_mfma_f32_16x16x32_bf16(a, b, c, 0, 0, 0); }
DEV float shfl_xor_f(float v, int m) { return __shfl_xor(v, m); }
DEV unsigned cvt_pk_bf16(float lo, float hi) { unsigned r; asm("v_cvt_pk_bf16_f32 %0, %1, %2" : "=v"(r) : "v"(lo), "v"(hi)); return r; }
DEV float ex2(float x) { return __builtin_amdgcn_exp2f(x); }
DEV float rcp_f(float x) { return __builtin_amdgcn_rcpf(x); }
DEV float rsq_f(float x) { return 1.0f / sqrtf(x); }
DEV void atomic_add_f(float* p, float v) { (void)__hip_atomic_fetch_add(p, v, __ATOMIC_RELAXED, __HIP_MEMORY_SCOPE_AGENT); }
#endif

namespace cfg {
constexpr int D = 2048, S = 8192, NCTX = 256, MTOK = 8448, DEPTH = 4;
constexpr int ABIN = 7168, FFH = 5632, FF2 = 11264, QKV = 6144;
constexpr int NCHUNK = 66;
constexpr float EPS = 1e-6f;
constexpr float HSCALE = 0.08838834764831845f;
constexpr float LOG2E = 1.4426950408889634f;
}
using namespace cfg;

DEV float bf_lo(unsigned w) { return __builtin_bit_cast(float, w << 16); }
DEV float bf_hi(unsigned w) { return __builtin_bit_cast(float, w & 0xffff0000u); }
DEV float wave_sum(float v) {
#pragma unroll
    for (int o = 1; o < 64; o <<= 1) v += shfl_xor_f(v, o);
    return v;
}
DEV float silu_f(float x) { return x * rcp_f(1.0f + ex2(-x * LOG2E)); }
DEV float lg2gamma(const float* decay_exp, int iab, int dir, int head) {
    const float e = decay_exp[(iab * 2 + dir) * 8 + head];
    return log1pf(-exp2f(-e)) * LOG2E;
}
DEV bf16x8 extract8(const u32x4 (&vd)[8], int mt) {
    u32x4 w;
#pragma unroll
    for (int q = 0; q < 4; ++q) {
        const unsigned X = vd[2 * q][mt >> 1], Y = vd[2 * q + 1][mt >> 1];
        w[q] = (mt & 1) ? ((X >> 16) | (Y & 0xffff0000u)) : ((X & 0xffffu) | (Y << 16));
    }
    return __builtin_bit_cast(bf16x8, w);
}

struct RowopArgs {
    const float* y;
    const float* xin_lat; const float* xin_ctx;
    float* xout_lat; float* xout_ctx;
    bf16_t* h;
    const float* modacc; const float* ada_b; const float* norm_g;
    int ly, jg_y, jgate, lh, jg_h, jshift, jscale, nctx;
    const float* ypart; int nypart;
};
DEV f32x4 ld4(const float* p) { return *(const f32x4*)p; }
constexpr int MODPART = 4 * 2 * 6 * 2048;
DEV f32x4 modvec(const RowopArgs& a, int l, int s, int j, int col) {
    const float* q = a.modacc + (size_t)((l * 2 + s) * 6 + j) * D + col;
    return ((ld4(q) + ld4(q + MODPART)) + (ld4(q + 2 * MODPART) + ld4(q + 3 * MODPART))) + ld4(a.ada_b + (size_t)l * 6 * D + j * D + col);
}
template <class CP>
DEV void rowop_coefs(const RowopArgs& a, const int s, CP coef, const int tid) {
    const int col = 4 * tid;
    f32x4 A = (f32x4){0.f, 0.f, 0.f, 0.f}, B = A, SH = A;
    if (a.ly >= 0) A = modvec(a, a.ly, s, a.jgate, col) * ld4(a.norm_g + (size_t)(a.ly * 4 + a.jg_y) * D + col);
    if (a.lh >= 0) { B = ld4(a.norm_g + (size_t)(a.lh * 4 + a.jg_h) * D + col) * (modvec(a, a.lh, s, a.jscale, col) + 1.0f); SH = modvec(a, a.lh, s, a.jshift, col); }
    *(f32x4*)(coef + col) = A; *(f32x4*)(coef + D + col) = B; *(f32x4*)(coef + 2 * D + col) = SH;
}
template <class CP>
DEV void rowop_stream(const RowopArgs& a, const int s, CP coef, const int row_begin, const int row_end, const int gw, const int NGW, const int lane) {
    const bool hasy = a.ly >= 0, hash = a.lh >= 0;
    for (int m = row_begin + gw; m < row_end; m += NGW) {
        const float* xr = (s == 0) ? a.xin_lat + (size_t)m * D : a.xin_ctx + (size_t)(m - S) * D;
        f32x4 x[8];
#pragma unroll
        for (int j = 0; j < 8; ++j) x[j] = ld4(xr + 4 * lane + 256 * j);
        if (hasy) {
            f32x4 y[8]; float ss = 0.f;
            if (s == 0) {
                const float* yr = a.y + (size_t)m * D;
#pragma unroll
                for (int j = 0; j < 8; ++j) y[j] = ld4(yr + 4 * lane + 256 * j);
            } else {
#pragma unroll
                for (int j = 0; j < 8; ++j) y[j] = (f32x4){0.f, 0.f, 0.f, 0.f};
                for (int pp = 0; pp < a.nypart; ++pp) { const float* yr = a.ypart + ((size_t)pp * 256 + (m - S)) * D;
#pragma unroll
                    for (int j = 0; j < 8; ++j) y[j] = y[j] + ld4(yr + 4 * lane + 256 * j); }
            }
#pragma unroll
            for (int j = 0; j < 8; ++j) { ss += (y[j][0] * y[j][0] + y[j][1] * y[j][1]) + (y[j][2] * y[j][2] + y[j][3] * y[j][3]); }
            const float r1 = rsq_f(wave_sum(ss) * (1.0f / D) + EPS);
#pragma unroll
            for (int j = 0; j < 8; ++j) x[j] = x[j] + *(const f32x4*)(coef + 4 * lane + 256 * j) * (y[j] * r1);
        }
        float* xo = (s == 0) ? (a.xout_lat ? a.xout_lat + (size_t)m * D : nullptr) : (a.xout_ctx ? a.xout_ctx + (size_t)(m - S) * D : nullptr);
        if (xo) {
#pragma unroll
            for (int j = 0; j < 8; ++j) *(f32x4*)(xo + 4 * lane + 256 * j) = x[j];
        }
        if (hash) {
            float ss = 0.f;
#pragma unroll
            for (int j = 0; j < 8; ++j) ss += (x[j][0] * x[j][0] + x[j][1] * x[j][1]) + (x[j][2] * x[j][2] + x[j][3] * x[j][3]);
            const float r2 = rsq_f(wave_sum(ss) * (1.0f / D) + EPS);
            bf16_t* hr = a.h + (size_t)m * D;
#pragma unroll
            for (int j = 0; j < 8; ++j) { const f32x4 v = (x[j] * r2) * *(const f32x4*)(coef + D + 4 * lane + 256 * j) + *(const f32x4*)(coef + 2 * D + 4 * lane + 256 * j);
                u32x2 w; w[0] = cvt_pk_bf16(v[0], v[1]); w[1] = cvt_pk_bf16(v[2], v[3]); *(u32x2*)(hr + 4 * lane + 256 * j) = w; }
        }
    }
}

DEV void conv_loadz(const bf16_t* P, int t, int c, float (&z)[8]) {
    const u32x4 cg = *(const u32x4*)(P + (size_t)t * ABIN + 1024 + c), u = *(const u32x4*)(P + (size_t)t * ABIN + 2048 + c);
#pragma unroll
    for (int e = 0; e < 4; ++e) { z[2 * e] = bf_lo(cg[e]) * bf_lo(u[e]); z[2 * e + 1] = bf_hi(cg[e]) * bf_hi(u[e]); }
}
DEV void conv_task(const bf16_t* P, bf16_t* YAB, const float* convw, int task, int lane) {
    const int half = task & 1, t0 = (task >> 1) * 8, c = half * 512 + lane * 8;
    float w0[8], w1[8], w2[8], zp[8], zc[8], zn[8];
#pragma unroll
    for (int e = 0; e < 8; ++e) { w0[e] = convw[c + e]; w1[e] = convw[1024 + c + e]; w2[e] = convw[2048 + c + e]; zp[e] = 0.f; zn[e] = 0.f; }
    if (t0 != 0 && t0 != S) conv_loadz(P, t0 - 1, c, zp);
    conv_loadz(P, t0, c, zc);
    for (int i = 0; i < 8; ++i) {
        const int t = t0 + i;
        if (t != S - 1 && t != MTOK - 1) conv_loadz(P, t + 1, c, zn);
        else {
#pragma unroll
            for (int e = 0; e < 8; ++e) zn[e] = 0.f;
        }
        const u32x4 bg = *(const u32x4*)(P + (size_t)t * ABIN + c);
        float o[8];
#pragma unroll
        for (int e = 0; e < 8; ++e) { const float b = (e & 1) ? bf_hi(bg[e >> 1]) : bf_lo(bg[e >> 1]); o[e] = b * (w0[e] * zp[e] + w1[e] * zc[e] + w2[e] * zn[e]); }
        u32x4 w; w[0] = cvt_pk_bf16(o[0], o[1]); w[1] = cvt_pk_bf16(o[2], o[3]); w[2] = cvt_pk_bf16(o[4], o[5]); w[3] = cvt_pk_bf16(o[6], o[7]);
        *(u32x4*)(YAB + (size_t)t * D + c) = w;
#pragma unroll
        for (int e = 0; e < 8; ++e) { zp[e] = zc[e]; zc[e] = zn[e]; }
    }
}

DEV int chunk_row(int cidx) { return cidx < 2 ? S + 128 * cidx : 128 * (cidx - 2); }
DEV void r1_task(const bf16_t* P, float* KVt, float lg2, int cidx, int head, int dir, int quad, int lane) {
    const int i = lane & 15, g = lane >> 4;
    const int dk0 = 64 * (quad >> 1), dv0 = 64 * (quad & 1);
    const bf16_t* Kp = P + (size_t)chunk_row(cidx) * ABIN + 4096 + head * 128 + dk0 + 4 * i;
    const bf16_t* Vp = P + (size_t)chunk_row(cidx) * ABIN + 5120 + head * 128 + dv0 + 4 * i;
    f32x4 acc[4][4];
#pragma unroll
    for (int a = 0; a < 4; ++a)
#pragma unroll
        for (int b = 0; b < 4; ++b) acc[a][b] = (f32x4){0.f, 0.f, 0.f, 0.f};
    for (int s = 0; s < 4; ++s) {
        u32x2 kd[8], vd[8]; float w[8];
#pragma unroll
        for (int jj = 0; jj < 8; ++jj) {
            const int tj = 32 * s + 8 * g + jj;
            kd[jj] = *(const u32x2*)(Kp + (size_t)tj * ABIN); vd[jj] = *(const u32x2*)(Vp + (size_t)tj * ABIN);
            w[jj] = ex2(lg2 * (float)(dir == 0 ? 127 - tj : tj));
        }
        bf16x8 af[4], bfr[4];
#pragma unroll
        for (int mt = 0; mt < 4; ++mt) {
            u32x4 wd;
#pragma unroll
            for (int q = 0; q < 4; ++q) {
                const unsigned X = kd[2 * q][mt >> 1], Y = kd[2 * q + 1][mt >> 1];
                const float lo = ((mt & 1) ? bf_hi(X) : bf_lo(X)) * w[2 * q], hi = ((mt & 1) ? bf_hi(Y) : bf_lo(Y)) * w[2 * q + 1];
                wd[q] = cvt_pk_bf16(lo, hi);
            }
            af[mt] = __builtin_bit_cast(bf16x8, wd);
        }
#pragma unroll
        for (int nt = 0; nt < 4; ++nt) {
            u32x4 wd;
#pragma unroll
            for (int q = 0; q < 4; ++q) {
                const unsigned X = vd[2 * q][nt >> 1], Y = vd[2 * q + 1][nt >> 1];
                wd[q] = (nt & 1) ? ((X >> 16) | (Y & 0xffff0000u)) : ((X & 0xffffu) | (Y << 16));
            }
            bfr[nt] = __builtin_bit_cast(bf16x8, wd);
        }
#pragma unroll
        for (int mt = 0; mt < 4; ++mt)
#pragma unroll
            for (int nt = 0; nt < 4; ++nt) acc[mt][nt] = mfma16(af[mt], bfr[nt], acc[mt][nt]);
    }
    float* out = KVt + ((((size_t)cidx * 8 + head) * 2 + dir) * 128) * 128;
#pragma unroll
    for (int nt = 0; nt < 4; ++nt)
#pragma unroll
        for (int reg = 0; reg < 4; ++reg) {
            const int dv = dv0 + 4 * i + nt, dk = dk0 + 16 * g + 4 * reg;
            *(f32x4*)(out + (size_t)dv * 128 + dk) = (f32x4){acc[0][nt][reg], acc[1][nt][reg], acc[2][nt][reg], acc[3][nt][reg]};
        }
}
DEV void r2_item(const float* KVt, bf16_t* St, const float* decay_exp, int iab, int item) {
    const int hd = item >> 13, e = (item & 8191) * 2, head = hd >> 1, dir = hd & 1;
    const float cd = exp2f(128.0f * lg2gamma(decay_exp, iab, dir, head));
    float s0 = 0.f, s1 = 0.f;
#pragma unroll 6
    for (int step = 0; step < NCHUNK; ++step) {
        const int c = dir == 0 ? step : (step < 2 ? 1 - step : 67 - step);
        const size_t off = (((size_t)c * 8 + head) * 2 + dir) * 16384 + e;
        *(unsigned*)(St + off) = cvt_pk_bf16(s0, s1);
        const f32x2 kv = *(const f32x2*)(KVt + off);
        s0 = s0 * cd + kv[0]; s1 = s1 * cd + kv[1];
    }
}
DEV void r3_task(const bf16_t* P, const bf16_t* St, bf16_t* YAB, float lg2f, float lg2b, int cidx, int head, int qb, int lane) {
    const int i = lane & 15, g = lane >> 4, qi = 16 * qb + i, rowbase = chunk_row(cidx);
    const bf16_t* Prow = P + (size_t)rowbase * ABIN;
    bf16x8 qf[4];
#pragma unroll
    for (int s = 0; s < 4; ++s) qf[s] = *(const bf16x8*)(Prow + (size_t)qi * ABIN + 3072 + head * 128 + 32 * s + 8 * g);
    f32x4 sacc[8];
#pragma unroll
    for (int mt = 0; mt < 8; ++mt) {
        f32x4 a = (f32x4){0.f, 0.f, 0.f, 0.f};
#pragma unroll
        for (int s = 0; s < 4; ++s) { const bf16x8 kf = *(const bf16x8*)(Prow + (size_t)(16 * mt + i) * ABIN + 4096 + head * 128 + 32 * s + 8 * g); a = mfma16(kf, qf[s], a); }
        sacc[mt] = a;
    }
#pragma unroll
    for (int mt = 0; mt < 8; ++mt)
#pragma unroll
        for (int reg = 0; reg < 4; ++reg) {
            const int diff = qi - (16 * mt + 4 * g + reg);
            const float d = diff > 0 ? ex2((float)diff * lg2f) : (diff < 0 ? ex2((float)(-diff) * lg2b) : 2.0f);
            sacc[mt][reg] *= d;
        }
    bf16x8 pf[4];
#pragma unroll
    for (int s = 0; s < 4; ++s) {
        u32x4 w; w[0] = cvt_pk_bf16(sacc[2 * s][0], sacc[2 * s][1]); w[1] = cvt_pk_bf16(sacc[2 * s][2], sacc[2 * s][3]);
        w[2] = cvt_pk_bf16(sacc[2 * s + 1][0], sacc[2 * s + 1][1]); w[3] = cvt_pk_bf16(sacc[2 * s + 1][2], sacc[2 * s + 1][3]);
        pf[s] = __builtin_bit_cast(bf16x8, w);
    }
    f32x4 oacc[8];
#pragma unroll
    for (int mt = 0; mt < 8; ++mt) oacc[mt] = (f32x4){0.f, 0.f, 0.f, 0.f};
#pragma unroll
    for (int s = 0; s < 4; ++s) {
        u32x4 vd[8];
#pragma unroll
        for (int jj = 0; jj < 8; ++jj) { const int key = 32 * s + (jj < 4 ? 4 * g + jj : 16 + 4 * g + jj - 4); vd[jj] = *(const u32x4*)(Prow + (size_t)key * ABIN + 5120 + head * 128 + 8 * i); }
#pragma unroll
        for (int mt = 0; mt < 8; ++mt) oacc[mt] = mfma16(extract8(vd, mt), pf[s], oacc[mt]);
    }
#pragma unroll
    for (int dir = 0; dir < 2; ++dir) {
        f32x4 tacc[8];
#pragma unroll
        for (int mt = 0; mt < 8; ++mt) tacc[mt] = (f32x4){0.f, 0.f, 0.f, 0.f};
        const bf16_t* Sp = St + ((((size_t)cidx * 8 + head) * 2 + dir) * 128) * 128;
#pragma unroll
        for (int s = 0; s < 4; ++s)
#pragma unroll
            for (int mt = 0; mt < 8; ++mt) { const bf16x8 sf = *(const bf16x8*)(Sp + (size_t)(8 * i + mt) * 128 + 32 * s + 8 * g); tacc[mt] = mfma16(sf, qf[s], tacc[mt]); }
        const float qd = dir == 0 ? ex2((float)(qi + 1) * lg2f) : ex2((float)(128 - qi) * lg2b);
#pragma unroll
        for (int mt = 0; mt < 8; ++mt) oacc[mt] = oacc[mt] + tacc[mt] * qd;
    }
    float ss = 0.f;
#pragma unroll
    for (int mt = 0; mt < 8; ++mt) ss += (oacc[mt][0] * oacc[mt][0] + oacc[mt][1] * oacc[mt][1]) + (oacc[mt][2] * oacc[mt][2] + oacc[mt][3] * oacc[mt][3]);
    ss += shfl_xor_f(ss, 16); ss += shfl_xor_f(ss, 32);
    const float rinv = rsq_f(ss * (1.0f / 128.0f) + EPS);
#pragma unroll
    for (int reg = 0; reg < 4; ++reg) {
        const int dvb = 32 * g + 8 * reg;
        const u32x4 gt = *(const u32x4*)(Prow + (size_t)qi * ABIN + 6144 + head * 128 + dvb);
        float o[8];
#pragma unroll
        for (int mt = 0; mt < 8; ++mt) { const float gv = (mt & 1) ? bf_hi(gt[mt >> 1]) : bf_lo(gt[mt >> 1]); o[mt] = silu_f(gv) * (oacc[mt][reg] * rinv); }
        u32x4 w; w[0] = cvt_pk_bf16(o[0], o[1]); w[1] = cvt_pk_bf16(o[2], o[3]); w[2] = cvt_pk_bf16(o[4], o[5]); w[3] = cvt_pk_bf16(o[6], o[7]);
        *(u32x4*)(YAB + (size_t)(rowbase + qi) * D + 1024 + head * 128 + dvb) = w;
    }
}

template <bool WIN>
DEV void attn_task(const bf16_t* P, bf16_t* YAB, const float* rpb, int h, int qtok0, int r, int c0, int kc0, int lane) {
    const int i = lane & 15, g = lane >> 4, qtok = qtok0 + i;
    bf16x8 qf[4];
#pragma unroll
    for (int s = 0; s < 4; ++s) qf[s] = *(const bf16x8*)(P + (size_t)qtok * QKV + h * 128 + 32 * s + 8 * g);
    const int c = c0 + i;
    const int sr = r - 4 < 0 ? 0 : (r - 4 > 120 ? 120 : r - 4);
    const int sc = c - 8 < 0 ? 0 : (c - 8 > 48 ? 48 : c - 8);
    float m_run = -1e30f, l_run = 0.f;
    f32x4 oacc[8];
#pragma unroll
    for (int mt = 0; mt < 8; ++mt) oacc[mt] = (f32x4){0.f, 0.f, 0.f, 0.f};
    for (int b = WIN ? 0 : 8; b < 16; ++b) {
        const int kb = b < 8 ? (sr + b) * 64 + kc0 : S + 32 * (b - 8);
        f32x4 sa[2];
#pragma unroll
        for (int mt = 0; mt < 2; ++mt) {
            f32x4 a = (f32x4){0.f, 0.f, 0.f, 0.f};
#pragma unroll
            for (int s = 0; s < 4; ++s) { const bf16x8 kf = *(const bf16x8*)(P + (size_t)(kb + 16 * mt + i) * QKV + 2048 + h * 128 + 32 * s + 8 * g); a = mfma16(kf, qf[s], a); }
            sa[mt] = a;
        }
        float bm = -1e30f;
#pragma unroll
        for (int mt = 0; mt < 2; ++mt)
#pragma unroll
            for (int reg = 0; reg < 4; ++reg) {
                float v = sa[mt][reg] * HSCALE;
                if (WIN && b < 8) {
                    const int kcol = kc0 + 16 * mt + 4 * g + reg;
                    const bool valid = kcol >= sc && kcol < sc + 16;
                    const int dc = valid ? kcol - c + 15 : 0;
                    const float bias = rpb[(h * 15 + (sr + b - r + 7)) * 31 + dc];
                    v = valid ? v + bias : -1e30f;
                }
                sa[mt][reg] = v; bm = fmaxf(bm, v);
            }
        bm = fmaxf(bm, shfl_xor_f(bm, 16)); bm = fmaxf(bm, shfl_xor_f(bm, 32));
        const float m_new = fmaxf(m_run, bm);
        const float alpha = ex2((m_run - m_new) * LOG2E);
        m_run = m_new;
        float ps = 0.f;
#pragma unroll
        for (int mt = 0; mt < 2; ++mt)
#pragma unroll
            for (int reg = 0; reg < 4; ++reg) { const float pv = ex2((sa[mt][reg] - m_new) * LOG2E); sa[mt][reg] = pv; ps += pv; }
        l_run = l_run * alpha + ps;
#pragma unroll
        for (int mt = 0; mt < 8; ++mt) oacc[mt] = oacc[mt] * alpha;
        u32x4 pw; pw[0] = cvt_pk_bf16(sa[0][0], sa[0][1]); pw[1] = cvt_pk_bf16(sa[0][2], sa[0][3]); pw[2] = cvt_pk_bf16(sa[1][0], sa[1][1]); pw[3] = cvt_pk_bf16(sa[1][2], sa[1][3]);
        const bf16x8 pf = __builtin_bit_cast(bf16x8, pw);
        u32x4 vd[8];
#pragma unroll
        for (int jj = 0; jj < 8; ++jj) { const int key = kb + (jj < 4 ? 4 * g + jj : 16 + 4 * g + jj - 4); vd[jj] = *(const u32x4*)(P + (size_t)key * QKV + 4096 + h * 128 + 8 * i); }
#pragma unroll
        for (int mt = 0; mt < 8; ++mt) oacc[mt] = mfma16(extract8(vd, mt), pf, oacc[mt]);
    }
    l_run += shfl_xor_f(l_run, 16); l_run += shfl_xor_f(l_run, 32);
    const float inv = 1.0f / l_run;
#pragma unroll
    for (int reg = 0; reg < 4; ++reg) {
        const int dvb = 32 * g + 8 * reg;
        u32x4 w;
#pragma unroll
        for (int q = 0; q < 4; ++q) w[q] = cvt_pk_bf16(oacc[2 * q][reg] * inv, oacc[2 * q + 1][reg] * inv);
        *(u32x4*)(YAB + (size_t)qtok * D + h * 128 + dvb) = w;
    }
}

struct Unit { int pm, pn, ks, nt, kofs; };
struct EpiF32 {
    static constexpr bool PERM = false, AFTER_DRAIN = false;
    float* C; int ldc; float* Cpart;
    DEV void operator()(const f32x4 (&acc)[2][2][4][2], const Unit& u, int wr, int wc, int fr, int fq) const {
        const int row0 = (u.ks >= 0 ? 0 : u.pm * 256) + wr * 64 + fr, col0 = u.pn * 256 + wc * 32 + 4 * fq;
        float* base = u.ks >= 0 ? Cpart + (size_t)u.ks * 256 * ldc : C;
#pragma unroll
        for (int ai = 0; ai < 2; ++ai)
#pragma unroll
            for (int m = 0; m < 4; ++m) { float* rowp = base + (size_t)(row0 + ai * 128 + m * 16) * ldc + col0;
#pragma unroll
                for (int bj = 0; bj < 2; ++bj)
#pragma unroll
                    for (int n = 0; n < 2; ++n) *(f32x4*)(rowp + bj * 128 + n * 16) = acc[ai][bj][m][n]; }
    }
};
struct EpiBf16 {
    static constexpr bool PERM = true, AFTER_DRAIN = false;
    bf16_t* O; int ldc;
    DEV void operator()(const f32x4 (&acc)[2][2][4][2], const Unit& u, int wr, int wc, int fr, int fq) const {
        const int row0 = u.pm * 256 + wr * 64 + fr, col0 = u.pn * 256 + wc * 32 + 8 * fq;
#pragma unroll
        for (int ai = 0; ai < 2; ++ai)
#pragma unroll
            for (int m = 0; m < 4; ++m) { bf16_t* rowp = O + (size_t)(row0 + ai * 128 + m * 16) * ldc + col0;
#pragma unroll
                for (int bj = 0; bj < 2; ++bj) { const f32x4 v0 = acc[ai][bj][m][0], v1 = acc[ai][bj][m][1];
                    u32x4 w; w[0] = cvt_pk_bf16(v0[0], v0[1]); w[1] = cvt_pk_bf16(v0[2], v0[3]); w[2] = cvt_pk_bf16(v1[0], v1[1]); w[3] = cvt_pk_bf16(v1[2], v1[3]);
                    *(u32x4*)(rowp + bj * 128) = w; } }
    }
};
struct EpiInProj {
    static constexpr bool PERM = true, AFTER_DRAIN = false;
    bf16_t* O; const f32x2* rope;
    DEV void operator()(const f32x4 (&acc)[2][2][4][2], const Unit& u, int wr, int wc, int fr, int fq) const {
        const int row0 = u.pm * 256 + wr * 64 + fr, col0 = u.pn * 256 + wc * 32 + 8 * fq;
        const bool isk = u.pn >= 16 && u.pn < 20, isq = u.pn >= 12 && u.pn < 16, dorope = (isq || isk) && u.pm < 32;
        const float sc = isk ? HSCALE : 1.0f;
#pragma unroll
        for (int ai = 0; ai < 2; ++ai)
#pragma unroll
            for (int m = 0; m < 4; ++m) { const int row = row0 + ai * 128 + m * 16; bf16_t* rowp = O + (size_t)row * ABIN + col0;
                f32x4 cs01 = (f32x4){1.f, 0.f, 1.f, 0.f}, cs23 = cs01, cs45 = cs01, cs67 = cs01;
                if (dorope) { const int pidx = (wc < 2) ? (row >> 6) : 128 + (row & 63); const f32x2* tp = rope + pidx * 32 + 16 * (wc & 1) + 4 * fq;
                    const f32x4 t0 = *(const f32x4*)tp, t1 = *(const f32x4*)(tp + 2); cs01 = t0; cs23 = t0; cs45 = t1; cs67 = t1; }
#pragma unroll
                for (int bj = 0; bj < 2; ++bj) { f32x4 v0 = acc[ai][bj][m][0], v1 = acc[ai][bj][m][1];
                    if (dorope) {
                        const f32x4 a0 = v0, a1 = v1;
                        v0[0] = a0[0] * cs01[0] - a0[1] * cs01[1]; v0[1] = a0[0] * cs01[1] + a0[1] * cs01[0];
                        v0[2] = a0[2] * cs23[2] - a0[3] * cs23[3]; v0[3] = a0[2] * cs23[3] + a0[3] * cs23[2];
                        v1[0] = a1[0] * cs45[0] - a1[1] * cs45[1]; v1[1] = a1[0] * cs45[1] + a1[1] * cs45[0];
                        v1[2] = a1[2] * cs67[2] - a1[3] * cs67[3]; v1[3] = a1[2] * cs67[3] + a1[3] * cs67[2];
                    }
                    v0 = v0 * sc; v1 = v1 * sc;
                    u32x4 w; w[0] = cvt_pk_bf16(v0[0], v0[1]); w[1] = cvt_pk_bf16(v0[2], v0[3]); w[2] = cvt_pk_bf16(v1[0], v1[1]); w[3] = cvt_pk_bf16(v1[2], v1[3]);
                    *(u32x4*)(rowp + bj * 128) = w; } }
    }
};
struct EpiSwiglu {
    static constexpr bool PERM = true, AFTER_DRAIN = false;
    bf16_t* O;
    DEV void operator()(const f32x4 (&acc)[2][2][4][2], const Unit& u, int wr, int wc, int fr, int fq) const {
        const int row0 = u.pm * 256 + wr * 64 + fr, col0 = u.pn * 128 + wc * 32 + 8 * fq;
#pragma unroll
        for (int ai = 0; ai < 2; ++ai)
#pragma unroll
            for (int m = 0; m < 4; ++m) { bf16_t* rowp = O + (size_t)(row0 + ai * 128 + m * 16) * FFH + col0;
                const f32x4 g0 = acc[ai][0][m][0], g1 = acc[ai][0][m][1], u0 = acc[ai][1][m][0], u1 = acc[ai][1][m][1];
                u32x4 w; w[0] = cvt_pk_bf16(silu_f(g0[0]) * u0[0], silu_f(g0[1]) * u0[1]); w[1] = cvt_pk_bf16(silu_f(g0[2]) * u0[2], silu_f(g0[3]) * u0[3]);
                w[2] = cvt_pk_bf16(silu_f(g1[0]) * u1[0], silu_f(g1[1]) * u1[1]); w[3] = cvt_pk_bf16(silu_f(g1[2]) * u1[2], silu_f(g1[3]) * u1[3]);
                *(u32x4*)rowp = w; }
    }
};

#ifndef HOST_EMU
namespace pg8 {
#define PG8_LAS __attribute__((address_space(3)))
constexpr int BM = 256, BK = 64, HALF = 128, HTB = HALF * BK * 2, STAGE_BYTES = 8 * HTB, NXCD = 8, WGM = 8;
__host__ __device__ __forceinline__ int lds_byte(int r, int c) { const int st = (r >> 4) * 2 + (c >> 5), rr = r & 15, cc = c & 31, ob = rr * 64 + cc * 2; return st * 1024 + (ob ^ (((ob >> 9) & 1) << 5)); }
__host__ __device__ __forceinline__ void stage_rc(int b, int& R, int& C) { const int st = b / 1024, sb = b % 1024, swz = sb ^ (((sb >> 9) & 1) << 5); R = (st >> 1) * 16 + swz / 64; C = (st & 1) * 32 + (swz % 64) / 2; }
__host__ __device__ __forceinline__ int perm32(int rho) { const int n = rho >> 4, i = rho & 15; return 8 * (i >> 2) + 4 * n + (i & 3); }
struct Gemm { const bf16_t* A; const bf16_t* Bt; int M, N, K; };
struct StaticOrder {
    int nM, nN, nwg, G, c, ntK;
    __host__ __device__ void init(int M, int N, int K, int G_, int c_) { nM = M / BM; nN = N / BM; nwg = nM * nN; G = G_; c = c_; ntK = K / BK; }
    __host__ __device__ void map(int wgid, Unit& u) const {
        { const int q = nwg / NXCD, r = nwg % NXCD, xcd = wgid % NXCD, off = wgid / NXCD; wgid = (xcd < r ? xcd * (q + 1) : r * (q + 1) + (xcd - r) * q) + off; }
        const int nig = WGM * nN, gid = wgid / nig, fm = gid * WGM, gsz = (nM - fm) < WGM ? (nM - fm) : WGM;
        u.pm = fm + ((wgid % nig) % gsz); u.pn = (wgid % nig) / gsz; u.ks = -1; u.nt = ntK; u.kofs = 0;
    }
    __host__ __device__ bool next(int i, Unit& u) const { const long L = (long)i * G + c; if (L >= nwg) return false; map((int)L, u); return true; }
    __device__ __forceinline__ void a_ready(const Unit&) const {}
    __device__ __forceinline__ void done(const Unit&) const {}
};
struct MixedOrder {
    StaticOrder base; int nsplit, pmx, ntS, nNx;
    __host__ __device__ void init(int M, int N, int K, int G_, int c_, int pmx_, int nsplit_) { base.init(M, N, K, G_, c_); pmx = pmx_; nsplit = nsplit_; ntS = nsplit_ ? (K / BK) / nsplit_ : 0; nNx = N / BM; }
    __host__ __device__ bool next(int i, Unit& u) const {
        const long L = (long)i * base.G + base.c;
        if (L < base.nwg) { base.map((int)L, u); return true; }
        const long L2 = L - base.nwg; if (L2 >= (long)nsplit * nNx) return false;
        u.pm = pmx; u.pn = (int)(L2 % nNx); u.ks = (int)(L2 / nNx); u.nt = ntS; u.kofs = u.ks * ntS * BK * 2; return true;
    }
    __device__ __forceinline__ void a_ready(const Unit&) const {}
    __device__ __forceinline__ void done(const Unit&) const {}
};
template <class Epi, class Sched, bool ALIGN_EPI = false, bool SP2 = false>
__device__ __forceinline__ void gemm_phase(PG8_LAS unsigned char* lds, const Gemm g, const Sched& S, const Epi& E, const int tid) {
    const int wid = __builtin_amdgcn_readfirstlane(tid >> 6), lane = tid & 63, wr = wid >> 2, wc = wid & 3, fr = lane & 15, fq = lane >> 4;
    const int K = g.K;
    unsigned voffA[2], voffB[2];
#pragma unroll
    for (int i = 0; i < 2; ++i) { int R, C; stage_rc(tid * 16 + i * 8192, R, C); const int Rb = Epi::PERM ? ((R & ~31) + perm32(R & 31)) : R;
        voffA[i] = (unsigned)(R * K + C) * 2u; voffB[i] = (unsigned)(Rb * K + C) * 2u; }
    const size_t kstep = (size_t)(BK * 2);
    const size_t hstep = (size_t)HALF * K * 2;
    const size_t tstep = 2 * hstep;
    const unsigned ldsw = (unsigned)wid * 1024u;
    const int aoff = lds_byte(wr * 64 + fr, fq * 8), boff = lds_byte(wc * 32 + fr, fq * 8);
#define PG8_SA(b, h) (((b) * 2 + (h)) * HTB)
#define PG8_SB(b, h) ((4 + (b) * 2 + (h)) * HTB)
#define PG8_STAGE(bufoff, gbase, voff) do { _Pragma("unroll") for (int _i = 0; _i < 2; ++_i) \
        __builtin_amdgcn_global_load_lds((const unsigned*)((const char*)(gbase) + (voff)[_i]), (PG8_LAS unsigned*)(lds + (bufoff) + ldsw + _i * 8192), 16, 0, 0); } while (0)
#define PG8_LDA(dst, b, h) do { _Pragma("unroll") for (int m = 0; m < 4; ++m) _Pragma("unroll") for (int k = 0; k < 2; ++k) dst[m][k] = *(const PG8_LAS bf16x8*)(lds + PG8_SA(b, h) + aoff + m * 2048 + k * 1024); } while (0)
#define PG8_LDB(dst, b, h) do { _Pragma("unroll") for (int n = 0; n < 2; ++n) _Pragma("unroll") for (int k = 0; k < 2; ++k) dst[n][k] = *(const PG8_LAS bf16x8*)(lds + PG8_SB(b, h) + boff + n * 2048 + k * 1024); } while (0)
#define PG8_MMA(ai, bj, At, Bt) do { __builtin_amdgcn_s_setprio(1); _Pragma("unroll") for (int m = 0; m < 4; ++m) _Pragma("unroll") for (int n = 0; n < 2; ++n) _Pragma("unroll") for (int k = 0; k < 2; ++k) \
        acc[ai][bj][m][n] = __builtin_amdgcn_mfma_f32_16x16x32_bf16(Bt[n][k], At[m][k], acc[ai][bj][m][n], 0, 0, 0); __builtin_amdgcn_s_setprio(0); } while (0)
#define PG8_WAIT_V(n) asm volatile("s_waitcnt vmcnt(" #n ")" ::: "memory")
#define PG8_WAIT_L(n) asm volatile("s_waitcnt lgkmcnt(" #n ")" ::: "memory")
#define PG8_BAR __builtin_amdgcn_s_barrier()
#define PG8_SCHED __builtin_amdgcn_sched_barrier(0)
    Unit cur, nxt; int ui = 0;
    if (!S.next(0, cur)) return;
    f32x4 acc[2][2][4][2];
#pragma unroll
    for (int a = 0; a < 2; ++a)
#pragma unroll
        for (int b = 0; b < 2; ++b)
#pragma unroll
            for (int m = 0; m < 4; ++m)
#pragma unroll
                for (int n = 0; n < 2; ++n) acc[a][b][m][n] = (f32x4){0.f, 0.f, 0.f, 0.f};
    bf16x8 At[4][2], B0[2][2], B1[2][2];
    const char* cA = (const char*)g.A + (size_t)cur.pm * tstep + cur.kofs; const char* cB = (const char*)g.Bt + (size_t)cur.pn * tstep + cur.kofs;
    S.a_ready(cur);
    if constexpr (SP2) {
        PG8_STAGE(PG8_SB(0, 0), cB, voffB); PG8_STAGE(PG8_SB(0, 1), cB + hstep, voffB); PG8_STAGE(PG8_SA(0, 0), cA, voffA); PG8_STAGE(PG8_SA(0, 1), cA + hstep, voffA);
        if (wr == 1) PG8_BAR;
        PG8_WAIT_V(2); PG8_BAR;
        PG8_STAGE(PG8_SB(1, 0), cB + kstep, voffB); PG8_STAGE(PG8_SA(1, 0), cA + kstep, voffA); PG8_STAGE(PG8_SB(1, 1), cB + hstep + kstep, voffB);
        PG8_WAIT_V(6); PG8_BAR;
    } else {
        PG8_STAGE(PG8_SB(0, 0), cB, voffB); PG8_STAGE(PG8_SA(0, 0), cA, voffA); PG8_STAGE(PG8_SB(0, 1), cB + hstep, voffB); PG8_STAGE(PG8_SA(0, 1), cA + hstep, voffA);
        if (wr == 1) PG8_BAR;
        PG8_WAIT_V(4); PG8_BAR;
        PG8_STAGE(PG8_SB(1, 0), cB + kstep, voffB); PG8_STAGE(PG8_SA(1, 0), cA + kstep, voffA); PG8_STAGE(PG8_SB(1, 1), cB + hstep + kstep, voffB);
        PG8_WAIT_V(6); PG8_BAR;
    }
    for (;;) {
        const bool has_next = S.next(ui + 1, nxt);
        const char* nA = has_next ? (const char*)g.A + (size_t)nxt.pm * tstep + nxt.kofs : cA; const char* nB = has_next ? (const char*)g.Bt + (size_t)nxt.pn * tstep + nxt.kofs : cB;
        const int nt = cur.nt;
        for (int t = 0; t < nt; t += 2) {
            const bool last = (t == nt - 2);
            const char* a1 = cA + (size_t)(t + 1) * kstep;
            const char* a2 = last ? nA : cA + (size_t)(t + 2) * kstep; const char* b2 = last ? nB : cB + (size_t)(t + 2) * kstep;
            const char* a3 = a2 + kstep; const char* b3 = b2 + kstep;
            if (last && has_next) S.a_ready(nxt);
            if constexpr (SP2) {
            PG8_LDB(B0, 0, 0); PG8_LDB(B1, 0, 1); PG8_SCHED; PG8_LDA(At, 0, 0); PG8_STAGE(PG8_SA(1, 1), a1 + hstep, voffA);
            PG8_WAIT_V(8); PG8_WAIT_L(0); PG8_BAR; PG8_MMA(0, 0, At, B0); PG8_MMA(0, 1, At, B1); PG8_BAR; PG8_SCHED;
            PG8_LDA(At, 0, 1); PG8_STAGE(PG8_SB(0, 0), b2, voffB); PG8_STAGE(PG8_SB(0, 1), b2 + hstep, voffB); PG8_STAGE(PG8_SA(0, 0), a2, voffA);
            PG8_WAIT_V(8); PG8_WAIT_L(0); PG8_BAR; PG8_MMA(1, 0, At, B0); PG8_MMA(1, 1, At, B1); PG8_BAR; PG8_SCHED;
            PG8_LDB(B0, 1, 0); PG8_LDB(B1, 1, 1); PG8_SCHED; PG8_LDA(At, 1, 0); PG8_STAGE(PG8_SA(0, 1), a2 + hstep, voffA);
            PG8_WAIT_V(8); PG8_WAIT_L(0); PG8_BAR; PG8_MMA(0, 0, At, B0); PG8_MMA(0, 1, At, B1); PG8_BAR; PG8_SCHED;
            PG8_LDA(At, 1, 1); PG8_STAGE(PG8_SB(1, 0), b3, voffB); PG8_STAGE(PG8_SB(1, 1), b3 + hstep, voffB); PG8_STAGE(PG8_SA(1, 0), a3, voffA);
            PG8_WAIT_V(8); PG8_WAIT_L(0); PG8_BAR; PG8_MMA(1, 0, At, B0); PG8_MMA(1, 1, At, B1); PG8_BAR; PG8_SCHED;
            } else {
            PG8_LDB(B0, 0, 0); PG8_SCHED; PG8_LDA(At, 0, 0); PG8_STAGE(PG8_SA(1, 1), a1 + hstep, voffA);
            PG8_WAIT_L(8); PG8_BAR; PG8_WAIT_L(0); PG8_MMA(0, 0, At, B0); PG8_BAR; PG8_SCHED;
            PG8_LDB(B1, 0, 1); PG8_STAGE(PG8_SB(0, 0), b2, voffB);
            PG8_BAR; PG8_WAIT_L(0); PG8_MMA(0, 1, At, B1); PG8_BAR;
            PG8_LDA(At, 0, 1); PG8_STAGE(PG8_SA(0, 0), a2, voffA);
            PG8_BAR; PG8_WAIT_L(0); PG8_MMA(1, 0, At, B0); PG8_BAR; PG8_SCHED;
            PG8_STAGE(PG8_SB(0, 1), b2 + hstep, voffB);
            PG8_WAIT_V(6); PG8_BAR; PG8_MMA(1, 1, At, B1); PG8_BAR;
            PG8_LDB(B0, 1, 0); PG8_SCHED; PG8_LDA(At, 1, 0); PG8_STAGE(PG8_SA(0, 1), a2 + hstep, voffA);
            PG8_WAIT_L(8); PG8_BAR; PG8_WAIT_L(0); PG8_MMA(0, 0, At, B0); PG8_BAR; PG8_SCHED;
            PG8_LDB(B1, 1, 1); PG8_STAGE(PG8_SB(1, 0), b3, voffB);
            PG8_BAR; PG8_WAIT_L(0); PG8_MMA(0, 1, At, B1); PG8_BAR;
            PG8_LDA(At, 1, 1); PG8_STAGE(PG8_SA(1, 0), a3, voffA);
            PG8_BAR; PG8_WAIT_L(0); PG8_MMA(1, 0, At, B0); PG8_BAR; PG8_SCHED;
            PG8_STAGE(PG8_SB(1, 1), b3 + hstep, voffB);
            PG8_WAIT_V(6); PG8_BAR; PG8_MMA(1, 1, At, B1); PG8_BAR;
            }
        }
        if constexpr (ALIGN_EPI) { if (wr == 0) PG8_BAR; }
        if constexpr (!Epi::AFTER_DRAIN) { E(acc, cur, wr, wc, fr, fq); S.done(cur); }
        if (!has_next) break;
#pragma unroll
        for (int a = 0; a < 2; ++a)
#pragma unroll
            for (int b = 0; b < 2; ++b)
#pragma unroll
                for (int m = 0; m < 4; ++m)
#pragma unroll
                    for (int n = 0; n < 2; ++n) acc[a][b][m][n] = (f32x4){0.f, 0.f, 0.f, 0.f};
        cur = nxt; cA = nA; cB = nB; ++ui;
        if constexpr (ALIGN_EPI) { if (wr == 1) PG8_BAR; }
    }
    PG8_WAIT_V(0);
    if constexpr (!ALIGN_EPI) { if (wr == 0) PG8_BAR; }
    PG8_BAR;
#undef PG8_SA
#undef PG8_SB
#undef PG8_STAGE
#undef PG8_LDA
#undef PG8_LDB
#undef PG8_MMA
#undef PG8_WAIT_V
#undef PG8_WAIT_L
#undef PG8_BAR
#undef PG8_SCHED
}
}
#ifndef PG8_SP2
#define PG8_SP2 true
#endif
#ifndef PG8_ALIGN
#define PG8_ALIGN true
#endif

#define XB_TMO      128
#define XB_XCNT(j)  (256  + 64 * (j))
#define XB_XSUB(j)  (1280 + 64 * (j))
#define XB_XGEN(j)  (2304 + 64 * (j))
#define XB_TOP      3328
#define XB_TOPGEN   3392
#define XCD_BAR_WORDS 3456
#define XB_SPIN_CAP (1u << 18)
__device__ __forceinline__ unsigned xb_ld(unsigned* p)              { return __hip_atomic_load(p, __ATOMIC_RELAXED, __HIP_MEMORY_SCOPE_AGENT); }
__device__ __forceinline__ unsigned xb_add(unsigned* p, unsigned v) { return __hip_atomic_fetch_add(p, v, __ATOMIC_RELAXED, __HIP_MEMORY_SCOPE_AGENT); }
__device__ __forceinline__ unsigned xb_xcc_id() { return (unsigned)__builtin_amdgcn_s_getreg((3 << 11) | 20) & 0xFu; }
#define XB_SPIN(cond, bar) do { unsigned _sp = 0; while (cond) { __builtin_amdgcn_s_sleep(1); \
    if ((++_sp & 255u) == 0u) { if (xb_ld(&(bar)[XB_TMO])) break; if (_sp > XB_SPIN_CAP) { atomicAdd(&(bar)[XB_TMO], 1u); break; } } } } while (0)
struct XcdBarrier { unsigned* bar; unsigned x; volatile LAS unsigned* st; };
__device__ __forceinline__ XcdBarrier xcd_barrier_post(unsigned* bar, volatile LAS unsigned* st) {
    XcdBarrier b; b.bar = bar; b.x = xb_xcc_id(); b.st = st;
    if (threadIdx.x == 0) (void)xb_add(&bar[XB_XCNT(b.x)], 1u);
    return b;
}
__device__ __forceinline__ void xcd_barrier_complete(unsigned* bar, unsigned x, unsigned& nloc, unsigned& nx) {
    const unsigned G = gridDim.x * gridDim.y * gridDim.z;
    unsigned sum, cnt, mine, sp = 0u;
    for (;;) {
        sum = 0u; cnt = 0u; mine = 0u;
#pragma unroll
        for (unsigned j = 0; j < 16; ++j) { const unsigned c = xb_ld(&bar[XB_XCNT(j)]); sum += c; cnt += (c > 0u) ? 1u : 0u; mine = (j == x) ? c : mine; }
        if (sum == G) break;
        __builtin_amdgcn_s_sleep(1);
        if ((++sp & 255u) == 0u) { if (xb_ld(&bar[XB_TMO])) break; if (sp > XB_SPIN_CAP) { atomicAdd(&bar[XB_TMO], 1u); break; } }
    }
    nloc = mine > 0u ? mine : 1u; nx = cnt > 0u ? cnt : 1u;
}
__device__ __forceinline__ void xcd_barrier(const XcdBarrier& b) {
    asm volatile("s_waitcnt vmcnt(0)" ::: "memory");
    __syncthreads();
    if (threadIdx.x == 0) {
        unsigned* bar = b.bar;
        __builtin_amdgcn_s_waitcnt(0);
        unsigned nloc = b.st[0], nx = b.st[1];
        if (nloc == 0u) { xcd_barrier_complete(bar, b.x, nloc, nx); b.st[0] = nloc; b.st[1] = nx; }
        const unsigned old = xb_add(&bar[XB_XSUB(b.x)], 1u);
        const unsigned gen = old / nloc;
        if (old + 1u == (gen + 1u) * nloc) {
            __builtin_amdgcn_fence(__ATOMIC_RELEASE, "agent");
            asm volatile("s_waitcnt vmcnt(0)" ::: "memory");
            const unsigned og = xb_add(&bar[XB_TOP], 1u);
            const unsigned tg = og / nx;
            if (og + 1u == (tg + 1u) * nx) xb_add(&bar[XB_TOPGEN], 1u);
            else XB_SPIN(xb_ld(&bar[XB_TOPGEN]) == tg, bar);
            __builtin_amdgcn_fence(__ATOMIC_ACQUIRE, "agent");
            xb_add(&bar[XB_XGEN(b.x)], 1u);
            asm volatile("s_waitcnt vmcnt(0)" ::: "memory");
        } else {
            XB_SPIN(xb_ld(&bar[XB_XGEN(b.x)]) == gen, bar);
            __builtin_amdgcn_fence(__ATOMIC_ACQUIRE, "agent");
            asm volatile("s_waitcnt vmcnt(0)" ::: "memory");
        }
    }
    __syncthreads();
}

constexpr size_t al256(size_t x) { return (x + 255) & ~(size_t)255; }
constexpr size_t WS_CTL = 0;
constexpr size_t CTL_ZERO_BYTES = 65536;
constexpr size_t WS_MODACC = 4u << 20;
constexpr size_t WS_ROPE = 1u << 20;
constexpr size_t WS_WABIN = 8u << 20;
constexpr size_t SZ_WABIN = (size_t)ABIN * D * 2;
constexpr size_t WS_WABOUT = WS_WABIN + 2 * SZ_WABIN;
constexpr size_t SZ_WSQ = (size_t)D * D * 2;
constexpr size_t WS_WQKV = WS_WABOUT + 2 * SZ_WSQ;
constexpr size_t SZ_WQKV = (size_t)QKV * D * 2;
constexpr size_t WS_WNAOUT = WS_WQKV + 2 * SZ_WQKV;
constexpr size_t WS_WFFIN = WS_WNAOUT + 2 * SZ_WSQ;
constexpr size_t SZ_WFFIN = (size_t)FF2 * D * 2;
constexpr size_t WS_WFFOUT = WS_WFFIN + 4 * SZ_WFFIN;
constexpr size_t SZ_WFFOUT = (size_t)D * FFH * 2;
constexpr size_t WS_X = WS_WFFOUT + 4 * SZ_WFFOUT;
constexpr size_t WS_H = WS_X + (size_t)MTOK * D * 4;
constexpr size_t WS_P = WS_H + (size_t)MTOK * D * 2;
constexpr size_t WS_YAB = WS_P + (size_t)MTOK * ABIN * 2;
constexpr size_t WS_Y = WS_YAB + (size_t)MTOK * D * 2;
constexpr size_t WS_HID = WS_Y + (size_t)MTOK * D * 4;
constexpr size_t WS_KVT = WS_HID + (size_t)MTOK * FFH * 2;
constexpr size_t WS_ST = WS_KVT + (size_t)NCHUNK * 16 * 16384 * 4;
constexpr size_t WS_YC = WS_ST + (size_t)NCHUNK * 16 * 16384 * 2;
constexpr size_t WS_END = WS_YC + (size_t)22 * 256 * D * 4;
constexpr int NSPLIT_OUT = 8, NSPLIT_FFO = 22;
static_assert(WS_WABIN % 256 == 0 && WS_X % 256 == 0 && WS_P % 256 == 0 && WS_KVT % 256 == 0 && WS_ST % 256 == 0, "ws alignment");

constexpr int RING_BYTES = 131072, LDSCTL_OFF = RING_BYTES, MISC_OFF = LDSCTL_OFF + 320, LDS_BYTES = 147456;
constexpr int NPHASE = 2 + 9 * DEPTH;

struct Params { const float* in[16]; float* out; unsigned char* ws; int ph_lo, ph_hi, li, pad; };

__device__ __forceinline__ void transpose_item(const float* W, int ldw, int K, bf16_t* Wt, int k0, int n0s, int n0d, LAS float* scr, int lane) {
#pragma unroll 8
    for (int i = 0; i < 32; ++i) { const int kk = 2 * i + (lane >> 5); scr[kk * 33 + (lane & 31)] = W[(size_t)(k0 + kk) * ldw + n0s + (lane & 31)]; }
    asm volatile("s_waitcnt lgkmcnt(0)" ::: "memory");
    const int c = lane & 7;
#pragma unroll
    for (int j = 0; j < 4; ++j) { const int n = (lane >> 3) + 8 * j; const LAS float* s = scr + (8 * c) * 33 + n;
        u32x4 o; o[0] = cvt_pk_bf16(s[0 * 33], s[1 * 33]); o[1] = cvt_pk_bf16(s[2 * 33], s[3 * 33]); o[2] = cvt_pk_bf16(s[4 * 33], s[5 * 33]); o[3] = cvt_pk_bf16(s[6 * 33], s[7 * 33]);
        *(u32x4*)(Wt + (size_t)(n0d + n) * K + k0 + 8 * c) = o; }
    asm volatile("s_waitcnt lgkmcnt(0)" ::: "memory");
}
__device__ __forceinline__ void transpose_matrix_item(const float* W, int K, int N, bf16_t* Wt, bool ffperm, int item, LAS float* scr, int lane) {
    const int nblk = N / 32, kb = item / nblk, nb = item % nblk, n0d = 32 * nb;
    int n0s = n0d;
    if (ffperm) { const int t = n0d >> 8, j = n0d & 255; n0s = j < 128 ? 128 * t + j : FFH + 128 * t + (j - 128); }
    transpose_item(W, N, K, Wt, 64 * kb, n0s, n0d, scr, lane);
}

__global__ void __launch_bounds__(512, 2) mega_fwd(Params p) {
    extern __shared__ __attribute__((aligned(16))) unsigned char lds_raw[];
    LAS unsigned char* lds = (LAS unsigned char*)lds_raw;
    const int G = gridDim.x, bx = blockIdx.x, NGW = G * 8;
#define SITE_COORDS int tid = threadIdx.x; asm volatile("" : "+v"(tid)); const int lane = tid & 63, wave = __builtin_amdgcn_readfirstlane(tid >> 6); \
    const int vcu = (G % 8 == 0) ? (bx % 8) * (G / 8) + bx / 8 : bx; const int gw = vcu * 8 + wave; (void)lane; (void)gw; (void)vcu
    unsigned char* ws = p.ws;
    volatile LAS unsigned* MISC = (volatile LAS unsigned*)(lds + MISC_OFF);
    { const int tid = threadIdx.x; for (int u = tid; u < (LDS_BYTES - LDSCTL_OFF) / 4; u += 512) ((LAS unsigned*)(lds + LDSCTL_OFF))[u] = 0u; }
    __syncthreads();
    const int lo = p.ph_lo, hi = p.ph_hi;
    const bool multi = (hi - lo) > 1;
    XcdBarrier bar; bar.bar = (unsigned*)(ws + WS_CTL) + p.li * 4096; bar.x = 0; bar.st = nullptr;
    if (multi) bar = xcd_barrier_post((unsigned*)(ws + WS_CTL) + p.li * 4096, MISC + 8);
#ifndef SITE_MASK
#define SITE_MASK 0xffff
#endif
#define EN(i) (((SITE_MASK) >> (i)) & 1)
#ifndef REPEAT_MASK
#define REPEAT_MASK 0
#endif
    int rmask_ = REPEAT_MASK; asm volatile("" : "+s"(rmask_));
#define REP(i) ((rmask_ >> (i)) & 1)
#define IN(k) (lo <= (k) && (k) < hi)
#define ROWOP_RUN(a0) do { RowopArgs ra_ = (a0); if (rep_ + 1 < nrep_) { ra_.xout_lat = (float*)(ws + WS_END); ra_.xout_ctx = ra_.xout_lat + (size_t)S * D; ra_.h = (bf16_t*)(ws + WS_END + (size_t)MTOK * D * 4); } LAS float* cf0 = (LAS float*)lds; LAS float* cf1 = (LAS float*)(lds + 24576); \
        rowop_coefs(ra_, 0, cf0, tid); if (ra_.nctx) rowop_coefs(ra_, 1, cf1, tid); __syncthreads(); \
        rowop_stream(ra_, 0, cf0, 0, S, gw, NGW, lane); if (ra_.nctx) rowop_stream(ra_, 1, cf1, S, S + ra_.nctx, gw, NGW, lane); __syncthreads(); } while (0)
#ifndef DOUBLE_BAR
#define DOUBLE_BAR 0
#endif
#define SEAM(k, knext) do { if (IN(k) && IN(knext)) { xcd_barrier(bar); if (DOUBLE_BAR) xcd_barrier(bar); } } while (0)

    const float* x_in = p.in[0]; const float* c_in = p.in[1]; const float* ctx_in = p.in[2]; const float* cctx_in = p.in[3];
    const float* ada_w = p.in[4]; const float* ada_b = p.in[5]; const float* norm_g = p.in[6];
    const float* ab_w_in = p.in[7]; const float* ab_conv_w = p.in[8]; const float* ab_decay = p.in[9]; const float* ab_w_out = p.in[10];
    const float* na_w_qkv = p.in[11]; const float* na_rpb = p.in[12]; const float* na_w_out = p.in[13];
    const float* ffn_w_in = p.in[14]; const float* ffn_w_out = p.in[15];
    float* modacc = (float*)(ws + WS_MODACC);
    f32x2* rope = (f32x2*)(ws + WS_ROPE);
    float* X = (float*)(ws + WS_X); bf16_t* H = (bf16_t*)(ws + WS_H); bf16_t* P = (bf16_t*)(ws + WS_P); bf16_t* YAB = (bf16_t*)(ws + WS_YAB);
    float* Y = (float*)(ws + WS_Y); bf16_t* HID = (bf16_t*)(ws + WS_HID); float* KVT = (float*)(ws + WS_KVT); bf16_t* ST = (bf16_t*)(ws + WS_ST); float* YC = (float*)(ws + WS_YC);

    for (int nrep_ = 1 + REP(0), rep_ = 0; rep_ < nrep_; ++rep_) if (EN(0) && IN(0)) {
        SITE_COORDS;
        LAS float* scr = (LAS float*)(lds + wave * 16384);
        constexpr int I_ABIN = (D / 64) * (ABIN / 32), I_SQ = (D / 64) * (D / 32), I_QKV = (D / 64) * (QKV / 32), I_FFIN = (D / 64) * (FF2 / 32), I_FFOUT = (FFH / 64) * (D / 32);
        constexpr int NITEMS = 2 * (I_ABIN + I_SQ + I_QKV + I_SQ) + 4 * (I_FFIN + I_FFOUT);
        for (int it = gw; it < NITEMS; it += NGW) {
            int r = it;
            if (r < 2 * I_ABIN) { const int i = r / I_ABIN; transpose_matrix_item(ab_w_in + (size_t)i * D * ABIN, D, ABIN, (bf16_t*)(ws + WS_WABIN + i * SZ_WABIN), false, r % I_ABIN, scr, lane); continue; } r -= 2 * I_ABIN;
            if (r < 2 * I_SQ) { const int i = r / I_SQ; transpose_matrix_item(ab_w_out + (size_t)i * D * D, D, D, (bf16_t*)(ws + WS_WABOUT + i * SZ_WSQ), false, r % I_SQ, scr, lane); continue; } r -= 2 * I_SQ;
            if (r < 2 * I_QKV) { const int i = r / I_QKV; transpose_matrix_item(na_w_qkv + (size_t)i * D * QKV, D, QKV, (bf16_t*)(ws + WS_WQKV + i * SZ_WQKV), false, r % I_QKV, scr, lane); continue; } r -= 2 * I_QKV;
            if (r < 2 * I_SQ) { const int i = r / I_SQ; transpose_matrix_item(na_w_out + (size_t)i * D * D, D, D, (bf16_t*)(ws + WS_WNAOUT + i * SZ_WSQ), false, r % I_SQ, scr, lane); continue; } r -= 2 * I_SQ;
            if (r < 4 * I_FFIN) { const int i = r / I_FFIN; transpose_matrix_item(ffn_w_in + (size_t)i * D * FF2, D, FF2, (bf16_t*)(ws + WS_WFFIN + i * SZ_WFFIN), true, r % I_FFIN, scr, lane); continue; } r -= 4 * I_FFIN;
            { const int i = r / I_FFOUT; transpose_matrix_item(ffn_w_out + (size_t)i * FFH * D, FFH, D, (bf16_t*)(ws + WS_WFFOUT + i * SZ_WFFOUT), false, r % I_FFOUT, scr, lane); }
        }
        for (int it = vcu; it < 4 * 4 * 6; it += G) {
            const int l = it / 24, kp = (it % 24) / 6, nc = it % 6, n = nc * 2048 + 4 * tid;
            f32x4 aL = (f32x4){0.f, 0.f, 0.f, 0.f}, aC = aL;
            const float* wp = ada_w + ((size_t)l * D + kp * 512) * (6 * D) + n;
#pragma unroll 8
            for (int k = 0; k < 512; ++k) { const f32x4 w = *(const f32x4*)(wp + (size_t)k * (6 * D)); const float cl = c_in[kp * 512 + k], cc = cctx_in[kp * 512 + k];
                const float sl = cl / (1.0f + __expf(-cl)), sc = cc / (1.0f + __expf(-cc)); aL = aL + w * sl; aC = aC + w * sc; }
            *(f32x4*)(modacc + (size_t)kp * MODPART + (size_t)(l * 2 + 0) * 6 * D + n) = aL;
            *(f32x4*)(modacc + (size_t)kp * MODPART + (size_t)(l * 2 + 1) * 6 * D + n) = aC;
        }
        for (int idx = bx * 512 + tid; idx < 192 * 32; idx += G * 512) {
            const int pi = idx >> 5, f = idx & 31; const float pos = (float)(pi < 128 ? pi : pi - 128);
            const float ang = pos * powf(10000.0f, -(float)f / 32.0f);
            rope[idx] = (f32x2){cosf(ang), sinf(ang)};
        }
    }
    SEAM(0, 1);
    for (int nrep_ = 1 + REP(1), rep_ = 0; rep_ < nrep_; ++rep_) if (EN(1) && IN(1)) {
        SITE_COORDS;
        RowopArgs a; a.y = nullptr; a.xin_lat = x_in; a.xin_ctx = ctx_in; a.xout_lat = X; a.xout_ctx = X + (size_t)S * D; a.h = H; a.modacc = modacc; a.ada_b = ada_b; a.norm_g = norm_g;
        a.ly = -1; a.jg_y = 0; a.jgate = 0; a.lh = 0; a.jg_h = 0; a.jshift = 0; a.jscale = 1; a.nctx = NCTX; a.ypart = nullptr; a.nypart = 0;
        ROWOP_RUN(a);
    }
    SEAM(1, 2);
    for (int layer = 0; layer < DEPTH; ++layer) {
        const int pb = 2 + 9 * layer, iab = layer >> 1;
        const bool even = (layer & 1) == 0, last = layer == DEPTH - 1;
        const int Mrows = last ? S : MTOK;
        if (even) {
            for (int nrep_ = 1 + REP(2), rep_ = 0; rep_ < nrep_; ++rep_) if (EN(2) && IN(pb + 0)) {
                SITE_COORDS;
                pg8::Gemm g{H, (const bf16_t*)(ws + WS_WABIN + iab * SZ_WABIN), MTOK, ABIN, D}; pg8::StaticOrder So; So.init(MTOK, ABIN, D, G, bx);
                EpiInProj E{P, rope};
                pg8::gemm_phase<EpiInProj, pg8::StaticOrder, PG8_ALIGN, PG8_SP2>(lds, g, So, E, tid);
            }
            SEAM(pb + 0, pb + 1);
            for (int nrep_ = 1 + REP(3), rep_ = 0; rep_ < nrep_; ++rep_) if (EN(3) && IN(pb + 1)) {
                SITE_COORDS;
                for (int bt = vcu; bt < NCHUNK * 8; bt += G) {
                    const int cidx = bt >> 3, head = bt & 7, dir = wave >> 2, quad = wave & 3;
                    r1_task(P, KVT, lg2gamma(ab_decay, iab, dir, head), cidx, head, dir, quad, lane);
                }
                for (int t = gw; t < (MTOK / 8) * 2; t += NGW) conv_task(P, YAB, ab_conv_w + (size_t)iab * 3 * 1024, t, lane);
            }
            SEAM(pb + 1, pb + 2);
            for (int nrep_ = 1 + REP(4), rep_ = 0; rep_ < nrep_; ++rep_) if (EN(4) && IN(pb + 2)) {
                SITE_COORDS;
                for (int it = vcu * 512 + tid; it < 131072; it += G * 512) r2_item(KVT, ST, ab_decay, iab, it);
            }
            SEAM(pb + 2, pb + 3);
            for (int nrep_ = 1 + REP(5), rep_ = 0; rep_ < nrep_; ++rep_) if (EN(5) && IN(pb + 3)) {
                SITE_COORDS;
                for (int bt = vcu; bt < NCHUNK * 8; bt += G) {
                    const int cidx = bt >> 3, head = bt & 7;
                    r3_task(P, ST, YAB, lg2gamma(ab_decay, iab, 0, head), lg2gamma(ab_decay, iab, 1, head), cidx, head, wave, lane);
                }
            }
            SEAM(pb + 3, pb + 4);
        } else {
            for (int nrep_ = 1 + REP(6), rep_ = 0; rep_ < nrep_; ++rep_) if (EN(6) && IN(pb + 0)) {
                SITE_COORDS;
                pg8::Gemm g{H, (const bf16_t*)(ws + WS_WQKV + iab * SZ_WQKV), MTOK, QKV, D}; pg8::StaticOrder So; So.init(MTOK, QKV, D, G, bx);
                EpiBf16 E{P, QKV};
                pg8::gemm_phase<EpiBf16, pg8::StaticOrder, PG8_ALIGN, PG8_SP2>(lds, g, So, E, tid);
            }
            SEAM(pb + 0, pb + 1);
            for (int nrep_ = 1 + REP(7), rep_ = 0; rep_ < nrep_; ++rep_) if (EN(7) && IN(pb + 1)) {
                SITE_COORDS;
                const float* rpb = na_rpb + (size_t)iab * 16 * 15 * 31;
                const int per = (1024 + G - 1) / G;
                for (int bt = vcu * per; bt < (vcu + 1) * per && bt < 1024; ++bt) {
                    const int h = bt >> 6, rp = bt & 63, r = 2 * rp + (wave >> 2), cgp = wave & 3;
                    const int kc0 = cgp == 0 ? 0 : (cgp == 1 ? 8 : (cgp == 2 ? 24 : 32));
                    attn_task<true>(P, YAB, rpb, h, r * 64 + 16 * cgp, r, 16 * cgp, kc0, lane);
                }
                if (!last) for (int t = gw; t < 256; t += NGW) attn_task<false>(P, YAB, rpb, t >> 4, S + 16 * (t & 15), 0, 0, 0, lane);
            }
            SEAM(pb + 1, pb + 4);
        }
        for (int nrep_ = 1 + REP(8), rep_ = 0; rep_ < nrep_; ++rep_) if (EN(8) && IN(pb + 4)) {
            SITE_COORDS;
            const bf16_t* wt = even ? (const bf16_t*)(ws + WS_WABOUT + iab * SZ_WSQ) : (const bf16_t*)(ws + WS_WNAOUT + iab * SZ_WSQ);
            pg8::Gemm g{YAB, wt, MTOK, D, D}; pg8::MixedOrder So; So.init(S, D, D, G, bx, 32, last ? 0 : NSPLIT_OUT);
            EpiF32 E{Y, D, YC};
            pg8::gemm_phase<EpiF32, pg8::MixedOrder, PG8_ALIGN, PG8_SP2>(lds, g, So, E, tid);
        }
        SEAM(pb + 4, pb + 5);
        for (int nrep_ = 1 + REP(9), rep_ = 0; rep_ < nrep_; ++rep_) if (EN(9) && IN(pb + 5)) {
            SITE_COORDS;
            RowopArgs a; a.y = Y; a.xin_lat = X; a.xin_ctx = X + (size_t)S * D; a.xout_lat = X; a.xout_ctx = X + (size_t)S * D; a.h = H; a.modacc = modacc; a.ada_b = ada_b; a.norm_g = norm_g;
            a.ly = layer; a.jg_y = 1; a.jgate = 2; a.lh = layer; a.jg_h = 2; a.jshift = 3; a.jscale = 4; a.nctx = last ? 0 : NCTX; a.ypart = YC; a.nypart = NSPLIT_OUT;
            ROWOP_RUN(a);
        }
        SEAM(pb + 5, pb + 6);
        for (int nrep_ = 1 + REP(10), rep_ = 0; rep_ < nrep_; ++rep_) if (EN(10) && IN(pb + 6)) {
            SITE_COORDS;
            pg8::Gemm g{H, (const bf16_t*)(ws + WS_WFFIN + layer * SZ_WFFIN), Mrows, FF2, D}; pg8::StaticOrder So; So.init(Mrows, FF2, D, G, bx);
            EpiSwiglu E{HID};
            pg8::gemm_phase<EpiSwiglu, pg8::StaticOrder, PG8_ALIGN, PG8_SP2>(lds, g, So, E, tid);
        }
        SEAM(pb + 6, pb + 7);
        for (int nrep_ = 1 + REP(11), rep_ = 0; rep_ < nrep_; ++rep_) if (EN(11) && IN(pb + 7)) {
            SITE_COORDS;
            pg8::Gemm g{HID, (const bf16_t*)(ws + WS_WFFOUT + layer * SZ_WFFOUT), MTOK, D, FFH}; pg8::MixedOrder So; So.init(S, D, FFH, G, bx, 32, last ? 0 : NSPLIT_FFO);
            EpiF32 E{Y, D, YC};
            pg8::gemm_phase<EpiF32, pg8::MixedOrder, PG8_ALIGN, PG8_SP2>(lds, g, So, E, tid);
        }
        SEAM(pb + 7, pb + 8);
        for (int nrep_ = 1 + REP(12), rep_ = 0; rep_ < nrep_; ++rep_) if (EN(12) && IN(pb + 8)) {
            SITE_COORDS;
            RowopArgs a; a.y = Y; a.xin_lat = X; a.xin_ctx = X + (size_t)S * D; a.xout_lat = last ? p.out : X; a.xout_ctx = last ? nullptr : X + (size_t)S * D; a.h = H; a.modacc = modacc; a.ada_b = ada_b; a.norm_g = norm_g;
            a.ly = layer; a.jg_y = 3; a.jgate = 5; a.lh = last ? -1 : layer + 1; a.jg_h = 0; a.jshift = 0; a.jscale = 1; a.nctx = last ? 0 : NCTX; a.ypart = YC; a.nypart = NSPLIT_FFO;
            ROWOP_RUN(a);
        }
        if (!last) SEAM(pb + 8, pb + 9);
    }
#undef IN
#undef SEAM
}

#ifndef MK_MODE
#define MK_MODE 1
#endif
extern "C" void kernel_launch(void* const* d_in, const int* in_sizes, int n_in, void* d_out, int out_size, void* d_ws, size_t ws_size, hipStream_t stream) {
    static int grid = 0;
    if (grid == 0) {
        if (n_in != 16 || out_size != S * D || ws_size < WS_END) { fprintf(stderr, "kernel_launch: unexpected shapes (n_in %d out %d ws %zu need %zu)\n", n_in, out_size, ws_size, (size_t)WS_END); grid = -1; return; }
        int dev = 0, cus = 0, per_cu = 0;
        if (hipGetDevice(&dev) != hipSuccess || hipDeviceGetAttribute(&cus, hipDeviceAttributeMultiprocessorCount, dev) != hipSuccess) { grid = -1; return; }
        if (hipFuncSetAttribute((const void*)mega_fwd, hipFuncAttributeMaxDynamicSharedMemorySize, LDS_BYTES) != hipSuccess) { fprintf(stderr, "kernel_launch: hipFuncSetAttribute failed\n"); grid = -1; return; }
        if (hipOccupancyMaxActiveBlocksPerMultiprocessor(&per_cu, (const void*)mega_fwd, 512, LDS_BYTES) != hipSuccess || per_cu < 1) fprintf(stderr, "kernel_launch: occupancy query says %d\n", per_cu);
        (void)hipGetLastError();
        grid = cus;
    }
    if (grid < 0) return;
    if (hipMemsetAsync((char*)d_ws + WS_CTL, 0, CTL_ZERO_BYTES, stream) != hipSuccess) { fprintf(stderr, "kernel_launch: memset failed\n"); return; }
    Params a{};
    for (int i = 0; i < 16; ++i) a.in[i] = (const float*)d_in[i];
    a.out = (float*)d_out; a.ws = (unsigned char*)d_ws; a.pad = 0;
#if MK_MODE == 1
    a.ph_lo = 0; a.ph_hi = NPHASE; a.li = 0;
    hipLaunchKernelGGL(mega_fwd, dim3(grid), dim3(512), LDS_BYTES, stream, a);
#else
    for (int ph = 0; ph < NPHASE; ++ph) {
        if (ph >= 2) { const int layer = (ph - 2) / 9, slot = (ph - 2) % 9; if ((layer & 1) && (slot == 2 || slot == 3)) continue; }
        a.ph_lo = ph; a.ph_hi = ph + 1; a.li = 0;
        hipLaunchKernelGGL(mega_fwd, dim3(grid), dim3(512), LDS_BYTES, stream, a);
    }
#endif
    const hipError_t le = hipPeekAtLastError();
    if (le != hipSuccess) fprintf(stderr, "kernel_launch: launch failed: %s\n", hipGetErrorName(le));
}
#endif
```

```cpp
#ifndef HOST_EMU
#include <hip/hip_runtime.h>
#include <cstdio>
#include <cstdint>
#define DEV __device__ __forceinline__
#define HDEV __host__ __device__ __forceinline__
#define LAS __attribute__((address_space(3)))
#endif

typedef unsigned short bf16_t;
typedef short bf16x8 __attribute__((ext_vector_type(8)));
typedef float f32x4 __attribute__((ext_vector_type(4)));
typedef float f32x2 __attribute__((ext_vector_type(2)));
typedef unsigned u32x4 __attribute__((ext_vector_type(4)));
typedef unsigned u32x2 __attribute__((ext_vector_type(2)));

#ifndef HOST_EMU
DEV f32x4 mfma16(bf16x8 a, bf16x8 b, f32x4 c) { return __builtin_amdgcn_mfma_f32_16x16x32_bf16(a, b, c, 0, 0, 0); }
DEV float shfl_xor_f(float v, int m) { return __shfl_xor(v, m); }
DEV unsigned cvt_pk_bf16(float lo, float hi) { unsigned r; asm("v_cvt_pk_bf16_f32 %0, %1, %2" : "=v"(r) : "v"(lo), "v"(hi)); return r; }
DEV float ex2(float x) { return __builtin_amdgcn_exp2f(x); }
DEV float rcp_f(float x) { return __builtin_amdgcn_rcpf(x); }
DEV float rsq_f(float x) { return 1.0f / sqrtf(x); }
DEV void atomic_add_f(float* p, float v) { (void)__hip_atomic_fetch_add(p, v, __ATOMIC_RELAXED, __HIP_MEMORY_SCOPE_AGENT); }
#endif

namespace cfg {
constexpr int D = 2048, S = 8192, NCTX = 256, MTOK = 8448, DEPTH = 4;
constexpr int ABIN = 7168, FFH = 5632, FF2 = 11264, QKV = 6144;
constexpr int NCHUNK = 66;
constexpr float EPS = 1e-6f;
constexpr float HSCALE = 0.08838834764831845f;
constexpr float LOG2E = 1.4426950408889634f;
}
using namespace cfg;

DEV float bf_lo(unsigned w) { return __builtin_bit_cast(float, w << 16); }
DEV float bf_hi(unsigned w) { return __builtin_bit_cast(float, w & 0xffff0000u); }
DEV float wave_sum(float v) {
#pragma unroll
    for (int o = 1; o < 64; o <<= 1) v += shfl_xor_f(v, o);
    return v;
}
DEV float silu_f(float x) { return x * rcp_f(1.0f + ex2(-x * LOG2E)); }
DEV float lg2gamma(const float* decay_exp, int iab, int dir, int head) {
    const float e = decay_exp[(iab * 2 + dir) * 8 + head];
    return log1pf(-exp2f(-e)) * LOG2E;
}
DEV bf16x8 extract8(const u32x4 (&vd)[8], int mt) {
    u32x4 w;
#pragma unroll
    for (int q = 0; q < 4; ++q) {
        const unsigned X = vd[2 * q][mt >> 1], Y = vd[2 * q + 1][mt >> 1];
        w[q] = (mt & 1) ? ((X >> 16) | (Y & 0xffff0000u)) : ((X & 0xffffu) | (Y << 16));
    }
    return __builtin_bit_cast(bf16x8, w);
}

struct RowopArgs {
    const float* y;
    const float* xin_lat; const float* xin_ctx;
    float* xout_lat; float* xout_ctx;
    bf16_t* h;
    const float* modacc; const float* ada_b; const float* norm_g;
    int ly, jg_y, jgate, lh, jg_h, jshift, jscale, nctx;
    const float* ypart; int nypart;
};
DEV f32x4 ld4(const float* p) { return *(const f32x4*)p; }
constexpr int MODPART = 4 * 2 * 6 * 2048;
DEV f32x4 modvec(const RowopArgs& a, int l, int s, int j, int col) {
    const float* q = a.modacc + (size_t)((l * 2 + s) * 6 + j) * D + col;
    return ((ld4(q) + ld4(q + MODPART)) + (ld4(q + 2 * MODPART) + ld4(q + 3 * MODPART))) + ld4(a.ada_b + (size_t)l * 6 * D + j * D + col);
}
template <class CP>
DEV void rowop_coefs(const RowopArgs& a, const int s, CP coef, const int tid) {
    const int col = 4 * tid;
    f32x4 A = (f32x4){0.f, 0.f, 0.f, 0.f}, B = A, SH = A;
    if (a.ly >= 0) A = modvec(a, a.ly, s, a.jgate, col) * ld4(a.norm_g + (size_t)(a.ly * 4 + a.jg_y) * D + col);
    if (a.lh >= 0) { B = ld4(a.norm_g + (size_t)(a.lh * 4 + a.jg_h) * D + col) * (modvec(a, a.lh, s, a.jscale, col) + 1.0f); SH = modvec(a, a.lh, s, a.jshift, col); }
    *(f32x4*)(coef + col) = A; *(f32x4*)(coef + D + col) = B; *(f32x4*)(coef + 2 * D + col) = SH;
}
template <class CP>
DEV void rowop_row(const RowopArgs& a, const int s, CP coef, const int m, f32x4 (&x)[8], const f32x4 (&y)[8], const int lane) {
    const bool hasy = a.ly >= 0, hash = a.lh >= 0;
    if (hasy) {
        float ss = 0.f;
#pragma unroll
        for (int j = 0; j < 8; ++j) ss += (y[j][0] * y[j][0] + y[j][1] * y[j][1]) + (y[j][2] * y[j][2] + y[j][3] * y[j][3]);
        const float r1 = rsq_f(wave_sum(ss) * (1.0f / D) + EPS);
#pragma unroll
        for (int j = 0; j < 8; ++j) x[j] = x[j] + *(const f32x4*)(coef + 4 * lane + 256 * j) * (y[j] * r1);
    }
    float* xo = (s == 0) ? (a.xout_lat ? a.xout_lat + (size_t)m * D : nullptr) : (a.xout_ctx ? a.xout_ctx + (size_t)(m - S) * D : nullptr);
    if (xo) {
#pragma unroll
        for (int j = 0; j < 8; ++j) *(f32x4*)(xo + 4 * lane + 256 * j) = x[j];
    }
    if (hash) {
        float ss = 0.f;
#pragma unroll
        for (int j = 0; j < 8; ++j) ss += (x[j][0] * x[j][0] + x[j][1] * x[j][1]) + (x[j][2] * x[j][2] + x[j][3] * x[j][3]);
        const float r2 = rsq_f(wave_sum(ss) * (1.0f / D) + EPS);
        bf16_t* hr = a.h + (size_t)m * D;
#pragma unroll
        for (int j = 0; j < 8; ++j) { const f32x4 v = (x[j] * r2) * *(const f32x4*)(coef + D + 4 * lane + 256 * j) + *(const f32x4*)(coef + 2 * D + 4 * lane + 256 * j);
            u32x2 w; w[0] = cvt_pk_bf16(v[0], v[1]); w[1] = cvt_pk_bf16(v[2], v[3]); *(u32x2*)(hr + 4 * lane + 256 * j) = w; }
    }
}
template <class CP>
DEV void rowop_stream(const RowopArgs& a, CP coef, const int gw, const int NGW, const int lane) {
    for (int m = gw; m < S; m += NGW) {
        const float* xr = a.xin_lat + (size_t)m * D;
        f32x4 x[8], y[8];
#pragma unroll
        for (int j = 0; j < 8; ++j) { x[j] = ld4(xr + 4 * lane + 256 * j); y[j] = (f32x4){0.f, 0.f, 0.f, 0.f}; }
        if (a.ly >= 0) { const float* yr = a.y + (size_t)m * D;
#pragma unroll
            for (int j = 0; j < 8; ++j) y[j] = ld4(yr + 4 * lane + 256 * j); }
        rowop_row(a, 0, coef, m, x, y, lane);
    }
}
#ifndef HOST_EMU
template <class CP, class LP>
DEV void rowop_ctx(const RowopArgs& a, CP coef, LP yrow, const int vcu, const int G, const int wave, const int lane) {
    for (int r = vcu; r < a.nctx; r += G) {
        if (a.ly >= 0) {
            const int col = 256 * wave + 4 * lane; const float* yp = a.ypart + (size_t)r * D + col;
            f32x4 acc = (f32x4){0.f, 0.f, 0.f, 0.f};
#pragma unroll 11
            for (int pp = 0; pp < a.nypart; ++pp) acc = acc + ld4(yp + (size_t)pp * 256 * D);
            *(f32x4*)(yrow + col) = acc;
        }
        __syncthreads();
        if (wave == 0) {
            const float* xr = a.xin_ctx + (size_t)r * D;
            f32x4 x[8], y[8];
#pragma unroll
            for (int j = 0; j < 8; ++j) { x[j] = ld4(xr + 4 * lane + 256 * j); y[j] = *(const f32x4*)(yrow + 4 * lane + 256 * j); }
            rowop_row(a, 1, coef, S + r, x, y, lane);
        }
        __syncthreads();
    }
}
#endif

DEV void conv_loadz(const bf16_t* P, int t, int c, float (&z)[8]) {
    const u32x4 cg = *(const u32x4*)(P + (size_t)t * ABIN + 1024 + c), u = *(const u32x4*)(P + (size_t)t * ABIN + 2048 + c);
#pragma unroll
    for (int e = 0; e < 4; ++e) { z[2 * e] = bf_lo(cg[e]) * bf_lo(u[e]); z[2 * e + 1] = bf_hi(cg[e]) * bf_hi(u[e]); }
}
DEV void conv_task(const bf16_t* P, bf16_t* YAB, const float* convw, int task, int lane) {
    const int half = task & 1, t0 = (task >> 1) * 8, c = half * 512 + lane * 8;
    float w0[8], w1[8], w2[8], zp[8], zc[8], zn[8];
#pragma unroll
    for (int e = 0; e < 8; ++e) { w0[e] = convw[c + e]; w1[e] = convw[1024 + c + e]; w2[e] = convw[2048 + c + e]; zp[e] = 0.f; zn[e] = 0.f; }
    if (t0 != 0 && t0 != S) conv_loadz(P, t0 - 1, c, zp);
    conv_loadz(P, t0, c, zc);
    for (int i = 0; i < 8; ++i) {
        const int t = t0 + i;
        if (t != S - 1 && t != MTOK - 1) conv_loadz(P, t + 1, c, zn);
        else {
#pragma unroll
            for (int e = 0; e < 8; ++e) zn[e] = 0.f;
        }
        const u32x4 bg = *(const u32x4*)(P + (size_t)t * ABIN + c);
        float o[8];
#pragma unroll
        for (int e = 0; e < 8; ++e) { const float b = (e & 1) ? bf_hi(bg[e >> 1]) : bf_lo(bg[e >> 1]); o[e] = b * (w0[e] * zp[e] + w1[e] * zc[e] + w2[e] * zn[e]); }
        u32x4 w; w[0] = cvt_pk_bf16(o[0], o[1]); w[1] = cvt_pk_bf16(o[2], o[3]); w[2] = cvt_pk_bf16(o[4], o[5]); w[3] = cvt_pk_bf16(o[6], o[7]);
        *(u32x4*)(YAB + (size_t)t * D + c) = w;
#pragma unroll
        for (int e = 0; e < 8; ++e) { zp[e] = zc[e]; zc[e] = zn[e]; }
    }
}

DEV int chunk_row(int cidx) { return cidx < 2 ? S + 128 * cidx : 128 * (cidx - 2); }
DEV void r1_task(const bf16_t* P, float* KVt, float lg2, int cidx, int head, int dir, int quad, int lane) {
    const int i = lane & 15, g = lane >> 4;
    const int dk0 = 64 * (quad >> 1), dv0 = 64 * (quad & 1);
    const bf16_t* Kp = P + (size_t)chunk_row(cidx) * ABIN + 4096 + head * 128 + dk0 + 4 * i;
    const bf16_t* Vp = P + (size_t)chunk_row(cidx) * ABIN + 5120 + head * 128 + dv0 + 4 * i;
    f32x4 acc[4][4];
#pragma unroll
    for (int a = 0; a < 4; ++a)
#pragma unroll
        for (int b = 0; b < 4; ++b) acc[a][b] = (f32x4){0.f, 0.f, 0.f, 0.f};
    for (int s = 0; s < 4; ++s) {
        u32x2 kd[8], vd[8]; float w[8];
#pragma unroll
        for (int jj = 0; jj < 8; ++jj) {
            const int tj = 32 * s + 8 * g + jj;
            kd[jj] = *(const u32x2*)(Kp + (size_t)tj * ABIN); vd[jj] = *(const u32x2*)(Vp + (size_t)tj * ABIN);
            w[jj] = ex2(lg2 * (float)(dir == 0 ? 127 - tj : tj));
        }
        bf16x8 af[4], bfr[4];
#pragma unroll
        for (int mt = 0; mt < 4; ++mt) {
            u32x4 wd;
#pragma unroll
            for (int q = 0; q < 4; ++q) {
                const unsigned X = kd[2 * q][mt >> 1], Y = kd[2 * q + 1][mt >> 1];
                const float lo = ((mt & 1) ? bf_hi(X) : bf_lo(X)) * w[2 * q], hi = ((mt & 1) ? bf_hi(Y) : bf_lo(Y)) * w[2 * q + 1];
                wd[q] = cvt_pk_bf16(lo, hi);
            }
            af[mt] = __builtin_bit_cast(bf16x8, wd);
        }
#pragma unroll
        for (int nt = 0; nt < 4; ++nt) {
            u32x4 wd;
#pragma unroll
            for (int q = 0; q < 4; ++q) {
                const unsigned X = vd[2 * q][nt >> 1], Y = vd[2 * q + 1][nt >> 1];
                wd[q] = (nt & 1) ? ((X >> 16) | (Y & 0xffff0000u)) : ((X & 0xffffu) | (Y << 16));
            }
            bfr[nt] = __builtin_bit_cast(bf16x8, wd);
        }
#pragma unroll
        for (int mt = 0; mt < 4; ++mt)
#pragma unroll
            for (int nt = 0; nt < 4; ++nt) acc[mt][nt] = mfma16(af[mt], bfr[nt], acc[mt][nt]);
    }
    float* out = KVt + ((((size_t)cidx * 8 + head) * 2 + dir) * 128) * 128;
#pragma unroll
    for (int nt = 0; nt < 4; ++nt)
#pragma unroll
        for (int reg = 0; reg < 4; ++reg) {
            const int dv = dv0 + 4 * i + nt, dk = dk0 + 16 * g + 4 * reg;
            *(f32x4*)(out + (size_t)dv * 128 + dk) = (f32x4){acc[0][nt][reg], acc[1][nt][reg], acc[2][nt][reg], acc[3][nt][reg]};
        }
}
DEV void r2_item(const float* KVt, bf16_t* St, const float* decay_exp, int iab, int item) {
    const int hd = item >> 13, e = (item & 8191) * 2, head = hd >> 1, dir = hd & 1;
    const float cd = exp2f(128.0f * lg2gamma(decay_exp, iab, dir, head));
    float s0 = 0.f, s1 = 0.f;
#pragma unroll 6
    for (int step = 0; step < NCHUNK; ++step) {
        const int c = dir == 0 ? step : (step < 2 ? 1 - step : 67 - step);
        const size_t off = (((size_t)c * 8 + head) * 2 + dir) * 16384 + e;
        *(unsigned*)(St + off) = cvt_pk_bf16(s0, s1);
        const f32x2 kv = *(const f32x2*)(KVt + off);
        s0 = s0 * cd + kv[0]; s1 = s1 * cd + kv[1];
    }
}
DEV void r3_task(const bf16_t* P, const bf16_t* St, bf16_t* YAB, float lg2f, float lg2b, int cidx, int head, int qb, int lane) {
    const int i = lane & 15, g = lane >> 4, qi = 16 * qb + i, rowbase = chunk_row(cidx);
    const bf16_t* Prow = P + (size_t)rowbase * ABIN;
    bf16x8 qf[4];
#pragma unroll
    for (int s = 0; s < 4; ++s) qf[s] = *(const bf16x8*)(Prow + (size_t)qi * ABIN + 3072 + head * 128 + 32 * s + 8 * g);
    f32x4 sacc[8];
#pragma unroll
    for (int mt = 0; mt < 8; ++mt) {
        f32x4 a = (f32x4){0.f, 0.f, 0.f, 0.f};
#pragma unroll
        for (int s = 0; s < 4; ++s) { const bf16x8 kf = *(const bf16x8*)(Prow + (size_t)(16 * mt + i) * ABIN + 4096 + head * 128 + 32 * s + 8 * g); a = mfma16(kf, qf[s], a); }
        sacc[mt] = a;
    }
#pragma unroll
    for (int mt = 0; mt < 8; ++mt)
#pragma unroll
        for (int reg = 0; reg < 4; ++reg) {
            const int diff = qi - (16 * mt + 4 * g + reg);
            const float d = diff > 0 ? ex2((float)diff * lg2f) : (diff < 0 ? ex2((float)(-diff) * lg2b) : 2.0f);
            sacc[mt][reg] *= d;
        }
    bf16x8 pf[4];
#pragma unroll
    for (int s = 0; s < 4; ++s) {
        u32x4 w; w[0] = cvt_pk_bf16(sacc[2 * s][0], sacc[2 * s][1]); w[1] = cvt_pk_bf16(sacc[2 * s][2], sacc[2 * s][3]);
        w[2] = cvt_pk_bf16(sacc[2 * s + 1][0], sacc[2 * s + 1][1]); w[3] = cvt_pk_bf16(sacc[2 * s + 1][2], sacc[2 * s + 1][3]);
        pf[s] = __builtin_bit_cast(bf16x8, w);
    }
    f32x4 oacc[8];
#pragma unroll
    for (int mt = 0; mt < 8; ++mt) oacc[mt] = (f32x4){0.f, 0.f, 0.f, 0.f};
#pragma unroll
    for (int s = 0; s < 4; ++s) {
        u32x4 vd[8];
#pragma unroll
        for (int jj = 0; jj < 8; ++jj) { const int key = 32 * s + (jj < 4 ? 4 * g + jj : 16 + 4 * g + jj - 4); vd[jj] = *(const u32x4*)(Prow + (size_t)key * ABIN + 5120 + head * 128 + 8 * i); }
#pragma unroll
        for (int mt = 0; mt < 8; ++mt) oacc[mt] = mfma16(extract8(vd, mt), pf[s], oacc[mt]);
    }
#pragma unroll
    for (int dir = 0; dir < 2; ++dir) {
        f32x4 tacc[8];
#pragma unroll
        for (int mt = 0; mt < 8; ++mt) tacc[mt] = (f32x4){0.f, 0.f, 0.f, 0.f};
        const bf16_t* Sp = St + ((((size_t)cidx * 8 + head) * 2 + dir) * 128) * 128;
#pragma unroll
        for (int s = 0; s < 4; ++s)
#pragma unroll
            for (int mt = 0; mt < 8; ++mt) { const bf16x8 sf = *(const bf16x8*)(Sp + (size_t)(8 * i + mt) * 128 + 32 * s + 8 * g); tacc[mt] = mfma16(sf, qf[s], tacc[mt]); }
        const float qd = dir == 0 ? ex2((float)(qi + 1) * lg2f) : ex2((float)(128 - qi) * lg2b);
#pragma unroll
        for (int mt = 0; mt < 8; ++mt) oacc[mt] = oacc[mt] + tacc[mt] * qd;
    }
    float ss = 0.f;
#pragma unroll
    for (int mt = 0; mt < 8; ++mt) ss += (oacc[mt][0] * oacc[mt][0] + oacc[mt][1] * oacc[mt][1]) + (oacc[mt][2] * oacc[mt][2] + oacc[mt][3] * oacc[mt][3]);
    ss += shfl_xor_f(ss, 16); ss += shfl_xor_f(ss, 32);
    const float rinv = rsq_f(ss * (1.0f / 128.0f) + EPS);
#pragma unroll
    for (int reg = 0; reg < 4; ++reg) {
        const int dvb = 32 * g + 8 * reg;
        const u32x4 gt = *(const u32x4*)(Prow + (size_t)qi * ABIN + 6144 + head * 128 + dvb);
        float o[8];
#pragma unroll
        for (int mt = 0; mt < 8; ++mt) { const float gv = (mt & 1) ? bf_hi(gt[mt >> 1]) : bf_lo(gt[mt >> 1]); o[mt] = silu_f(gv) * (oacc[mt][reg] * rinv); }
        u32x4 w; w[0] = cvt_pk_bf16(o[0], o[1]); w[1] = cvt_pk_bf16(o[2], o[3]); w[2] = cvt_pk_bf16(o[4], o[5]); w[3] = cvt_pk_bf16(o[6], o[7]);
        *(u32x4*)(YAB + (size_t)(rowbase + qi) * D + 1024 + head * 128 + dvb) = w;
    }
}

template <bool WIN>
DEV void attn_task(const bf16_t* P, bf16_t* YAB, const float* rpb, int h, int qtok0, int r, int c0, int kc0, int lane) {
    const int i = lane & 15, g = lane >> 4, qtok = qtok0 + i;
    bf16x8 qf[4];
#pragma unroll
    for (int s = 0; s < 4; ++s) qf[s] = *(const bf16x8*)(P + (size_t)qtok * QKV + h * 128 + 32 * s + 8 * g);
    const int c = c0 + i;
    const int sr = r - 4 < 0 ? 0 : (r - 4 > 120 ? 120 : r - 4);
    const int sc = c - 8 < 0 ? 0 : (c - 8 > 48 ? 48 : c - 8);
    float m_run = -1e30f, l_run = 0.f;
    f32x4 oacc[8];
#pragma unroll
    for (int mt = 0; mt < 8; ++mt) oacc[mt] = (f32x4){0.f, 0.f, 0.f, 0.f};
    for (int b = WIN ? 0 : 8; b < 16; ++b) {
        const int kb = b < 8 ? (sr + b) * 64 + kc0 : S + 32 * (b - 8);
        f32x4 sa[2];
#pragma unroll
        for (int mt = 0; mt < 2; ++mt) {
            f32x4 a = (f32x4){0.f, 0.f, 0.f, 0.f};
#pragma unroll
            for (int s = 0; s < 4; ++s) { const bf16x8 kf = *(const bf16x8*)(P + (size_t)(kb + 16 * mt + i) * QKV + 2048 + h * 128 + 32 * s + 8 * g); a = mfma16(kf, qf[s], a); }
            sa[mt] = a;
        }
        float bm = -1e30f;
#pragma unroll
        for (int mt = 0; mt < 2; ++mt)
#pragma unroll
            for (int reg = 0; reg < 4; ++reg) {
                float v = sa[mt][reg] * HSCALE;
                if (WIN && b < 8) {
                    const int kcol = kc0 + 16 * mt + 4 * g + reg;
                    const bool valid = kcol >= sc && kcol < sc + 16;
                    const int dc = valid ? kcol - c + 15 : 0;
                    const float bias = rpb[(h * 15 + (sr + b - r + 7)) * 31 + dc];
                    v = valid ? v + bias : -1e30f;
                }
                sa[mt][reg] = v; bm = fmaxf(bm, v);
            }
        bm = fmaxf(bm, shfl_xor_f(bm, 16)); bm = fmaxf(bm, shfl_xor_f(bm, 32));
        const float m_new = fmaxf(m_run, bm);
        const float alpha = ex2((m_run - m_new) * LOG2E);
        m_run = m_new;
        float ps = 0.f;
#pragma unroll
        for (int mt = 0; mt < 2; ++mt)
#pragma unroll
            for (int reg = 0; reg < 4; ++reg) { const float pv = ex2((sa[mt][reg] - m_new) * LOG2E); sa[mt][reg] = pv; ps += pv; }
        l_run = l_run * alpha + ps;
#pragma unroll
        for (int mt = 0; mt < 8; ++mt) oacc[mt] = oacc[mt] * alpha;
        u32x4 pw; pw[0] = cvt_pk_bf16(sa[0][0], sa[0][1]); pw[1] = cvt_pk_bf16(sa[0][2], sa[0][3]); pw[2] = cvt_pk_bf16(sa[1][0], sa[1][1]); pw[3] = cvt_pk_bf16(sa[1][2], sa[1][3]);
        const bf16x8 pf = __builtin_bit_cast(bf16x8, pw);
        u32x4 vd[8];
#pragma unroll
        for (int jj = 0; jj < 8; ++jj) { const int key = kb + (jj < 4 ? 4 * g + jj : 16 + 4 * g + jj - 4); vd[jj] = *(const u32x4*)(P + (size_t)key * QKV + 4096 + h * 128 + 8 * i); }
#pragma unroll
        for (int mt = 0; mt < 8; ++mt) oacc[mt] = mfma16(extract8(vd, mt), pf, oacc[mt]);
    }
    l_run += shfl_xor_f(l_run, 16); l_run += shfl_xor_f(l_run, 32);
    const float inv = 1.0f / l_run;
#pragma unroll
    for (int reg = 0; reg < 4; ++reg) {
        const int dvb = 32 * g + 8 * reg;
        u32x4 w;
#pragma unroll
        for (int q = 0; q < 4; ++q) w[q] = cvt_pk_bf16(oacc[2 * q][reg] * inv, oacc[2 * q + 1][reg] * inv);
        *(u32x4*)(YAB + (size_t)qtok * D + h * 128 + dvb) = w;
    }
}

struct Unit { int pm, pn, ks, nt, kofs; };
struct EpiF32 {
    static constexpr bool PERM = false, AFTER_DRAIN = false;
    float* C; int ldc; float* Cpart;
    DEV void operator()(const f32x4 (&acc)[2][2][4][2], const Unit& u, int wr, int wc, int fr, int fq) const {
        const int row0 = (u.ks >= 0 ? 0 : u.pm * 256) + wr * 64 + fr, col0 = u.pn * 256 + wc * 32 + 4 * fq;
        float* base = u.ks >= 0 ? Cpart + (size_t)u.ks * 256 * ldc : C;
#pragma unroll
        for (int ai = 0; ai < 2; ++ai)
#pragma unroll
            for (int m = 0; m < 4; ++m) { float* rowp = base + (size_t)(row0 + ai * 128 + m * 16) * ldc + col0;
#pragma unroll
                for (int bj = 0; bj < 2; ++bj)
#pragma unroll
                    for (int n = 0; n < 2; ++n) *(f32x4*)(rowp + bj * 128 + n * 16) = acc[ai][bj][m][n]; }
    }
};
struct EpiBf16 {
    static constexpr bool PERM = true, AFTER_DRAIN = false;
    bf16_t* O; int ldc;
    DEV void operator()(const f32x4 (&acc)[2][2][4][2], const Unit& u, int wr, int wc, int fr, int fq) const {
        const int row0 = u.pm * 256 + wr * 64 + fr, col0 = u.pn * 256 + wc * 32 + 8 * fq;
#pragma unroll
        for (int ai = 0; ai < 2; ++ai)
#pragma unroll
            for (int m = 0; m < 4; ++m) { bf16_t* rowp = O + (size_t)(row0 + ai * 128 + m * 16) * ldc + col0;
#pragma unroll
                for (int bj = 0; bj < 2; ++bj) { const f32x4 v0 = acc[ai][bj][m][0], v1 = acc[ai][bj][m][1];
                    u32x4 w; w[0] = cvt_pk_bf16(v0[0], v0[1]); w[1] = cvt_pk_bf16(v0[2], v0[3]); w[2] = cvt_pk_bf16(v1[0], v1[1]); w[3] = cvt_pk_bf16(v1[2], v1[3]);
                    *(u32x4*)(rowp + bj * 128) = w; } }
    }
};
struct EpiInProj {
    static constexpr bool PERM = true, AFTER_DRAIN = false;
    bf16_t* O; const f32x2* rope;
    DEV void operator()(const f32x4 (&acc)[2][2][4][2], const Unit& u, int wr, int wc, int fr, int fq) const {
        const int row0 = u.pm * 256 + wr * 64 + fr, col0 = u.pn * 256 + wc * 32 + 8 * fq;
        const bool isk = u.pn >= 16 && u.pn < 20, isq = u.pn >= 12 && u.pn < 16, dorope = (isq || isk) && u.pm < 32;
        const float sc = isk ? HSCALE : 1.0f;
#pragma unroll
        for (int ai = 0; ai < 2; ++ai)
#pragma unroll
            for (int m = 0; m < 4; ++m) { const int row = row0 + ai * 128 + m * 16; bf16_t* rowp = O + (size_t)row * ABIN + col0;
                f32x4 cs01 = (f32x4){1.f, 0.f, 1.f, 0.f}, cs23 = cs01, cs45 = cs01, cs67 = cs01;
                if (dorope) { const int pidx = (wc < 2) ? (row >> 6) : 128 + (row & 63); const f32x2* tp = rope + pidx * 32 + 16 * (wc & 1) + 4 * fq;
                    const f32x4 t0 = *(const f32x4*)tp, t1 = *(const f32x4*)(tp + 2); cs01 = t0; cs23 = t0; cs45 = t1; cs67 = t1; }
#pragma unroll
                for (int bj = 0; bj < 2; ++bj) { f32x4 v0 = acc[ai][bj][m][0], v1 = acc[ai][bj][m][1];
                    if (dorope) {
                        const f32x4 a0 = v0, a1 = v1;
                        v0[0] = a0[0] * cs01[0] - a0[1] * cs01[1]; v0[1] = a0[0] * cs01[1] + a0[1] * cs01[0];
                        v0[2] = a0[2] * cs23[2] - a0[3] * cs23[3]; v0[3] = a0[2] * cs23[3] + a0[3] * cs23[2];
                        v1[0] = a1[0] * cs45[0] - a1[1] * cs45[1]; v1[1] = a1[0] * cs45[1] + a1[1] * cs45[0];
                        v1[2] = a1[2] * cs67[2] - a1[3] * cs67[3]; v1[3] = a1[2] * cs67[3] + a1[3] * cs67[2];
                    }
                    v0 = v0 * sc; v1 = v1 * sc;
                    u32x4 w; w[0] = cvt_pk_bf16(v0[0], v0[1]); w[1] = cvt_pk_bf16(v0[2], v0[3]); w[2] = cvt_pk_bf16(v1[0], v1[1]); w[3] = cvt_pk_bf16(v1[2], v1[3]);
                    *(u32x4*)(rowp + bj * 128) = w; } }
    }
};
struct EpiSwiglu {
    static constexpr bool PERM = true, AFTER_DRAIN = false;
    bf16_t* O;
    DEV void operator()(const f32x4 (&acc)[2][2][4][2], const Unit& u, int wr, int wc, int fr, int fq) const {
        const int row0 = u.pm * 256 + wr * 64 + fr, col0 = u.pn * 128 + wc * 32 + 8 * fq;
#pragma unroll
        for (int ai = 0; ai < 2; ++ai)
#pragma unroll
            for (int m = 0; m < 4; ++m) { bf16_t* rowp = O + (size_t)(row0 + ai * 128 + m * 16) * FFH + col0;
                const f32x4 g0 = acc[ai][0][m][0], g1 = acc[ai][0][m][1], u0 = acc[ai][1][m][0], u1 = acc[ai][1][m][1];
                u32x4 w; w[0] = cvt_pk_bf16(silu_f(g0[0]) * u0[0], silu_f(g0[1]) * u0[1]); w[1] = cvt_pk_bf16(silu_f(g0[2]) * u0[2], silu_f(g0[3]) * u0[3]);
                w[2] = cvt_pk_bf16(silu_f(g1[0]) * u1[0], silu_f(g1[1]) * u1[1]); w[3] = cvt_pk_bf16(silu_f(g1[2]) * u1[2], silu_f(g1[3]) * u1[3]);
                *(u32x4*)rowp = w; }
    }
};

#ifndef HOST_EMU
namespace pg8 {
#define PG8_LAS __attribute__((address_space(3)))
constexpr int BM = 256, BK = 64, HALF = 128, HTB = HALF * BK * 2, STAGE_BYTES = 8 * HTB, NXCD = 8, WGM = 8;
__host__ __device__ __forceinline__ int lds_byte(int r, int c) { const int st = (r >> 4) * 2 + (c >> 5), rr = r & 15, cc = c & 31, ob = rr * 64 + cc * 2; return st * 1024 + (ob ^ (((ob >> 9) & 1) << 5)); }
__host__ __device__ __forceinline__ void stage_rc(int b, int& R, int& C) { const int st = b / 1024, sb = b % 1024, swz = sb ^ (((sb >> 9) & 1) << 5); R = (st >> 1) * 16 + swz / 64; C = (st & 1) * 32 + (swz % 64) / 2; }
__host__ __device__ __forceinline__ int perm32(int rho) { const int n = rho >> 4, i = rho & 15; return 8 * (i >> 2) + 4 * n + (i & 3); }
struct Gemm { const bf16_t* A; const bf16_t* Bt; int M, N, K; };
struct StaticOrder {
    int nM, nN, nwg, G, c, ntK;
    __host__ __device__ void init(int M, int N, int K, int G_, int c_) { nM = M / BM; nN = N / BM; nwg = nM * nN; G = G_; c = c_; ntK = K / BK; }
    __host__ __device__ void map(int wgid, Unit& u) const {
        { const int q = nwg / NXCD, r = nwg % NXCD, xcd = wgid % NXCD, off = wgid / NXCD; wgid = (xcd < r ? xcd * (q + 1) : r * (q + 1) + (xcd - r) * q) + off; }
        const int nig = WGM * nN, gid = wgid / nig, fm = gid * WGM, gsz = (nM - fm) < WGM ? (nM - fm) : WGM;
        u.pm = fm + ((wgid % nig) % gsz); u.pn = (wgid % nig) / gsz; u.ks = -1; u.nt = ntK; u.kofs = 0;
    }
    __host__ __device__ bool next(int i, Unit& u) const { const long L = (long)i * G + c; if (L >= nwg) return false; map((int)L, u); return true; }
    __device__ __forceinline__ void a_ready(const Unit&) const {}
    __device__ __forceinline__ void done(const Unit&) const {}
};
struct MixedOrder {
    StaticOrder base; int nsplit, pmx, ntS, nNx;
    __host__ __device__ void init(int M, int N, int K, int G_, int c_, int pmx_, int nsplit_) { base.init(M, N, K, G_, c_); pmx = pmx_; nsplit = nsplit_; ntS = nsplit_ ? (K / BK) / nsplit_ : 0; nNx = N / BM; }
    __host__ __device__ bool next(int i, Unit& u) const {
        const long L = (long)i * base.G + base.c;
        if (L < base.nwg) { base.map((int)L, u); return true; }
        const long L2 = L - base.nwg; if (L2 >= (long)nsplit * nNx) return false;
        u.pm = pmx; u.pn = (int)(L2 % nNx); u.ks = (int)(L2 / nNx); u.nt = ntS; u.kofs = u.ks * ntS * BK * 2; return true;
    }
    __device__ __forceinline__ void a_ready(const Unit&) const {}
    __device__ __forceinline__ void done(const Unit&) const {}
};
template <class Epi, class Sched, bool ALIGN_EPI = false, bool SP2 = false>
__device__ __forceinline__ void gemm_phase(PG8_LAS unsigned char* lds, const Gemm g, const Sched& S, const Epi& E, const int tid) {
    const int wid = __builtin_amdgcn_readfirstlane(tid >> 6), lane = tid & 63, wr = wid >> 2, wc = wid & 3, fr = lane & 15, fq = lane >> 4;
    const int K = g.K;
    unsigned voffA[2], voffB[2];
#pragma unroll
    for (int i = 0; i < 2; ++i) { int R, C; stage_rc(tid * 16 + i * 8192, R, C); const int Rb = Epi::PERM ? ((R & ~31) + perm32(R & 31)) : R;
        voffA[i] = (unsigned)(R * K + C) * 2u; voffB[i] = (unsigned)(Rb * K + C) * 2u; }
    const size_t kstep = (size_t)(BK * 2);
    const size_t hstep = (size_t)HALF * K * 2;
    const size_t tstep = 2 * hstep;
    const unsigned ldsw = (unsigned)wid * 1024u;
    const int aoff = lds_byte(wr * 64 + fr, fq * 8), boff = lds_byte(wc * 32 + fr, fq * 8);
#define PG8_SA(b, h) (((b) * 2 + (h)) * HTB)
#define PG8_SB(b, h) ((4 + (b) * 2 + (h)) * HTB)
#define PG8_STAGE(bufoff, gbase, voff) do { _Pragma("unroll") for (int _i = 0; _i < 2; ++_i) \
        __builtin_amdgcn_global_load_lds((const unsigned*)((const char*)(gbase) + (voff)[_i]), (PG8_LAS unsigned*)(lds + (bufoff) + ldsw + _i * 8192), 16, 0, 0); } while (0)
#define PG8_LDA(dst, b, h) do { _Pragma("unroll") for (int m = 0; m < 4; ++m) _Pragma("unroll") for (int k = 0; k < 2; ++k) dst[m][k] = *(const PG8_LAS bf16x8*)(lds + PG8_SA(b, h) + aoff + m * 2048 + k * 1024); } while (0)
#define PG8_LDB(dst, b, h) do { _Pragma("unroll") for (int n = 0; n < 2; ++n) _Pragma("unroll") for (int k = 0; k < 2; ++k) dst[n][k] = *(const PG8_LAS bf16x8*)(lds + PG8_SB(b, h) + boff + n * 2048 + k * 1024); } while (0)
#define PG8_MMA(ai, bj, At, Bt) do { __builtin_amdgcn_s_setprio(1); _Pragma("unroll") for (int m = 0; m < 4; ++m) _Pragma("unroll") for (int n = 0; n < 2; ++n) _Pragma("unroll") for (int k = 0; k < 2; ++k) \
        acc[ai][bj][m][n] = __builtin_amdgcn_mfma_f32_16x16x32_bf16(Bt[n][k], At[m][k], acc[ai][bj][m][n], 0, 0, 0); __builtin_amdgcn_s_setprio(0); } while (0)
#define PG8_WAIT_V(n) asm volatile("s_waitcnt vmcnt(" #n ")" ::: "memory")
#define PG8_WAIT_L(n) asm volatile("s_waitcnt lgkmcnt(" #n ")" ::: "memory")
#define PG8_BAR __builtin_amdgcn_s_barrier()
#define PG8_SCHED __builtin_amdgcn_sched_barrier(0)
    Unit cur, nxt; int ui = 0;
    if (!S.next(0, cur)) return;
    f32x4 acc[2][2][4][2];
#pragma unroll
    for (int a = 0; a < 2; ++a)
#pragma unroll
        for (int b = 0; b < 2; ++b)
#pragma unroll
            for (int m = 0; m < 4; ++m)
#pragma unroll
                for (int n = 0; n < 2; ++n) acc[a][b][m][n] = (f32x4){0.f, 0.f, 0.f, 0.f};
    bf16x8 At[4][2], B0[2][2], B1[2][2];
    const char* cA = (const char*)g.A + (size_t)cur.pm * tstep + cur.kofs; const char* cB = (const char*)g.Bt + (size_t)cur.pn * tstep + cur.kofs;
    S.a_ready(cur);
    if constexpr (SP2) {
        PG8_STAGE(PG8_SB(0, 0), cB, voffB); PG8_STAGE(PG8_SB(0, 1), cB + hstep, voffB); PG8_STAGE(PG8_SA(0, 0), cA, voffA); PG8_STAGE(PG8_SA(0, 1), cA + hstep, voffA);
        if (wr == 1) PG8_BAR;
        PG8_WAIT_V(2); PG8_BAR;
        PG8_STAGE(PG8_SB(1, 0), cB + kstep, voffB); PG8_STAGE(PG8_SA(1, 0), cA + kstep, voffA); PG8_STAGE(PG8_SB(1, 1), cB + hstep + kstep, voffB);
        PG8_WAIT_V(6); PG8_BAR;
    } else {
        PG8_STAGE(PG8_SB(0, 0), cB, voffB); PG8_STAGE(PG8_SA(0, 0), cA, voffA); PG8_STAGE(PG8_SB(0, 1), cB + hstep, voffB); PG8_STAGE(PG8_SA(0, 1), cA + hstep, voffA);
        if (wr == 1) PG8_BAR;
        PG8_WAIT_V(4); PG8_BAR;
        PG8_STAGE(PG8_SB(1, 0), cB + kstep, voffB); PG8_STAGE(PG8_SA(1, 0), cA + kstep, voffA); PG8_STAGE(PG8_SB(1, 1), cB + hstep + kstep, voffB);
        PG8_WAIT_V(6); PG8_BAR;
    }
    for (;;) {
        const bool has_next = S.next(ui + 1, nxt);
        const char* nA = has_next ? (const char*)g.A + (size_t)nxt.pm * tstep + nxt.kofs : cA; const char* nB = has_next ? (const char*)g.Bt + (size_t)nxt.pn * tstep + nxt.kofs : cB;
        const int nt = cur.nt;
        for (int t = 0; t < nt; t += 2) {
            const bool last = (t == nt - 2);
            const char* a1 = cA + (size_t)(t + 1) * kstep;
            const char* a2 = last ? nA : cA + (size_t)(t + 2) * kstep; const char* b2 = last ? nB : cB + (size_t)(t + 2) * kstep;
            const char* a3 = a2 + kstep; const char* b3 = b2 + kstep;
            if (last && has_next) S.a_ready(nxt);
            if constexpr (SP2) {
            PG8_LDB(B0, 0, 0); PG8_LDB(B1, 0, 1); PG8_SCHED; PG8_LDA(At, 0, 0); PG8_STAGE(PG8_SA(1, 1), a1 + hstep, voffA);
            PG8_WAIT_V(8); PG8_WAIT_L(0); PG8_BAR; PG8_MMA(0, 0, At, B0); PG8_MMA(0, 1, At, B1); PG8_BAR; PG8_SCHED;
            PG8_LDA(At, 0, 1); PG8_STAGE(PG8_SB(0, 0), b2, voffB); PG8_STAGE(PG8_SB(0, 1), b2 + hstep, voffB); PG8_STAGE(PG8_SA(0, 0), a2, voffA);
            PG8_WAIT_V(8); PG8_WAIT_L(0); PG8_BAR; PG8_MMA(1, 0, At, B0); PG8_MMA(1, 1, At, B1); PG8_BAR; PG8_SCHED;
            PG8_LDB(B0, 1, 0); PG8_LDB(B1, 1, 1); PG8_SCHED; PG8_LDA(At, 1, 0); PG8_STAGE(PG8_SA(0, 1), a2 + hstep, voffA);
            PG8_WAIT_V(8); PG8_WAIT_L(0); PG8_BAR; PG8_MMA(0, 0, At, B0); PG8_MMA(0, 1, At, B1); PG8_BAR; PG8_SCHED;
            PG8_LDA(At, 1, 1); PG8_STAGE(PG8_SB(1, 0), b3, voffB); PG8_STAGE(PG8_SB(1, 1), b3 + hstep, voffB); PG8_STAGE(PG8_SA(1, 0), a3, voffA);
            PG8_WAIT_V(8); PG8_WAIT_L(0); PG8_BAR; PG8_MMA(1, 0, At, B0); PG8_MMA(1, 1, At, B1); PG8_BAR; PG8_SCHED;
            } else {
            PG8_LDB(B0, 0, 0); PG8_SCHED; PG8_LDA(At, 0, 0); PG8_STAGE(PG8_SA(1, 1), a1 + hstep, voffA);
            PG8_WAIT_L(8); PG8_BAR; PG8_WAIT_L(0); PG8_MMA(0, 0, At, B0); PG8_BAR; PG8_SCHED;
            PG8_LDB(B1, 0, 1); PG8_STAGE(PG8_SB(0, 0), b2, voffB);
            PG8_BAR; PG8_WAIT_L(0); PG8_MMA(0, 1, At, B1); PG8_BAR;
            PG8_LDA(At, 0, 1); PG8_STAGE(PG8_SA(0, 0), a2, voffA);
            PG8_BAR; PG8_WAIT_L(0); PG8_MMA(1, 0, At, B0); PG8_BAR; PG8_SCHED;
            PG8_STAGE(PG8_SB(0, 1), b2 + hstep, voffB);
            PG8_WAIT_V(6); PG8_BAR; PG8_MMA(1, 1, At, B1); PG8_BAR;
            PG8_LDB(B0, 1, 0); PG8_SCHED; PG8_LDA(At, 1, 0); PG8_STAGE(PG8_SA(0, 1), a2 + hstep, voffA);
            PG8_WAIT_L(8); PG8_BAR; PG8_WAIT_L(0); PG8_MMA(0, 0, At, B0); PG8_BAR; PG8_SCHED;
            PG8_LDB(B1, 1, 1); PG8_STAGE(PG8_SB(1, 0), b3, voffB);
            PG8_BAR; PG8_WAIT_L(0); PG8_MMA(0, 1, At, B1); PG8_BAR;
            PG8_LDA(At, 1, 1); PG8_STAGE(PG8_SA(1, 0), a3, voffA);
            PG8_BAR; PG8_WAIT_L(0); PG8_MMA(1, 0, At, B0); PG8_BAR; PG8_SCHED;
            PG8_STAGE(PG8_SB(1, 1), b3 + hstep, voffB);
            PG8_WAIT_V(6); PG8_BAR; PG8_MMA(1, 1, At, B1); PG8_BAR;
            }
        }
        if constexpr (ALIGN_EPI) { if (wr == 0) PG8_BAR; }
        if constexpr (!Epi::AFTER_DRAIN) { E(acc, cur, wr, wc, fr, fq); S.done(cur); }
        if (!has_next) break;
#pragma unroll
        for (int a = 0; a < 2; ++a)
#pragma unroll
            for (int b = 0; b < 2; ++b)
#pragma unroll
                for (int m = 0; m < 4; ++m)
#pragma unroll
                    for (int n = 0; n < 2; ++n) acc[a][b][m][n] = (f32x4){0.f, 0.f, 0.f, 0.f};
        cur = nxt; cA = nA; cB = nB; ++ui;
        if constexpr (ALIGN_EPI) { if (wr == 1) PG8_BAR; }
    }
    PG8_WAIT_V(0);
    if constexpr (!ALIGN_EPI) { if (wr == 0) PG8_BAR; }
    PG8_BAR;
#undef PG8_SA
#undef PG8_SB
#undef PG8_STAGE
#undef PG8_LDA
#undef PG8_LDB
#undef PG8_MMA
#undef PG8_WAIT_V
#undef PG8_WAIT_L
#undef PG8_BAR
#undef PG8_SCHED
}
}
#ifndef PG8_SP2
#define PG8_SP2 true
#endif
#ifndef PG8_ALIGN
#define PG8_ALIGN true
#endif

#define XB_TMO      128
#define XB_XCNT(j)  (256  + 64 * (j))
#define XB_XSUB(j)  (1280 + 64 * (j))
#define XB_XGEN(j)  (2304 + 64 * (j))
#define XB_TOP      3328
#define XB_TOPGEN   3392
#define XCD_BAR_WORDS 3456
#define XB_SPIN_CAP (1u << 18)
__device__ __forceinline__ unsigned xb_ld(unsigned* p)              { return __hip_atomic_load(p, __ATOMIC_RELAXED, __HIP_MEMORY_SCOPE_AGENT); }
__device__ __forceinline__ unsigned xb_add(unsigned* p, unsigned v) { return __hip_atomic_fetch_add(p, v, __ATOMIC_RELAXED, __HIP_MEMORY_SCOPE_AGENT); }
__device__ __forceinline__ unsigned xb_xcc_id() { return (unsigned)__builtin_amdgcn_s_getreg((3 << 11) | 20) & 0xFu; }
#define XB_SPIN(cond, bar) do { unsigned _sp = 0; while (cond) { __builtin_amdgcn_s_sleep(1); \
    if ((++_sp & 255u) == 0u) { if (xb_ld(&(bar)[XB_TMO])) break; if (_sp > XB_SPIN_CAP) { atomicAdd(&(bar)[XB_TMO], 1u); break; } } } } while (0)
struct XcdBarrier { unsigned* bar; unsigned x; volatile LAS unsigned* st; };
__device__ __forceinline__ XcdBarrier xcd_barrier_post(unsigned* bar, volatile LAS unsigned* st) {
    XcdBarrier b; b.bar = bar; b.x = xb_xcc_id(); b.st = st;
    if (threadIdx.x == 0) (void)xb_add(&bar[XB_XCNT(b.x)], 1u);
    return b;
}
__device__ __forceinline__ void xcd_barrier_complete(unsigned* bar, unsigned x, unsigned& nloc, unsigned& nx) {
    const unsigned G = gridDim.x * gridDim.y * gridDim.z;
    unsigned sum, cnt, mine, sp = 0u;
    for (;;) {
        sum = 0u; cnt = 0u; mine = 0u;
#pragma unroll
        for (unsigned j = 0; j < 16; ++j) { const unsigned c = xb_ld(&bar[XB_XCNT(j)]); sum += c; cnt += (c > 0u) ? 1u : 0u; mine = (j == x) ? c : mine; }
        if (sum == G) break;
        __builtin_amdgcn_s_sleep(1);
        if ((++sp & 255u) == 0u) { if (xb_ld(&bar[XB_TMO])) break; if (sp > XB_SPIN_CAP) { atomicAdd(&bar[XB_TMO], 1u); break; } }
    }
    nloc = mine > 0u ? mine : 1u; nx = cnt > 0u ? cnt : 1u;
}
__device__ __forceinline__ void xcd_barrier(const XcdBarrier& b) {
    asm volatile("s_waitcnt vmcnt(0)" ::: "memory");
    __syncthreads();
    if (threadIdx.x == 0) {
        unsigned* bar = b.bar;
        __builtin_amdgcn_s_waitcnt(0);
        unsigned nloc = b.st[0], nx = b.st[1];
        if (nloc == 0u) { xcd_barrier_complete(bar, b.x, nloc, nx); b.st[0] = nloc; b.st[1] = nx; }
        const unsigned old = xb_add(&bar[XB_XSUB(b.x)], 1u);
        const unsigned gen = old / nloc;
        if (old + 1u == (gen + 1u) * nloc) {
            __builtin_amdgcn_fence(__ATOMIC_RELEASE, "agent");
            asm volatile("s_waitcnt vmcnt(0)" ::: "memory");
            const unsigned og = xb_add(&bar[XB_TOP], 1u);
            const unsigned tg = og / nx;
            if (og + 1u == (tg + 1u) * nx) xb_add(&bar[XB_TOPGEN], 1u);
            else XB_SPIN(xb_ld(&bar[XB_TOPGEN]) == tg, bar);
            __builtin_amdgcn_fence(__ATOMIC_ACQUIRE, "agent");
            xb_add(&bar[XB_XGEN(b.x)], 1u);
            asm volatile("s_waitcnt vmcnt(0)" ::: "memory");
        } else {
            XB_SPIN(xb_ld(&bar[XB_XGEN(b.x)]) == gen, bar);
            __builtin_amdgcn_fence(__ATOMIC_ACQUIRE, "agent");
            asm volatile("s_waitcnt vmcnt(0)" ::: "memory");
        }
    }
    __syncthreads();
}

constexpr size_t al256(size_t x) { return (x + 255) & ~(size_t)255; }
constexpr size_t WS_CTL = 0;
constexpr size_t CTL_ZERO_BYTES = 65536;
constexpr size_t WS_MODACC = 4u << 20;
constexpr size_t WS_ROPE = 1u << 20;
constexpr size_t WS_WABIN = 8u << 20;
constexpr size_t SZ_WABIN = (size_t)ABIN * D * 2;
constexpr size_t WS_WABOUT = WS_WABIN + 2 * SZ_WABIN;
constexpr size_t SZ_WSQ = (size_t)D * D * 2;
constexpr size_t WS_WQKV = WS_WABOUT + 2 * SZ_WSQ;
constexpr size_t SZ_WQKV = (size_t)QKV * D * 2;
constexpr size_t WS_WNAOUT = WS_WQKV + 2 * SZ_WQKV;
constexpr size_t WS_WFFIN = WS_WNAOUT + 2 * SZ_WSQ;
constexpr size_t SZ_WFFIN = (size_t)FF2 * D * 2;
constexpr size_t WS_WFFOUT = WS_WFFIN + 4 * SZ_WFFIN;
constexpr size_t SZ_WFFOUT = (size_t)D * FFH * 2;
constexpr size_t WS_X = WS_WFFOUT + 4 * SZ_WFFOUT;
constexpr size_t WS_H = WS_X + (size_t)MTOK * D * 4;
constexpr size_t WS_P = WS_H + (size_t)MTOK * D * 2;
constexpr size_t WS_YAB = WS_P + (size_t)MTOK * ABIN * 2;
constexpr size_t WS_Y = WS_YAB + (size_t)MTOK * D * 2;
constexpr size_t WS_HID = WS_Y + (size_t)MTOK * D * 4;
constexpr size_t WS_KVT = WS_HID + (size_t)MTOK * FFH * 2;
constexpr size_t WS_ST = WS_KVT + (size_t)NCHUNK * 16 * 16384 * 4;
constexpr size_t WS_YC = WS_ST + (size_t)NCHUNK * 16 * 16384 * 2;
constexpr size_t WS_END = WS_YC + (size_t)22 * 256 * D * 4;
constexpr int NSPLIT_OUT = 8, NSPLIT_FFO = 22;
static_assert(WS_WABIN % 256 == 0 && WS_X % 256 == 0 && WS_P % 256 == 0 && WS_KVT % 256 == 0 && WS_ST % 256 == 0, "ws alignment");

constexpr int RING_BYTES = 131072, LDSCTL_OFF = RING_BYTES, MISC_OFF = LDSCTL_OFF + 320, LDS_BYTES = 147456;
constexpr int NPHASE = 2 + 9 * DEPTH;

struct Params { const float* in[16]; float* out; unsigned char* ws; int ph_lo, ph_hi, li, pad; };

__device__ __forceinline__ void transpose_item(const float* W, int ldw, int K, bf16_t* Wt, int k0, int n0s, int n0d, LAS float* scr, int lane) {
#pragma unroll 8
    for (int i = 0; i < 32; ++i) { const int kk = 2 * i + (lane >> 5); scr[kk * 33 + (lane & 31)] = W[(size_t)(k0 + kk) * ldw + n0s + (lane & 31)]; }
    asm volatile("s_waitcnt lgkmcnt(0)" ::: "memory");
    const int c = lane & 7;
#pragma unroll
    for (int j = 0; j < 4; ++j) { const int n = (lane >> 3) + 8 * j; const LAS float* s = scr + (8 * c) * 33 + n;
        u32x4 o; o[0] = cvt_pk_bf16(s[0 * 33], s[1 * 33]); o[1] = cvt_pk_bf16(s[2 * 33], s[3 * 33]); o[2] = cvt_pk_bf16(s[4 * 33], s[5 * 33]); o[3] = cvt_pk_bf16(s[6 * 33], s[7 * 33]);
        *(u32x4*)(Wt + (size_t)(n0d + n) * K + k0 + 8 * c) = o; }
    asm volatile("s_waitcnt lgkmcnt(0)" ::: "memory");
}
__device__ __forceinline__ void transpose_matrix_item(const float* W, int K, int N, bf16_t* Wt, bool ffperm, int item, LAS float* scr, int lane) {
    const int nblk = N / 32, kb = item / nblk, nb = item % nblk, n0d = 32 * nb;
    int n0s = n0d;
    if (ffperm) { const int t = n0d >> 8, j = n0d & 255; n0s = j < 128 ? 128 * t + j : FFH + 128 * t + (j - 128); }
    transpose_item(W, N, K, Wt, 64 * kb, n0s, n0d, scr, lane);
}

__global__ void __launch_bounds__(512, 2) mega_fwd(Params p) {
    extern __shared__ __attribute__((aligned(16))) unsigned char lds_raw[];
    LAS unsigned char* lds = (LAS unsigned char*)lds_raw;
    const int G = gridDim.x, bx = blockIdx.x, NGW = G * 8;
#define SITE_COORDS int tid = threadIdx.x; asm volatile("" : "+v"(tid)); const int lane = tid & 63, wave = __builtin_amdgcn_readfirstlane(tid >> 6); \
    const int vcu = (G % 8 == 0) ? (bx % 8) * (G / 8) + bx / 8 : bx; const int gw = vcu * 8 + wave; (void)lane; (void)gw; (void)vcu
    unsigned char* ws = p.ws;
    volatile LAS unsigned* MISC = (volatile LAS unsigned*)(lds + MISC_OFF);
    { const int tid = threadIdx.x; for (int u = tid; u < (LDS_BYTES - LDSCTL_OFF) / 4; u += 512) ((LAS unsigned*)(lds + LDSCTL_OFF))[u] = 0u; }
    __syncthreads();
    const int lo = p.ph_lo, hi = p.ph_hi;
    const bool multi = (hi - lo) > 1;
    XcdBarrier bar; bar.bar = (unsigned*)(ws + WS_CTL) + p.li * 4096; bar.x = 0; bar.st = nullptr;
    if (multi) bar = xcd_barrier_post((unsigned*)(ws + WS_CTL) + p.li * 4096, MISC + 8);
#ifndef SITE_MASK
#define SITE_MASK 0xffff
#endif
#define EN(i) (((SITE_MASK) >> (i)) & 1)
#ifndef REPEAT_MASK
#define REPEAT_MASK 0
#endif
    int rmask_ = REPEAT_MASK; asm volatile("" : "+s"(rmask_));
#define REP(i) ((rmask_ >> (i)) & 1)
#define IN(k) (lo <= (k) && (k) < hi)
#define ROWOP_RUN(a0) do { RowopArgs ra_ = (a0); if (rep_ + 1 < nrep_) { ra_.xout_lat = (float*)(ws + WS_END); ra_.xout_ctx = ra_.xout_lat + (size_t)S * D; ra_.h = (bf16_t*)(ws + WS_END + (size_t)MTOK * D * 4); } LAS float* cf0 = (LAS float*)lds; LAS float* cf1 = (LAS float*)(lds + 24576); \
        rowop_coefs(ra_, 0, cf0, tid); if (ra_.nctx) rowop_coefs(ra_, 1, cf1, tid); __syncthreads(); \
        if (ra_.nctx) rowop_ctx(ra_, cf1, (LAS float*)(lds + 49152), vcu, G, wave, lane); \
        rowop_stream(ra_, cf0, gw, NGW, lane); __syncthreads(); } while (0)
#ifndef DOUBLE_BAR
#define DOUBLE_BAR 0
#endif
#define SEAM(k, knext) do { if (IN(k) && IN(knext)) { xcd_barrier(bar); if (DOUBLE_BAR) xcd_barrier(bar); } } while (0)

    const float* x_in = p.in[0]; const float* c_in = p.in[1]; const float* ctx_in = p.in[2]; const float* cctx_in = p.in[3];
    const float* ada_w = p.in[4]; const float* ada_b = p.in[5]; const float* norm_g = p.in[6];
    const float* ab_w_in = p.in[7]; const float* ab_conv_w = p.in[8]; const float* ab_decay = p.in[9]; const float* ab_w_out = p.in[10];
    const float* na_w_qkv = p.in[11]; const float* na_rpb = p.in[12]; const float* na_w_out = p.in[13];
    const float* ffn_w_in = p.in[14]; const float* ffn_w_out = p.in[15];
    float* modacc = (float*)(ws + WS_MODACC);
    f32x2* rope = (f32x2*)(ws + WS_ROPE);
    float* X = (float*)(ws + WS_X); bf16_t* H = (bf16_t*)(ws + WS_H); bf16_t* P = (bf16_t*)(ws + WS_P); bf16_t* YAB = (bf16_t*)(ws + WS_YAB);
    float* Y = (float*)(ws + WS_Y); bf16_t* HID = (bf16_t*)(ws + WS_HID); float* KVT = (float*)(ws + WS_KVT); bf16_t* ST = (bf16_t*)(ws + WS_ST); float* YC = (float*)(ws + WS_YC);

    for (int nrep_ = 1 + REP(0), rep_ = 0; rep_ < nrep_; ++rep_) if (EN(0) && IN(0)) {
        SITE_COORDS;
        LAS float* scr = (LAS float*)(lds + wave * 16384);
        constexpr int I_ABIN = (D / 64) * (ABIN / 32), I_SQ = (D / 64) * (D / 32), I_QKV = (D / 64) * (QKV / 32), I_FFIN = (D / 64) * (FF2 / 32), I_FFOUT = (FFH / 64) * (D / 32);
        constexpr int NITEMS = 2 * (I_ABIN + I_SQ + I_QKV + I_SQ) + 4 * (I_FFIN + I_FFOUT);
        for (int it = gw; it < NITEMS; it += NGW) {
            int r = it;
            if (r < 2 * I_ABIN) { const int i = r / I_ABIN; transpose_matrix_item(ab_w_in + (size_t)i * D * ABIN, D, ABIN, (bf16_t*)(ws + WS_WABIN + i * SZ_WABIN), false, r % I_ABIN, scr, lane); continue; } r -= 2 * I_ABIN;
            if (r < 2 * I_SQ) { const int i = r / I_SQ; transpose_matrix_item(ab_w_out + (size_t)i * D * D, D, D, (bf16_t*)(ws + WS_WABOUT + i * SZ_WSQ), false, r % I_SQ, scr, lane); continue; } r -= 2 * I_SQ;
            if (r < 2 * I_QKV) { const int i = r / I_QKV; transpose_matrix_item(na_w_qkv + (size_t)i * D * QKV, D, QKV, (bf16_t*)(ws + WS_WQKV + i * SZ_WQKV), false, r % I_QKV, scr, lane); continue; } r -= 2 * I_QKV;
            if (r < 2 * I_SQ) { const int i = r / I_SQ; transpose_matrix_item(na_w_out + (size_t)i * D * D, D, D, (bf16_t*)(ws + WS_WNAOUT + i * SZ_WSQ), false, r % I_SQ, scr, lane); continue; } r -= 2 * I_SQ;
            if (r < 4 * I_FFIN) { const int i = r / I_FFIN; transpose_matrix_item(ffn_w_in + (size_t)i * D * FF2, D, FF2, (bf16_t*)(ws + WS_WFFIN + i * SZ_WFFIN), true, r % I_FFIN, scr, lane); continue; } r -= 4 * I_FFIN;
            { const int i = r / I_FFOUT; transpose_matrix_item(ffn_w_out + (size_t)i * FFH * D, FFH, D, (bf16_t*)(ws + WS_WFFOUT + i * SZ_WFFOUT), false, r % I_FFOUT, scr, lane); }
        }
        for (int it = vcu; it < 4 * 4 * 6; it += G) {
            const int l = it / 24, kp = (it % 24) / 6, nc = it % 6, n = nc * 2048 + 4 * tid;
            f32x4 aL = (f32x4){0.f, 0.f, 0.f, 0.f}, aC = aL;
            const float* wp = ada_w + ((size_t)l * D + kp * 512) * (6 * D) + n;
#pragma unroll 8
            for (int k = 0; k < 512; ++k) { const f32x4 w = *(const f32x4*)(wp + (size_t)k * (6 * D)); const float cl = c_in[kp * 512 + k], cc = cctx_in[kp * 512 + k];
                const float sl = cl / (1.0f + __expf(-cl)), sc = cc / (1.0f + __expf(-cc)); aL = aL + w * sl; aC = aC + w * sc; }
            *(f32x4*)(modacc + (size_t)kp * MODPART + (size_t)(l * 2 + 0) * 6 * D + n) = aL;
            *(f32x4*)(modacc + (size_t)kp * MODPART + (size_t)(l * 2 + 1) * 6 * D + n) = aC;
        }
        for (int idx = bx * 512 + tid; idx < 192 * 32; idx += G * 512) {
            const int pi = idx >> 5, f = idx & 31; const float pos = (float)(pi < 128 ? pi : pi - 128);
            const float ang = pos * powf(10000.0f, -(float)f / 32.0f);
            rope[idx] = (f32x2){cosf(ang), sinf(ang)};
        }
    }
    SEAM(0, 1);
    for (int nrep_ = 1 + REP(1), rep_ = 0; rep_ < nrep_; ++rep_) if (EN(1) && IN(1)) {
        SITE_COORDS;
        RowopArgs a; a.y = nullptr; a.xin_lat = x_in; a.xin_ctx = ctx_in; a.xout_lat = X; a.xout_ctx = X + (size_t)S * D; a.h = H; a.modacc = modacc; a.ada_b = ada_b; a.norm_g = norm_g;
        a.ly = -1; a.jg_y = 0; a.jgate = 0; a.lh = 0; a.jg_h = 0; a.jshift = 0; a.jscale = 1; a.nctx = NCTX; a.ypart = nullptr; a.nypart = 0;
        ROWOP_RUN(a);
    }
    SEAM(1, 2);
    for (int layer = 0; layer < DEPTH; ++layer) {
        const int pb = 2 + 9 * layer, iab = layer >> 1;
        const bool even = (layer & 1) == 0, last = layer == DEPTH - 1;
        const int Mrows = last ? S : MTOK;
        if (even) {
            for (int nrep_ = 1 + REP(2), rep_ = 0; rep_ < nrep_; ++rep_) if (EN(2) && IN(pb + 0)) {
                SITE_COORDS;
                pg8::Gemm g{H, (const bf16_t*)(ws + WS_WABIN + iab * SZ_WABIN), MTOK, ABIN, D}; pg8::StaticOrder So; So.init(MTOK, ABIN, D, G, bx);
                EpiInProj E{P, rope};
                pg8::gemm_phase<EpiInProj, pg8::StaticOrder, PG8_ALIGN, PG8_SP2>(lds, g, So, E, tid);
            }
            SEAM(pb + 0, pb + 1);
            for (int nrep_ = 1 + REP(3), rep_ = 0; rep_ < nrep_; ++rep_) if (EN(3) && IN(pb + 1)) {
                SITE_COORDS;
                for (int bt = vcu; bt < NCHUNK * 8; bt += G) {
                    const int cidx = bt >> 3, head = bt & 7, dir = wave >> 2, quad = wave & 3;
                    r1_task(P, KVT, lg2gamma(ab_decay, iab, dir, head), cidx, head, dir, quad, lane);
                }
                for (int t = gw; t < (MTOK / 8) * 2; t += NGW) conv_task(P, YAB, ab_conv_w + (size_t)iab * 3 * 1024, t, lane);
            }
            SEAM(pb + 1, pb + 2);
            for (int nrep_ = 1 + REP(4), rep_ = 0; rep_ < nrep_; ++rep_) if (EN(4) && IN(pb + 2)) {
                SITE_COORDS;
                for (int it = vcu * 512 + tid; it < 131072; it += G * 512) r2_item(KVT, ST, ab_decay, iab, it);
            }
            SEAM(pb + 2, pb + 3);
            for (int nrep_ = 1 + REP(5), rep_ = 0; rep_ < nrep_; ++rep_) if (EN(5) && IN(pb + 3)) {
                SITE_COORDS;
                for (int bt = vcu; bt < NCHUNK * 8; bt += G) {
                    const int cidx = bt >> 3, head = bt & 7;
                    r3_task(P, ST, YAB, lg2gamma(ab_decay, iab, 0, head), lg2gamma(ab_decay, iab, 1, head), cidx, head, wave, lane);
                }
            }
            SEAM(pb + 3, pb + 4);
        } else {
            for (int nrep_ = 1 + REP(6), rep_ = 0; rep_ < nrep_; ++rep_) if (EN(6) && IN(pb + 0)) {
                SITE_COORDS;
                pg8::Gemm g{H, (const bf16_t*)(ws + WS_WQKV + iab * SZ_WQKV), MTOK, QKV, D}; pg8::StaticOrder So; So.init(MTOK, QKV, D, G, bx);
                EpiBf16 E{P, QKV};
                pg8::gemm_phase<EpiBf16, pg8::StaticOrder, PG8_ALIGN, PG8_SP2>(lds, g, So, E, tid);
            }
            SEAM(pb + 0, pb + 1);
            for (int nrep_ = 1 + REP(7), rep_ = 0; rep_ < nrep_; ++rep_) if (EN(7) && IN(pb + 1)) {
                SITE_COORDS;
                const float* rpb = na_rpb + (size_t)iab * 16 * 15 * 31;
                const int per = (1024 + G - 1) / G;
                for (int bt = vcu * per; bt < (vcu + 1) * per && bt < 1024; ++bt) {
                    const int h = bt >> 6, rp = bt & 63, r = 2 * rp + (wave >> 2), cgp = wave & 3;
                    const int kc0 = cgp == 0 ? 0 : (cgp == 1 ? 8 : (cgp == 2 ? 24 : 32));
                    attn_task<true>(P, YAB, rpb, h, r * 64 + 16 * cgp, r, 16 * cgp, kc0, lane);
                }
                if (!last) for (int t = gw; t < 256; t += NGW) attn_task<false>(P, YAB, rpb, t >> 4, S + 16 * (t & 15), 0, 0, 0, lane);
            }
            SEAM(pb + 1, pb + 4);
        }
        for (int nrep_ = 1 + REP(8), rep_ = 0; rep_ < nrep_; ++rep_) if (EN(8) && IN(pb + 4)) {
            SITE_COORDS;
            const bf16_t* wt = even ? (const bf16_t*)(ws + WS_WABOUT + iab * SZ_WSQ) : (const bf16_t*)(ws + WS_WNAOUT + iab * SZ_WSQ);
            pg8::Gemm g{YAB, wt, MTOK, D, D}; pg8::MixedOrder So; So.init(S, D, D, G, bx, 32, last ? 0 : NSPLIT_OUT);
            EpiF32 E{Y, D, YC};
            pg8::gemm_phase<EpiF32, pg8::MixedOrder, PG8_ALIGN, PG8_SP2>(lds, g, So, E, tid);
        }
        SEAM(pb + 4, pb + 5);
        for (int nrep_ = 1 + REP(9), rep_ = 0; rep_ < nrep_; ++rep_) if (EN(9) && IN(pb + 5)) {
            SITE_COORDS;
            RowopArgs a; a.y = Y; a.xin_lat = X; a.xin_ctx = X + (size_t)S * D; a.xout_lat = X; a.xout_ctx = X + (size_t)S * D; a.h = H; a.modacc = modacc; a.ada_b = ada_b; a.norm_g = norm_g;
            a.ly = layer; a.jg_y = 1; a.jgate = 2; a.lh = layer; a.jg_h = 2; a.jshift = 3; a.jscale = 4; a.nctx = last ? 0 : NCTX; a.ypart = YC; a.nypart = NSPLIT_OUT;
            ROWOP_RUN(a);
        }
        SEAM(pb + 5, pb + 6);
        for (int nrep_ = 1 + REP(10), rep_ = 0; rep_ < nrep_; ++rep_) if (EN(10) && IN(pb + 6)) {
            SITE_COORDS;
            pg8::Gemm g{H, (const bf16_t*)(ws + WS_WFFIN + layer * SZ_WFFIN), Mrows, FF2, D}; pg8::StaticOrder So; So.init(Mrows, FF2, D, G, bx);
            EpiSwiglu E{HID};
            pg8::gemm_phase<EpiSwiglu, pg8::StaticOrder, PG8_ALIGN, PG8_SP2>(lds, g, So, E, tid);
        }
        SEAM(pb + 6, pb + 7);
        for (int nrep_ = 1 + REP(11), rep_ = 0; rep_ < nrep_; ++rep_) if (EN(11) && IN(pb + 7)) {
            SITE_COORDS;
            pg8::Gemm g{HID, (const bf16_t*)(ws + WS_WFFOUT + layer * SZ_WFFOUT), MTOK, D, FFH}; pg8::MixedOrder So; So.init(S, D, FFH, G, bx, 32, last ? 0 : NSPLIT_FFO);
            EpiF32 E{Y, D, YC};
            pg8::gemm_phase<EpiF32, pg8::MixedOrder, PG8_ALIGN, PG8_SP2>(lds, g, So, E, tid);
        }
        SEAM(pb + 7, pb + 8);
        for (int nrep_ = 1 + REP(12), rep_ = 0; rep_ < nrep_; ++rep_) if (EN(12) && IN(pb + 8)) {
            SITE_COORDS;
            RowopArgs a; a.y = Y; a.xin_lat = X; a.xin_ctx = X + (size_t)S * D; a.xout_lat = last ? p.out : X; a.xout_ctx = last ? nullptr : X + (size_t)S * D; a.h = H; a.modacc = modacc; a.ada_b = ada_b; a.norm_g = norm_g;
            a.ly = layer; a.jg_y = 3; a.jgate = 5; a.lh = last ? -1 : layer + 1; a.jg_h = 0; a.jshift = 0; a.jscale = 1; a.nctx = last ? 0 : NCTX; a.ypart = YC; a.nypart = NSPLIT_FFO;
            ROWOP_RUN(a);
        }
        if (!last) SEAM(pb + 8, pb + 9);
    }
#undef IN
#undef SEAM
}

#ifndef MK_MODE
#define MK_MODE 1
#endif
extern "C" void kernel_launch(void* const* d_in, const int* in_sizes, int n_in, void* d_out, int out_size, void* d_ws, size_t ws_size, hipStream_t stream) {
    static int grid = 0;
    if (grid == 0) {
        if (n_in != 16 || out_size != S * D || ws_size < WS_END) { fprintf(stderr, "kernel_launch: unexpected shapes (n_in %d out %d ws %zu need %zu)\n", n_in, out_size, ws_size, (size_t)WS_END); grid = -1; return; }
        int dev = 0, cus = 0, per_cu = 0;
        if (hipGetDevice(&dev) != hipSuccess || hipDeviceGetAttribute(&cus, hipDeviceAttributeMultiprocessorCount, dev) != hipSuccess) { grid = -1; return; }
        if (hipFuncSetAttribute((const void*)mega_fwd, hipFuncAttributeMaxDynamicSharedMemorySize, LDS_BYTES) != hipSuccess) { fprintf(stderr, "kernel_launch: hipFuncSetAttribute failed\n"); grid = -1; return; }
        if (hipOccupancyMaxActiveBlocksPerMultiprocessor(&per_cu, (const void*)mega_fwd, 512, LDS_BYTES) != hipSuccess || per_cu < 1) fprintf(stderr, "kernel_launch: occupancy query says %d\n", per_cu);
        (void)hipGetLastError();
        grid = cus;
    }
    if (grid < 0) return;
    if (hipMemsetAsync((char*)d_ws + WS_CTL, 0, CTL_ZERO_BYTES, stream) != hipSuccess) { fprintf(stderr, "kernel_launch: memset failed\n"); return; }
    Params a{};
    for (int i = 0; i < 16; ++i) a.in[i] = (const float*)d_in[i];
    a.out = (float*)d_out; a.ws = (unsigned char*)d_ws; a.pad = 0;
#if MK_MODE == 1
    a.ph_lo = 0; a.ph_hi = NPHASE; a.li = 0;
    hipLaunchKernelGGL(mega_fwd, dim3(grid), dim3(512), LDS_BYTES, stream, a);
#else
    for (int ph = 0; ph < NPHASE; ++ph) {
        if (ph >= 2) { const int layer = (ph - 2) / 9, slot = (ph - 2) % 9; if ((layer & 1) && (slot == 2 || slot == 3)) continue; }
        a.ph_lo = ph; a.ph_hi = ph + 1; a.li = 0;
        hipLaunchKernelGGL(mega_fwd, dim3(grid), dim3(512), LDS_BYTES, stream, a);
    }
#endif
    const hipError_t le = hipPeekAtLastError();
    if (le != hipSuccess) fprintf(stderr, "kernel_launch: launch failed: %s\n", hipGetErrorName(le));
}
#endif
```

```cpp
#ifndef HOST_EMU
#include <hip/hip_runtime.h>
#include <cstdio>
#include <cstdint>
#define DEV __device__ __forceinline__
#define HDEV __host__ __device__ __forceinline__
#define LAS __attribute__((address_space(3)))
#endif

typedef unsigned short bf16_t;
typedef short bf16x8 __attribute__((ext_vector_type(8)));
typedef float f32x4 __attribute__((ext_vector_type(4)));
typedef float f32x2 __attribute__((ext_vector_type(2)));
typedef unsigned u32x4 __attribute__((ext_vector_type(4)));
typedef unsigned u32x2 __attribute__((ext_vector_type(2)));

#ifndef HOST_EMU
DEV f32x4 mfma16(bf16x8 a, bf16x8 b, f32x4 c) { return __builtin_amdgcn_mfma_f32_16x16x32_bf16(a, b, c, 0, 0, 0); }
DEV float shfl_xor_f(float v, int m) { return __shfl_xor(v, m); }
DEV unsigned cvt_pk_bf16(float lo, float hi) { unsigned r; asm("v_cvt_pk_bf16_f32 %0, %1, %2" : "=v"(r) : "v"(lo), "v"(hi)); return r; }
DEV float ex2(float x) { return __builtin_amdgcn_exp2f(x); }
DEV float rcp_f(float x) { return __builtin_amdgcn_rcpf(x); }
DEV float rsq_f(float x) { return 1.0f / sqrtf(x); }
DEV void atomic_add_f(float* p, float v) { (void)__hip_atomic_fetch_add(p, v, __ATOMIC_RELAXED, __HIP_MEMORY_SCOPE_AGENT); }
#endif

namespace cfg {
constexpr int D = 2048, S = 8192, NCTX = 256, MTOK = 8448, DEPTH = 4;
constexpr int ABIN = 7168, FFH = 5632, FF2 = 11264, QKV = 6144;
constexpr int NCHUNK = 66;
constexpr float EPS = 1e-6f;
constexpr float HSCALE = 0.08838834764831845f;
constexpr float LOG2E = 1.4426950408889634f;
}
using namespace cfg;

DEV float bf_lo(unsigned w) { return __builtin_bit_cast(float, w << 16); }
DEV float bf_hi(unsigned w) { return __builtin_bit_cast(float, w & 0xffff0000u); }
DEV float wave_sum(float v) {
#pragma unroll
    for (int o = 1; o < 64; o <<= 1) v += shfl_xor_f(v, o);
    return v;
}
DEV float silu_f(float x) { return x * rcp_f(1.0f + ex2(-x * LOG2E)); }
DEV float lg2gamma(const float* decay_exp, int iab, int dir, int head) {
    const float e = decay_exp[(iab * 2 + dir) * 8 + head];
    return log1pf(-exp2f(-e)) * LOG2E;
}
DEV bf16x8 extract8(const u32x4 (&vd)[8], int mt) {
    u32x4 w;
#pragma unroll
    for (int q = 0; q < 4; ++q) {
        const unsigned X = vd[2 * q][mt >> 1], Y = vd[2 * q + 1][mt >> 1];
        w[q] = (mt & 1) ? ((X >> 16) | (Y & 0xffff0000u)) : ((X & 0xffffu) | (Y << 16));
    }
    return __builtin_bit_cast(bf16x8, w);
}

struct RowopArgs {
    const float* y;
    const float* xin_lat; const float* xin_ctx;
    float* xout_lat; float* xout_ctx;
    bf16_t* h;
    const float* modacc; const float* ada_b; const float* norm_g;
    int ly, jg_y, jgate, lh, jg_h, jshift, jscale, nctx;
    const float* ypart; int nypart;
};
DEV f32x4 ld4(const float* p) { return *(const f32x4*)p; }
constexpr int MODPART = 4 * 2 * 6 * 2048;
DEV f32x4 modvec(const RowopArgs& a, int l, int s, int j, int col) {
    const float* q = a.modacc + (size_t)((l * 2 + s) * 6 + j) * D + col;
    return ((ld4(q) + ld4(q + MODPART)) + (ld4(q + 2 * MODPART) + ld4(q + 3 * MODPART))) + ld4(a.ada_b + (size_t)l * 6 * D + j * D + col);
}
template <class CP>
DEV void rowop_coefs(const RowopArgs& a, const int s, CP coef, const int tid) {
    const int col = 4 * tid;
    f32x4 A = (f32x4){0.f, 0.f, 0.f, 0.f}, B = A, SH = A;
    if (a.ly >= 0) A = modvec(a, a.ly, s, a.jgate, col) * ld4(a.norm_g + (size_t)(a.ly * 4 + a.jg_y) * D + col);
    if (a.lh >= 0) { B = ld4(a.norm_g + (size_t)(a.lh * 4 + a.jg_h) * D + col) * (modvec(a, a.lh, s, a.jscale, col) + 1.0f); SH = modvec(a, a.lh, s, a.jshift, col); }
    *(f32x4*)(coef + col) = A; *(f32x4*)(coef + D + col) = B; *(f32x4*)(coef + 2 * D + col) = SH;
}
template <class CP>
DEV void rowop_row(const RowopArgs& a, const int s, CP coef, const int m, f32x4 (&x)[8], const f32x4 (&y)[8], const int lane) {
    const bool hasy = a.ly >= 0, hash = a.lh >= 0;
    if (hasy) {
        float ss = 0.f;
#pragma unroll
        for (int j = 0; j < 8; ++j) ss += (y[j][0] * y[j][0] + y[j][1] * y[j][1]) + (y[j][2] * y[j][2] + y[j][3] * y[j][3]);
        const float r1 = rsq_f(wave_sum(ss) * (1.0f / D) + EPS);
#pragma unroll
        for (int j = 0; j < 8; ++j) x[j] = x[j] + *(const f32x4*)(coef + 4 * lane + 256 * j) * (y[j] * r1);
    }
    float* xo = (s == 0) ? (a.xout_lat ? a.xout_lat + (size_t)m * D : nullptr) : (a.xout_ctx ? a.xout_ctx + (size_t)(m - S) * D : nullptr);
    if (xo) {
#pragma unroll
        for (int j = 0; j < 8; ++j) *(f32x4*)(xo + 4 * lane + 256 * j) = x[j];
    }
    if (hash) {
        float ss = 0.f;
#pragma unroll
        for (int j = 0; j < 8; ++j) ss += (x[j][0] * x[j][0] + x[j][1] * x[j][1]) + (x[j][2] * x[j][2] + x[j][3] * x[j][3]);
        const float r2 = rsq_f(wave_sum(ss) * (1.0f / D) + EPS);
        bf16_t* hr = a.h + (size_t)m * D;
#pragma unroll
        for (int j = 0; j < 8; ++j) { const f32x4 v = (x[j] * r2) * *(const f32x4*)(coef + D + 4 * lane + 256 * j) + *(const f32x4*)(coef + 2 * D + 4 * lane + 256 * j);
            u32x2 w; w[0] = cvt_pk_bf16(v[0], v[1]); w[1] = cvt_pk_bf16(v[2], v[3]); *(u32x2*)(hr + 4 * lane + 256 * j) = w; }
    }
}
template <class CP>
DEV void rowop_stream(const RowopArgs& a, CP coef, const int gw, const int NGW, const int lane) {
    for (int m = gw; m < S; m += NGW) {
        const float* xr = a.xin_lat + (size_t)m * D;
        f32x4 x[8], y[8];
#pragma unroll
        for (int j = 0; j < 8; ++j) { x[j] = ld4(xr + 4 * lane + 256 * j); y[j] = (f32x4){0.f, 0.f, 0.f, 0.f}; }
        if (a.ly >= 0) { const float* yr = a.y + (size_t)m * D;
#pragma unroll
            for (int j = 0; j < 8; ++j) y[j] = ld4(yr + 4 * lane + 256 * j); }
        rowop_row(a, 0, coef, m, x, y, lane);
    }
}
#ifndef HOST_EMU
template <class CP, class LP>
DEV void rowop_ctx(const RowopArgs& a, CP coef, LP yrow, const int vcu, const int G, const int wave, const int lane) {
    for (int r = vcu; r < a.nctx; r += G) {
        if (a.ly >= 0) {
            const int col = 256 * wave + 4 * lane; const float* yp = a.ypart + (size_t)r * D + col;
            f32x4 acc = (f32x4){0.f, 0.f, 0.f, 0.f};
#pragma unroll 11
            for (int pp = 0; pp < a.nypart; ++pp) acc = acc + ld4(yp + (size_t)pp * 256 * D);
            *(f32x4*)(yrow + col) = acc;
        }
        __syncthreads();
        if (wave == 0) {
            const float* xr = a.xin_ctx + (size_t)r * D;
            f32x4 x[8], y[8];
#pragma unroll
            for (int j = 0; j < 8; ++j) { x[j] = ld4(xr + 4 * lane + 256 * j); y[j] = *(const f32x4*)(yrow + 4 * lane + 256 * j); }
            rowop_row(a, 1, coef, S + r, x, y, lane);
        }
        __syncthreads();
    }
}
#endif

DEV void conv_loadz(const bf16_t* P, int t, int c, float (&z)[8]) {
    const u32x4 cg = *(const u32x4*)(P + (size_t)t * ABIN + 1024 + c), u = *(const u32x4*)(P + (size_t)t * ABIN + 2048 + c);
#pragma unroll
    for (int e = 0; e < 4; ++e) { z[2 * e] = bf_lo(cg[e]) * bf_lo(u[e]); z[2 * e + 1] = bf_hi(cg[e]) * bf_hi(u[e]); }
}
DEV void conv_task(const bf16_t* P, bf16_t* YAB, const float* convw, int task, int lane) {
    const int half = task & 1, t0 = (task >> 1) * 8, c = half * 512 + lane * 8;
    float w0[8], w1[8], w2[8], zp[8], zc[8], zn[8];
#pragma unroll
    for (int e = 0; e < 8; ++e) { w0[e] = convw[c + e]; w1[e] = convw[1024 + c + e]; w2[e] = convw[2048 + c + e]; zp[e] = 0.f; zn[e] = 0.f; }
    if (t0 != 0 && t0 != S) conv_loadz(P, t0 - 1, c, zp);
    conv_loadz(P, t0, c, zc);
    for (int i = 0; i < 8; ++i) {
        const int t = t0 + i;
        if (t != S - 1 && t != MTOK - 1) conv_loadz(P, t + 1, c, zn);
        else {
#pragma unroll
            for (int e = 0; e < 8; ++e) zn[e] = 0.f;
        }
        const u32x4 bg = *(const u32x4*)(P + (size_t)t * ABIN + c);
        float o[8];
#pragma unroll
        for (int e = 0; e < 8; ++e) { const float b = (e & 1) ? bf_hi(bg[e >> 1]) : bf_lo(bg[e >> 1]); o[e] = b * (w0[e] * zp[e] + w1[e] * zc[e] + w2[e] * zn[e]); }
        u32x4 w; w[0] = cvt_pk_bf16(o[0], o[1]); w[1] = cvt_pk_bf16(o[2], o[3]); w[2] = cvt_pk_bf16(o[4], o[5]); w[3] = cvt_pk_bf16(o[6], o[7]);
        *(u32x4*)(YAB + (size_t)t * D + c) = w;
#pragma unroll
        for (int e = 0; e < 8; ++e) { zp[e] = zc[e]; zc[e] = zn[e]; }
    }
}

DEV int chunk_row(int cidx) { return cidx < 2 ? S + 128 * cidx : 128 * (cidx - 2); }
DEV void r1_task(const bf16_t* P, float* KVt, float lg2, int cidx, int head, int dir, int quad, int lane) {
    const int i = lane & 15, g = lane >> 4;
    const int dk0 = 64 * (quad >> 1), dv0 = 64 * (quad & 1);
    const bf16_t* Kp = P + (size_t)chunk_row(cidx) * ABIN + 4096 + head * 128 + dk0 + 4 * i;
    const bf16_t* Vp = P + (size_t)chunk_row(cidx) * ABIN + 5120 + head * 128 + dv0 + 4 * i;
    f32x4 acc[4][4];
#pragma unroll
    for (int a = 0; a < 4; ++a)
#pragma unroll
        for (int b = 0; b < 4; ++b) acc[a][b] = (f32x4){0.f, 0.f, 0.f, 0.f};
    for (int s = 0; s < 4; ++s) {
        u32x2 kd[8], vd[8]; float w[8];
#pragma unroll
        for (int jj = 0; jj < 8; ++jj) {
            const int tj = 32 * s + 8 * g + jj;
            kd[jj] = *(const u32x2*)(Kp + (size_t)tj * ABIN); vd[jj] = *(const u32x2*)(Vp + (size_t)tj * ABIN);
            w[jj] = ex2(lg2 * (float)(dir == 0 ? 127 - tj : tj));
        }
        bf16x8 af[4], bfr[4];
#pragma unroll
        for (int mt = 0; mt < 4; ++mt) {
            u32x4 wd;
#pragma unroll
            for (int q = 0; q < 4; ++q) {
                const unsigned X = kd[2 * q][mt >> 1], Y = kd[2 * q + 1][mt >> 1];
                const float lo = ((mt & 1) ? bf_hi(X) : bf_lo(X)) * w[2 * q], hi = ((mt & 1) ? bf_hi(Y) : bf_lo(Y)) * w[2 * q + 1];
                wd[q] = cvt_pk_bf16(lo, hi);
            }
            af[mt] = __builtin_bit_cast(bf16x8, wd);
        }
#pragma unroll
        for (int nt = 0; nt < 4; ++nt) {
            u32x4 wd;
#pragma unroll
            for (int q = 0; q < 4; ++q) {
                const unsigned X = vd[2 * q][nt >> 1], Y = vd[2 * q + 1][nt >> 1];
                wd[q] = (nt & 1) ? ((X >> 16) | (Y & 0xffff0000u)) : ((X & 0xffffu) | (Y << 16));
            }
            bfr[nt] = __builtin_bit_cast(bf16x8, wd);
        }
#pragma unroll
        for (int mt = 0; mt < 4; ++mt)
#pragma unroll
            for (int nt = 0; nt < 4; ++nt) acc[mt][nt] = mfma16(af[mt], bfr[nt], acc[mt][nt]);
    }
    float* out = KVt + ((((size_t)cidx * 8 + head) * 2 + dir) * 128) * 128;
#pragma unroll
    for (int nt = 0; nt < 4; ++nt)
#pragma unroll
        for (int reg = 0; reg < 4; ++reg) {
            const int dv = dv0 + 4 * i + nt, dk = dk0 + 16 * g + 4 * reg;
            *(f32x4*)(out + (size_t)dv * 128 + dk) = (f32x4){acc[0][nt][reg], acc[1][nt][reg], acc[2][nt][reg], acc[3][nt][reg]};
        }
}
DEV void r2_item(const float* KVt, bf16_t* St, const float* decay_exp, int iab, int item) {
    const int hd = item >> 13, e = (item & 8191) * 2, head = hd >> 1, dir = hd & 1;
    const float cd = exp2f(128.0f * lg2gamma(decay_exp, iab, dir, head));
    float s0 = 0.f, s1 = 0.f;
#pragma unroll 6
    for (int step = 0; step < NCHUNK; ++step) {
        const int c = dir == 0 ? step : (step < 2 ? 1 - step : 67 - step);
        const size_t off = (((size_t)c * 8 + head) * 2 + dir) * 16384 + e;
        *(unsigned*)(St + off) = cvt_pk_bf16(s0, s1);
        const f32x2 kv = *(const f32x2*)(KVt + off);
        s0 = s0 * cd + kv[0]; s1 = s1 * cd + kv[1];
    }
}
DEV void r3_task(const bf16_t* P, const bf16_t* St, bf16_t* YAB, float lg2f, float lg2b, int cidx, int head, int qb, int lane) {
    const int i = lane & 15, g = lane >> 4, qi = 16 * qb + i, rowbase = chunk_row(cidx);
    const bf16_t* Prow = P + (size_t)rowbase * ABIN;
    bf16x8 qf[4];
#pragma unroll
    for (int s = 0; s < 4; ++s) qf[s] = *(const bf16x8*)(Prow + (size_t)qi * ABIN + 3072 + head * 128 + 32 * s + 8 * g);
    f32x4 sacc[8];
#pragma unroll
    for (int mt = 0; mt < 8; ++mt) {
        f32x4 a = (f32x4){0.f, 0.f, 0.f, 0.f};
#pragma unroll
        for (int s = 0; s < 4; ++s) { const bf16x8 kf = *(const bf16x8*)(Prow + (size_t)(16 * mt + i) * ABIN + 4096 + head * 128 + 32 * s + 8 * g); a = mfma16(kf, qf[s], a); }
        sacc[mt] = a;
    }
#pragma unroll
    for (int mt = 0; mt < 8; ++mt)
#pragma unroll
        for (int reg = 0; reg < 4; ++reg) {
            const int diff = qi - (16 * mt + 4 * g + reg);
            const float d = diff > 0 ? ex2((float)diff * lg2f) : (diff < 0 ? ex2((float)(-diff) * lg2b) : 2.0f);
            sacc[mt][reg] *= d;
        }
    bf16x8 pf[4];
#pragma unroll
    for (int s = 0; s < 4; ++s) {
        u32x4 w; w[0] = cvt_pk_bf16(sacc[2 * s][0], sacc[2 * s][1]); w[1] = cvt_pk_bf16(sacc[2 * s][2], sacc[2 * s][3]);
        w[2] = cvt_pk_bf16(sacc[2 * s + 1][0], sacc[2 * s + 1][1]); w[3] = cvt_pk_bf16(sacc[2 * s + 1][2], sacc[2 * s + 1][3]);
        pf[s] = __builtin_bit_cast(bf16x8, w);
    }
    f32x4 oacc[8];
#pragma unroll
    for (int mt = 0; mt < 8; ++mt) oacc[mt] = (f32x4){0.f, 0.f, 0.f, 0.f};
#pragma unroll
    for (int s = 0; s < 4; ++s) {
        u32x4 vd[8];
#pragma unroll
        for (int jj = 0; jj < 8; ++jj) { const int key = 32 * s + (jj < 4 ? 4 * g + jj : 16 + 4 * g + jj - 4); vd[jj] = *(const u32x4*)(Prow + (size_t)key * ABIN + 5120 + head * 128 + 8 * i); }
#pragma unroll
        for (int mt = 0; mt < 8; ++mt) oacc[mt] = mfma16(extract8(vd, mt), pf[s], oacc[mt]);
    }
#pragma unroll
    for (int dir = 0; dir < 2; ++dir) {
        f32x4 tacc[8];
#pragma unroll
        for (int mt = 0; mt < 8; ++mt) tacc[mt] = (f32x4){0.f, 0.f, 0.f, 0.f};
        const bf16_t* Sp = St + ((((size_t)cidx * 8 + head) * 2 + dir) * 128) * 128;
#pragma unroll
        for (int s = 0; s < 4; ++s)
#pragma unroll
            for (int mt = 0; mt < 8; ++mt) { const bf16x8 sf = *(const bf16x8*)(Sp + (size_t)(8 * i + mt) * 128 + 32 * s + 8 * g); tacc[mt] = mfma16(sf, qf[s], tacc[mt]); }
        const float qd = dir == 0 ? ex2((float)(qi + 1) * lg2f) : ex2((float)(128 - qi) * lg2b);
#pragma unroll
        for (int mt = 0; mt < 8; ++mt) oacc[mt] = oacc[mt] + tacc[mt] * qd;
    }
    float ss = 0.f;
#pragma unroll
    for (int mt = 0; mt < 8; ++mt) ss += (oacc[mt][0] * oacc[mt][0] + oacc[mt][1] * oacc[mt][1]) + (oacc[mt][2] * oacc[mt][2] + oacc[mt][3] * oacc[mt][3]);
    ss += shfl_xor_f(ss, 16); ss += shfl_xor_f(ss, 32);
    const float rinv = rsq_f(ss * (1.0f / 128.0f) + EPS);
#pragma unroll
    for (int reg = 0; reg < 4; ++reg) {
        const int dvb = 32 * g + 8 * reg;
        const u32x4 gt = *(const u32x4*)(Prow + (size_t)qi * ABIN + 6144 + head * 128 + dvb);
        float o[8];
#pragma unroll
        for (int mt = 0; mt < 8; ++mt) { const float gv = (mt & 1) ? bf_hi(gt[mt >> 1]) : bf_lo(gt[mt >> 1]); o[mt] = silu_f(gv) * (oacc[mt][reg] * rinv); }
        u32x4 w; w[0] = cvt_pk_bf16(o[0], o[1]); w[1] = cvt_pk_bf16(o[2], o[3]); w[2] = cvt_pk_bf16(o[4], o[5]); w[3] = cvt_pk_bf16(o[6], o[7]);
        *(u32x4*)(YAB + (size_t)(rowbase + qi) * D + 1024 + head * 128 + dvb) = w;
    }
}

struct AttnTile { bf16x8 qf[4]; f32x4 oacc[8]; float m_run, l_run; };
DEV void attn_tile_init(AttnTile& t, const bf16_t* P, int qtok, int h, int g) {
#pragma unroll
    for (int s = 0; s < 4; ++s) t.qf[s] = *(const bf16x8*)(P + (size_t)qtok * QKV + h * 128 + 32 * s + 8 * g);
#pragma unroll
    for (int mt = 0; mt < 8; ++mt) t.oacc[mt] = (f32x4){0.f, 0.f, 0.f, 0.f};
    t.m_run = -1e30f; t.l_run = 0.f;
}
DEV void attn_tile_step(AttnTile& t, f32x4 (&sa)[2], const u32x4 (&vd)[8], const bool win, const float* rpbrow, const int kc0, const int c, const int sc, const int g) {
    float bm = -1e30f;
#pragma unroll
    for (int mt = 0; mt < 2; ++mt)
#pragma unroll
        for (int reg = 0; reg < 4; ++reg) {
            float v = sa[mt][reg] * HSCALE;
            if (win) {
                const int kcol = kc0 + 16 * mt + 4 * g + reg;
                const bool valid = kcol >= sc && kcol < sc + 16;
                const float bias = rpbrow[valid ? kcol - c + 15 : 0];
                v = valid ? v + bias : -1e30f;
            }
            sa[mt][reg] = v; bm = fmaxf(bm, v);
        }
    bm = fmaxf(bm, shfl_xor_f(bm, 16)); bm = fmaxf(bm, shfl_xor_f(bm, 32));
    const float m_new = fmaxf(t.m_run, bm);
    const float alpha = ex2((t.m_run - m_new) * LOG2E);
    t.m_run = m_new;
    float ps = 0.f;
#pragma unroll
    for (int mt = 0; mt < 2; ++mt)
#pragma unroll
        for (int reg = 0; reg < 4; ++reg) { const float pv = ex2((sa[mt][reg] - m_new) * LOG2E); sa[mt][reg] = pv; ps += pv; }
    t.l_run = t.l_run * alpha + ps;
#pragma unroll
    for (int mt = 0; mt < 8; ++mt) t.oacc[mt] = t.oacc[mt] * alpha;
    u32x4 pw; pw[0] = cvt_pk_bf16(sa[0][0], sa[0][1]); pw[1] = cvt_pk_bf16(sa[0][2], sa[0][3]); pw[2] = cvt_pk_bf16(sa[1][0], sa[1][1]); pw[3] = cvt_pk_bf16(sa[1][2], sa[1][3]);
    const bf16x8 pf = __builtin_bit_cast(bf16x8, pw);
#pragma unroll
    for (int mt = 0; mt < 8; ++mt) t.oacc[mt] = mfma16(extract8(vd, mt), pf, t.oacc[mt]);
}
DEV void attn_tile_store(AttnTile& t, bf16_t* YAB, int qtok, int h, int g) {
    float l = t.l_run; l += shfl_xor_f(l, 16); l += shfl_xor_f(l, 32);
    const float inv = 1.0f / l;
#pragma unroll
    for (int reg = 0; reg < 4; ++reg) {
        const int dvb = 32 * g + 8 * reg;
        u32x4 w;
#pragma unroll
        for (int q = 0; q < 4; ++q) w[q] = cvt_pk_bf16(t.oacc[2 * q][reg] * inv, t.oacc[2 * q + 1][reg] * inv);
        *(u32x4*)(YAB + (size_t)qtok * D + h * 128 + dvb) = w;
    }
}
DEV void attn_scores2(const bf16_t* P, int kb, int h, int i, int g, const AttnTile& ta, const AttnTile& tb, const bool doA, const bool doB, f32x4 (&saA)[2], f32x4 (&saB)[2], u32x4 (&vd)[8]) {
#pragma unroll
    for (int jj = 0; jj < 8; ++jj) { const int key = kb + (jj < 4 ? 4 * g + jj : 16 + 4 * g + jj - 4); vd[jj] = *(const u32x4*)(P + (size_t)key * QKV + 4096 + h * 128 + 8 * i); }
#pragma unroll
    for (int mt = 0; mt < 2; ++mt) {
        bf16x8 kf[4];
#pragma unroll
        for (int s = 0; s < 4; ++s) kf[s] = *(const bf16x8*)(P + (size_t)(kb + 16 * mt + i) * QKV + 2048 + h * 128 + 32 * s + 8 * g);
        f32x4 a = (f32x4){0.f, 0.f, 0.f, 0.f}, b = a;
        if (doA) {
#pragma unroll
            for (int s = 0; s < 4; ++s) a = mfma16(kf[s], ta.qf[s], a);
        }
        if (doB) {
#pragma unroll
            for (int s = 0; s < 4; ++s) b = mfma16(kf[s], tb.qf[s], b);
        }
        saA[mt] = a; saB[mt] = b;
    }
}
template <bool WIN>
DEV void attn_task2(const bf16_t* P, bf16_t* YAB, const float* rpb, int h, int qtokA0, int qtokB0, int rA, int c0, int kc0, int lane) {
    const int i = lane & 15, g = lane >> 4;
    AttnTile ta, tb;
    attn_tile_init(ta, P, qtokA0 + i, h, g); attn_tile_init(tb, P, qtokB0 + i, h, g);
    const int c = c0 + i, sc = c - 8 < 0 ? 0 : (c - 8 > 48 ? 48 : c - 8);
    if (WIN) {
        const int rB = rA + 1;
        const int srA = rA - 4 < 0 ? 0 : (rA - 4 > 120 ? 120 : rA - 4), srB = rB - 4 < 0 ? 0 : (rB - 4 > 120 ? 120 : rB - 4);
        for (int kr = srA; kr < srB + 8; ++kr) {
            f32x4 saA[2], saB[2]; u32x4 vd[8];
            const bool doA = kr < srA + 8, doB = kr >= srB;
            attn_scores2(P, kr * 64 + kc0, h, i, g, ta, tb, doA, doB, saA, saB, vd);
            if (doA) attn_tile_step(ta, saA, vd, true, rpb + (h * 15 + (kr - rA + 7)) * 31, kc0, c, sc, g);
            if (doB) attn_tile_step(tb, saB, vd, true, rpb + (h * 15 + (kr - rB + 7)) * 31, kc0, c, sc, g);
        }
    }
    for (int b = 0; b < 8; ++b) {
        f32x4 saA[2], saB[2]; u32x4 vd[8];
        attn_scores2(P, S + 32 * b, h, i, g, ta, tb, true, true, saA, saB, vd);
        attn_tile_step(ta, saA, vd, false, rpb, 0, 0, 0, g);
        attn_tile_step(tb, saB, vd, false, rpb, 0, 0, 0, g);
    }
    attn_tile_store(ta, YAB, qtokA0 + i, h, g); attn_tile_store(tb, YAB, qtokB0 + i, h, g);
}

struct Unit { int pm, pn, ks, nt, kofs; };
struct EpiF32 {
    static constexpr bool PERM = false, AFTER_DRAIN = false;
    float* C; int ldc; float* Cpart;
    DEV void operator()(const f32x4 (&acc)[2][2][4][2], const Unit& u, int wr, int wc, int fr, int fq) const {
        const int row0 = (u.ks >= 0 ? 0 : u.pm * 256) + wr * 64 + fr, col0 = u.pn * 256 + wc * 32 + 4 * fq;
        float* base = u.ks >= 0 ? Cpart + (size_t)u.ks * 256 * ldc : C;
#pragma unroll
        for (int ai = 0; ai < 2; ++ai)
#pragma unroll
            for (int m = 0; m < 4; ++m) { float* rowp = base + (size_t)(row0 + ai * 128 + m * 16) * ldc + col0;
#pragma unroll
                for (int bj = 0; bj < 2; ++bj)
#pragma unroll
                    for (int n = 0; n < 2; ++n) *(f32x4*)(rowp + bj * 128 + n * 16) = acc[ai][bj][m][n]; }
    }
};
struct EpiBf16 {
    static constexpr bool PERM = true, AFTER_DRAIN = false;
    bf16_t* O; int ldc;
    DEV void operator()(const f32x4 (&acc)[2][2][4][2], const Unit& u, int wr, int wc, int fr, int fq) const {
        const int row0 = u.pm * 256 + wr * 64 + fr, col0 = u.pn * 256 + wc * 32 + 8 * fq;
#pragma unroll
        for (int ai = 0; ai < 2; ++ai)
#pragma unroll
            for (int m = 0; m < 4; ++m) { bf16_t* rowp = O + (size_t)(row0 + ai * 128 + m * 16) * ldc + col0;
#pragma unroll
                for (int bj = 0; bj < 2; ++bj) { const f32x4 v0 = acc[ai][bj][m][0], v1 = acc[ai][bj][m][1];
                    u32x4 w; w[0] = cvt_pk_bf16(v0[0], v0[1]); w[1] = cvt_pk_bf16(v0[2], v0[3]); w[2] = cvt_pk_bf16(v1[0], v1[1]); w[3] = cvt_pk_bf16(v1[2], v1[3]);
                    *(u32x4*)(rowp + bj * 128) = w; } }
    }
};
struct EpiInProj {
    static constexpr bool PERM = true, AFTER_DRAIN = false;
    bf16_t* O; const f32x2* rope;
    DEV void operator()(const f32x4 (&acc)[2][2][4][2], const Unit& u, int wr, int wc, int fr, int fq) const {
        const int row0 = u.pm * 256 + wr * 64 + fr, col0 = u.pn * 256 + wc * 32 + 8 * fq;
        const bool isk = u.pn >= 16 && u.pn < 20, isq = u.pn >= 12 && u.pn < 16, dorope = (isq || isk) && u.pm < 32;
        const float sc = isk ? HSCALE : 1.0f;
#pragma unroll
        for (int ai = 0; ai < 2; ++ai)
#pragma unroll
            for (int m = 0; m < 4; ++m) { const int row = row0 + ai * 128 + m * 16; bf16_t* rowp = O + (size_t)row * ABIN + col0;
                f32x4 cs01 = (f32x4){1.f, 0.f, 1.f, 0.f}, cs23 = cs01, cs45 = cs01, cs67 = cs01;
                if (dorope) { const int pidx = (wc < 2) ? (row >> 6) : 128 + (row & 63); const f32x2* tp = rope + pidx * 32 + 16 * (wc & 1) + 4 * fq;
                    const f32x4 t0 = *(const f32x4*)tp, t1 = *(const f32x4*)(tp + 2); cs01 = t0; cs23 = t0; cs45 = t1; cs67 = t1; }
#pragma unroll
                for (int bj = 0; bj < 2; ++bj) { f32x4 v0 = acc[ai][bj][m][0], v1 = acc[ai][bj][m][1];
                    if (dorope) {
                        const f32x4 a0 = v0, a1 = v1;
                        v0[0] = a0[0] * cs01[0] - a0[1] * cs01[1]; v0[1] = a0[0] * cs01[1] + a0[1] * cs01[0];
                        v0[2] = a0[2] * cs23[2] - a0[3] * cs23[3]; v0[3] = a0[2] * cs23[3] + a0[3] * cs23[2];
                        v1[0] = a1[0] * cs45[0] - a1[1] * cs45[1]; v1[1] = a1[0] * cs45[1] + a1[1] * cs45[0];
                        v1[2] = a1[2] * cs67[2] - a1[3] * cs67[3]; v1[3] = a1[2] * cs67[3] + a1[3] * cs67[2];
                    }
                    v0 = v0 * sc; v1 = v1 * sc;
                    u32x4 w; w[0] = cvt_pk_bf16(v0[0], v0[1]); w[1] = cvt_pk_bf16(v0[2], v0[3]); w[2] = cvt_pk_bf16(v1[0], v1[1]); w[3] = cvt_pk_bf16(v1[2], v1[3]);
                    *(u32x4*)(rowp + bj * 128) = w; } }
    }
};
struct EpiSwiglu {
    static constexpr bool PERM = true, AFTER_DRAIN = false;
    bf16_t* O;
    DEV void operator()(const f32x4 (&acc)[2][2][4][2], const Unit& u, int wr, int wc, int fr, int fq) const {
        const int row0 = u.pm * 256 + wr * 64 + fr, col0 = u.pn * 128 + wc * 32 + 8 * fq;
#pragma unroll
        for (int ai = 0; ai < 2; ++ai)
#pragma unroll
            for (int m = 0; m < 4; ++m) { bf16_t* rowp = O + (size_t)(row0 + ai * 128 + m * 16) * FFH + col0;
                const f32x4 g0 = acc[ai][0][m][0], g1 = acc[ai][0][m][1], u0 = acc[ai][1][m][0], u1 = acc[ai][1][m][1];
                u32x4 w; w[0] = cvt_pk_bf16(silu_f(g0[0]) * u0[0], silu_f(g0[1]) * u0[1]); w[1] = cvt_pk_bf16(silu_f(g0[2]) * u0[2], silu_f(g0[3]) * u0[3]);
                w[2] = cvt_pk_bf16(silu_f(g1[0]) * u1[0], silu_f(g1[1]) * u1[1]); w[3] = cvt_pk_bf16(silu_f(g1[2]) * u1[2], silu_f(g1[3]) * u1[3]);
                *(u32x4*)rowp = w; }
    }
};

#ifndef HOST_EMU
namespace pg8 {
#define PG8_LAS __attribute__((address_space(3)))
constexpr int BM = 256, BK = 64, HALF = 128, HTB = HALF * BK * 2, STAGE_BYTES = 8 * HTB, NXCD = 8, WGM = 8;
__host__ __device__ __forceinline__ int lds_byte(int r, int c) { const int st = (r >> 4) * 2 + (c >> 5), rr = r & 15, cc = c & 31, ob = rr * 64 + cc * 2; return st * 1024 + (ob ^ (((ob >> 9) & 1) << 5)); }
__host__ __device__ __forceinline__ void stage_rc(int b, int& R, int& C) { const int st = b / 1024, sb = b % 1024, swz = sb ^ (((sb >> 9) & 1) << 5); R = (st >> 1) * 16 + swz / 64; C = (st & 1) * 32 + (swz % 64) / 2; }
__host__ __device__ __forceinline__ int perm32(int rho) { const int n = rho >> 4, i = rho & 15; return 8 * (i >> 2) + 4 * n + (i & 3); }
struct Gemm { const bf16_t* A; const bf16_t* Bt; int M, N, K; };
struct StaticOrder {
    int nM, nN, nwg, G, c, ntK;
    __host__ __device__ void init(int M, int N, int K, int G_, int c_) { nM = M / BM; nN = N / BM; nwg = nM * nN; G = G_; c = c_; ntK = K / BK; }
    __host__ __device__ void map(int wgid, Unit& u) const {
        { const int q = nwg / NXCD, r = nwg % NXCD, xcd = wgid % NXCD, off = wgid / NXCD; wgid = (xcd < r ? xcd * (q + 1) : r * (q + 1) + (xcd - r) * q) + off; }
        const int nig = WGM * nN, gid = wgid / nig, fm = gid * WGM, gsz = (nM - fm) < WGM ? (nM - fm) : WGM;
        u.pm = fm + ((wgid % nig) % gsz); u.pn = (wgid % nig) / gsz; u.ks = -1; u.nt = ntK; u.kofs = 0;
    }
    __host__ __device__ bool next(int i, Unit& u) const { const long L = (long)i * G + c; if (L >= nwg) return false; map((int)L, u); return true; }
    __device__ __forceinline__ void a_ready(const Unit&) const {}
    __device__ __forceinline__ void done(const Unit&) const {}
};
struct MixedOrder {
    StaticOrder base; int nsplit, pmx, ntS, nNx;
    __host__ __device__ void init(int M, int N, int K, int G_, int c_, int pmx_, int nsplit_) { base.init(M, N, K, G_, c_); pmx = pmx_; nsplit = nsplit_; ntS = nsplit_ ? (K / BK) / nsplit_ : 0; nNx = N / BM; }
    __host__ __device__ bool next(int i, Unit& u) const {
        const long L = (long)i * base.G + base.c;
        if (L < base.nwg) { base.map((int)L, u); return true; }
        const long L2 = L - base.nwg; if (L2 >= (long)nsplit * nNx) return false;
        u.pm = pmx; u.pn = (int)(L2 % nNx); u.ks = (int)(L2 / nNx); u.nt = ntS; u.kofs = u.ks * ntS * BK * 2; return true;
    }
    __device__ __forceinline__ void a_ready(const Unit&) const {}
    __device__ __forceinline__ void done(const Unit&) const {}
};
template <class Epi, class Sched, bool ALIGN_EPI = false, bool SP2 = false>
__device__ __forceinline__ void gemm_phase(PG8_LAS unsigned char* lds, const Gemm g, const Sched& S, const Epi& E, const int tid) {
    const int wid = __builtin_amdgcn_readfirstlane(tid >> 6), lane = tid & 63, wr = wid >> 2, wc = wid & 3, fr = lane & 15, fq = lane >> 4;
    const int K = g.K;
    unsigned voffA[2], voffB[2];
#pragma unroll
    for (int i = 0; i < 2; ++i) { int R, C; stage_rc(tid * 16 + i * 8192, R, C); const int Rb = Epi::PERM ? ((R & ~31) + perm32(R & 31)) : R;
        voffA[i] = (unsigned)(R * K + C) * 2u; voffB[i] = (unsigned)(Rb * K + C) * 2u; }
    const size_t kstep = (size_t)(BK * 2);
    const size_t hstep = (size_t)HALF * K * 2;
    const size_t tstep = 2 * hstep;
    const unsigned ldsw = (unsigned)wid * 1024u;
    const int aoff = lds_byte(wr * 64 + fr, fq * 8), boff = lds_byte(wc * 32 + fr, fq * 8);
#define PG8_SA(b, h) (((b) * 2 + (h)) * HTB)
#define PG8_SB(b, h) ((4 + (b) * 2 + (h)) * HTB)
#define PG8_STAGE(bufoff, gbase, voff) do { _Pragma("unroll") for (int _i = 0; _i < 2; ++_i) \
        __builtin_amdgcn_global_load_lds((const unsigned*)((const char*)(gbase) + (voff)[_i]), (PG8_LAS unsigned*)(lds + (bufoff) + ldsw + _i * 8192), 16, 0, 0); } while (0)
#define PG8_LDA(dst, b, h) do { _Pragma("unroll") for (int m = 0; m < 4; ++m) _Pragma("unroll") for (int k = 0; k < 2; ++k) dst[m][k] = *(const PG8_LAS bf16x8*)(lds + PG8_SA(b, h) + aoff + m * 2048 + k * 1024); } while (0)
#define PG8_LDB(dst, b, h) do { _Pragma("unroll") for (int n = 0; n < 2; ++n) _Pragma("unroll") for (int k = 0; k < 2; ++k) dst[n][k] = *(const PG8_LAS bf16x8*)(lds + PG8_SB(b, h) + boff + n * 2048 + k * 1024); } while (0)
#define PG8_MMA(ai, bj, At, Bt) do { __builtin_amdgcn_s_setprio(1); _Pragma("unroll") for (int m = 0; m < 4; ++m) _Pragma("unroll") for (int n = 0; n < 2; ++n) _Pragma("unroll") for (int k = 0; k < 2; ++k) \
        acc[ai][bj][m][n] = __builtin_amdgcn_mfma_f32_16x16x32_bf16(Bt[n][k], At[m][k], acc[ai][bj][m][n], 0, 0, 0); __builtin_amdgcn_s_setprio(0); } while (0)
#define PG8_WAIT_V(n) asm volatile("s_waitcnt vmcnt(" #n ")" ::: "memory")
#define PG8_WAIT_L(n) asm volatile("s_waitcnt lgkmcnt(" #n ")" ::: "memory")
#define PG8_BAR __builtin_amdgcn_s_barrier()
#define PG8_SCHED __builtin_amdgcn_sched_barrier(0)
    Unit cur, nxt; int ui = 0;
    if (!S.next(0, cur)) return;
    f32x4 acc[2][2][4][2];
#pragma unroll
    for (int a = 0; a < 2; ++a)
#pragma unroll
        for (int b = 0; b < 2; ++b)
#pragma unroll
            for (int m = 0; m < 4; ++m)
#pragma unroll
                for (int n = 0; n < 2; ++n) acc[a][b][m][n] = (f32x4){0.f, 0.f, 0.f, 0.f};
    bf16x8 At[4][2], B0[2][2], B1[2][2];
    const char* cA = (const char*)g.A + (size_t)cur.pm * tstep + cur.kofs; const char* cB = (const char*)g.Bt + (size_t)cur.pn * tstep + cur.kofs;
    S.a_ready(cur);
    if constexpr (SP2) {
        PG8_STAGE(PG8_SB(0, 0), cB, voffB); PG8_STAGE(PG8_SB(0, 1), cB + hstep, voffB); PG8_STAGE(PG8_SA(0, 0), cA, voffA); PG8_STAGE(PG8_SA(0, 1), cA + hstep, voffA);
        if (wr == 1) PG8_BAR;
        PG8_WAIT_V(2); PG8_BAR;
        PG8_STAGE(PG8_SB(1, 0), cB + kstep, voffB); PG8_STAGE(PG8_SA(1, 0), cA + kstep, voffA); PG8_STAGE(PG8_SB(1, 1), cB + hstep + kstep, voffB);
        PG8_WAIT_V(6); PG8_BAR;
    } else {
        PG8_STAGE(PG8_SB(0, 0), cB, voffB); PG8_STAGE(PG8_SA(0, 0), cA, voffA); PG8_STAGE(PG8_SB(0, 1), cB + hstep, voffB); PG8_STAGE(PG8_SA(0, 1), cA + hstep, voffA);
        if (wr == 1) PG8_BAR;
        PG8_WAIT_V(4); PG8_BAR;
        PG8_STAGE(PG8_SB(1, 0), cB + kstep, voffB); PG8_STAGE(PG8_SA(1, 0), cA + kstep, voffA); PG8_STAGE(PG8_SB(1, 1), cB + hstep + kstep, voffB);
        PG8_WAIT_V(6); PG8_BAR;
    }
    for (;;) {
        const bool has_next = S.next(ui + 1, nxt);
        const char* nA = has_next ? (const char*)g.A + (size_t)nxt.pm * tstep + nxt.kofs : cA; const char* nB = has_next ? (const char*)g.Bt + (size_t)nxt.pn * tstep + nxt.kofs : cB;
        const int nt = cur.nt;
        for (int t = 0; t < nt; t += 2) {
            const bool last = (t == nt - 2);
            const char* a1 = cA + (size_t)(t + 1) * kstep;
            const char* a2 = last ? nA : cA + (size_t)(t + 2) * kstep; const char* b2 = last ? nB : cB + (size_t)(t + 2) * kstep;
            const char* a3 = a2 + kstep; const char* b3 = b2 + kstep;
            if (last && has_next) S.a_ready(nxt);
            if constexpr (SP2) {
            PG8_LDB(B0, 0, 0); PG8_LDB(B1, 0, 1); PG8_SCHED; PG8_LDA(At, 0, 0); PG8_STAGE(PG8_SA(1, 1), a1 + hstep, voffA);
            PG8_WAIT_V(8); PG8_WAIT_L(0); PG8_BAR; PG8_MMA(0, 0, At, B0); PG8_MMA(0, 1, At, B1); PG8_BAR; PG8_SCHED;
            PG8_LDA(At, 0, 1); PG8_STAGE(PG8_SB(0, 0), b2, voffB); PG8_STAGE(PG8_SB(0, 1), b2 + hstep, voffB); PG8_STAGE(PG8_SA(0, 0), a2, voffA);
            PG8_WAIT_V(8); PG8_WAIT_L(0); PG8_BAR; PG8_MMA(1, 0, At, B0); PG8_MMA(1, 1, At, B1); PG8_BAR; PG8_SCHED;
            PG8_LDB(B0, 1, 0); PG8_LDB(B1, 1, 1); PG8_SCHED; PG8_LDA(At, 1, 0); PG8_STAGE(PG8_SA(0, 1), a2 + hstep, voffA);
            PG8_WAIT_V(8); PG8_WAIT_L(0); PG8_BAR; PG8_MMA(0, 0, At, B0); PG8_MMA(0, 1, At, B1); PG8_BAR; PG8_SCHED;
            PG8_LDA(At, 1, 1); PG8_STAGE(PG8_SB(1, 0), b3, voffB); PG8_STAGE(PG8_SB(1, 1), b3 + hstep, voffB); PG8_STAGE(PG8_SA(1, 0), a3, voffA);
            PG8_WAIT_V(8); PG8_WAIT_L(0); PG8_BAR; PG8_MMA(1, 0, At, B0); PG8_MMA(1, 1, At, B1); PG8_BAR; PG8_SCHED;
            } else {
            PG8_LDB(B0, 0, 0); PG8_SCHED; PG8_LDA(At, 0, 0); PG8_STAGE(PG8_SA(1, 1), a1 + hstep, voffA);
            PG8_WAIT_L(8); PG8_BAR; PG8_WAIT_L(0); PG8_MMA(0, 0, At, B0); PG8_BAR; PG8_SCHED;
            PG8_LDB(B1, 0, 1); PG8_STAGE(PG8_SB(0, 0), b2, voffB);
            PG8_BAR; PG8_WAIT_L(0); PG8_MMA(0, 1, At, B1); PG8_BAR;
            PG8_LDA(At, 0, 1); PG8_STAGE(PG8_SA(0, 0), a2, voffA);
            PG8_BAR; PG8_WAIT_L(0); PG8_MMA(1, 0, At, B0); PG8_BAR; PG8_SCHED;
            PG8_STAGE(PG8_SB(0, 1), b2 + hstep, voffB);
            PG8_WAIT_V(6); PG8_BAR; PG8_MMA(1, 1, At, B1); PG8_BAR;
            PG8_LDB(B0, 1, 0); PG8_SCHED; PG8_LDA(At, 1, 0); PG8_STAGE(PG8_SA(0, 1), a2 + hstep, voffA);
            PG8_WAIT_L(8); PG8_BAR; PG8_WAIT_L(0); PG8_MMA(0, 0, At, B0); PG8_BAR; PG8_SCHED;
            PG8_LDB(B1, 1, 1); PG8_STAGE(PG8_SB(1, 0), b3, voffB);
            PG8_BAR; PG8_WAIT_L(0); PG8_MMA(0, 1, At, B1); PG8_BAR;
            PG8_LDA(At, 1, 1); PG8_STAGE(PG8_SA(1, 0), a3, voffA);
            PG8_BAR; PG8_WAIT_L(0); PG8_MMA(1, 0, At, B0); PG8_BAR; PG8_SCHED;
            PG8_STAGE(PG8_SB(1, 1), b3 + hstep, voffB);
            PG8_WAIT_V(6); PG8_BAR; PG8_MMA(1, 1, At, B1); PG8_BAR;
            }
        }
        if constexpr (ALIGN_EPI) { if (wr == 0) PG8_BAR; }
        if constexpr (!Epi::AFTER_DRAIN) { E(acc, cur, wr, wc, fr, fq); S.done(cur); }
        if (!has_next) break;
#pragma unroll
        for (int a = 0; a < 2; ++a)
#pragma unroll
            for (int b = 0; b < 2; ++b)
#pragma unroll
                for (int m = 0; m < 4; ++m)
#pragma unroll
                    for (int n = 0; n < 2; ++n) acc[a][b][m][n] = (f32x4){0.f, 0.f, 0.f, 0.f};
        cur = nxt; cA = nA; cB = nB; ++ui;
        if constexpr (ALIGN_EPI) { if (wr == 1) PG8_BAR; }
    }
    PG8_WAIT_V(0);
    if constexpr (!ALIGN_EPI) { if (wr == 0) PG8_BAR; }
    PG8_BAR;
#undef PG8_SA
#undef PG8_SB
#undef PG8_STAGE
#undef PG8_LDA
#undef PG8_LDB
#undef PG8_MMA
#undef PG8_WAIT_V
#undef PG8_WAIT_L
#undef PG8_BAR
#undef PG8_SCHED
}
}
#ifndef PG8_SP2
#define PG8_SP2 true
#endif
#ifndef PG8_ALIGN
#define PG8_ALIGN true
#endif

#define XB_TMO      128
#define XB_XCNT(j)  (256  + 64 * (j))
#define XB_XSUB(j)  (1280 + 64 * (j))
#define XB_XGEN(j)  (2304 + 64 * (j))
#define XB_TOP      3328
#define XB_TOPGEN   3392
#define XCD_BAR_WORDS 3456
#define XB_SPIN_CAP (1u << 18)
__device__ __forceinline__ unsigned xb_ld(unsigned* p)              { return __hip_atomic_load(p, __ATOMIC_RELAXED, __HIP_MEMORY_SCOPE_AGENT); }
__device__ __forceinline__ unsigned xb_add(unsigned* p, unsigned v) { return __hip_atomic_fetch_add(p, v, __ATOMIC_RELAXED, __HIP_MEMORY_SCOPE_AGENT); }
__device__ __forceinline__ unsigned xb_xcc_id() { return (unsigned)__builtin_amdgcn_s_getreg((3 << 11) | 20) & 0xFu; }
#define XB_SPIN(cond, bar) do { unsigned _sp = 0; while (cond) { __builtin_amdgcn_s_sleep(1); \
    if ((++_sp & 255u) == 0u) { if (xb_ld(&(bar)[XB_TMO])) break; if (_sp > XB_SPIN_CAP) { atomicAdd(&(bar)[XB_TMO], 1u); break; } } } } while (0)
struct XcdBarrier { unsigned* bar; unsigned x; volatile LAS unsigned* st; };
__device__ __forceinline__ XcdBarrier xcd_barrier_post(unsigned* bar, volatile LAS unsigned* st) {
    XcdBarrier b; b.bar = bar; b.x = xb_xcc_id(); b.st = st;
    if (threadIdx.x == 0) (void)xb_add(&bar[XB_XCNT(b.x)], 1u);
    return b;
}
__device__ __forceinline__ void xcd_barrier_complete(unsigned* bar, unsigned x, unsigned& nloc, unsigned& nx) {
    const unsigned G = gridDim.x * gridDim.y * gridDim.z;
    unsigned sum, cnt, mine, sp = 0u;
    for (;;) {
        sum = 0u; cnt = 0u; mine = 0u;
#pragma unroll
        for (unsigned j = 0; j < 16; ++j) { const unsigned c = xb_ld(&bar[XB_XCNT(j)]); sum += c; cnt += (c > 0u) ? 1u : 0u; mine = (j == x) ? c : mine; }
        if (sum == G) break;
        __builtin_amdgcn_s_sleep(1);
        if ((++sp & 255u) == 0u) { if (xb_ld(&bar[XB_TMO])) break; if (sp > XB_SPIN_CAP) { atomicAdd(&bar[XB_TMO], 1u); break; } }
    }
    nloc = mine > 0u ? mine : 1u; nx = cnt > 0u ? cnt : 1u;
}
__device__ __forceinline__ void xcd_barrier(const XcdBarrier& b) {
    asm volatile("s_waitcnt vmcnt(0)" ::: "memory");
    __syncthreads();
    if (threadIdx.x == 0) {
        unsigned* bar = b.bar;
        __builtin_amdgcn_s_waitcnt(0);
        unsigned nloc = b.st[0], nx = b.st[1];
        if (nloc == 0u) { xcd_barrier_complete(bar, b.x, nloc, nx); b.st[0] = nloc; b.st[1] = nx; }
        const unsigned old = xb_add(&bar[XB_XSUB(b.x)], 1u);
        const unsigned gen = old / nloc;
        if (old + 1u == (gen + 1u) * nloc) {
            __builtin_amdgcn_fence(__ATOMIC_RELEASE, "agent");
            asm volatile("s_waitcnt vmcnt(0)" ::: "memory");
            const unsigned og = xb_add(&bar[XB_TOP], 1u);
            const unsigned tg = og / nx;
            if (og + 1u == (tg + 1u) * nx) xb_add(&bar[XB_TOPGEN], 1u);
            else XB_SPIN(xb_ld(&bar[XB_TOPGEN]) == tg, bar);
            __builtin_amdgcn_fence(__ATOMIC_ACQUIRE, "agent");
            xb_add(&bar[XB_XGEN(b.x)], 1u);
            asm volatile("s_waitcnt vmcnt(0)" ::: "memory");
        } else {
            XB_SPIN(xb_ld(&bar[XB_XGEN(b.x)]) == gen, bar);
            __builtin_amdgcn_fence(__ATOMIC_ACQUIRE, "agent");
            asm volatile("s_waitcnt vmcnt(0)" ::: "memory");
        }
    }
    __syncthreads();
}

constexpr size_t al256(size_t x) { return (x + 255) & ~(size_t)255; }
constexpr size_t WS_CTL = 0;
constexpr size_t CTL_ZERO_BYTES = 65536;
constexpr size_t WS_MODACC = 4u << 20;
constexpr size_t WS_ROPE = 1u << 20;
constexpr size_t WS_WABIN = 8u << 20;
constexpr size_t SZ_WABIN = (size_t)ABIN * D * 2;
constexpr size_t WS_WABOUT = WS_WABIN + 2 * SZ_WABIN;
constexpr size_t SZ_WSQ = (size_t)D * D * 2;
constexpr size_t WS_WQKV = WS_WABOUT + 2 * SZ_WSQ;
constexpr size_t SZ_WQKV = (size_t)QKV * D * 2;
constexpr size_t WS_WNAOUT = WS_WQKV + 2 * SZ_WQKV;
constexpr size_t WS_WFFIN = WS_WNAOUT + 2 * SZ_WSQ;
constexpr size_t SZ_WFFIN = (size_t)FF2 * D * 2;
constexpr size_t WS_WFFOUT = WS_WFFIN + 4 * SZ_WFFIN;
constexpr size_t SZ_WFFOUT = (size_t)D * FFH * 2;
constexpr size_t WS_X = WS_WFFOUT + 4 * SZ_WFFOUT;
constexpr size_t WS_H = WS_X + (size_t)MTOK * D * 4;
constexpr size_t WS_P = WS_H + (size_t)MTOK * D * 2;
constexpr size_t WS_YAB = WS_P + (size_t)MTOK * ABIN * 2;
constexpr size_t WS_Y = WS_YAB + (size_t)MTOK * D * 2;
constexpr size_t WS_HID = WS_Y + (size_t)MTOK * D * 4;
constexpr size_t WS_KVT = WS_HID + (size_t)MTOK * FFH * 2;
constexpr size_t WS_ST = WS_KVT + (size_t)NCHUNK * 16 * 16384 * 4;
constexpr size_t WS_YC = WS_ST + (size_t)NCHUNK * 16 * 16384 * 2;
constexpr size_t WS_END = WS_YC + (size_t)22 * 256 * D * 4;
constexpr int NSPLIT_OUT = 8, NSPLIT_FFO = 22;
static_assert(WS_WABIN % 256 == 0 && WS_X % 256 == 0 && WS_P % 256 == 0 && WS_KVT % 256 == 0 && WS_ST % 256 == 0, "ws alignment");

constexpr int RING_BYTES = 131072, LDSCTL_OFF = RING_BYTES, MISC_OFF = LDSCTL_OFF + 320, LDS_BYTES = 147456;
constexpr int NPHASE = 2 + 9 * DEPTH;

struct Params { const float* in[16]; float* out; unsigned char* ws; int ph_lo, ph_hi, li, pad; };

__device__ __forceinline__ void transpose_item(const float* W, int ldw, int K, bf16_t* Wt, int k0, int n0s, int n0d, LAS float* scr, int lane) {
#pragma unroll 8
    for (int i = 0; i < 32; ++i) { const int kk = 2 * i + (lane >> 5); scr[kk * 33 + (lane & 31)] = W[(size_t)(k0 + kk) * ldw + n0s + (lane & 31)]; }
    asm volatile("s_waitcnt lgkmcnt(0)" ::: "memory");
    const int c = lane & 7;
#pragma unroll
    for (int j = 0; j < 4; ++j) { const int n = (lane >> 3) + 8 * j; const LAS float* s = scr + (8 * c) * 33 + n;
        u32x4 o; o[0] = cvt_pk_bf16(s[0 * 33], s[1 * 33]); o[1] = cvt_pk_bf16(s[2 * 33], s[3 * 33]); o[2] = cvt_pk_bf16(s[4 * 33], s[5 * 33]); o[3] = cvt_pk_bf16(s[6 * 33], s[7 * 33]);
        *(u32x4*)(Wt + (size_t)(n0d + n) * K + k0 + 8 * c) = o; }
    asm volatile("s_waitcnt lgkmcnt(0)" ::: "memory");
}
__device__ __forceinline__ void transpose_matrix_item(const float* W, int K, int N, bf16_t* Wt, bool ffperm, int item, LAS float* scr, int lane) {
    const int nblk = N / 32, kb = item / nblk, nb = item % nblk, n0d = 32 * nb;
    int n0s = n0d;
    if (ffperm) { const int t = n0d >> 8, j = n0d & 255; n0s = j < 128 ? 128 * t + j : FFH + 128 * t + (j - 128); }
    transpose_item(W, N, K, Wt, 64 * kb, n0s, n0d, scr, lane);
}

__global__ void __launch_bounds__(512, 2) mega_fwd(Params p) {
    extern __shared__ __attribute__((aligned(16))) unsigned char lds_raw[];
    LAS unsigned char* lds = (LAS unsigned char*)lds_raw;
    const int G = gridDim.x, bx = blockIdx.x, NGW = G * 8;
#define SITE_COORDS int tid = threadIdx.x; asm volatile("" : "+v"(tid)); const int lane = tid & 63, wave = __builtin_amdgcn_readfirstlane(tid >> 6); \
    const int vcu = (G % 8 == 0) ? (bx % 8) * (G / 8) + bx / 8 : bx; const int gw = vcu * 8 + wave; (void)lane; (void)gw; (void)vcu
    unsigned char* ws = p.ws;
    volatile LAS unsigned* MISC = (volatile LAS unsigned*)(lds + MISC_OFF);
    { const int tid = threadIdx.x; for (int u = tid; u < (LDS_BYTES - LDSCTL_OFF) / 4; u += 512) ((LAS unsigned*)(lds + LDSCTL_OFF))[u] = 0u; }
    __syncthreads();
    const int lo = p.ph_lo, hi = p.ph_hi;
    const bool multi = (hi - lo) > 1;
    XcdBarrier bar; bar.bar = (unsigned*)(ws + WS_CTL) + p.li * 4096; bar.x = 0; bar.st = nullptr;
    if (multi) bar = xcd_barrier_post((unsigned*)(ws + WS_CTL) + p.li * 4096, MISC + 8);
#ifndef SITE_MASK
#define SITE_MASK 0xffff
#endif
#define EN(i) (((SITE_MASK) >> (i)) & 1)
#ifndef REPEAT_MASK
#define REPEAT_MASK 0
#endif
    int rmask_ = REPEAT_MASK; asm volatile("" : "+s"(rmask_));
#define REP(i) ((rmask_ >> (i)) & 1)
#define IN(k) (lo <= (k) && (k) < hi)
#define ROWOP_RUN(a0) do { RowopArgs ra_ = (a0); if (rep_ + 1 < nrep_) { ra_.xout_lat = (float*)(ws + WS_END); ra_.xout_ctx = ra_.xout_lat + (size_t)S * D; ra_.h = (bf16_t*)(ws + WS_END + (size_t)MTOK * D * 4); } LAS float* cf0 = (LAS float*)lds; LAS float* cf1 = (LAS float*)(lds + 24576); \
        rowop_coefs(ra_, 0, cf0, tid); if (ra_.nctx) rowop_coefs(ra_, 1, cf1, tid); __syncthreads(); \
        if (ra_.nctx) rowop_ctx(ra_, cf1, (LAS float*)(lds + 49152), vcu, G, wave, lane); \
        rowop_stream(ra_, cf0, gw, NGW, lane); __syncthreads(); } while (0)
#ifndef DOUBLE_BAR
#define DOUBLE_BAR 0
#endif
#define SEAM(k, knext) do { if (IN(k) && IN(knext)) { xcd_barrier(bar); if (DOUBLE_BAR) xcd_barrier(bar); } } while (0)

    const float* x_in = p.in[0]; const float* c_in = p.in[1]; const float* ctx_in = p.in[2]; const float* cctx_in = p.in[3];
    const float* ada_w = p.in[4]; const float* ada_b = p.in[5]; const float* norm_g = p.in[6];
    const float* ab_w_in = p.in[7]; const float* ab_conv_w = p.in[8]; const float* ab_decay = p.in[9]; const float* ab_w_out = p.in[10];
    const float* na_w_qkv = p.in[11]; const float* na_rpb = p.in[12]; const float* na_w_out = p.in[13];
    const float* ffn_w_in = p.in[14]; const float* ffn_w_out = p.in[15];
    float* modacc = (float*)(ws + WS_MODACC);
    f32x2* rope = (f32x2*)(ws + WS_ROPE);
    float* X = (float*)(ws + WS_X); bf16_t* H = (bf16_t*)(ws + WS_H); bf16_t* P = (bf16_t*)(ws + WS_P); bf16_t* YAB = (bf16_t*)(ws + WS_YAB);
    float* Y = (float*)(ws + WS_Y); bf16_t* HID = (bf16_t*)(ws + WS_HID); float* KVT = (float*)(ws + WS_KVT); bf16_t* ST = (bf16_t*)(ws + WS_ST); float* YC = (float*)(ws + WS_YC);

    for (int nrep_ = 1 + REP(0), rep_ = 0; rep_ < nrep_; ++rep_) if (EN(0) && IN(0)) {
        SITE_COORDS;
        LAS float* scr = (LAS float*)(lds + wave * 16384);
        constexpr int I_ABIN = (D / 64) * (ABIN / 32), I_SQ = (D / 64) * (D / 32), I_QKV = (D / 64) * (QKV / 32), I_FFIN = (D / 64) * (FF2 / 32), I_FFOUT = (FFH / 64) * (D / 32);
        constexpr int NITEMS = 2 * (I_ABIN + I_SQ + I_QKV + I_SQ) + 4 * (I_FFIN + I_FFOUT);
        for (int it = gw; it < NITEMS; it += NGW) {
            int r = it;
            if (r < 2 * I_ABIN) { const int i = r / I_ABIN; transpose_matrix_item(ab_w_in + (size_t)i * D * ABIN, D, ABIN, (bf16_t*)(ws + WS_WABIN + i * SZ_WABIN), false, r % I_ABIN, scr, lane); continue; } r -= 2 * I_ABIN;
            if (r < 2 * I_SQ) { const int i = r / I_SQ; transpose_matrix_item(ab_w_out + (size_t)i * D * D, D, D, (bf16_t*)(ws + WS_WABOUT + i * SZ_WSQ), false, r % I_SQ, scr, lane); continue; } r -= 2 * I_SQ;
            if (r < 2 * I_QKV) { const int i = r / I_QKV; transpose_matrix_item(na_w_qkv + (size_t)i * D * QKV, D, QKV, (bf16_t*)(ws + WS_WQKV + i * SZ_WQKV), false, r % I_QKV, scr, lane); continue; } r -= 2 * I_QKV;
            if (r < 2 * I_SQ) { const int i = r / I_SQ; transpose_matrix_item(na_w_out + (size_t)i * D * D, D, D, (bf16_t*)(ws + WS_WNAOUT + i * SZ_WSQ), false, r % I_SQ, scr, lane); continue; } r -= 2 * I_SQ;
            if (r < 4 * I_FFIN) { const int i = r / I_FFIN; transpose_matrix_item(ffn_w_in + (size_t)i * D * FF2, D, FF2, (bf16_t*)(ws + WS_WFFIN + i * SZ_WFFIN), true, r % I_FFIN, scr, lane); continue; } r -= 4 * I_FFIN;
            { const int i = r / I_FFOUT; transpose_matrix_item(ffn_w_out + (size_t)i * FFH * D, FFH, D, (bf16_t*)(ws + WS_WFFOUT + i * SZ_WFFOUT), false, r % I_FFOUT, scr, lane); }
        }
        for (int it = vcu; it < 4 * 4 * 6; it += G) {
            const int l = it / 24, kp = (it % 24) / 6, nc = it % 6, n = nc * 2048 + 4 * tid;
            f32x4 aL = (f32x4){0.f, 0.f, 0.f, 0.f}, aC = aL;
            const float* wp = ada_w + ((size_t)l * D + kp * 512) * (6 * D) + n;
#pragma unroll 8
            for (int k = 0; k < 512; ++k) { const f32x4 w = *(const f32x4*)(wp + (size_t)k * (6 * D)); const float cl = c_in[kp * 512 + k], cc = cctx_in[kp * 512 + k];
                const float sl = cl / (1.0f + __expf(-cl)), sc = cc / (1.0f + __expf(-cc)); aL = aL + w * sl; aC = aC + w * sc; }
            *(f32x4*)(modacc + (size_t)kp * MODPART + (size_t)(l * 2 + 0) * 6 * D + n) = aL;
            *(f32x4*)(modacc + (size_t)kp * MODPART + (size_t)(l * 2 + 1) * 6 * D + n) = aC;
        }
        for (int idx = bx * 512 + tid; idx < 192 * 32; idx += G * 512) {
            const int pi = idx >> 5, f = idx & 31; const float pos = (float)(pi < 128 ? pi : pi - 128);
            const float ang = pos * powf(10000.0f, -(float)f / 32.0f);
            rope[idx] = (f32x2){cosf(ang), sinf(ang)};
        }
    }
    SEAM(0, 1);
    for (int nrep_ = 1 + REP(1), rep_ = 0; rep_ < nrep_; ++rep_) if (EN(1) && IN(1)) {
        SITE_COORDS;
        RowopArgs a; a.y = nullptr; a.xin_lat = x_in; a.xin_ctx = ctx_in; a.xout_lat = X; a.xout_ctx = X + (size_t)S * D; a.h = H; a.modacc = modacc; a.ada_b = ada_b; a.norm_g = norm_g;
        a.ly = -1; a.jg_y = 0; a.jgate = 0; a.lh = 0; a.jg_h = 0; a.jshift = 0; a.jscale = 1; a.nctx = NCTX; a.ypart = nullptr; a.nypart = 0;
        ROWOP_RUN(a);
    }
    SEAM(1, 2);
    for (int layer = 0; layer < DEPTH; ++layer) {
        const int pb = 2 + 9 * layer, iab = layer >> 1;
        const bool even = (layer & 1) == 0, last = layer == DEPTH - 1;
        const int Mrows = last ? S : MTOK;
        if (even) {
            for (int nrep_ = 1 + REP(2), rep_ = 0; rep_ < nrep_; ++rep_) if (EN(2) && IN(pb + 0)) {
                SITE_COORDS;
                pg8::Gemm g{H, (const bf16_t*)(ws + WS_WABIN + iab * SZ_WABIN), MTOK, ABIN, D}; pg8::StaticOrder So; So.init(MTOK, ABIN, D, G, bx);
                EpiInProj E{P, rope};
                pg8::gemm_phase<EpiInProj, pg8::StaticOrder, PG8_ALIGN, PG8_SP2>(lds, g, So, E, tid);
            }
            SEAM(pb + 0, pb + 1);
            for (int nrep_ = 1 + REP(3), rep_ = 0; rep_ < nrep_; ++rep_) if (EN(3) && IN(pb + 1)) {
                SITE_COORDS;
                for (int bt = vcu; bt < NCHUNK * 8; bt += G) {
                    const int cidx = bt >> 3, head = bt & 7, dir = wave >> 2, quad = wave & 3;
                    r1_task(P, KVT, lg2gamma(ab_decay, iab, dir, head), cidx, head, dir, quad, lane);
                }
                for (int t = gw; t < (MTOK / 8) * 2; t += NGW) conv_task(P, YAB, ab_conv_w + (size_t)iab * 3 * 1024, t, lane);
            }
            SEAM(pb + 1, pb + 2);
            for (int nrep_ = 1 + REP(4), rep_ = 0; rep_ < nrep_; ++rep_) if (EN(4) && IN(pb + 2)) {
                SITE_COORDS;
                for (int it = vcu * 512 + tid; it < 131072; it += G * 512) r2_item(KVT, ST, ab_decay, iab, it);
            }
            SEAM(pb + 2, pb + 3);
            for (int nrep_ = 1 + REP(5), rep_ = 0; rep_ < nrep_; ++rep_) if (EN(5) && IN(pb + 3)) {
                SITE_COORDS;
                for (int bt = vcu; bt < NCHUNK * 8; bt += G) {
                    const int cidx = bt >> 3, head = bt & 7;
                    r3_task(P, ST, YAB, lg2gamma(ab_decay, iab, 0, head), lg2gamma(ab_decay, iab, 1, head), cidx, head, wave, lane);
                }
            }
            SEAM(pb + 3, pb + 4);
        } else {
            for (int nrep_ = 1 + REP(6), rep_ = 0; rep_ < nrep_; ++rep_) if (EN(6) && IN(pb + 0)) {
                SITE_COORDS;
                pg8::Gemm g{H, (const bf16_t*)(ws + WS_WQKV + iab * SZ_WQKV), MTOK, QKV, D}; pg8::StaticOrder So; So.init(MTOK, QKV, D, G, bx);
                EpiBf16 E{P, QKV};
                pg8::gemm_phase<EpiBf16, pg8::StaticOrder, PG8_ALIGN, PG8_SP2>(lds, g, So, E, tid);
            }
            SEAM(pb + 0, pb + 1);
            for (int nrep_ = 1 + REP(7), rep_ = 0; rep_ < nrep_; ++rep_) if (EN(7) && IN(pb + 1)) {
                SITE_COORDS;
                const float* rpb = na_rpb + (size_t)iab * 16 * 15 * 31;
                const int per = (512 + G - 1) / G;
                for (int bt = vcu * per; bt < (vcu + 1) * per && bt < 512; ++bt) {
                    const int h = bt >> 5, rq = bt & 31, r = 4 * rq + 2 * (wave >> 2), cgp = wave & 3;
                    const int kc0 = cgp == 0 ? 0 : (cgp == 1 ? 8 : (cgp == 2 ? 24 : 32));
                    attn_task2<true>(P, YAB, rpb, h, r * 64 + 16 * cgp, (r + 1) * 64 + 16 * cgp, r, 16 * cgp, kc0, lane);
                }
                if (!last) for (int t = gw; t < 128; t += NGW) attn_task2<false>(P, YAB, rpb, t >> 3, S + 32 * (t & 7), S + 32 * (t & 7) + 16, 0, 0, 0, lane);
            }
            SEAM(pb + 1, pb + 4);
        }
        for (int nrep_ = 1 + REP(8), rep_ = 0; rep_ < nrep_; ++rep_) if (EN(8) && IN(pb + 4)) {
            SITE_COORDS;
            const bf16_t* wt = even ? (const bf16_t*)(ws + WS_WABOUT + iab * SZ_WSQ) : (const bf16_t*)(ws + WS_WNAOUT + iab * SZ_WSQ);
            pg8::Gemm g{YAB, wt, MTOK, D, D}; pg8::MixedOrder So; So.init(S, D, D, G, bx, 32, last ? 0 : NSPLIT_OUT);
            EpiF32 E{Y, D, YC};
            pg8::gemm_phase<EpiF32, pg8::MixedOrder, PG8_ALIGN, PG8_SP2>(lds, g, So, E, tid);
        }
        SEAM(pb + 4, pb + 5);
        for (int nrep_ = 1 + REP(9), rep_ = 0; rep_ < nrep_; ++rep_) if (EN(9) && IN(pb + 5)) {
            SITE_COORDS;
            RowopArgs a; a.y = Y; a.xin_lat = X; a.xin_ctx = X + (size_t)S * D; a.xout_lat = X; a.xout_ctx = X + (size_t)S * D; a.h = H; a.modacc = modacc; a.ada_b = ada_b; a.norm_g = norm_g;
            a.ly = layer; a.jg_y = 1; a.jgate = 2; a.lh = layer; a.jg_h = 2; a.jshift = 3; a.jscale = 4; a.nctx = last ? 0 : NCTX; a.ypart = YC; a.nypart = NSPLIT_OUT;
            ROWOP_RUN(a);
        }
        SEAM(pb + 5, pb + 6);
        for (int nrep_ = 1 + REP(10), rep_ = 0; rep_ < nrep_; ++rep_) if (EN(10) && IN(pb + 6)) {
            SITE_COORDS;
            pg8::Gemm g{H, (const bf16_t*)(ws + WS_WFFIN + layer * SZ_WFFIN), Mrows, FF2, D}; pg8::StaticOrder So; So.init(Mrows, FF2, D, G, bx);
            EpiSwiglu E{HID};
            pg8::gemm_phase<EpiSwiglu, pg8::StaticOrder, PG8_ALIGN, PG8_SP2>(lds, g, So, E, tid);
        }
        SEAM(pb + 6, pb + 7);
        for (int nrep_ = 1 + REP(11), rep_ = 0; rep_ < nrep_; ++rep_) if (EN(11) && IN(pb + 7)) {
            SITE_COORDS;
            pg8::Gemm g{HID, (const bf16_t*)(ws + WS_WFFOUT + layer * SZ_WFFOUT), MTOK, D, FFH}; pg8::MixedOrder So; So.init(S, D, FFH, G, bx, 32, last ? 0 : NSPLIT_FFO);
            EpiF32 E{Y, D, YC};
            pg8::gemm_phase<EpiF32, pg8::MixedOrder, PG8_ALIGN, PG8_SP2>(lds, g, So, E, tid);
        }
        SEAM(pb + 7, pb + 8);
        for (int nrep_ = 1 + REP(12), rep_ = 0; rep_ < nrep_; ++rep_) if (EN(12) && IN(pb + 8)) {
            SITE_COORDS;
            RowopArgs a; a.y = Y; a.xin_lat = X; a.xin_ctx = X + (size_t)S * D; a.xout_lat = last ? p.out : X; a.xout_ctx = last ? nullptr : X + (size_t)S * D; a.h = H; a.modacc = modacc; a.ada_b = ada_b; a.norm_g = norm_g;
            a.ly = layer; a.jg_y = 3; a.jgate = 5; a.lh = last ? -1 : layer + 1; a.jg_h = 0; a.jshift = 0; a.jscale = 1; a.nctx = last ? 0 : NCTX; a.ypart = YC; a.nypart = NSPLIT_FFO;
            ROWOP_RUN(a);
        }
        if (!last) SEAM(pb + 8, pb + 9);
    }
#undef IN
#undef SEAM
}

#ifndef MK_MODE
#define MK_MODE 1
#endif
extern "C" void kernel_launch(void* const* d_in, const int* in_sizes, int n_in, void* d_out, int out_size, void* d_ws, size_t ws_size, hipStream_t stream) {
    static int grid = 0;
    if (grid == 0) {
        if (n_in != 16 || out_size != S * D || ws_size < WS_END) { fprintf(stderr, "kernel_launch: unexpected shapes (n_in %d out %d ws %zu need %zu)\n", n_in, out_size, ws_size, (size_t)WS_END); grid = -1; return; }
        int dev = 0, cus = 0, per_cu = 0;
        if (hipGetDevice(&dev) != hipSuccess || hipDeviceGetAttribute(&cus, hipDeviceAttributeMultiprocessorCount, dev) != hipSuccess) { grid = -1; return; }
        if (hipFuncSetAttribute((const void*)mega_fwd, hipFuncAttributeMaxDynamicSharedMemorySize, LDS_BYTES) != hipSuccess) { fprintf(stderr, "kernel_launch: hipFuncSetAttribute failed\n"); grid = -1; return; }
        if (hipOccupancyMaxActiveBlocksPerMultiprocessor(&per_cu, (const void*)mega_fwd, 512, LDS_BYTES) != hipSuccess || per_cu < 1) fprintf(stderr, "kernel_launch: occupancy query says %d\n", per_cu);
        (void)hipGetLastError();
        grid = cus;
    }
    if (grid < 0) return;
    if (hipMemsetAsync((char*)d_ws + WS_CTL, 0, CTL_ZERO_BYTES, stream) != hipSuccess) { fprintf(stderr, "kernel_launch: memset failed\n"); return; }
    Params a{};
    for (int i = 0; i < 16; ++i) a.in[i] = (const float*)d_in[i];
    a.out = (float*)d_out; a.ws = (unsigned char*)d_ws; a.pad = 0;
#if MK_MODE == 1
    a.ph_lo = 0; a.ph_hi = NPHASE; a.li = 0;
    hipLaunchKernelGGL(mega_fwd, dim3(grid), dim3(512), LDS_BYTES, stream, a);
#else
    for (int ph = 0; ph < NPHASE; ++ph) {
        if (ph >= 2) { const int layer = (ph - 2) / 9, slot = (ph - 2) % 9; if ((layer & 1) && (slot == 2 || slot == 3)) continue; }
        a.ph_lo = ph; a.ph_hi = ph + 1; a.li = 0;
        hipLaunchKernelGGL(mega_fwd, dim3(grid), dim3(512), LDS_BYTES, stream, a);
    }
#endif
    const hipError_t le = hipPeekAtLastError();
    if (le != hipSuccess) fprintf(stderr, "kernel_launch: launch failed: %s\n", hipGetErrorName(le));
}
#endif
```

```cpp
#ifndef HOST_EMU
#include <hip/hip_runtime.h>
#include <cstdio>
#include <cstdint>
#define DEV __device__ __forceinline__
#define HDEV __host__ __device__ __forceinline__
#define LAS __attribute__((address_space(3)))
#define GAS __attribute__((address_space(1)))
#endif

typedef unsigned short bf16_t;
typedef short bf16x8 __attribute__((ext_vector_type(8)));
typedef float f32x4 __attribute__((ext_vector_type(4)));
typedef float f32x2 __attribute__((ext_vector_type(2)));
typedef unsigned u32x4 __attribute__((ext_vector_type(4)));
typedef unsigned u32x2 __attribute__((ext_vector_type(2)));

#ifndef HOST_EMU
#define SCHED_FENCE() __builtin_amdgcn_sched_barrier(0)
DEV f32x4 mfma16(bf16x8 a, bf16x8 b, f32x4 c) { return __builtin_amdgcn_mfma_f32_16x16x32_bf16(a, b, c, 0, 0, 0); }
DEV float shfl_xor_f(float v, int m) { return __shfl_xor(v, m); }
DEV unsigned cvt_pk_bf16(float lo, float hi) { unsigned r; asm("v_cvt_pk_bf16_f32 %0, %1, %2" : "=v"(r) : "v"(lo), "v"(hi)); return r; }
DEV float ex2(float x) { return __builtin_amdgcn_exp2f(x); }
DEV float rcp_f(float x) { return __builtin_amdgcn_rcpf(x); }
DEV float rsq_f(float x) { return 1.0f / sqrtf(x); }
DEV void atomic_add_f(float* p, float v) { (void)__hip_atomic_fetch_add(p, v, __ATOMIC_RELAXED, __HIP_MEMORY_SCOPE_AGENT); }
#endif

namespace cfg {
constexpr int D = 2048, S = 8192, NCTX = 256, MTOK = 8448, DEPTH = 4;
constexpr int ABIN = 7168, FFH = 5632, FF2 = 11264, QKV = 6144;
constexpr int NCHUNK = 66;
constexpr float EPS = 1e-6f;
constexpr float HSCALE = 0.08838834764831845f;
constexpr float LOG2E = 1.4426950408889634f;
}
using namespace cfg;

DEV float bf_lo(unsigned w) { return __builtin_bit_cast(float, w << 16); }
DEV float bf_hi(unsigned w) { return __builtin_bit_cast(float, w & 0xffff0000u); }
DEV float wave_sum(float v) {
#pragma unroll
    for (int o = 1; o < 64; o <<= 1) v += shfl_xor_f(v, o);
    return v;
}
DEV float silu_f(float x) { return x * rcp_f(1.0f + ex2(-x * LOG2E)); }
DEV float lg2gamma(const float* decay_exp, int iab, int dir, int head) {
    const float e = decay_exp[(iab * 2 + dir) * 8 + head];
    return log1pf(-exp2f(-e)) * LOG2E;
}
DEV bf16x8 extract8(const u32x4 (&vd)[8], int mt) {
    u32x4 w;
#pragma unroll
    for (int q = 0; q < 4; ++q) {
        const unsigned X = vd[2 * q][mt >> 1], Y = vd[2 * q + 1][mt >> 1];
        w[q] = (mt & 1) ? ((X >> 16) | (Y & 0xffff0000u)) : ((X & 0xffffu) | (Y << 16));
    }
    return __builtin_bit_cast(bf16x8, w);
}

struct RowopArgs {
    const bf16_t* y;
    const float* xin_lat; const float* xin_ctx;
    float* xout_lat; float* xout_ctx;
    bf16_t* h;
    const float* modacc; const float* ada_b; const float* norm_g;
    const float* modf;
    int ly, jg_y, jgate, lh, jg_h, jshift, jscale, nctx;
    int xin16, xout16;
    const bf16_t* ypart; int nypart;
};
DEV f32x4 ld4(const float* p) { return *(const f32x4*)p; }
constexpr int MODPART = 4 * 2 * 6 * 2048;
DEV f32x4 modvec_partials(const float* modacc, const float* ada_b, int l, int s, int j, int col) {
    const float* q = modacc + (size_t)((l * 2 + s) * 6 + j) * D + col;
    f32x4 r = ld4(ada_b + (size_t)l * 6 * D + j * D + col);
#pragma unroll
    for (int kp = 0; kp < 16; ++kp) r = r + ld4(q + (size_t)kp * MODPART);
    return r;
}
DEV f32x4 modvec(const RowopArgs& a, int l, int s, int j, int col) {
    if (a.modf) return ld4(a.modf + (size_t)((l * 2 + s) * 6 + j) * D + col);
    return modvec_partials(a.modacc, a.ada_b, l, s, j, col);
}
template <class CP>
DEV void rowop_coefs(const RowopArgs& a, const int s, CP coef, const int tid) {
    const int col = 4 * tid;
    f32x4 A = (f32x4){0.f, 0.f, 0.f, 0.f}, B = A, SH = A;
    if (a.ly >= 0) A = modvec(a, a.ly, s, a.jgate, col) * ld4(a.norm_g + (size_t)(a.ly * 4 + a.jg_y) * D + col);
    if (a.lh >= 0) { B = ld4(a.norm_g + (size_t)(a.lh * 4 + a.jg_h) * D + col) * (modvec(a, a.lh, s, a.jscale, col) + 1.0f); SH = modvec(a, a.lh, s, a.jshift, col); }
    *(f32x4*)(coef + col) = A; *(f32x4*)(coef + D + col) = B; *(f32x4*)(coef + 2 * D + col) = SH;
}
template <class CP>
DEV void rowop_row(const RowopArgs& a, const int s, CP coef, const int m, f32x4 (&x)[8], const f32x4 (&y)[8], const int lane) {
    const bool hasy = a.ly >= 0, hash = a.lh >= 0;
    if (hasy) {
        float ss = 0.f;
#pragma unroll
        for (int j = 0; j < 8; ++j) ss += (y[j][0] * y[j][0] + y[j][1] * y[j][1]) + (y[j][2] * y[j][2] + y[j][3] * y[j][3]);
        const float r1 = rsq_f(wave_sum(ss) * (1.0f / D) + EPS);
#pragma unroll
        for (int j = 0; j < 8; ++j) x[j] = x[j] + *(const f32x4*)(coef + 4 * lane + 256 * j) * (y[j] * r1);
    }
    float* xb = (s == 0) ? a.xout_lat : a.xout_ctx; const size_t xrow = (size_t)((s == 0) ? m : m - S) * D;
    if (xb) {
        if (a.xout16) { bf16_t* xo = (bf16_t*)xb + xrow;
#pragma unroll
            for (int j = 0; j < 8; ++j) { u32x2 w; w[0] = cvt_pk_bf16(x[j][0], x[j][1]); w[1] = cvt_pk_bf16(x[j][2], x[j][3]); __builtin_nontemporal_store(w, (u32x2*)(xo + 4 * lane + 256 * j)); }
        } else { float* xo = xb + xrow;
#pragma unroll
            for (int j = 0; j < 8; ++j) __builtin_nontemporal_store(x[j], (f32x4*)(xo + 4 * lane + 256 * j));
        }
    }
    if (hash) {
        float ss = 0.f;
#pragma unroll
        for (int j = 0; j < 8; ++j) ss += (x[j][0] * x[j][0] + x[j][1] * x[j][1]) + (x[j][2] * x[j][2] + x[j][3] * x[j][3]);
        const float r2 = rsq_f(wave_sum(ss) * (1.0f / D) + EPS);
        bf16_t* hr = a.h + (size_t)m * D;
#pragma unroll
        for (int j = 0; j < 8; ++j) { const f32x4 v = (x[j] * r2) * *(const f32x4*)(coef + D + 4 * lane + 256 * j) + *(const f32x4*)(coef + 2 * D + 4 * lane + 256 * j);
            u32x2 w; w[0] = cvt_pk_bf16(v[0], v[1]); w[1] = cvt_pk_bf16(v[2], v[3]); __builtin_nontemporal_store(w, (u32x2*)(hr + 4 * lane + 256 * j)); }
    }
}
template <class CP>
DEV void rowop_stream(const RowopArgs& a, CP coef, const int gw, const int NGW, const int lane) {
    for (int m = gw; m < S; m += NGW) {
        f32x4 x[8], y[8];
        if (a.xin16) { const bf16_t* xr = (const bf16_t*)a.xin_lat + (size_t)m * D;
#pragma unroll
            for (int j = 0; j < 8; ++j) { const u32x2 w = __builtin_nontemporal_load((const u32x2*)(xr + 4 * lane + 256 * j)); x[j] = (f32x4){bf_lo(w[0]), bf_hi(w[0]), bf_lo(w[1]), bf_hi(w[1])}; }
        } else { const float* xr = a.xin_lat + (size_t)m * D;
#pragma unroll
            for (int j = 0; j < 8; ++j) x[j] = ld4(xr + 4 * lane + 256 * j);
        }
#pragma unroll
        for (int j = 0; j < 8; ++j) y[j] = (f32x4){0.f, 0.f, 0.f, 0.f};
        if (a.ly >= 0) { const bf16_t* yr = a.y + (size_t)m * D;
#pragma unroll
            for (int j = 0; j < 8; ++j) { const u32x2 w = __builtin_nontemporal_load((const u32x2*)(yr + 4 * lane + 256 * j)); y[j] = (f32x4){bf_lo(w[0]), bf_hi(w[0]), bf_lo(w[1]), bf_hi(w[1])}; } }
        rowop_row(a, 0, coef, m, x, y, lane);
    }
}
#ifndef HOST_EMU
template <class CP, class LP>
DEV void rowop_ctx(const RowopArgs& a, CP coef, LP red, const int vcu, const int G, const int wave, const int lane) {
    const bool hasy = a.ly >= 0, hash = a.lh >= 0;
    for (int r = vcu; r < a.nctx; r += G) {
        const int col = 256 * wave + 4 * lane;
        f32x4 x;
        if (a.xin16) { const u32x2 w = *(const u32x2*)((const bf16_t*)a.xin_ctx + (size_t)r * D + col); x = (f32x4){bf_lo(w[0]), bf_hi(w[0]), bf_lo(w[1]), bf_hi(w[1])}; }
        else x = ld4(a.xin_ctx + (size_t)r * D + col);
        if (hasy) {
            const bf16_t* yp = a.ypart + (size_t)r * D + col;
            f32x4 y = (f32x4){0.f, 0.f, 0.f, 0.f};
#pragma unroll 11
            for (int pp = 0; pp < a.nypart; ++pp) { const u32x2 w = *(const u32x2*)(yp + (size_t)pp * 256 * D); y = y + (f32x4){bf_lo(w[0]), bf_hi(w[0]), bf_lo(w[1]), bf_hi(w[1])}; }
            const float ss = wave_sum((y[0] * y[0] + y[1] * y[1]) + (y[2] * y[2] + y[3] * y[3]));
            if (lane == 0) red[wave] = ss;
            __syncthreads();
            float tot = 0.f;
#pragma unroll
            for (int w8 = 0; w8 < 8; ++w8) tot += red[w8];
            const float r1 = rsq_f(tot * (1.0f / D) + EPS);
            x = x + *(const f32x4*)(coef + col) * (y * r1);
        }
        if (a.xout_ctx) { if (a.xout16) { u32x2 w; w[0] = cvt_pk_bf16(x[0], x[1]); w[1] = cvt_pk_bf16(x[2], x[3]); *(u32x2*)((bf16_t*)a.xout_ctx + (size_t)r * D + col) = w; } else *(f32x4*)(a.xout_ctx + (size_t)r * D + col) = x; }
        if (hash) {
            const float ss = wave_sum((x[0] * x[0] + x[1] * x[1]) + (x[2] * x[2] + x[3] * x[3]));
            if (lane == 0) red[16 + wave] = ss;
            __syncthreads();
            float tot = 0.f;
#pragma unroll
            for (int w8 = 0; w8 < 8; ++w8) tot += red[16 + w8];
            const float r2 = rsq_f(tot * (1.0f / D) + EPS);
            const f32x4 v = (x * r2) * *(const f32x4*)(coef + D + col) + *(const f32x4*)(coef + 2 * D + col);
            u32x2 w; w[0] = cvt_pk_bf16(v[0], v[1]); w[1] = cvt_pk_bf16(v[2], v[3]); *(u32x2*)(a.h + (size_t)(S + r) * D + col) = w;
        }
        __syncthreads();
    }
}
#endif

DEV void conv_loadz(const bf16_t* P, int t, int c, float (&z)[8]) {
    const u32x4 cg = *(const u32x4*)(P + (size_t)t * ABIN + 1024 + c), u = *(const u32x4*)(P + (size_t)t * ABIN + 2048 + c);
#pragma unroll
    for (int e = 0; e < 4; ++e) { z[2 * e] = bf_lo(cg[e]) * bf_lo(u[e]); z[2 * e + 1] = bf_hi(cg[e]) * bf_hi(u[e]); }
}
DEV void conv_task(const bf16_t* P, bf16_t* YAB, const float* convw, int task, int lane) {
    const int half = task & 1, t0 = (task >> 1) * 8, c = half * 512 + lane * 8;
    u32x4 cgv[10], uv[10], bgv[8];
#pragma unroll
    for (int k = 0; k < 10; ++k) {
        const int t = t0 - 1 + k;
        const bool ok = !((k == 0 && (t0 == 0 || t0 == S)) || (k == 9 && (t0 + 8 == S || t0 + 8 == MTOK)));
        const int tt = ok ? t : t0;
        cgv[k] = __builtin_nontemporal_load((const u32x4*)(P + (size_t)tt * ABIN + 1024 + c)); uv[k] = __builtin_nontemporal_load((const u32x4*)(P + (size_t)tt * ABIN + 2048 + c));
        if (!ok) { cgv[k] = (u32x4){0u, 0u, 0u, 0u}; }
    }
#pragma unroll
    for (int k = 0; k < 8; ++k) bgv[k] = __builtin_nontemporal_load((const u32x4*)(P + (size_t)(t0 + k) * ABIN + c));
    float w0[8], w1[8], w2[8];
#pragma unroll
    for (int e = 0; e < 8; ++e) { w0[e] = convw[c + e]; w1[e] = convw[1024 + c + e]; w2[e] = convw[2048 + c + e]; }
#pragma unroll
    for (int k = 0; k < 8; ++k) {
        float o[8];
#pragma unroll
        for (int e = 0; e < 8; ++e) {
            const int d = e >> 1;
            const float zp = (e & 1) ? bf_hi(cgv[k][d]) * bf_hi(uv[k][d]) : bf_lo(cgv[k][d]) * bf_lo(uv[k][d]);
            const float zc = (e & 1) ? bf_hi(cgv[k + 1][d]) * bf_hi(uv[k + 1][d]) : bf_lo(cgv[k + 1][d]) * bf_lo(uv[k + 1][d]);
            const float zn = (e & 1) ? bf_hi(cgv[k + 2][d]) * bf_hi(uv[k + 2][d]) : bf_lo(cgv[k + 2][d]) * bf_lo(uv[k + 2][d]);
            const float b = (e & 1) ? bf_hi(bgv[k][d]) : bf_lo(bgv[k][d]);
            o[e] = b * (w0[e] * zp + w1[e] * zc + w2[e] * zn);
        }
        u32x4 w; w[0] = cvt_pk_bf16(o[0], o[1]); w[1] = cvt_pk_bf16(o[2], o[3]); w[2] = cvt_pk_bf16(o[4], o[5]); w[3] = cvt_pk_bf16(o[6], o[7]);
        *(u32x4*)(YAB + (size_t)(t0 + k) * D + c) = w;
    }
}

DEV int chunk_row(int cidx) { return cidx < 2 ? S + 128 * cidx : 128 * (cidx - 2); }
DEV void r1_task(const bf16_t* P, float* KVt, float lg2, int cidx, int head, int dir, int quad, int lane) {
    const int i = lane & 15, g = lane >> 4;
    const int dk0 = 64 * (quad >> 1), dv0 = 64 * (quad & 1);
    const bf16_t* Kp = P + (size_t)chunk_row(cidx) * ABIN + 4096 + head * 128 + dk0 + 4 * i;
    const bf16_t* Vp = P + (size_t)chunk_row(cidx) * ABIN + 5120 + head * 128 + dv0 + 4 * i;
    f32x4 acc[4][4];
#pragma unroll
    for (int a = 0; a < 4; ++a)
#pragma unroll
        for (int b = 0; b < 4; ++b) acc[a][b] = (f32x4){0.f, 0.f, 0.f, 0.f};
#pragma unroll 1
    for (int s = 0; s < 4; ++s) {
        u32x2 kd[8], vd[8]; float w[8];
#pragma unroll
        for (int jj = 0; jj < 8; ++jj) {
            const int tj = 32 * s + 8 * g + jj;
            kd[jj] = *(const u32x2*)(Kp + (size_t)tj * ABIN); vd[jj] = *(const u32x2*)(Vp + (size_t)tj * ABIN);
            w[jj] = ex2(lg2 * (float)(dir == 0 ? 127 - tj : tj));
        }
        bf16x8 af[4], bfr[4];
#pragma unroll
        for (int mt = 0; mt < 4; ++mt) {
            u32x4 wd;
#pragma unroll
            for (int q = 0; q < 4; ++q) {
                const unsigned X = kd[2 * q][mt >> 1], Y = kd[2 * q + 1][mt >> 1];
                const float lo = ((mt & 1) ? bf_hi(X) : bf_lo(X)) * w[2 * q], hi = ((mt & 1) ? bf_hi(Y) : bf_lo(Y)) * w[2 * q + 1];
                wd[q] = cvt_pk_bf16(lo, hi);
            }
            af[mt] = __builtin_bit_cast(bf16x8, wd);
        }
#pragma unroll
        for (int nt = 0; nt < 4; ++nt) {
            u32x4 wd;
#pragma unroll
            for (int q = 0; q < 4; ++q) {
                const unsigned X = vd[2 * q][nt >> 1], Y = vd[2 * q + 1][nt >> 1];
                wd[q] = (nt & 1) ? ((X >> 16) | (Y & 0xffff0000u)) : ((X & 0xffffu) | (Y << 16));
            }
            bfr[nt] = __builtin_bit_cast(bf16x8, wd);
        }
#pragma unroll
        for (int mt = 0; mt < 4; ++mt)
#pragma unroll
            for (int nt = 0; nt < 4; ++nt) acc[mt][nt] = mfma16(af[mt], bfr[nt], acc[mt][nt]);
    }
    float* out = KVt + ((((size_t)cidx * 8 + head) * 2 + dir) * 128) * 128;
#pragma unroll
    for (int nt = 0; nt < 4; ++nt)
#pragma unroll
        for (int reg = 0; reg < 4; ++reg) {
            const int dv = dv0 + 4 * i + nt, dk = dk0 + 16 * g + 4 * reg;
            *(f32x4*)(out + (size_t)dv * 128 + dk) = (f32x4){acc[0][nt][reg], acc[1][nt][reg], acc[2][nt][reg], acc[3][nt][reg]};
        }
}
DEV void r2_item(const bf16_t* KVt, bf16_t* St, const float* decay_exp, int iab, int item) {
    const int hd = __builtin_amdgcn_readfirstlane(item >> 13), e = (item & 8191) * 2, head = hd >> 1, dir = hd & 1;
    const float cd = exp2f(128.0f * lg2gamma(decay_exp, iab, dir, head));
    float s0 = 0.f, s1 = 0.f;
    unsigned kv[66];
#pragma unroll
    for (int k = 0; k < 66; ++k) { const int c = dir == 0 ? k : (k < 2 ? 1 - k : 67 - k); kv[k] = __builtin_nontemporal_load((const unsigned*)(KVt + (((size_t)c * 8 + head) * 2 + dir) * 16384 + e)); }
#pragma unroll
    for (int k = 0; k < 66; ++k) { const int c = dir == 0 ? k : (k < 2 ? 1 - k : 67 - k);
        *(unsigned*)(St + (((size_t)c * 8 + head) * 2 + dir) * 16384 + e) = cvt_pk_bf16(s0, s1);
        s0 = s0 * cd + bf_lo(kv[k]); s1 = s1 * cd + bf_hi(kv[k]); }
}
DEV void r3_task(const bf16_t* P, const bf16_t* St, bf16_t* YAB, float lg2f, float lg2b, int cidx, int head, int qb, int lane) {
    const int i = lane & 15, g = lane >> 4, qi = 16 * qb + i, rowbase = chunk_row(cidx);
    const bf16_t* Prow = P + (size_t)rowbase * ABIN;
    bf16x8 qf[4];
#pragma unroll
    for (int s = 0; s < 4; ++s) qf[s] = *(const bf16x8*)(Prow + (size_t)qi * ABIN + 3072 + head * 128 + 32 * s + 8 * g);
    f32x4 sacc[8];
#pragma unroll
    for (int mt = 0; mt < 8; ++mt) {
        f32x4 a = (f32x4){0.f, 0.f, 0.f, 0.f};
#pragma unroll
        for (int s = 0; s < 4; ++s) { const bf16x8 kf = *(const bf16x8*)(Prow + (size_t)(16 * mt + i) * ABIN + 4096 + head * 128 + 32 * s + 8 * g); a = mfma16(kf, qf[s], a); }
        sacc[mt] = a;
    }
#pragma unroll
    for (int mt = 0; mt < 8; ++mt)
#pragma unroll
        for (int reg = 0; reg < 4; ++reg) {
            const int diff = qi - (16 * mt + 4 * g + reg);
            const float d = diff > 0 ? ex2((float)diff * lg2f) : (diff < 0 ? ex2((float)(-diff) * lg2b) : 2.0f);
            sacc[mt][reg] *= d;
        }
    bf16x8 pf[4];
#pragma unroll
    for (int s = 0; s < 4; ++s) {
        u32x4 w; w[0] = cvt_pk_bf16(sacc[2 * s][0], sacc[2 * s][1]); w[1] = cvt_pk_bf16(sacc[2 * s][2], sacc[2 * s][3]);
        w[2] = cvt_pk_bf16(sacc[2 * s + 1][0], sacc[2 * s + 1][1]); w[3] = cvt_pk_bf16(sacc[2 * s + 1][2], sacc[2 * s + 1][3]);
        pf[s] = __builtin_bit_cast(bf16x8, w);
    }
    f32x4 oacc[8];
#pragma unroll
    for (int mt = 0; mt < 8; ++mt) oacc[mt] = (f32x4){0.f, 0.f, 0.f, 0.f};
#pragma unroll
    for (int s = 0; s < 4; ++s) {
        u32x4 vd[8];
#pragma unroll
        for (int jj = 0; jj < 8; ++jj) { const int key = 32 * s + (jj < 4 ? 4 * g + jj : 16 + 4 * g + jj - 4); vd[jj] = *(const u32x4*)(Prow + (size_t)key * ABIN + 5120 + head * 128 + 8 * i); }
#pragma unroll
        for (int mt = 0; mt < 8; ++mt) oacc[mt] = mfma16(extract8(vd, mt), pf[s], oacc[mt]);
    }
#pragma unroll
    for (int dir = 0; dir < 2; ++dir) {
        f32x4 tacc[8];
#pragma unroll
        for (int mt = 0; mt < 8; ++mt) tacc[mt] = (f32x4){0.f, 0.f, 0.f, 0.f};
        const bf16_t* Sp = St + ((((size_t)cidx * 8 + head) * 2 + dir) * 128) * 128;
#pragma unroll
        for (int s = 0; s < 4; ++s)
#pragma unroll
            for (int mt = 0; mt < 8; ++mt) { const bf16x8 sf = *(const bf16x8*)(Sp + (size_t)(8 * i + mt) * 128 + 32 * s + 8 * g); tacc[mt] = mfma16(sf, qf[s], tacc[mt]); }
        const float qd = dir == 0 ? ex2((float)(qi + 1) * lg2f) : ex2((float)(128 - qi) * lg2b);
#pragma unroll
        for (int mt = 0; mt < 8; ++mt) oacc[mt] = oacc[mt] + tacc[mt] * qd;
    }
    float ss = 0.f;
#pragma unroll
    for (int mt = 0; mt < 8; ++mt) ss += (oacc[mt][0] * oacc[mt][0] + oacc[mt][1] * oacc[mt][1]) + (oacc[mt][2] * oacc[mt][2] + oacc[mt][3] * oacc[mt][3]);
    ss += shfl_xor_f(ss, 16); ss += shfl_xor_f(ss, 32);
    const float rinv = rsq_f(ss * (1.0f / 128.0f) + EPS);
#pragma unroll
    for (int reg = 0; reg < 4; ++reg) {
        const int dvb = 32 * g + 8 * reg;
        const u32x4 gt = *(const u32x4*)(Prow + (size_t)qi * ABIN + 6144 + head * 128 + dvb);
        float o[8];
#pragma unroll
        for (int mt = 0; mt < 8; ++mt) { const float gv = (mt & 1) ? bf_hi(gt[mt >> 1]) : bf_lo(gt[mt >> 1]); o[mt] = silu_f(gv) * (oacc[mt][reg] * rinv); }
        u32x4 w; w[0] = cvt_pk_bf16(o[0], o[1]); w[1] = cvt_pk_bf16(o[2], o[3]); w[2] = cvt_pk_bf16(o[4], o[5]); w[3] = cvt_pk_bf16(o[6], o[7]);
        *(u32x4*)(YAB + (size_t)(rowbase + qi) * D + 1024 + head * 128 + dvb) = w;
    }
}

struct AttnTile { bf16x8 qf[4]; f32x4 oacc[8]; float m_run, l_run; };
DEV void attn_tile_init(AttnTile& t, const bf16_t* P, int qtok, int h, int g) {
#pragma unroll
    for (int s = 0; s < 4; ++s) t.qf[s] = *(const bf16x8*)(P + (size_t)qtok * QKV + h * 128 + 32 * s + 8 * g);
#pragma unroll
    for (int mt = 0; mt < 8; ++mt) t.oacc[mt] = (f32x4){0.f, 0.f, 0.f, 0.f};
    t.m_run = -5e29f; t.l_run = 0.f;
}
template <class RP>
DEV void attn_tile_step(AttnTile& t, f32x4 (&sa)[2], const u32x4 (&vd)[8], const bool win, const bool rowok, RP rpbrow, const int kc0, const int c, const int sc, const int g) {
    float bm = -1e30f;
#pragma unroll
    for (int mt = 0; mt < 2; ++mt)
#pragma unroll
        for (int reg = 0; reg < 4; ++reg) {
            float v = sa[mt][reg] * HSCALE;
            if (win) {
                const int kcol = kc0 + 16 * mt + 4 * g + reg;
                const bool valid = rowok && kcol >= sc && kcol < sc + 16;
                const float bias = rpbrow[valid ? kcol - c + 15 : 0];
                v = valid ? v + bias : -1e30f;
            }
            sa[mt][reg] = v; bm = fmaxf(bm, v);
        }
    bm = fmaxf(bm, shfl_xor_f(bm, 16)); bm = fmaxf(bm, shfl_xor_f(bm, 32));
    const float m_new = fmaxf(t.m_run, bm);
    const float alpha = ex2((t.m_run - m_new) * LOG2E);
    t.m_run = m_new;
    float ps = 0.f;
#pragma unroll
    for (int mt = 0; mt < 2; ++mt)
#pragma unroll
        for (int reg = 0; reg < 4; ++reg) { const float pv = ex2((sa[mt][reg] - m_new) * LOG2E); sa[mt][reg] = pv; ps += pv; }
    t.l_run = t.l_run * alpha + ps;
#pragma unroll
    for (int mt = 0; mt < 8; ++mt) t.oacc[mt] = t.oacc[mt] * alpha;
    u32x4 pw; pw[0] = cvt_pk_bf16(sa[0][0], sa[0][1]); pw[1] = cvt_pk_bf16(sa[0][2], sa[0][3]); pw[2] = cvt_pk_bf16(sa[1][0], sa[1][1]); pw[3] = cvt_pk_bf16(sa[1][2], sa[1][3]);
    const bf16x8 pf = __builtin_bit_cast(bf16x8, pw);
#pragma unroll
    for (int mt = 0; mt < 8; ++mt) t.oacc[mt] = mfma16(extract8(vd, mt), pf, t.oacc[mt]);
}
template <class RP>
DEV bf16x8 attn_tile_soft(AttnTile& t, f32x4 (&sa)[2], const bool win, const bool rowok, RP rpbrow, const int kc0, const int c, const int sc, const int g) {
    float bm = -1e30f;
#pragma unroll
    for (int mt = 0; mt < 2; ++mt)
#pragma unroll
        for (int reg = 0; reg < 4; ++reg) {
            float v = sa[mt][reg] * HSCALE;
            if (win) {
                const int kcol = kc0 + 16 * mt + 4 * g + reg;
                const bool valid = rowok && kcol >= sc && kcol < sc + 16;
                const float bias = rpbrow[valid ? kcol - c + 15 : 0];
                v = valid ? v + bias : -1e30f;
            }
            sa[mt][reg] = v; bm = fmaxf(bm, v);
        }
    bm = fmaxf(bm, shfl_xor_f(bm, 16)); bm = fmaxf(bm, shfl_xor_f(bm, 32));
    const float m_new = fmaxf(t.m_run, bm);
    const float alpha = ex2((t.m_run - m_new) * LOG2E);
    t.m_run = m_new;
    float ps = 0.f;
#pragma unroll
    for (int mt = 0; mt < 2; ++mt)
#pragma unroll
        for (int reg = 0; reg < 4; ++reg) { const float pv = ex2((sa[mt][reg] - m_new) * LOG2E); sa[mt][reg] = pv; ps += pv; }
    t.l_run = t.l_run * alpha + ps;
#pragma unroll
    for (int mt = 0; mt < 8; ++mt) t.oacc[mt] = t.oacc[mt] * alpha;
    u32x4 pw; pw[0] = cvt_pk_bf16(sa[0][0], sa[0][1]); pw[1] = cvt_pk_bf16(sa[0][2], sa[0][3]); pw[2] = cvt_pk_bf16(sa[1][0], sa[1][1]); pw[3] = cvt_pk_bf16(sa[1][2], sa[1][3]);
    return __builtin_bit_cast(bf16x8, pw);
}
DEV void attn_tile_store(AttnTile& t, bf16_t* YAB, int qtok, int h, int g) {
    float l = t.l_run; l += shfl_xor_f(l, 16); l += shfl_xor_f(l, 32);
    const float inv = 1.0f / l;
#pragma unroll
    for (int reg = 0; reg < 4; ++reg) {
        const int dvb = 32 * g + 8 * reg;
        u32x4 w;
#pragma unroll
        for (int q = 0; q < 4; ++q) w[q] = cvt_pk_bf16(t.oacc[2 * q][reg] * inv, t.oacc[2 * q + 1][reg] * inv);
        *(u32x4*)(YAB + (size_t)qtok * D + h * 128 + dvb) = w;
    }
}
DEV void attn_scores2(const bf16_t* P, int kb, int h, int i, int g, const AttnTile& ta, const AttnTile& tb, const bool doA, const bool doB, f32x4 (&saA)[2], f32x4 (&saB)[2], u32x4 (&vd)[8]) {
#pragma unroll
    for (int jj = 0; jj < 8; ++jj) { const int key = kb + (jj < 4 ? 4 * g + jj : 16 + 4 * g + jj - 4); vd[jj] = *(const u32x4*)(P + (size_t)key * QKV + 4096 + h * 128 + 8 * i); }
#pragma unroll
    for (int mt = 0; mt < 2; ++mt) {
        bf16x8 kf[4];
#pragma unroll
        for (int s = 0; s < 4; ++s) kf[s] = *(const bf16x8*)(P + (size_t)(kb + 16 * mt + i) * QKV + 2048 + h * 128 + 32 * s + 8 * g);
        f32x4 a = (f32x4){0.f, 0.f, 0.f, 0.f}, b = a;
        if (doA) {
#pragma unroll
            for (int s = 0; s < 4; ++s) a = mfma16(kf[s], ta.qf[s], a);
        }
        if (doB) {
#pragma unroll
            for (int s = 0; s < 4; ++s) b = mfma16(kf[s], tb.qf[s], b);
        }
        saA[mt] = a; saB[mt] = b;
        SCHED_FENCE();
    }
}
template <bool WIN>
DEV void attn_task2(const bf16_t* P, bf16_t* YAB, const float* rpb, int h, int qtokA0, int qtokB0, int rA, int c0, int kc0, int lane) {
    const int i = lane & 15, g = lane >> 4;
    AttnTile ta, tb;
    attn_tile_init(ta, P, qtokA0 + i, h, g); attn_tile_init(tb, P, qtokB0 + i, h, g);
    const int c = c0 + i, sc = c - 8 < 0 ? 0 : (c - 8 > 48 ? 48 : c - 8);
    if (WIN) {
        const int rB = rA + 1;
        const int srA = rA - 4 < 0 ? 0 : (rA - 4 > 120 ? 120 : rA - 4), srB = rB - 4 < 0 ? 0 : (rB - 4 > 120 ? 120 : rB - 4);
        for (int kr = srA; kr < srB + 8; ++kr) {
            f32x4 saA[2], saB[2]; u32x4 vd[8];
            const bool doA = kr < srA + 8, doB = kr >= srB;
            attn_scores2(P, kr * 64 + kc0, h, i, g, ta, tb, doA, doB, saA, saB, vd);
            if (doA) attn_tile_step(ta, saA, vd, true, true, rpb + (h * 15 + (kr - rA + 7)) * 31, kc0, c, sc, g);
            if (doB) attn_tile_step(tb, saB, vd, true, true, rpb + (h * 15 + (kr - rB + 7)) * 31, kc0, c, sc, g);
        }
    }
    for (int b = 0; b < 8; ++b) {
        f32x4 saA[2], saB[2]; u32x4 vd[8];
        attn_scores2(P, S + 32 * b, h, i, g, ta, tb, true, true, saA, saB, vd);
        attn_tile_step(ta, saA, vd, false, true, rpb, 0, 0, 0, g);
        attn_tile_step(tb, saB, vd, false, true, rpb, 0, 0, 0, g);
    }
    attn_tile_store(ta, YAB, qtokA0 + i, h, g); attn_tile_store(tb, YAB, qtokB0 + i, h, g);
}

struct Unit { int pm, pn, ks, nt, kofs; };
struct EpiY {
    static constexpr bool PERM = true, AFTER_DRAIN = false;
    bf16_t* Yb; int ldc; bf16_t* Cpart;
    DEV void operator()(const f32x4 (&acc)[2][2][4][2], const Unit& u, int wr, int wc, int fr, int fq) const {
        bf16_t* base = u.ks >= 0 ? Cpart + (size_t)u.ks * 256 * ldc : Yb + (size_t)u.pm * 256 * ldc;
        base += (size_t)(wr * 64 + fr) * ldc + u.pn * 256 + wc * 32 + 8 * fq;
#pragma unroll
        for (int ai = 0; ai < 2; ++ai)
#pragma unroll
            for (int m = 0; m < 4; ++m) { bf16_t* rowp = base + (size_t)(ai * 128 + m * 16) * ldc;
#pragma unroll
                for (int bj = 0; bj < 2; ++bj) { const f32x4 v0 = acc[ai][bj][m][0], v1 = acc[ai][bj][m][1];
                    u32x4 w; w[0] = cvt_pk_bf16(v0[0], v0[1]); w[1] = cvt_pk_bf16(v0[2], v0[3]); w[2] = cvt_pk_bf16(v1[0], v1[1]); w[3] = cvt_pk_bf16(v1[2], v1[3]);
                    *(u32x4*)(rowp + bj * 128) = w; } }
    }
};
struct EpiBf16 {
    static constexpr bool PERM = true, AFTER_DRAIN = false;
    bf16_t* O; int ldc;
    DEV void operator()(const f32x4 (&acc)[2][2][4][2], const Unit& u, int wr, int wc, int fr, int fq) const {
        const int row0 = u.pm * 256 + wr * 64 + fr, col0 = u.pn * 256 + wc * 32 + 8 * fq;
#pragma unroll
        for (int ai = 0; ai < 2; ++ai)
#pragma unroll
            for (int m = 0; m < 4; ++m) { bf16_t* rowp = O + (size_t)(row0 + ai * 128 + m * 16) * ldc + col0;
#pragma unroll
                for (int bj = 0; bj < 2; ++bj) { const f32x4 v0 = acc[ai][bj][m][0], v1 = acc[ai][bj][m][1];
                    u32x4 w; w[0] = cvt_pk_bf16(v0[0], v0[1]); w[1] = cvt_pk_bf16(v0[2], v0[3]); w[2] = cvt_pk_bf16(v1[0], v1[1]); w[3] = cvt_pk_bf16(v1[2], v1[3]);
                    *(u32x4*)(rowp + bj * 128) = w; } }
    }
};
struct EpiInProj {
    static constexpr bool PERM = true, AFTER_DRAIN = false;
    bf16_t* O; const f32x2* rope;
    DEV void operator()(const f32x4 (&acc)[2][2][4][2], const Unit& u, int wr, int wc, int fr, int fq) const {
        const int row0 = u.pm * 256 + wr * 64 + fr, col0 = u.pn * 256 + wc * 32 + 8 * fq;
        const bool isk = u.pn >= 16 && u.pn < 20, isq = u.pn >= 12 && u.pn < 16, dorope = (isq || isk) && u.pm < 32;
        const float sc = isk ? HSCALE : 1.0f;
#pragma unroll
        for (int ai = 0; ai < 2; ++ai)
#pragma unroll
            for (int m = 0; m < 4; ++m) { const int row = row0 + ai * 128 + m * 16; bf16_t* rowp = O + (size_t)row * ABIN + col0;
                f32x4 cs01 = (f32x4){1.f, 0.f, 1.f, 0.f}, cs23 = cs01, cs45 = cs01, cs67 = cs01;
                if (dorope) { const int pidx = (wc < 2) ? (row >> 6) : 128 + (row & 63); const f32x2* tp = rope + pidx * 32 + 16 * (wc & 1) + 4 * fq;
                    const f32x4 t0 = *(const f32x4*)tp, t1 = *(const f32x4*)(tp + 2); cs01 = t0; cs23 = t0; cs45 = t1; cs67 = t1; }
#pragma unroll
                for (int bj = 0; bj < 2; ++bj) { f32x4 v0 = acc[ai][bj][m][0], v1 = acc[ai][bj][m][1];
                    if (dorope) {
                        const f32x4 a0 = v0, a1 = v1;
                        v0[0] = a0[0] * cs01[0] - a0[1] * cs01[1]; v0[1] = a0[0] * cs01[1] + a0[1] * cs01[0];
                        v0[2] = a0[2] * cs23[2] - a0[3] * cs23[3]; v0[3] = a0[2] * cs23[3] + a0[3] * cs23[2];
                        v1[0] = a1[0] * cs45[0] - a1[1] * cs45[1]; v1[1] = a1[0] * cs45[1] + a1[1] * cs45[0];
                        v1[2] = a1[2] * cs67[2] - a1[3] * cs67[3]; v1[3] = a1[2] * cs67[3] + a1[3] * cs67[2];
                    }
                    v0 = v0 * sc; v1 = v1 * sc;
                    u32x4 w; w[0] = cvt_pk_bf16(v0[0], v0[1]); w[1] = cvt_pk_bf16(v0[2], v0[3]); w[2] = cvt_pk_bf16(v1[0], v1[1]); w[3] = cvt_pk_bf16(v1[2], v1[3]);
                    *(u32x4*)(rowp + bj * 128) = w; } }
    }
};
struct EpiSwiglu {
    static constexpr bool PERM = true, AFTER_DRAIN = false;
    bf16_t* O;
    DEV void operator()(const f32x4 (&acc)[2][2][4][2], const Unit& u, int wr, int wc, int fr, int fq) const {
        const int row0 = u.pm * 256 + wr * 64 + fr, col0 = u.pn * 128 + wc * 32 + 8 * fq;
#pragma unroll
        for (int ai = 0; ai < 2; ++ai)
#pragma unroll
            for (int m = 0; m < 4; ++m) { bf16_t* rowp = O + (size_t)(row0 + ai * 128 + m * 16) * FFH + col0;
                const f32x4 g0 = acc[ai][0][m][0], g1 = acc[ai][0][m][1], u0 = acc[ai][1][m][0], u1 = acc[ai][1][m][1];
                u32x4 w; w[0] = cvt_pk_bf16(silu_f(g0[0]) * u0[0], silu_f(g0[1]) * u0[1]); w[1] = cvt_pk_bf16(silu_f(g0[2]) * u0[2], silu_f(g0[3]) * u0[3]);
                w[2] = cvt_pk_bf16(silu_f(g1[0]) * u1[0], silu_f(g1[1]) * u1[1]); w[3] = cvt_pk_bf16(silu_f(g1[2]) * u1[2], silu_f(g1[3]) * u1[3]);
                *(u32x4*)rowp = w; }
    }
};

#ifndef HOST_EMU
namespace pg8 {
#define PG8_LAS __attribute__((address_space(3)))
constexpr int BM = 256, BK = 64, HALF = 128, HTB = HALF * BK * 2, STAGE_BYTES = 8 * HTB, NXCD = 8, WGM = 8;
__host__ __device__ __forceinline__ int lds_byte(int r, int c) { const int st = (r >> 4) * 2 + (c >> 5), rr = r & 15, cc = c & 31, ob = rr * 64 + cc * 2; return st * 1024 + (ob ^ (((ob >> 9) & 1) << 5)); }
__host__ __device__ __forceinline__ void stage_rc(int b, int& R, int& C) { const int st = b / 1024, sb = b % 1024, swz = sb ^ (((sb >> 9) & 1) << 5); R = (st >> 1) * 16 + swz / 64; C = (st & 1) * 32 + (swz % 64) / 2; }
__host__ __device__ __forceinline__ int perm32(int rho) { const int n = rho >> 4, i = rho & 15; return 8 * (i >> 2) + 4 * n + (i & 3); }
struct Gemm { const bf16_t* A; const bf16_t* Bt; int M, N, K; };
struct StaticOrder {
    int nM, nN, nwg, G, c, ntK;
    __host__ __device__ __forceinline__ void init(int M, int N, int K, int G_, int c_) { nM = M / BM; nN = N / BM; nwg = nM * nN; G = G_; c = c_; ntK = K / BK; }
    __host__ __device__ __forceinline__ void map(int wgid, Unit& u) const {
        { const int q = nwg / NXCD, r = nwg % NXCD, xcd = wgid % NXCD, off = wgid / NXCD; wgid = (xcd < r ? xcd * (q + 1) : r * (q + 1) + (xcd - r) * q) + off; }
        const int nig = WGM * nN, gid = wgid / nig, fm = gid * WGM, gsz = (nM - fm) < WGM ? (nM - fm) : WGM;
        u.pm = fm + ((wgid % nig) % gsz); u.pn = (wgid % nig) / gsz; u.ks = -1; u.nt = ntK; u.kofs = 0;
    }
    __host__ __device__ __forceinline__ bool next(int i, Unit& u) const { const long L = (long)i * G + c; if (L >= nwg) return false; map((int)L, u); return true; }
    __device__ __forceinline__ void a_ready(const Unit&) const {}
    __device__ __forceinline__ void done(const Unit&) const {}
};
struct MixedOrder {
    StaticOrder base; int nsplit, pmx, ntS, nNx;
    __host__ __device__ __forceinline__ void init(int M, int N, int K, int G_, int c_, int pmx_, int nsplit_) { base.init(M, N, K, G_, c_); pmx = pmx_; nsplit = nsplit_; ntS = nsplit_ ? (K / BK) / nsplit_ : 0; nNx = N / BM; }
    __host__ __device__ __forceinline__ bool next(int i, Unit& u) const {
        const long L = (long)i * base.G + base.c;
        if (L < base.nwg) { base.map((int)L, u); return true; }
        const long L2 = L - base.nwg; if (L2 >= (long)nsplit * nNx) return false;
        u.pm = pmx; u.pn = (int)(L2 % nNx); u.ks = (int)(L2 / nNx); u.nt = ntS; u.kofs = u.ks * ntS * BK * 2; return true;
    }
    __device__ __forceinline__ void a_ready(const Unit&) const {}
    __device__ __forceinline__ void done(const Unit&) const {}
};
template <class Epi, class Sched, bool ALIGN_EPI = false, bool SP2 = false>
__device__ __forceinline__ void gemm_phase(PG8_LAS unsigned char* lds, const Gemm g, const Sched& S, const Epi& E, const int tid) {
    const int wid = __builtin_amdgcn_readfirstlane(tid >> 6), lane = tid & 63, wr = wid >> 2, wc = wid & 3, fr = lane & 15, fq = lane >> 4;
    const int K = g.K;
    unsigned voffA[2], voffB[2];
#pragma unroll
    for (int i = 0; i < 2; ++i) { int R, C; stage_rc(tid * 16 + i * 8192, R, C); const int Rb = Epi::PERM ? ((R & ~31) + perm32(R & 31)) : R;
        voffA[i] = (unsigned)(R * K + C) * 2u; voffB[i] = (unsigned)(Rb * K + C) * 2u; }
    const size_t kstep = (size_t)(BK * 2);
    const size_t hstep = (size_t)HALF * K * 2;
    const size_t tstep = 2 * hstep;
    const unsigned ldsw = (unsigned)wid * 1024u;
    const int aoff = lds_byte(wr * 64 + fr, fq * 8), boff = lds_byte(wc * 32 + fr, fq * 8);
#define PG8_SA(b, h) (((b) * 2 + (h)) * HTB)
#define PG8_SB(b, h) ((4 + (b) * 2 + (h)) * HTB)
#define PG8_STAGE(bufoff, gbase, voff) do { _Pragma("unroll") for (int _i = 0; _i < 2; ++_i) \
        __builtin_amdgcn_global_load_lds((const unsigned*)((const char*)(gbase) + (voff)[_i]), (PG8_LAS unsigned*)(lds + (bufoff) + ldsw + _i * 8192), 16, 0, 0); } while (0)
#define PG8_LDA(dst, b, h) do { _Pragma("unroll") for (int m = 0; m < 4; ++m) _Pragma("unroll") for (int k = 0; k < 2; ++k) dst[m][k] = *(const PG8_LAS bf16x8*)(lds + PG8_SA(b, h) + aoff + m * 2048 + k * 1024); } while (0)
#define PG8_LDB(dst, b, h) do { _Pragma("unroll") for (int n = 0; n < 2; ++n) _Pragma("unroll") for (int k = 0; k < 2; ++k) dst[n][k] = *(const PG8_LAS bf16x8*)(lds + PG8_SB(b, h) + boff + n * 2048 + k * 1024); } while (0)
#define PG8_MMA(ai, bj, At, Bt) do { __builtin_amdgcn_s_setprio(1); _Pragma("unroll") for (int m = 0; m < 4; ++m) _Pragma("unroll") for (int n = 0; n < 2; ++n) _Pragma("unroll") for (int k = 0; k < 2; ++k) \
        acc[ai][bj][m][n] = __builtin_amdgcn_mfma_f32_16x16x32_bf16(Bt[n][k], At[m][k], acc[ai][bj][m][n], 0, 0, 0); __builtin_amdgcn_s_setprio(0); } while (0)
#define PG8_WAIT_V(n) asm volatile("s_waitcnt vmcnt(" #n ")" ::: "memory")
#define PG8_WAIT_L(n) asm volatile("s_waitcnt lgkmcnt(" #n ")" ::: "memory")
#define PG8_BAR __builtin_amdgcn_s_barrier()
#define PG8_SCHED __builtin_amdgcn_sched_barrier(0)
    Unit cur, nxt; int ui = 0;
    if (!S.next(0, cur)) return;
    f32x4 acc[2][2][4][2];
#pragma unroll
    for (int a = 0; a < 2; ++a)
#pragma unroll
        for (int b = 0; b < 2; ++b)
#pragma unroll
            for (int m = 0; m < 4; ++m)
#pragma unroll
                for (int n = 0; n < 2; ++n) acc[a][b][m][n] = (f32x4){0.f, 0.f, 0.f, 0.f};
    bf16x8 At[4][2], B0[2][2], B1[2][2];
    const char* cA = (const char*)g.A + (size_t)cur.pm * tstep + cur.kofs; const char* cB = (const char*)g.Bt + (size_t)cur.pn * tstep + cur.kofs;
    S.a_ready(cur);
    if constexpr (SP2) {
        PG8_STAGE(PG8_SB(0, 0), cB, voffB); PG8_STAGE(PG8_SB(0, 1), cB + hstep, voffB); PG8_STAGE(PG8_SA(0, 0), cA, voffA); PG8_STAGE(PG8_SA(0, 1), cA + hstep, voffA);
        if (wr == 1) PG8_BAR;
        PG8_WAIT_V(2); PG8_BAR;
        PG8_STAGE(PG8_SB(1, 0), cB + kstep, voffB); PG8_STAGE(PG8_SA(1, 0), cA + kstep, voffA); PG8_STAGE(PG8_SB(1, 1), cB + hstep + kstep, voffB);
        PG8_WAIT_V(6); PG8_BAR;
    } else {
        PG8_STAGE(PG8_SB(0, 0), cB, voffB); PG8_STAGE(PG8_SA(0, 0), cA, voffA); PG8_STAGE(PG8_SB(0, 1), cB + hstep, voffB); PG8_STAGE(PG8_SA(0, 1), cA + hstep, voffA);
        if (wr == 1) PG8_BAR;
        PG8_WAIT_V(4); PG8_BAR;
        PG8_STAGE(PG8_SB(1, 0), cB + kstep, voffB); PG8_STAGE(PG8_SA(1, 0), cA + kstep, voffA); PG8_STAGE(PG8_SB(1, 1), cB + hstep + kstep, voffB);
        PG8_WAIT_V(6); PG8_BAR;
    }
    for (;;) {
        const bool has_next = S.next(ui + 1, nxt);
        const char* nA = has_next ? (const char*)g.A + (size_t)nxt.pm * tstep + nxt.kofs : cA; const char* nB = has_next ? (const char*)g.Bt + (size_t)nxt.pn * tstep + nxt.kofs : cB;
        const int nt = cur.nt;
        for (int t = 0; t < nt; t += 2) {
            const bool last = (t == nt - 2);
            const char* a1 = cA + (size_t)(t + 1) * kstep;
            const char* a2 = last ? nA : cA + (size_t)(t + 2) * kstep; const char* b2 = last ? nB : cB + (size_t)(t + 2) * kstep;
            const char* a3 = a2 + kstep; const char* b3 = b2 + kstep;
            if (last && has_next) S.a_ready(nxt);
            if constexpr (SP2) {
            PG8_LDB(B0, 0, 0); PG8_LDB(B1, 0, 1); PG8_SCHED; PG8_LDA(At, 0, 0); PG8_STAGE(PG8_SA(1, 1), a1 + hstep, voffA);
            PG8_WAIT_V(8); PG8_WAIT_L(0); PG8_BAR; PG8_MMA(0, 0, At, B0); PG8_MMA(0, 1, At, B1); PG8_BAR; PG8_SCHED;
            PG8_LDA(At, 0, 1); PG8_STAGE(PG8_SB(0, 0), b2, voffB); PG8_STAGE(PG8_SB(0, 1), b2 + hstep, voffB); PG8_STAGE(PG8_SA(0, 0), a2, voffA);
            PG8_WAIT_V(8); PG8_WAIT_L(0); PG8_BAR; PG8_MMA(1, 0, At, B0); PG8_MMA(1, 1, At, B1); PG8_BAR; PG8_SCHED;
            PG8_LDB(B0, 1, 0); PG8_LDB(B1, 1, 1); PG8_SCHED; PG8_LDA(At, 1, 0); PG8_STAGE(PG8_SA(0, 1), a2 + hstep, voffA);
            PG8_WAIT_V(8); PG8_WAIT_L(0); PG8_BAR; PG8_MMA(0, 0, At, B0); PG8_MMA(0, 1, At, B1); PG8_BAR; PG8_SCHED;
            PG8_LDA(At, 1, 1); PG8_STAGE(PG8_SB(1, 0), b3, voffB); PG8_STAGE(PG8_SB(1, 1), b3 + hstep, voffB); PG8_STAGE(PG8_SA(1, 0), a3, voffA);
            PG8_WAIT_V(8); PG8_WAIT_L(0); PG8_BAR; PG8_MMA(1, 0, At, B0); PG8_MMA(1, 1, At, B1); PG8_BAR; PG8_SCHED;
            } else {
            PG8_LDB(B0, 0, 0); PG8_SCHED; PG8_LDA(At, 0, 0); PG8_STAGE(PG8_SA(1, 1), a1 + hstep, voffA);
            PG8_WAIT_L(8); PG8_BAR; PG8_WAIT_L(0); PG8_MMA(0, 0, At, B0); PG8_BAR; PG8_SCHED;
            PG8_LDB(B1, 0, 1); PG8_STAGE(PG8_SB(0, 0), b2, voffB);
            PG8_BAR; PG8_WAIT_L(0); PG8_MMA(0, 1, At, B1); PG8_BAR;
            PG8_LDA(At, 0, 1); PG8_STAGE(PG8_SA(0, 0), a2, voffA);
            PG8_BAR; PG8_WAIT_L(0); PG8_MMA(1, 0, At, B0); PG8_BAR; PG8_SCHED;
            PG8_STAGE(PG8_SB(0, 1), b2 + hstep, voffB);
            PG8_WAIT_V(6); PG8_BAR; PG8_MMA(1, 1, At, B1); PG8_BAR;
            PG8_LDB(B0, 1, 0); PG8_SCHED; PG8_LDA(At, 1, 0); PG8_STAGE(PG8_SA(0, 1), a2 + hstep, voffA);
            PG8_WAIT_L(8); PG8_BAR; PG8_WAIT_L(0); PG8_MMA(0, 0, At, B0); PG8_BAR; PG8_SCHED;
            PG8_LDB(B1, 1, 1); PG8_STAGE(PG8_SB(1, 0), b3, voffB);
            PG8_BAR; PG8_WAIT_L(0); PG8_MMA(0, 1, At, B1); PG8_BAR;
            PG8_LDA(At, 1, 1); PG8_STAGE(PG8_SA(1, 0), a3, voffA);
            PG8_BAR; PG8_WAIT_L(0); PG8_MMA(1, 0, At, B0); PG8_BAR; PG8_SCHED;
            PG8_STAGE(PG8_SB(1, 1), b3 + hstep, voffB);
            PG8_WAIT_V(6); PG8_BAR; PG8_MMA(1, 1, At, B1); PG8_BAR;
            }
        }
        if constexpr (ALIGN_EPI) { if (wr == 0) PG8_BAR; }
        if constexpr (!Epi::AFTER_DRAIN) { E(acc, cur, wr, wc, fr, fq); S.done(cur); }
        if (!has_next) break;
#pragma unroll
        for (int a = 0; a < 2; ++a)
#pragma unroll
            for (int b = 0; b < 2; ++b)
#pragma unroll
                for (int m = 0; m < 4; ++m)
#pragma unroll
                    for (int n = 0; n < 2; ++n) acc[a][b][m][n] = (f32x4){0.f, 0.f, 0.f, 0.f};
        cur = nxt; cA = nA; cB = nB; ++ui;
        if constexpr (ALIGN_EPI) { if (wr == 1) PG8_BAR; }
    }
    PG8_WAIT_V(0);
    if constexpr (!ALIGN_EPI) { if (wr == 0) PG8_BAR; }
    PG8_BAR;
#undef PG8_SA
#undef PG8_SB
#undef PG8_STAGE
#undef PG8_LDA
#undef PG8_LDB
#undef PG8_MMA
#undef PG8_WAIT_V
#undef PG8_WAIT_L
#undef PG8_BAR
#undef PG8_SCHED
}
}
#ifndef PG8_SP2
#define PG8_SP2 true
#endif
#ifndef PG8_ALIGN
#define PG8_ALIGN true
#endif

#define XB_TMO      128
#define XB_XCNT(j)  (256  + 64 * (j))
#define XB_XSUB(j)  (1280 + 64 * (j))
#define XB_XGEN(j)  (2304 + 64 * (j))
#define XB_TOP      3328
#define XB_TOPGEN   3392
#define XCD_BAR_WORDS 3456
#define XB_SPIN_CAP (1u << 18)
__device__ __forceinline__ unsigned xb_ld(unsigned* p)              { return __hip_atomic_load(p, __ATOMIC_RELAXED, __HIP_MEMORY_SCOPE_AGENT); }
__device__ __forceinline__ unsigned xb_add(unsigned* p, unsigned v) { return __hip_atomic_fetch_add(p, v, __ATOMIC_RELAXED, __HIP_MEMORY_SCOPE_AGENT); }
__device__ __forceinline__ unsigned xb_xcc_id() { return (unsigned)__builtin_amdgcn_s_getreg((3 << 11) | 20) & 0xFu; }
#define XB_SPIN(cond, bar) do { unsigned _sp = 0; while (cond) { __builtin_amdgcn_s_sleep(1); \
    if ((++_sp & 255u) == 0u) { if (xb_ld(&(bar)[XB_TMO])) break; if (_sp > XB_SPIN_CAP) { atomicAdd(&(bar)[XB_TMO], 1u); break; } } } } while (0)
struct XcdBarrier { unsigned* bar; unsigned x; volatile LAS unsigned* st; };
__device__ __forceinline__ XcdBarrier xcd_barrier_post(unsigned* bar, volatile LAS unsigned* st) {
    XcdBarrier b; b.bar = bar; b.x = xb_xcc_id(); b.st = st;
    if (threadIdx.x == 0) (void)xb_add(&bar[XB_XCNT(b.x)], 1u);
    return b;
}
__device__ __forceinline__ void xcd_barrier_complete(unsigned* bar, unsigned x, unsigned& nloc, unsigned& nx) {
    const unsigned G = gridDim.x * gridDim.y * gridDim.z;
    unsigned sum, cnt, mine, sp = 0u;
    for (;;) {
        sum = 0u; cnt = 0u; mine = 0u;
#pragma unroll
        for (unsigned j = 0; j < 16; ++j) { const unsigned c = xb_ld(&bar[XB_XCNT(j)]); sum += c; cnt += (c > 0u) ? 1u : 0u; mine = (j == x) ? c : mine; }
        if (sum == G) break;
        __builtin_amdgcn_s_sleep(1);
        if ((++sp & 255u) == 0u) { if (xb_ld(&bar[XB_TMO])) break; if (sp > XB_SPIN_CAP) { atomicAdd(&bar[XB_TMO], 1u); break; } }
    }
    nloc = mine > 0u ? mine : 1u; nx = cnt > 0u ? cnt : 1u;
}
__device__ __forceinline__ void xcd_barrier(const XcdBarrier& b) {
    asm volatile("s_waitcnt vmcnt(0)" ::: "memory");
    __syncthreads();
    if (threadIdx.x == 0) {
        unsigned* bar = b.bar;
        __builtin_amdgcn_s_waitcnt(0);
        unsigned nloc = b.st[0], nx = b.st[1];
        if (nloc == 0u) { xcd_barrier_complete(bar, b.x, nloc, nx); b.st[0] = nloc; b.st[1] = nx; }
        const unsigned old = xb_add(&bar[XB_XSUB(b.x)], 1u);
        const unsigned gen = old / nloc;
        if (old + 1u == (gen + 1u) * nloc) {
            __builtin_amdgcn_fence(__ATOMIC_RELEASE, "agent");
            asm volatile("s_waitcnt vmcnt(0)" ::: "memory");
            const unsigned og = xb_add(&bar[XB_TOP], 1u);
            const unsigned tg = og / nx;
            if (og + 1u == (tg + 1u) * nx) xb_add(&bar[XB_TOPGEN], 1u);
            else XB_SPIN(xb_ld(&bar[XB_TOPGEN]) == tg, bar);
            __builtin_amdgcn_fence(__ATOMIC_ACQUIRE, "agent");
            xb_add(&bar[XB_XGEN(b.x)], 1u);
            asm volatile("s_waitcnt vmcnt(0)" ::: "memory");
        } else {
            XB_SPIN(xb_ld(&bar[XB_XGEN(b.x)]) == gen, bar);
            __builtin_amdgcn_fence(__ATOMIC_ACQUIRE, "agent");
            asm volatile("s_waitcnt vmcnt(0)" ::: "memory");
        }
    }
    __syncthreads();
}

constexpr size_t al256(size_t x) { return (x + 255) & ~(size_t)255; }
constexpr size_t WS_CTL = 0;
constexpr size_t CTL_ZERO_BYTES = 65536;
constexpr size_t WS_MODACC = 2u << 20;
constexpr size_t WS_MODF = (1u << 20) + (512u << 10);
constexpr size_t WS_ROPE = 1u << 20;
constexpr size_t WS_WABIN = 8u << 20;
constexpr size_t SZ_WABIN = (size_t)ABIN * D * 2;
constexpr size_t WS_WABOUT = WS_WABIN + 2 * SZ_WABIN;
constexpr size_t SZ_WSQ = (size_t)D * D * 2;
constexpr size_t WS_WQKV = WS_WABOUT + 2 * SZ_WSQ;
constexpr size_t SZ_WQKV = (size_t)QKV * D * 2;
constexpr size_t WS_WNAOUT = WS_WQKV + 2 * SZ_WQKV;
constexpr size_t WS_WFFIN = WS_WNAOUT + 2 * SZ_WSQ;
constexpr size_t SZ_WFFIN = (size_t)FF2 * D * 2;
constexpr size_t WS_WFFOUT = WS_WFFIN + 4 * SZ_WFFIN;
constexpr size_t SZ_WFFOUT = (size_t)D * FFH * 2;
constexpr size_t WS_X = WS_WFFOUT + 4 * SZ_WFFOUT;
constexpr size_t WS_H = WS_X + (size_t)MTOK * D * 4;
constexpr size_t WS_P = WS_H + (size_t)MTOK * D * 2;
constexpr size_t WS_YAB = WS_P + (size_t)MTOK * ABIN * 2;
constexpr size_t WS_Y = WS_YAB + (size_t)MTOK * D * 2;
constexpr size_t WS_HID = WS_Y + (size_t)MTOK * D * 4;
constexpr size_t WS_KVT = WS_HID + (size_t)MTOK * FFH * 2;
constexpr size_t WS_ST = WS_KVT + (size_t)NCHUNK * 16 * 16384 * 4;
constexpr size_t WS_YC = WS_ST + (size_t)NCHUNK * 16 * 16384 * 2;
constexpr size_t WS_END = WS_YC + (size_t)22 * 256 * D * 4;
constexpr int NSPLIT_OUT = 8, NSPLIT_FFO = 22;
static_assert(WS_WABIN % 256 == 0 && WS_X % 256 == 0 && WS_P % 256 == 0 && WS_KVT % 256 == 0 && WS_ST % 256 == 0, "ws alignment");

constexpr int RING_BYTES = 131072, LDSCTL_OFF = RING_BYTES, MISC_OFF = LDSCTL_OFF + 320, PRM_OFF = LDSCTL_OFF + 1024, LDS_BYTES = 147456;
constexpr int NPHASE = 2 + 9 * DEPTH;

struct Params { const float* in[16]; float* out; unsigned char* ws; int ph_lo, ph_hi, li, pad; };

__device__ __forceinline__ void transpose_item(const float* W, int ldw, int K, bf16_t* Wt, int k0, int n0s, int n0d, LAS float* scr, int lane) {
    const int r = lane >> 3, c4 = (lane & 7) * 4;
    f32x4 v[8];
#pragma unroll
    for (int i = 0; i < 8; ++i) v[i] = __builtin_nontemporal_load((const f32x4*)(W + (size_t)(k0 + 8 * i + r) * ldw + n0s + c4));
#pragma unroll
    for (int i = 0; i < 8; ++i) { LAS float* d = scr + (8 * i + r) * 33 + c4; d[0] = v[i][0]; d[1] = v[i][1]; d[2] = v[i][2]; d[3] = v[i][3]; }
    asm volatile("s_waitcnt lgkmcnt(0)" ::: "memory");
    const int c = lane & 7;
#pragma unroll
    for (int j = 0; j < 4; ++j) { const int n = (lane >> 3) + 8 * j; const LAS float* s = scr + (8 * c) * 33 + n;
        u32x4 o; o[0] = cvt_pk_bf16(s[0 * 33], s[1 * 33]); o[1] = cvt_pk_bf16(s[2 * 33], s[3 * 33]); o[2] = cvt_pk_bf16(s[4 * 33], s[5 * 33]); o[3] = cvt_pk_bf16(s[6 * 33], s[7 * 33]);
        *(u32x4*)(Wt + (size_t)(n0d + n) * K + k0 + 8 * c) = o; }
    asm volatile("s_waitcnt lgkmcnt(0)" ::: "memory");
}
__device__ __forceinline__ void transpose_matrix_item(const float* W, int K, int N, bf16_t* Wt, bool ffperm, int item, LAS float* scr, int lane) {
    const int nblk = N / 32, kb = item / nblk, nb = item % nblk, n0d = 32 * nb;
    int n0s = n0d;
    if (ffperm) { const int t = n0d >> 8, j = n0d & 255; n0s = j < 128 ? 128 * t + j : FFH + 128 * t + (j - 128); }
    transpose_item(W, N, K, Wt, 64 * kb, n0s, n0d, scr, lane);
}

constexpr int I_ABIN = (D / 64) * (ABIN / 32), I_SQ = (D / 64) * (D / 32), I_QKV = (D / 64) * (QKV / 32), I_FFIN = (D / 64) * (FF2 / 32), I_FFOUT = (FFH / 64) * (D / 32);
__device__ __forceinline__ unsigned long long ldptr(LAS const unsigned* prm, int k) {
    const unsigned lo = prm[2 * k], hi = prm[2 * k + 1];
    return ((unsigned long long)(unsigned)__builtin_amdgcn_readfirstlane((int)hi) << 32) | (unsigned)__builtin_amdgcn_readfirstlane((int)lo);
}
__device__ __forceinline__ void cvt_mat(LAS const unsigned* prm, int type, int inst, int idx, LAS float* scr, int lane) {
    const int kin = type == 0 ? 7 : (type == 1 ? 10 : (type == 2 ? 11 : (type == 3 ? 13 : (type == 4 ? 14 : 15))));
    const int K = type == 5 ? FFH : D;
    const int N = type == 0 ? ABIN : (type == 2 ? QKV : (type == 4 ? FF2 : D));
    const size_t woff = type == 0 ? WS_WABIN : (type == 1 ? WS_WABOUT : (type == 2 ? WS_WQKV : (type == 3 ? WS_WNAOUT : (type == 4 ? WS_WFFIN : WS_WFFOUT))));
    const size_t wsz = type == 0 ? SZ_WABIN : (type == 2 ? SZ_WQKV : (type == 4 ? SZ_WFFIN : (type == 5 ? SZ_WFFOUT : SZ_WSQ)));
    const float* src = (const float*)(GAS const float*)ldptr(prm, kin) + (size_t)inst * K * N;
    unsigned char* ws = (unsigned char*)(GAS unsigned char*)ldptr(prm, 17);
    transpose_matrix_item(src, K, N, (bf16_t*)(ws + woff + inst * wsz), type == 4, idx, scr, lane);
}
constexpr int L0_ITEMS = I_ABIN + I_FFOUT;
__device__ __forceinline__ void cvt_l0_item(LAS const unsigned* p, int r, LAS float* scr, int lane) {
    int type, base;
    if (r < I_ABIN) { type = 0; base = 0; } else { type = 5; base = I_ABIN; }
    cvt_mat(p, type, 0, r - base, scr, lane);
}
constexpr int DLA = I_SQ, DL0 = DLA + I_FFIN, DL1 = DL0 + I_QKV, DL2 = DL1 + I_SQ, DL3 = DL2 + I_FFIN, DL4 = DL3 + I_FFOUT, DL5 = DL4 + I_ABIN, DL6 = DL5 + I_SQ, DL7 = DL6 + I_FFIN, DL8 = DL7 + I_FFOUT,
              DL9 = DL8 + I_QKV, DL10 = DL9 + I_SQ, DL11 = DL10 + I_FFIN, DL_END = DL11 + I_FFOUT;
static_assert(DL_END == 89600 && L0_ITEMS == 12800, "deferred list");
__device__ __forceinline__ void cvt_dl_item(LAS const unsigned* p, int gi, LAS float* scr, int lane) {
    int type, inst, base;
    if (gi < DL0) { if (gi < DLA) { type = 1; inst = 0; base = 0; } else { type = 4; inst = 0; base = DLA; } }
    else if (gi < DL4) { if (gi < DL2) { if (gi < DL1) { type = 2; inst = 0; base = DL0; } else { type = 3; inst = 0; base = DL1; } } else { if (gi < DL3) { type = 4; inst = 1; base = DL2; } else { type = 5; inst = 1; base = DL3; } } }
    else if (gi < DL8) { if (gi < DL6) { if (gi < DL5) { type = 0; inst = 1; base = DL4; } else { type = 1; inst = 1; base = DL5; } } else { if (gi < DL7) { type = 4; inst = 2; base = DL6; } else { type = 5; inst = 2; base = DL7; } } }
    else { if (gi < DL10) { if (gi < DL9) { type = 2; inst = 1; base = DL8; } else { type = 3; inst = 1; base = DL9; } } else { if (gi < DL11) { type = 4; inst = 3; base = DL10; } else { type = 5; inst = 3; base = DL11; } } }
    cvt_mat(p, type, inst, gi - base, scr, lane);
}
__device__ __forceinline__ void ada_item(LAS const unsigned* prm, int l, int nc, int kp, int tid) {
    if (tid < 384) {
        const int n = nc * 1536 + 4 * tid;
        f32x4 aL = (f32x4){0.f, 0.f, 0.f, 0.f}, aC = aL;
        const float* wp = (const float*)(GAS const float*)ldptr(prm, 4) + ((size_t)l * D + kp * 128) * (6 * D) + n;
        const float* cl_p = (const float*)(GAS const float*)ldptr(prm, 1) + kp * 128; const float* cc_p = (const float*)(GAS const float*)ldptr(prm, 3) + kp * 128;
        float* modacc = (float*)((unsigned char*)(GAS unsigned char*)ldptr(prm, 17) + WS_MODACC);
        const int l32 = tid & 31;
#pragma unroll 1
        for (int k0 = 0; k0 < 128; k0 += 32) {
            f32x4 w[32];
#pragma unroll
            for (int j = 0; j < 32; ++j) w[j] = __builtin_nontemporal_load((const f32x4*)(wp + (size_t)(k0 + j) * (6 * D)));
            const float clv = cl_p[k0 + l32], ccv = cc_p[k0 + l32];
            const float slv = clv / (1.0f + __expf(-clv)), scv = ccv / (1.0f + __expf(-ccv));
#pragma unroll
            for (int j = 0; j < 32; ++j) { const float sl = __builtin_bit_cast(float, __builtin_amdgcn_readlane(__builtin_bit_cast(int, slv), j)), sc = __builtin_bit_cast(float, __builtin_amdgcn_readlane(__builtin_bit_cast(int, scv), j));
                aL = aL + w[j] * sl; aC = aC + w[j] * sc; }
        }
        *(f32x4*)(modacc + (size_t)kp * MODPART + (size_t)(l * 2 + 0) * 6 * D + n) = aL;
        *(f32x4*)(modacc + (size_t)kp * MODPART + (size_t)(l * 2 + 1) * 6 * D + n) = aC;
    }
}
__device__ __forceinline__ void r1_block_task(const bf16_t* P, float* KVt, LAS unsigned char* lds, float lg2, int cidx, int head, int wave, int lane) {
    const int i = lane & 15, g = lane >> 4, dir = wave >> 2, quad = wave & 3;
    const int dk0 = 64 * (quad >> 1), dv0 = 64 * (quad & 1);
    const bf16_t* Prow = P + (size_t)chunk_row(cidx) * ABIN;
#pragma unroll
    for (int r = 0; r < 2; ++r)
#pragma unroll
        for (int j = 0; j < 4; ++j) {
            const int p = (j * 8 + wave) * 64 + lane, row = p >> 4, c = (p & 15) ^ (row & 15);
            const bf16_t* src = Prow + (size_t)row * ABIN + (r == 0 ? 4096 : 5120) + head * 128 + c * 8;
            __builtin_amdgcn_global_load_lds((const unsigned*)src, (LAS unsigned*)(lds + r * 32768 + (j * 8 + wave) * 1024), 16, 0, 0);
        }
    asm volatile("s_waitcnt vmcnt(0)" ::: "memory");
    asm volatile("s_waitcnt lgkmcnt(0)" ::: "memory"); __builtin_amdgcn_s_barrier(); asm volatile("" ::: "memory");
    int kbo[8], vbo[8];
#pragma unroll
    for (int jj = 0; jj < 8; ++jj) { const int tl = 8 * g + jj;
        kbo[jj] = tl * 256 + (((dk0 >> 3) + (i >> 1)) ^ (tl & 15)) * 16 + 8 * (i & 1);
        vbo[jj] = 32768 + tl * 256 + (((dv0 >> 3) + (i >> 1)) ^ (tl & 15)) * 16 + 8 * (i & 1); }
    f32x4 acc[4][4];
#pragma unroll
    for (int a = 0; a < 4; ++a)
#pragma unroll
        for (int b = 0; b < 4; ++b) acc[a][b] = (f32x4){0.f, 0.f, 0.f, 0.f};
#pragma unroll
    for (int s = 0; s < 4; ++s) {
        u32x2 kd[8], vd[8]; float w[8];
#pragma unroll
        for (int jj = 0; jj < 8; ++jj) {
            const int tj = 32 * s + 8 * g + jj;
            kd[jj] = *(LAS const u32x2*)(lds + kbo[jj] + 8192 * s); vd[jj] = *(LAS const u32x2*)(lds + vbo[jj] + 8192 * s);
            w[jj] = ex2(lg2 * (float)(dir == 0 ? 127 - tj : tj));
        }
        bf16x8 af[4], bfr[4];
#pragma unroll
        for (int mt = 0; mt < 4; ++mt) {
            u32x4 wd;
#pragma unroll
            for (int q = 0; q < 4; ++q) {
                const unsigned X = kd[2 * q][mt >> 1], Y = kd[2 * q + 1][mt >> 1];
                const float lo = ((mt & 1) ? bf_hi(X) : bf_lo(X)) * w[2 * q], hi = ((mt & 1) ? bf_hi(Y) : bf_lo(Y)) * w[2 * q + 1];
                wd[q] = cvt_pk_bf16(lo, hi);
            }
            af[mt] = __builtin_bit_cast(bf16x8, wd);
        }
#pragma unroll
        for (int nt = 0; nt < 4; ++nt) {
            u32x4 wd;
#pragma unroll
            for (int q = 0; q < 4; ++q) {
                const unsigned X = vd[2 * q][nt >> 1], Y = vd[2 * q + 1][nt >> 1];
                wd[q] = (nt & 1) ? ((X >> 16) | (Y & 0xffff0000u)) : ((X & 0xffffu) | (Y << 16));
            }
            bfr[nt] = __builtin_bit_cast(bf16x8, wd);
        }
#pragma unroll
        for (int mt = 0; mt < 4; ++mt)
#pragma unroll
            for (int nt = 0; nt < 4; ++nt) acc[mt][nt] = mfma16(af[mt], bfr[nt], acc[mt][nt]);
        SCHED_FENCE();
    }
    asm volatile("s_waitcnt lgkmcnt(0)" ::: "memory"); __builtin_amdgcn_s_barrier(); asm volatile("" ::: "memory");
    float* out = KVt + ((((size_t)cidx * 8 + head) * 2 + dir) * 128) * 128;
#pragma unroll
    for (int nt = 0; nt < 4; ++nt)
#pragma unroll
        for (int reg = 0; reg < 4; ++reg) {
            const int dv = dv0 + 4 * i + nt, dk = dk0 + 16 * g + 4 * reg;
            *(f32x4*)(out + (size_t)dv * 128 + dk) = (f32x4){acc[0][nt][reg], acc[1][nt][reg], acc[2][nt][reg], acc[3][nt][reg]};
        }
}

__device__ __forceinline__ void r1_issue_set(const bf16_t* Prow, LAS unsigned char* setp, const int head, const int wave, const int lane) {
#pragma unroll
    for (int r = 0; r < 2; ++r)
#pragma unroll
        for (int j = 0; j < 4; ++j) {
            const int p = (j * 8 + wave) * 64 + lane, row = p >> 4, c = (p & 15) ^ (row & 15);
            const bf16_t* src = Prow + (size_t)row * ABIN + (r == 0 ? 4096 : 5120) + head * 128 + c * 8;
            __builtin_amdgcn_global_load_lds((const unsigned*)src, (LAS unsigned*)(setp + r * 32768 + (j * 8 + wave) * 1024), 16, 0, 0);
        }
}
__device__ __forceinline__ void r1_phase_pipelined(const bf16_t* P, float* KVt, LAS unsigned char* lds, const float* decay_exp, const int iab, const int vcu, const int G, const int wave, const int lane) {
    const int i = lane & 15, g = lane >> 4, dir = wave >> 2, quad = wave & 3;
    const int dk0 = 64 * (quad >> 1), dv0 = 64 * (quad & 1);
    int bt = vcu; if (bt >= NCHUNK * 8) return;
    int kbo[8], vbo[8];
#pragma unroll
    for (int jj = 0; jj < 8; ++jj) { const int tl = 8 * g + jj;
        kbo[jj] = tl * 256 + (((dk0 >> 3) + (i >> 1)) ^ (tl & 15)) * 16 + 8 * (i & 1);
        vbo[jj] = 32768 + tl * 256 + (((dv0 >> 3) + (i >> 1)) ^ (tl & 15)) * 16 + 8 * (i & 1); }
    r1_issue_set(P + (size_t)chunk_row(bt >> 3) * ABIN, lds, bt & 7, wave, lane);
    for (int k = 0;; ++k) {
        const int cidx = bt >> 3, head = bt & 7, nbt = bt + G;
        const bool has_next = nbt < NCHUNK * 8;
        const float lg2 = lg2gamma(decay_exp, iab, dir, head);
        LAS const unsigned char* setp = lds + (k & 1) * 65536;
        if (has_next) { r1_issue_set(P + (size_t)chunk_row(nbt >> 3) * ABIN, lds + ((k + 1) & 1) * 65536, nbt & 7, wave, lane); asm volatile("s_waitcnt vmcnt(8)" ::: "memory"); }
        else asm volatile("s_waitcnt vmcnt(0)" ::: "memory");
        asm volatile("s_waitcnt lgkmcnt(0)" ::: "memory"); __builtin_amdgcn_s_barrier(); asm volatile("" ::: "memory");
        f32x4 acc[4][4];
#pragma unroll
        for (int a = 0; a < 4; ++a)
#pragma unroll
            for (int b = 0; b < 4; ++b) acc[a][b] = (f32x4){0.f, 0.f, 0.f, 0.f};
#pragma unroll
        for (int s = 0; s < 4; ++s) {
            u32x2 kd[8], vd[8]; float w[8];
#pragma unroll
            for (int jj = 0; jj < 8; ++jj) {
                const int tj = 32 * s + 8 * g + jj;
                kd[jj] = *(LAS const u32x2*)(setp + kbo[jj] + 8192 * s); vd[jj] = *(LAS const u32x2*)(setp + vbo[jj] + 8192 * s);
                w[jj] = ex2(lg2 * (float)(dir == 0 ? 127 - tj : tj));
            }
            bf16x8 af[4], bfr[4];
#pragma unroll
            for (int mt = 0; mt < 4; ++mt) {
                u32x4 wd;
#pragma unroll
                for (int q = 0; q < 4; ++q) {
                    const unsigned X = kd[2 * q][mt >> 1], Y = kd[2 * q + 1][mt >> 1];
                    const float lo = ((mt & 1) ? bf_hi(X) : bf_lo(X)) * w[2 * q], hi = ((mt & 1) ? bf_hi(Y) : bf_lo(Y)) * w[2 * q + 1];
                    wd[q] = cvt_pk_bf16(lo, hi);
                }
                af[mt] = __builtin_bit_cast(bf16x8, wd);
            }
#pragma unroll
            for (int nt = 0; nt < 4; ++nt) {
                u32x4 wd;
#pragma unroll
                for (int q = 0; q < 4; ++q) {
                    const unsigned X = vd[2 * q][nt >> 1], Y = vd[2 * q + 1][nt >> 1];
                    wd[q] = (nt & 1) ? ((X >> 16) | (Y & 0xffff0000u)) : ((X & 0xffffu) | (Y << 16));
                }
                bfr[nt] = __builtin_bit_cast(bf16x8, wd);
            }
#pragma unroll
            for (int mt = 0; mt < 4; ++mt)
#pragma unroll
                for (int nt = 0; nt < 4; ++nt) acc[mt][nt] = mfma16(af[mt], bfr[nt], acc[mt][nt]);
            SCHED_FENCE();
        }
        asm volatile("s_waitcnt lgkmcnt(0)" ::: "memory"); __builtin_amdgcn_s_barrier(); asm volatile("" ::: "memory");
        bf16_t* out = (bf16_t*)KVt + ((((size_t)cidx * 8 + head) * 2 + dir) * 128) * 128;
#pragma unroll
        for (int nt = 0; nt < 4; ++nt)
#pragma unroll
            for (int reg = 0; reg < 4; ++reg) {
                const int dv = dv0 + 4 * i + nt, dk = dk0 + 16 * g + 4 * reg;
                u32x2 w; w[0] = cvt_pk_bf16(acc[0][nt][reg], acc[1][nt][reg]); w[1] = cvt_pk_bf16(acc[2][nt][reg], acc[3][nt][reg]);
                *(u32x2*)(out + (size_t)dv * 128 + dk) = w;
            }
        if (!has_next) break;
        bt = nbt;
    }
}

__device__ __forceinline__ void r3_block_task(const bf16_t* P, const bf16_t* St, bf16_t* YAB, LAS unsigned char* lds, float lg2f, float lg2b, int cidx, int head, int wave, int lane) {
    const int i = lane & 15, g = lane >> 4, qi = 16 * wave + i, rowbase = chunk_row(cidx);
    const bf16_t* Prow = P + (size_t)rowbase * ABIN;
    bf16x8 qf[4];
#pragma unroll
    for (int s = 0; s < 4; ++s) qf[s] = *(const bf16x8*)(Prow + (size_t)qi * ABIN + 3072 + head * 128 + 32 * s + 8 * g);
#pragma unroll
    for (int r = 0; r < 4; ++r)
#pragma unroll
        for (int j = 0; j < 4; ++j) {
            const int p = (j * 8 + wave) * 64 + lane, row = p >> 4, c = (p & 15) ^ (r < 2 ? (row & 15) : ((row >> 3) & 15));
            const bf16_t* src = r == 0 ? Prow + (size_t)row * ABIN + 4096 + head * 128 + c * 8 : (r == 1 ? Prow + (size_t)row * ABIN + 5120 + head * 128 + c * 8
                                : St + ((((size_t)cidx * 8 + head) * 2 + (r - 2)) * 128 + row) * 128 + c * 8);
            __builtin_amdgcn_global_load_lds((const unsigned*)src, (LAS unsigned*)(lds + r * 32768 + (j * 8 + wave) * 1024), 16, 0, 0);
        }
    asm volatile("s_waitcnt vmcnt(0)" ::: "memory");
    asm volatile("s_waitcnt lgkmcnt(0)" ::: "memory"); __builtin_amdgcn_s_barrier(); asm volatile("" ::: "memory");
    int kb[4], sb[4], vb[8];
#pragma unroll
    for (int s = 0; s < 4; ++s) { kb[s] = i * 256 + ((4 * s + g) ^ i) * 16; sb[s] = 65536 + i * 2048 + ((4 * s + g) ^ i) * 16; }
#pragma unroll
    for (int jj = 0; jj < 8; ++jj) { const int kk = jj < 4 ? 4 * g + jj : 16 + 4 * g + jj - 4; vb[jj] = 32768 + kk * 256 + (i ^ (kk & 15)) * 16; }
    f32x4 sacc[8];
#pragma unroll
    for (int mt = 0; mt < 8; ++mt) {
        f32x4 a = (f32x4){0.f, 0.f, 0.f, 0.f};
#pragma unroll
        for (int s = 0; s < 4; ++s) { const bf16x8 kf = *(LAS const bf16x8*)(lds + kb[s] + 4096 * mt); a = mfma16(kf, qf[s], a); }
        sacc[mt] = a;
        if (mt & 1) SCHED_FENCE();
    }
#pragma unroll
    for (int mt = 0; mt < 8; ++mt)
#pragma unroll
        for (int reg = 0; reg < 4; ++reg) {
            const int diff = qi - (16 * mt + 4 * g + reg);
            const float d = diff > 0 ? ex2((float)diff * lg2f) : (diff < 0 ? ex2((float)(-diff) * lg2b) : 2.0f);
            sacc[mt][reg] *= d;
        }
    bf16x8 pf[4];
#pragma unroll
    for (int s = 0; s < 4; ++s) {
        u32x4 w; w[0] = cvt_pk_bf16(sacc[2 * s][0], sacc[2 * s][1]); w[1] = cvt_pk_bf16(sacc[2 * s][2], sacc[2 * s][3]);
        w[2] = cvt_pk_bf16(sacc[2 * s + 1][0], sacc[2 * s + 1][1]); w[3] = cvt_pk_bf16(sacc[2 * s + 1][2], sacc[2 * s + 1][3]);
        pf[s] = __builtin_bit_cast(bf16x8, w);
    }
    f32x4 oacc[8];
#pragma unroll
    for (int mt = 0; mt < 8; ++mt) oacc[mt] = (f32x4){0.f, 0.f, 0.f, 0.f};
#pragma unroll
    for (int s = 0; s < 4; ++s) {
        u32x4 vd[8];
#pragma unroll
        for (int jj = 0; jj < 8; ++jj) vd[jj] = *(LAS const u32x4*)(lds + vb[jj] + 8192 * s);
#pragma unroll
        for (int mt = 0; mt < 8; ++mt) oacc[mt] = mfma16(extract8(vd, mt), pf[s], oacc[mt]);
        SCHED_FENCE();
    }
#pragma unroll
    for (int dir = 0; dir < 2; ++dir) {
        f32x4 tacc[8];
#pragma unroll
        for (int mt = 0; mt < 8; ++mt) tacc[mt] = (f32x4){0.f, 0.f, 0.f, 0.f};
#pragma unroll
        for (int s = 0; s < 4; ++s) {
#pragma unroll
            for (int mt = 0; mt < 8; ++mt) { const bf16x8 sf = *(LAS const bf16x8*)(lds + sb[s] + 256 * mt + 32768 * dir); tacc[mt] = mfma16(sf, qf[s], tacc[mt]); }
            SCHED_FENCE();
        }
        const float qd = dir == 0 ? ex2((float)(qi + 1) * lg2f) : ex2((float)(128 - qi) * lg2b);
#pragma unroll
        for (int mt = 0; mt < 8; ++mt) oacc[mt] = oacc[mt] + tacc[mt] * qd;
    }
    asm volatile("s_waitcnt lgkmcnt(0)" ::: "memory"); __builtin_amdgcn_s_barrier(); asm volatile("" ::: "memory");
    float ss = 0.f;
#pragma unroll
    for (int mt = 0; mt < 8; ++mt) ss += (oacc[mt][0] * oacc[mt][0] + oacc[mt][1] * oacc[mt][1]) + (oacc[mt][2] * oacc[mt][2] + oacc[mt][3] * oacc[mt][3]);
    ss += shfl_xor_f(ss, 16); ss += shfl_xor_f(ss, 32);
    const float rinv = rsq_f(ss * (1.0f / 128.0f) + EPS);
#pragma unroll
    for (int reg = 0; reg < 4; ++reg) {
        const int dvb = 32 * g + 8 * reg;
        const u32x4 gt = *(const u32x4*)(Prow + (size_t)qi * ABIN + 6144 + head * 128 + dvb);
        float o[8];
#pragma unroll
        for (int mt = 0; mt < 8; ++mt) { const float gv = (mt & 1) ? bf_hi(gt[mt >> 1]) : bf_lo(gt[mt >> 1]); o[mt] = silu_f(gv) * (oacc[mt][reg] * rinv); }
        u32x4 w; w[0] = cvt_pk_bf16(o[0], o[1]); w[1] = cvt_pk_bf16(o[2], o[3]); w[2] = cvt_pk_bf16(o[4], o[5]); w[3] = cvt_pk_bf16(o[6], o[7]);
        *(u32x4*)(YAB + (size_t)(rowbase + qi) * D + 1024 + head * 128 + dvb) = w;
    }
}

__device__ __forceinline__ void r3_issue_regions(const bf16_t* Prow, const bf16_t* Stb, LAS unsigned char* lds, const int head, const int rlo, const int wave, const int lane) {
#pragma unroll
    for (int rr = 0; rr < 2; ++rr)
#pragma unroll
        for (int j = 0; j < 4; ++j) {
            const int r = rlo + rr;
            const int p = (j * 8 + wave) * 64 + lane, row = p >> 4, c = (p & 15) ^ (r < 2 ? (row & 15) : ((row >> 3) & 15));
            const bf16_t* src = r == 0 ? Prow + (size_t)row * ABIN + 4096 + head * 128 + c * 8 : (r == 1 ? Prow + (size_t)row * ABIN + 5120 + head * 128 + c * 8
                                : Stb + ((size_t)(r - 2) * 128 + row) * 128 + c * 8);
            __builtin_amdgcn_global_load_lds((const unsigned*)src, (LAS unsigned*)(lds + r * 32768 + (j * 8 + wave) * 1024), 16, 0, 0);
        }
}
__device__ __forceinline__ void r3_phase_pipelined(const bf16_t* P, const bf16_t* St, bf16_t* YAB, LAS unsigned char* lds, const float* decay_exp, const int iab, const int vcu, const int G, const int wave, const int lane) {
    const int i = lane & 15, g = lane >> 4;
    int bt = vcu; if (bt >= NCHUNK * 8) return;
    int kb[4], sb[4], vb[8];
#pragma unroll
    for (int s = 0; s < 4; ++s) { kb[s] = i * 256 + ((4 * s + g) ^ i) * 16; sb[s] = 65536 + i * 2048 + ((4 * s + g) ^ i) * 16; }
#pragma unroll
    for (int jj = 0; jj < 8; ++jj) { const int kk = jj < 4 ? 4 * g + jj : 16 + 4 * g + jj - 4; vb[jj] = 32768 + kk * 256 + (i ^ (kk & 15)) * 16; }
    bf16x8 qn[4];
    {   const int cidx = bt >> 3, head = bt & 7; const bf16_t* Prow = P + (size_t)chunk_row(cidx) * ABIN;
#pragma unroll
        for (int s = 0; s < 4; ++s) qn[s] = *(const bf16x8*)(Prow + (size_t)(16 * wave + i) * ABIN + 3072 + head * 128 + 32 * s + 8 * g);
        const bf16_t* Stb = St + (((size_t)cidx * 8 + head) * 2) * 16384;
        r3_issue_regions(Prow, Stb, lds, head, 0, wave, lane); r3_issue_regions(Prow, Stb, lds, head, 2, wave, lane); }
    for (;;) {
        const int cidx = bt >> 3, head = bt & 7, qi = 16 * wave + i, rowbase = chunk_row(cidx), nbt = bt + G;
        const bool has_next = nbt < NCHUNK * 8;
        const bf16_t* Prow = P + (size_t)rowbase * ABIN;
        const float lg2f = lg2gamma(decay_exp, iab, 0, head), lg2b = lg2gamma(decay_exp, iab, 1, head);
        bf16x8 qf[4];
#pragma unroll
        for (int s = 0; s < 4; ++s) qf[s] = qn[s];
        asm volatile("s_waitcnt vmcnt(8)" ::: "memory");
        asm volatile("s_waitcnt lgkmcnt(0)" ::: "memory"); __builtin_amdgcn_s_barrier(); asm volatile("" ::: "memory");
        f32x4 sacc[8];
#pragma unroll
        for (int mt = 0; mt < 8; ++mt) {
            f32x4 a = (f32x4){0.f, 0.f, 0.f, 0.f};
#pragma unroll
            for (int s = 0; s < 4; ++s) { const bf16x8 kf = *(LAS const bf16x8*)(lds + kb[s] + 4096 * mt); a = mfma16(kf, qf[s], a); }
            sacc[mt] = a;
            if (mt & 1) SCHED_FENCE();
        }
#pragma unroll
        for (int mt = 0; mt < 8; ++mt)
#pragma unroll
            for (int reg = 0; reg < 4; ++reg) {
                const int diff = qi - (16 * mt + 4 * g + reg);
                const float d = diff > 0 ? ex2((float)diff * lg2f) : (diff < 0 ? ex2((float)(-diff) * lg2b) : 2.0f);
                sacc[mt][reg] *= d;
            }
        bf16x8 pf[4];
#pragma unroll
        for (int s = 0; s < 4; ++s) {
            u32x4 w; w[0] = cvt_pk_bf16(sacc[2 * s][0], sacc[2 * s][1]); w[1] = cvt_pk_bf16(sacc[2 * s][2], sacc[2 * s][3]);
            w[2] = cvt_pk_bf16(sacc[2 * s + 1][0], sacc[2 * s + 1][1]); w[3] = cvt_pk_bf16(sacc[2 * s + 1][2], sacc[2 * s + 1][3]);
            pf[s] = __builtin_bit_cast(bf16x8, w);
        }
        f32x4 oacc[8];
#pragma unroll
        for (int mt = 0; mt < 8; ++mt) oacc[mt] = (f32x4){0.f, 0.f, 0.f, 0.f};
#pragma unroll
        for (int s = 0; s < 4; ++s) {
            u32x4 vd[8];
#pragma unroll
            for (int jj = 0; jj < 8; ++jj) vd[jj] = *(LAS const u32x4*)(lds + vb[jj] + 8192 * s);
#pragma unroll
            for (int mt = 0; mt < 8; ++mt) oacc[mt] = mfma16(extract8(vd, mt), pf[s], oacc[mt]);
            SCHED_FENCE();
        }
        asm volatile("s_waitcnt lgkmcnt(0)" ::: "memory"); __builtin_amdgcn_s_barrier(); asm volatile("" ::: "memory");
        if (has_next) {
            const int ncidx = nbt >> 3, nhead = nbt & 7; const bf16_t* nProw = P + (size_t)chunk_row(ncidx) * ABIN;
#pragma unroll
            for (int s = 0; s < 4; ++s) qn[s] = *(const bf16x8*)(nProw + (size_t)(16 * wave + i) * ABIN + 3072 + nhead * 128 + 32 * s + 8 * g);
            r3_issue_regions(nProw, St, lds, nhead, 0, wave, lane);
            asm volatile("s_waitcnt vmcnt(8)" ::: "memory");
        } else asm volatile("s_waitcnt vmcnt(0)" ::: "memory");
        asm volatile("s_waitcnt lgkmcnt(0)" ::: "memory"); __builtin_amdgcn_s_barrier(); asm volatile("" ::: "memory");
#pragma unroll
        for (int dir = 0; dir < 2; ++dir) {
            f32x4 tacc[8];
#pragma unroll
            for (int mt = 0; mt < 8; ++mt) tacc[mt] = (f32x4){0.f, 0.f, 0.f, 0.f};
#pragma unroll
            for (int s = 0; s < 4; ++s) {
#pragma unroll
                for (int mt = 0; mt < 8; ++mt) { const bf16x8 sf = *(LAS const bf16x8*)(lds + sb[s] + 256 * mt + 32768 * dir); tacc[mt] = mfma16(sf, qf[s], tacc[mt]); }
                SCHED_FENCE();
            }
            const float qd = dir == 0 ? ex2((float)(qi + 1) * lg2f) : ex2((float)(128 - qi) * lg2b);
#pragma unroll
            for (int mt = 0; mt < 8; ++mt) oacc[mt] = oacc[mt] + tacc[mt] * qd;
        }
        asm volatile("s_waitcnt lgkmcnt(0)" ::: "memory"); __builtin_amdgcn_s_barrier(); asm volatile("" ::: "memory");
        float ss = 0.f;
#pragma unroll
        for (int mt = 0; mt < 8; ++mt) ss += (oacc[mt][0] * oacc[mt][0] + oacc[mt][1] * oacc[mt][1]) + (oacc[mt][2] * oacc[mt][2] + oacc[mt][3] * oacc[mt][3]);
        ss += shfl_xor_f(ss, 16); ss += shfl_xor_f(ss, 32);
        const float rinv = rsq_f(ss * (1.0f / 128.0f) + EPS);
#pragma unroll
        for (int reg = 0; reg < 4; ++reg) {
            const int dvb = 32 * g + 8 * reg;
            const u32x4 gt = *(const u32x4*)(Prow + (size_t)qi * ABIN + 6144 + head * 128 + dvb);
            float o[8];
#pragma unroll
            for (int mt = 0; mt < 8; ++mt) { const float gv = (mt & 1) ? bf_hi(gt[mt >> 1]) : bf_lo(gt[mt >> 1]); o[mt] = silu_f(gv) * (oacc[mt][reg] * rinv); }
            u32x4 w; w[0] = cvt_pk_bf16(o[0], o[1]); w[1] = cvt_pk_bf16(o[2], o[3]); w[2] = cvt_pk_bf16(o[4], o[5]); w[3] = cvt_pk_bf16(o[6], o[7]);
            *(u32x4*)(YAB + (size_t)(rowbase + qi) * D + 1024 + head * 128 + dvb) = w;
        }
        if (!has_next) break;
        { const int ncidx = nbt >> 3, nhead = nbt & 7; const bf16_t* nProw = P + (size_t)chunk_row(ncidx) * ABIN;
          r3_issue_regions(nProw, St + (((size_t)ncidx * 8 + nhead) * 2) * 16384, lds, nhead, 2, wave, lane); }
        bt = nbt;
    }
}

__device__ __forceinline__ void na_stage_issue(const bf16_t* P, LAS unsigned char* slot, int tok0, int h, int wave, int lane) {
#pragma unroll
    for (int j = 0; j < 2; ++j) {
        const int p = (j * 8 + wave) * 64 + lane, key = p >> 4, c = (p & 15) ^ (key & 15);
        const bf16_t* src = P + (size_t)(tok0 + key) * QKV + 2048 + h * 128 + c * 8;
        __builtin_amdgcn_global_load_lds((const unsigned*)src, (LAS unsigned*)(slot + (j * 8 + wave) * 1024), 16, 0, 0);
        __builtin_amdgcn_global_load_lds((const unsigned*)(src + 2048), (LAS unsigned*)(slot + 16384 + (j * 8 + wave) * 1024), 16, 0, 0);
    }
}
__device__ __forceinline__ void na_half_step(AttnTile& ta, AttnTile& tb, LAS const unsigned char* slot, const int k0, const bool okA, const bool okB, const bool win,
                                             LAS const float* brA, LAS const float* brB, const int kc0, const int c, const int sc, const int i, const int g) {
    f32x4 saA[2], saB[2];
#pragma unroll
    for (int mt = 0; mt < 2; ++mt) {
        const int k = k0 + 16 * mt + i;
        bf16x8 kf[4];
#pragma unroll
        for (int s = 0; s < 4; ++s) kf[s] = *(LAS const bf16x8*)(slot + ((k << 4) + ((4 * s + g) ^ (k & 15))) * 16);
        f32x4 a = (f32x4){0.f, 0.f, 0.f, 0.f}, b = a;
#pragma unroll
        for (int s = 0; s < 4; ++s) { a = mfma16(kf[s], ta.qf[s], a); b = mfma16(kf[s], tb.qf[s], b); }
        saA[mt] = a; saB[mt] = b;
    }
    const bf16x8 pfA = attn_tile_soft(ta, saA, win, okA, brA, kc0, c, sc, g);
    const bf16x8 pfB = attn_tile_soft(tb, saB, win, okB, brB, kc0, c, sc, g);
    u32x4 vd[8];
#pragma unroll
    for (int jj = 0; jj < 8; ++jj) { const int k = k0 + (jj < 4 ? 4 * g + jj : 16 + 4 * g + jj - 4); vd[jj] = *(LAS const u32x4*)(slot + 16384 + ((k << 4) + (i ^ (k & 15))) * 16); }
#pragma unroll
    for (int mt = 0; mt < 8; ++mt) { const bf16x8 vf = extract8(vd, mt); ta.oacc[mt] = mfma16(vf, pfA, ta.oacc[mt]); tb.oacc[mt] = mfma16(vf, pfB, tb.oacc[mt]); }
}
__device__ __forceinline__ void na_block_task(const bf16_t* P, bf16_t* YAB, const float* rpbh, LAS unsigned char* lds, const int h, const int r0, const int tid, const int wave, const int lane) {
    const int i = lane & 15, g = lane >> 4, cgp = wave & 3, pair = wave >> 2;
    const int rA = r0 + 2 * pair, rB = rA + 1, c0 = 16 * cgp, kc0 = cgp == 0 ? 0 : (cgp == 1 ? 8 : (cgp == 2 ? 24 : 32));
    const int c = c0 + i, sc = c - 8 < 0 ? 0 : (c - 8 > 48 ? 48 : c - 8);
    const int srA = rA - 4 < 0 ? 0 : (rA - 4 > 120 ? 120 : rA - 4), srB = rB - 4 < 0 ? 0 : (rB - 4 > 120 ? 120 : rB - 4);
    const int srmin = r0 - 4 < 0 ? 0 : (r0 - 4 > 120 ? 120 : r0 - 4), srlast = r0 - 1 < 0 ? 0 : (r0 - 1 > 120 ? 120 : r0 - 1);
    const int nkr = srlast + 8 - srmin, nsw = (nkr + 1) >> 1, nst = nsw + 2;
    LAS float* bias = (LAS float*)(lds + LDSCTL_OFF + 2048);
    if (tid < 465) bias[tid] = rpbh[tid];
    AttnTile ta, tb;
    attn_tile_init(ta, P, rA * 64 + c0 + i, h, g); attn_tile_init(tb, P, rB * 64 + c0 + i, h, g);
    asm volatile("s_waitcnt vmcnt(0)" ::: "memory");
#define NA_ROWOFF(idx) (nkr == 11 ? ((idx) < 4 ? (((idx) & 1) ? 9 + ((idx) >> 1) : ((idx) >> 1)) : (idx) - 2) : (idx))
#define NA_ISSUE2(stg, slotp) do { const int s_ = (stg); \
        const int t0_ = s_ < nsw ? (srmin + NA_ROWOFF(2 * s_)) * 64 : S + 128 * (s_ - nsw); \
        const int t1_ = s_ < nsw ? (srmin + (2 * s_ + 1 < nkr ? NA_ROWOFF(2 * s_ + 1) : NA_ROWOFF(2 * s_))) * 64 : S + 128 * (s_ - nsw) + 64; \
        na_stage_issue(P, (slotp), t0_, h, wave, lane); na_stage_issue(P, (slotp) + 32768, t1_, h, wave, lane); } while (0)
    NA_ISSUE2(0, lds);
    for (int st = 0; st < nst; ++st) {
        if (st + 1 < nst) {
            NA_ISSUE2(st + 1, lds + ((st + 1) & 1) * 65536);
            asm volatile("s_waitcnt vmcnt(8)" ::: "memory");
        } else asm volatile("s_waitcnt vmcnt(0)" ::: "memory");
        asm volatile("s_waitcnt lgkmcnt(0)" ::: "memory"); __builtin_amdgcn_s_barrier(); asm volatile("" ::: "memory");
        const bool win = st < nsw;
#pragma unroll 1
        for (int sub = 0; sub < 2; ++sub) {
            LAS const unsigned char* slot = lds + (st & 1) * 65536 + sub * 32768;
            const int kr = srmin + NA_ROWOFF(2 * st + sub);
            if (win && 2 * st + sub >= nkr) break;
            const bool doA = !win || (kr >= srA && kr < srA + 8), doB = !win || (kr >= srB && kr < srB + 8);
            if (!doA && !doB) continue;
            const int nh = win ? 1 : 2;
#pragma unroll 1
            for (int hf = 0; hf < nh; ++hf)
                na_half_step(ta, tb, slot, win ? kc0 : 32 * hf, doA, doB, win, bias + (win && doA ? (kr - rA + 7) * 31 : 0), bias + (win && doB ? (kr - rB + 7) * 31 : 0), kc0, c, sc, i, g);
        }
        asm volatile("s_waitcnt lgkmcnt(0)" ::: "memory"); __builtin_amdgcn_s_barrier(); asm volatile("" ::: "memory");
    }
#undef NA_ISSUE2
#undef NA_ROWOFF
    attn_tile_store(ta, YAB, rA * 64 + c0 + i, h, g); attn_tile_store(tb, YAB, rB * 64 + c0 + i, h, g);
}

#ifndef MK_MODE
#define MK_MODE 1
#endif
__global__ void __launch_bounds__(512, 2) mega_fwd(Params p) {
    extern __shared__ __attribute__((aligned(16))) unsigned char lds_raw[];
    LAS unsigned char* lds = (LAS unsigned char*)lds_raw;
    const int G_k = gridDim.x, bx_k = blockIdx.x;
#define SITE_COORDS pt_t0_ = (PT_SITE >= 0) ? wall_clock64() : 0ull; int tid = threadIdx.x; asm volatile("" : "+v"(tid)); int Gl_ = G_k, bxl_ = bx_k; asm volatile("" : "+s"(Gl_), "+s"(bxl_)); const int G = Gl_, bx = bxl_, NGW = G * 8; (void)NGW; const int lane = tid & 63, wave = __builtin_amdgcn_readfirstlane(tid >> 6); \
    const int vcu = (bx & 7) * (G >> 3) + (bx >> 3); const int gw = vcu * 8 + wave;     (void)lane; (void)gw; (void)vcu; \
    LAS const unsigned* prm = (LAS const unsigned*)(lds + PRM_OFF); asm volatile("" : "+v"(prm)); unsigned char* ws = (unsigned char*)(GAS unsigned char*)ldptr(prm, 17); (void)ws; \
    float* modacc = (float*)(ws + WS_MODACC); f32x2* rope = (f32x2*)(ws + WS_ROPE); float* X = (float*)(ws + WS_X); bf16_t* H = (bf16_t*)(ws + WS_H); bf16_t* P = (bf16_t*)(ws + WS_P); bf16_t* YAB = (bf16_t*)(ws + WS_YAB); \
    float* Y = (float*)(ws + WS_Y); bf16_t* HID = (bf16_t*)(ws + WS_P)  ; float* KVT = (float*)(ws + WS_Y)  ; bf16_t* ST = (bf16_t*)(ws + WS_Y + (size_t)NCHUNK * 16 * 16384 * 2); float* YC = (float*)(ws + WS_YC); \
    (void)modacc; (void)rope; (void)X; (void)H; (void)P; (void)YAB; (void)Y; (void)HID; (void)KVT; (void)ST; (void)YC
#define INP(k) ((const float*)(GAS const float*)ldptr(prm, (k)))
    volatile LAS unsigned* MISC = (volatile LAS unsigned*)(lds + MISC_OFF);
    { const int tid = threadIdx.x; for (int u = tid; u < (LDS_BYTES - LDSCTL_OFF) / 4; u += 512) ((LAS unsigned*)(lds + LDSCTL_OFF))[u] = 0u; }
    __syncthreads();
    if (threadIdx.x == 0) { LAS unsigned long long* q = (LAS unsigned long long*)(lds + PRM_OFF);
        q[0] = (unsigned long long)p.in[0]; q[1] = (unsigned long long)p.in[1]; q[2] = (unsigned long long)p.in[2]; q[3] = (unsigned long long)p.in[3];
        q[4] = (unsigned long long)p.in[4]; q[5] = (unsigned long long)p.in[5]; q[6] = (unsigned long long)p.in[6]; q[7] = (unsigned long long)p.in[7];
        q[8] = (unsigned long long)p.in[8]; q[9] = (unsigned long long)p.in[9]; q[10] = (unsigned long long)p.in[10]; q[11] = (unsigned long long)p.in[11];
        q[12] = (unsigned long long)p.in[12]; q[13] = (unsigned long long)p.in[13]; q[14] = (unsigned long long)p.in[14]; q[15] = (unsigned long long)p.in[15];
        q[16] = (unsigned long long)p.out; q[17] = (unsigned long long)p.ws; }
    __syncthreads();
    const int lo = MK_MODE == 1 ? 0 : p.ph_lo, hi = MK_MODE == 1 ? NPHASE : p.ph_hi;
    const bool multi = (hi - lo) > 1;
    XcdBarrier bar; bar.bar = (unsigned*)(p.ws + WS_CTL) + p.li * 4096; bar.x = 0; bar.st = nullptr;
    if (multi) bar = xcd_barrier_post((unsigned*)(p.ws + WS_CTL) + p.li * 4096, MISC + 8);
#ifndef SITE_MASK
#define SITE_MASK 0xffff
#endif
#define EN(i) (((SITE_MASK) >> (i)) & 1)
#ifndef REPEAT_MASK
#define REPEAT_MASK 0
#endif
#if REPEAT_MASK != 0
    int rmask_ = REPEAT_MASK; asm volatile("" : "+s"(rmask_));
#define REP(i) ((rmask_ >> (i)) & 1)
#else
#define REP(i) 0
#endif
#define IN(k) (lo <= (k) && (k) < hi)
#ifndef DEFER_CVT
#define DEFER_CVT 1
#endif
#define DEFER_SLOT(rk_, nblk_, lo_, hi_) do { if (DEFER_CVT && G == 256) {     const int rk = (rk_); if (rk >= 0) { LAS float* scr_ = (LAS float*)(lds + wave * 16384); \
        for (int gi = (lo_) + rk * 8 + wave; gi < (hi_); gi += (nblk_) * 8) cvt_dl_item(prm, gi, scr_, lane); } __syncthreads(); } } while (0)
#define DEFER_ADA(rk_, lo_, hi_) do { if (DEFER_CVT && G == 256) { const int ai_ = (lo_) + (rk_); if ((rk_) >= 0 && ai_ < (hi_)) ada_item(prm, 1 + (ai_ >> 7), (ai_ >> 4) & 7, ai_ & 15, tid); } } while (0)
#define MODF_FINALIZE(l0_, l1_) do { for (int it = (vcu * 512 + tid); it < ((l1_) - (l0_)) * 2 * 6 * (D / 4); it += G * 512) { const int col = 4 * (it & 511), j6 = (it >> 9) % 6, ls = 2 * (l0_) + it / (512 * 6); \
        *(f32x4*)((float*)(ws + WS_MODF) + (size_t)(ls * 6 + j6) * D + col) = modvec_partials(modacc, INP(5), ls >> 1, ls & 1, j6, col); } } while (0)
#define ROWOP_RUN(a0) do { RowopArgs ra_ = (a0); if (rep_ + 1 < nrep_) { ra_.xout_lat = (float*)(ws + WS_END); ra_.xout_ctx = ra_.xout_lat + (size_t)S * D; ra_.h = (bf16_t*)(ws + WS_END + (size_t)MTOK * D * 4); } LAS float* cf0 = (LAS float*)lds; LAS float* cf1 = (LAS float*)(lds + 24576); \
        rowop_coefs(ra_, 0, cf0, tid); if (ra_.nctx) rowop_coefs(ra_, 1, cf1, tid); __syncthreads(); \
        if (ra_.nctx) rowop_ctx(ra_, cf1, (LAS float*)(lds + 49152), vcu, G, wave, lane); \
        rowop_stream(ra_, cf0, gw, NGW, lane); __syncthreads(); } while (0)
#ifndef DOUBLE_BAR
#define DOUBLE_BAR 0
#endif
#ifndef PT_SITE
#define PT_SITE -1
#endif
#ifndef PT_BLOCK
#define PT_BLOCK 0
#endif
#ifndef IDLE_Q
#define IDLE_Q 40.0f
#endif
#ifndef IDLE_PROBE
#define IDLE_PROBE 0
#endif
    unsigned long long idle_acc_ = 0ull, pt_t0_ = 0ull, pt_acc_ = 0ull; int pt_cur_ = -1; (void)pt_t0_; (void)pt_acc_; (void)pt_cur_;
#define SEAM(k, knext) do { if (PT_SITE >= 0) { if (pt_cur_ == PT_SITE) pt_acc_ += wall_clock64() - pt_t0_; pt_cur_ = -1; } if (IN(k) && IN(knext)) { unsigned long long t0_ = 0ull; if (IDLE_PROBE) t0_ = wall_clock64(); { XcdBarrier b_ = bar; asm volatile("" : "+s"(b_.x)); xcd_barrier(b_); if (DOUBLE_BAR) xcd_barrier(b_); } \
        if (IDLE_PROBE == 1 || (IDLE_PROBE >= 2 && IDLE_PROBE < 100 && (k) >= 2 && ((k) - 2) % 9 == IDLE_PROBE - 2) || (IDLE_PROBE >= 100 && (k) == IDLE_PROBE - 100)) idle_acc_ += wall_clock64() - t0_; } } while (0)

    for (int nrep_ = 1 + REP(0), rep_ = 0; rep_ < nrep_; ++rep_) if (EN(0) && IN(0) && ((pt_cur_ = 0), true)) {
        SITE_COORDS;
        LAS float* scr = (LAS float*)(lds + wave * 16384);
        if (DEFER_CVT && G == 256) {
            constexpr int L0_ADA_SHARE = 2048;
            if (vcu < 128) { ada_item(prm, 0, vcu >> 4, vcu & 15, tid); for (int it = L0_ITEMS - L0_ADA_SHARE + vcu * 8 + wave; it < L0_ITEMS; it += 1024) cvt_l0_item(prm, it, scr, lane); }
            else for (int it = (vcu - 128) * 8 + wave; it < L0_ITEMS - L0_ADA_SHARE; it += 1024) cvt_l0_item(prm, it, scr, lane);
        } else {
            for (int it = gw; it < L0_ITEMS; it += NGW) cvt_l0_item(prm, it, scr, lane);
            for (int it = gw; it < DL_END; it += NGW) cvt_dl_item(prm, it, scr, lane);
            for (int it = vcu; it < 4 * 128; it += G) ada_item(prm, it >> 7, (it >> 4) & 7, it & 15, tid);
        }
        for (int idx = bx * 512 + tid; idx < 192 * 32; idx += G * 512) {
            const int pi = idx >> 5, f = idx & 31; const float pos = (float)(pi < 128 ? pi : pi - 128);
            const float ang = pos * powf(10000.0f, -(float)f / 32.0f);
            rope[idx] = (f32x2){cosf(ang), sinf(ang)};
        }
    }
    SEAM(0, 1);
    for (int nrep_ = 1 + REP(1), rep_ = 0; rep_ < nrep_; ++rep_) if (EN(1) && IN(1) && ((pt_cur_ = 1), true)) {
        SITE_COORDS;
        RowopArgs a; a.y = nullptr; a.xin_lat = INP(0); a.xin_ctx = INP(2); a.xout_lat = nullptr; a.xout_ctx = nullptr; a.xin16 = 0; a.xout16 = 0;     a.h = H; a.modacc = modacc; a.ada_b = INP(5); a.norm_g = INP(6);
        a.ly = -1; a.jg_y = 0; a.jgate = 0; a.lh = 0; a.jg_h = 0; a.jshift = 0; a.jscale = 1; a.nctx = NCTX; a.ypart = nullptr; a.nypart = 0; a.modf = nullptr;
        if (DEFER_CVT && G == 256) MODF_FINALIZE(0, 1); else MODF_FINALIZE(0, 4);
        ROWOP_RUN(a);
    }
    SEAM(1, 2);
    for (int layer = 0; layer < DEPTH; ++layer) {
        const int pb = 2 + 9 * layer, iab = layer >> 1;
        const bool even = (layer & 1) == 0, last = layer == DEPTH - 1;
        const int Mrows = last ? S : MTOK;
        if (even) {
            for (int nrep_ = 1 + REP(2), rep_ = 0; rep_ < nrep_; ++rep_) if (EN(2) && IN(pb + 0) && ((pt_cur_ = 2), true)) {
                SITE_COORDS;
                if (rep_ == 0) { if (layer == 0) { DEFER_ADA(bx - 156, 0, 100); DEFER_SLOT(bx - 156, 100, 0, 6400); } else { DEFER_ADA(bx - 156, 268, 368); DEFER_SLOT(bx - 156, 100, 46784, 53184); } }
                pg8::Gemm g{H, (const bf16_t*)(ws + WS_WABIN + iab * SZ_WABIN), MTOK, ABIN, D}; pg8::StaticOrder So; So.init(MTOK, ABIN, D, G, bx);
                EpiInProj E{P, rope};
                pg8::gemm_phase<EpiInProj, pg8::StaticOrder, PG8_ALIGN, PG8_SP2>(lds, g, So, E, tid);
            }
            SEAM(pb + 0, pb + 1);
            for (int nrep_ = 1 + REP(3), rep_ = 0; rep_ < nrep_; ++rep_) if (EN(3) && IN(pb + 1) && ((pt_cur_ = 3), true)) {
                SITE_COORDS;
                if (rep_ == 0) { if (layer == 0) DEFER_SLOT(vcu - 16, 240, 6400, 12160); else DEFER_SLOT(vcu - 16, 240, 53184, 58944); }
                r1_phase_pipelined(P, KVT, lds, INP(9), iab, vcu, G, wave, lane);
                { const int cw0 = G == 256 ? (vcu - 16) * 8 + wave : gw, cwn = G == 256 ? 240 * 8 : NGW;
                  if (cw0 >= 0) for (int t = cw0; t < (MTOK / 8) * 2; t += cwn) conv_task(P, YAB, INP(8) + (size_t)iab * 3 * 1024, t, lane); }
            }
            SEAM(pb + 1, pb + 2);
            for (int nrep_ = 1 + REP(4), rep_ = 0; rep_ < nrep_; ++rep_) if (EN(4) && IN(pb + 2) && ((pt_cur_ = 4), true)) {
                SITE_COORDS;
                for (int it = vcu * 512 + tid; it < 131072; it += G * 512) r2_item((const bf16_t*)KVT, ST, INP(9), iab, it);
            }
            SEAM(pb + 2, pb + 3);
            for (int nrep_ = 1 + REP(5), rep_ = 0; rep_ < nrep_; ++rep_) if (EN(5) && IN(pb + 3) && ((pt_cur_ = 5), true)) {
                SITE_COORDS;
                if (rep_ == 0) { if (layer == 0) DEFER_SLOT(vcu - 16, 240, 12160, 19840); else DEFER_SLOT(vcu - 16, 240, 58944, 66624); }
                r3_phase_pipelined(P, ST, YAB, lds, INP(9), iab, vcu, G, wave, lane);
            }
            SEAM(pb + 3, pb + 4);
        } else {
            for (int nrep_ = 1 + REP(6), rep_ = 0; rep_ < nrep_; ++rep_) if (EN(6) && IN(pb + 0) && ((pt_cur_ = 6), true)) {
                SITE_COORDS;
                if (rep_ == 0) { if (layer == 1) DEFER_SLOT(bx - 24, 232, 25888, 40736); else DEFER_SLOT(bx - 24, 232, 72672, 87520); }
                pg8::Gemm g{H, (const bf16_t*)(ws + WS_WQKV + iab * SZ_WQKV), MTOK, QKV, D}; pg8::StaticOrder So; So.init(MTOK, QKV, D, G, bx);
                EpiBf16 E{P, QKV};
                pg8::gemm_phase<EpiBf16, pg8::StaticOrder, PG8_ALIGN, PG8_SP2>(lds, g, So, E, tid);
            }
            SEAM(pb + 0, pb + 1);
            for (int nrep_ = 1 + REP(7), rep_ = 0; rep_ < nrep_; ++rep_) if (EN(7) && IN(pb + 1) && ((pt_cur_ = 7), true)) {
                SITE_COORDS;
                const float* rpb = INP(12) + (size_t)iab * 16 * 15 * 31;
                for (int bt = vcu; bt < 512; bt += G) {
                    const int h = bt >> 5, rq = bt & 31;
                    na_block_task(P, YAB, rpb + h * 465, lds, h, 4 * rq, tid, wave, lane);
                }
                if (!last) for (int t = gw; t < 128; t += NGW) attn_task2<false>(P, YAB, rpb, t >> 3, S + 32 * (t & 7), S + 32 * (t & 7) + 16, 0, 0, 0, lane);
            }
            SEAM(pb + 1, pb + 4);
        }
        for (int nrep_ = 1 + REP(8), rep_ = 0; rep_ < nrep_; ++rep_) if (EN(8) && IN(pb + 4) && ((pt_cur_ = 8), true)) {
            SITE_COORDS;
            const bf16_t* wt = even ? (const bf16_t*)(ws + WS_WABOUT + iab * SZ_WSQ) : (const bf16_t*)(ws + WS_WNAOUT + iab * SZ_WSQ);
            pg8::Gemm g{YAB, wt, MTOK, D, D}; pg8::MixedOrder So; So.init(S, D, D, G, bx, 32, last ? 0 : NSPLIT_OUT);
            EpiY E{(bf16_t*)Y, D, (bf16_t*)YC};
            pg8::gemm_phase<EpiY, pg8::MixedOrder, PG8_ALIGN, PG8_SP2>(lds, g, So, E, tid);
        }
        SEAM(pb + 4, pb + 5);
        for (int nrep_ = 1 + REP(9), rep_ = 0; rep_ < nrep_; ++rep_) if (EN(9) && IN(pb + 5) && ((pt_cur_ = 9), true)) {
            SITE_COORDS;
            RowopArgs a; a.y = (const bf16_t*)Y; a.xin_lat = layer == 0 ? INP(0) : X; a.xin_ctx = layer == 0 ? INP(2) : (const float*)((const bf16_t*)X + (size_t)S * D); a.xout_lat = X; a.xout_ctx = (float*)((bf16_t*)X + (size_t)S * D); a.xin16 = layer == 0 ? 0 : 1; a.xout16 = 1;     a.h = H; a.modacc = modacc; a.ada_b = INP(5); a.norm_g = INP(6);
            a.ly = layer; a.jg_y = 1; a.jgate = 2; a.lh = layer; a.jg_h = 2; a.jshift = 3; a.jscale = 4; a.nctx = last ? 0 : NCTX; a.ypart = (const bf16_t*)YC; a.nypart = NSPLIT_OUT; a.modf = (const float*)(ws + WS_MODF);
            ROWOP_RUN(a);
        }
        SEAM(pb + 5, pb + 6);
        for (int nrep_ = 1 + REP(10), rep_ = 0; rep_ < nrep_; ++rep_) if (EN(10) && IN(pb + 6) && ((pt_cur_ = 10), true)) {
            SITE_COORDS;
            if (rep_ == 0) { if (layer == 0) { DEFER_ADA(bx - 172, 100, 184); DEFER_SLOT(bx - 172, 84, 19840, 25888); } else if (layer == 1) { DEFER_ADA(bx - 172, 184, 268); DEFER_SLOT(bx - 172, 84, 40736, 46784); } else if (layer == 2) { DEFER_ADA(bx - 172, 368, 384); DEFER_SLOT(bx - 172, 84, 66624, 72672); } else DEFER_SLOT(bx - 128, 128, 87520, DL_END); }
            pg8::Gemm g{H, (const bf16_t*)(ws + WS_WFFIN + layer * SZ_WFFIN), Mrows, FF2, D}; pg8::StaticOrder So; So.init(Mrows, FF2, D, G, bx);
            EpiSwiglu E{HID};
            pg8::gemm_phase<EpiSwiglu, pg8::StaticOrder, PG8_ALIGN, PG8_SP2>(lds, g, So, E, tid);
        }
        SEAM(pb + 6, pb + 7);
        for (int nrep_ = 1 + REP(11), rep_ = 0; rep_ < nrep_; ++rep_) if (EN(11) && IN(pb + 7) && ((pt_cur_ = 11), true)) {
            SITE_COORDS;
            if (rep_ == 0 && !last && DEFER_CVT && G == 256) MODF_FINALIZE(layer + 1, layer + 2);
            pg8::Gemm g{HID, (const bf16_t*)(ws + WS_WFFOUT + layer * SZ_WFFOUT), MTOK, D, FFH}; pg8::MixedOrder So; So.init(S, D, FFH, G, bx, 32, last ? 0 : NSPLIT_FFO);
            EpiY E{(bf16_t*)Y, D, (bf16_t*)YC};
            pg8::gemm_phase<EpiY, pg8::MixedOrder, PG8_ALIGN, PG8_SP2>(lds, g, So, E, tid);
        }
        SEAM(pb + 7, pb + 8);
        for (int nrep_ = 1 + REP(12), rep_ = 0; rep_ < nrep_; ++rep_) if (EN(12) && IN(pb + 8) && ((pt_cur_ = 12), true)) {
            SITE_COORDS;
            RowopArgs a; a.y = (const bf16_t*)Y; a.xin_lat = X; a.xin_ctx = (const float*)((const bf16_t*)X + (size_t)S * D); a.xout_lat = last ? (float*)(GAS float*)ldptr(prm, 16) : X; a.xout_ctx = last ? nullptr : (float*)((bf16_t*)X + (size_t)S * D); a.xin16 = 1; a.xout16 = last ? 0 : 1; a.h = H; a.modacc = modacc; a.ada_b = INP(5); a.norm_g = INP(6);
            a.ly = layer; a.jg_y = 3; a.jgate = 5; a.lh = last ? -1 : layer + 1; a.jg_h = 0; a.jshift = 0; a.jscale = 1; a.nctx = last ? 0 : NCTX; a.ypart = (const bf16_t*)YC; a.nypart = NSPLIT_FFO; a.modf = (const float*)(ws + WS_MODF);
            ROWOP_RUN(a);
        }
        if (!last) SEAM(pb + 8, pb + 9);
    }
    if (PT_SITE >= 0) { if (blockIdx.x == PT_BLOCK && threadIdx.x == 0) { const float us = (float)((double)pt_acc_ * 0.01); p.out[0] = 1000.0f * IDLE_Q * floorf(us / IDLE_Q + 0.5f); } }
    if (IDLE_PROBE) {
        unsigned long long* acc = (unsigned long long*)(p.ws + WS_CTL + 32768);
        if (threadIdx.x == 0) atomicAdd(acc, idle_acc_);
        xcd_barrier(bar);
        if (blockIdx.x == 0 && threadIdx.x == 0) { const unsigned long long tot = __hip_atomic_load(acc, __ATOMIC_RELAXED, __HIP_MEMORY_SCOPE_AGENT); const float us = (float)((double)tot / (double)G_k * 0.01); p.out[0] = 1000.0f * IDLE_Q * floorf(us / IDLE_Q + 0.5f); }
    }
#undef IN
#undef SEAM
}

extern "C" void kernel_launch(void* const* d_in, const int* in_sizes, int n_in, void* d_out, int out_size, void* d_ws, size_t ws_size, hipStream_t stream) {
    static int grid = 0;
    if (grid == 0) {
        if (n_in != 16 || out_size != S * D || ws_size < WS_END) { fprintf(stderr, "kernel_launch: unexpected shapes (n_in %d out %d ws %zu need %zu)\n", n_in, out_size, ws_size, (size_t)WS_END); grid = -1; return; }
        int dev = 0, cus = 0, per_cu = 0;
        if (hipGetDevice(&dev) != hipSuccess || hipDeviceGetAttribute(&cus, hipDeviceAttributeMultiprocessorCount, dev) != hipSuccess) { grid = -1; return; }
        if (hipFuncSetAttribute((const void*)mega_fwd, hipFuncAttributeMaxDynamicSharedMemorySize, LDS_BYTES) != hipSuccess) { fprintf(stderr, "kernel_launch: hipFuncSetAttribute failed\n"); grid = -1; return; }
        if (hipOccupancyMaxActiveBlocksPerMultiprocessor(&per_cu, (const void*)mega_fwd, 512, LDS_BYTES) != hipSuccess || per_cu < 1) fprintf(stderr, "kernel_launch: occupancy query says %d\n", per_cu);
        (void)hipGetLastError();
        grid = cus;
    }
    if (grid < 0) return;
    if (hipMemsetAsync((char*)d_ws + WS_CTL, 0, CTL_ZERO_BYTES, stream) != hipSuccess) { fprintf(stderr, "kernel_launch: memset failed\n"); return; }
    Params a{};
    for (int i = 0; i < 16; ++i) a.in[i] = (const float*)d_in[i];
    a.out = (float*)d_out; a.ws = (unsigned char*)d_ws; a.pad = 0;
#if MK_MODE == 1
    a.ph_lo = 0; a.ph_hi = NPHASE; a.li = 0;
    hipLaunchKernelGGL(mega_fwd, dim3(grid), dim3(512), LDS_BYTES, stream, a);
#else
    for (int ph = 0; ph < NPHASE; ++ph) {
        if (ph >= 2) { const int layer = (ph - 2) / 9, slot = (ph - 2) % 9; if ((layer & 1) && (slot == 2 || slot == 3)) continue; }
        a.ph_lo = ph; a.ph_hi = ph + 1; a.li = 0;
        hipLaunchKernelGGL(mega_fwd, dim3(grid), dim3(512), LDS_BYTES, stream, a);
    }
#endif
    const hipError_t le = hipPeekAtLastError();
    if (le != hipSuccess) fprintf(stderr, "kernel_launch: launch failed: %s\n", hipGetErrorName(le));
}
#endif
```

```cpp
#ifndef HOST_EMU
#include <hip/hip_runtime.h>
#include <cstdio>
#include <cstdint>
#define DEV __device__ __forceinline__
#define HDEV __host__ __device__ __forceinline__
#define LAS __attribute__((address_space(3)))
#define GAS __attribute__((address_space(1)))
#endif

typedef unsigned short bf16_t;
typedef short bf16x8 __attribute__((ext_vector_type(8)));
typedef float f32x4 __attribute__((ext_vector_type(4)));
typedef float f32x2 __attribute__((ext_vector_type(2)));
typedef unsigned u32x4 __attribute__((ext_vector_type(4)));
typedef unsigned u32x2 __attribute__((ext_vector_type(2)));

#ifndef HOST_EMU
#define SCHED_FENCE() __builtin_amdgcn_sched_barrier(0)
DEV f32x4 mfma16(bf16x8 a, bf16x8 b, f32x4 c) { return __builtin_amdgcn_mfma_f32_16x16x32_bf16(a, b, c, 0, 0, 0); }
DEV float shfl_xor_f(float v, int m) { return __shfl_xor(v, m); }
DEV unsigned cvt_pk_bf16(float lo, float hi) { unsigned r; asm("v_cvt_pk_bf16_f32 %0, %1, %2" : "=v"(r) : "v"(lo), "v"(hi)); return r; }
DEV float ex2(float x) { return __builtin_amdgcn_exp2f(x); }
DEV float rcp_f(float x) { return __builtin_amdgcn_rcpf(x); }
DEV float rsq_f(float x) { return 1.0f / sqrtf(x); }
DEV void atomic_add_f(float* p, float v) { (void)__hip_atomic_fetch_add(p, v, __ATOMIC_RELAXED, __HIP_MEMORY_SCOPE_AGENT); }
#endif

namespace cfg {
constexpr int D = 2048, S = 8192, NCTX = 256, MTOK = 8448, DEPTH = 4;
constexpr int ABIN = 7168, FFH = 5632, FF2 = 11264, QKV = 6144;
constexpr int NCHUNK = 66;
constexpr float EPS = 1e-6f;
constexpr float HSCALE = 0.08838834764831845f;
constexpr float LOG2E = 1.4426950408889634f;
}
using namespace cfg;

DEV float bf_lo(unsigned w) { return __builtin_bit_cast(float, w << 16); }
DEV float bf_hi(unsigned w) { return __builtin_bit_cast(float, w & 0xffff0000u); }
DEV float wave_sum(float v) {
#pragma unroll
    for (int o = 1; o < 64; o <<= 1) v += shfl_xor_f(v, o);
    return v;
}
DEV float silu_f(float x) { return x * rcp_f(1.0f + ex2(-x * LOG2E)); }
DEV float lg2gamma(const float* decay_exp, int iab, int dir, int head) {
    const float e = decay_exp[(iab * 2 + dir) * 8 + head];
    return log1pf(-exp2f(-e)) * LOG2E;
}
DEV bf16x8 extract8(const u32x4 (&vd)[8], int mt) {
    u32x4 w;
#pragma unroll
    for (int q = 0; q < 4; ++q) {
        const unsigned X = vd[2 * q][mt >> 1], Y = vd[2 * q + 1][mt >> 1];
        w[q] = (mt & 1) ? ((X >> 16) | (Y & 0xffff0000u)) : ((X & 0xffffu) | (Y << 16));
    }
    return __builtin_bit_cast(bf16x8, w);
}

struct RowopArgs {
    const bf16_t* y;
    const float* xin_lat; const float* xin_ctx;
    float* xout_lat; float* xout_ctx;
    bf16_t* h;
    const float* modacc; const float* ada_b; const float* norm_g;
    const float* modf;
    int ly, jg_y, jgate, lh, jg_h, jshift, jscale, nctx;
    int xin16, xout16;
    const bf16_t* ypart; int nypart;
};
DEV f32x4 ld4(const float* p) { return *(const f32x4*)p; }
constexpr int MODPART = 4 * 2 * 6 * 2048;
DEV f32x4 modvec_partials(const float* modacc, const float* ada_b, int l, int s, int j, int col) {
    const float* q = modacc + (size_t)((l * 2 + s) * 6 + j) * D + col;
    f32x4 r = ld4(ada_b + (size_t)l * 6 * D + j * D + col);
#pragma unroll
    for (int kp = 0; kp < 16; ++kp) r = r + ld4(q + (size_t)kp * MODPART);
    return r;
}
DEV f32x4 modvec(const RowopArgs& a, int l, int s, int j, int col) {
    if (a.modf) return ld4(a.modf + (size_t)((l * 2 + s) * 6 + j) * D + col);
    return modvec_partials(a.modacc, a.ada_b, l, s, j, col);
}
template <class CP>
DEV void rowop_coefs(const RowopArgs& a, const int s, CP coef, const int tid) {
    const int col = 4 * tid;
    f32x4 A = (f32x4){0.f, 0.f, 0.f, 0.f}, B = A, SH = A;
    if (a.ly >= 0) A = modvec(a, a.ly, s, a.jgate, col) * ld4(a.norm_g + (size_t)(a.ly * 4 + a.jg_y) * D + col);
    if (a.lh >= 0) { B = ld4(a.norm_g + (size_t)(a.lh * 4 + a.jg_h) * D + col) * (modvec(a, a.lh, s, a.jscale, col) + 1.0f); SH = modvec(a, a.lh, s, a.jshift, col); }
    *(f32x4*)(coef + col) = A; *(f32x4*)(coef + D + col) = B; *(f32x4*)(coef + 2 * D + col) = SH;
}
template <class CP>
DEV void rowop_row(const RowopArgs& a, const int s, CP coef, const int m, f32x4 (&x)[8], const f32x4 (&y)[8], const int lane) {
    const bool hasy = a.ly >= 0, hash = a.lh >= 0;
    if (hasy) {
        float ss = 0.f;
#pragma unroll
        for (int j = 0; j < 8; ++j) ss += (y[j][0] * y[j][0] + y[j][1] * y[j][1]) + (y[j][2] * y[j][2] + y[j][3] * y[j][3]);
        const float r1 = rsq_f(wave_sum(ss) * (1.0f / D) + EPS);
#pragma unroll
        for (int j = 0; j < 8; ++j) x[j] = x[j] + *(const f32x4*)(coef + 4 * lane + 256 * j) * (y[j] * r1);
    }
    float* xb = (s == 0) ? a.xout_lat : a.xout_ctx; const size_t xrow = (size_t)((s == 0) ? m : m - S) * D;
    if (xb) {
        if (a.xout16) { bf16_t* xo = (bf16_t*)xb + xrow;
#pragma unroll
            for (int j = 0; j < 8; ++j) { u32x2 w; w[0] = cvt_pk_bf16(x[j][0], x[j][1]); w[1] = cvt_pk_bf16(x[j][2], x[j][3]); __builtin_nontemporal_store(w, (u32x2*)(xo + 4 * lane + 256 * j)); }
        } else { float* xo = xb + xrow;
#pragma unroll
            for (int j = 0; j < 8; ++j) __builtin_nontemporal_store(x[j], (f32x4*)(xo + 4 * lane + 256 * j));
        }
    }
    if (hash) {
        float ss = 0.f;
#pragma unroll
        for (int j = 0; j < 8; ++j) ss += (x[j][0] * x[j][0] + x[j][1] * x[j][1]) + (x[j][2] * x[j][2] + x[j][3] * x[j][3]);
        const float r2 = rsq_f(wave_sum(ss) * (1.0f / D) + EPS);
        bf16_t* hr = a.h + (size_t)m * D;
#pragma unroll
        for (int j = 0; j < 8; ++j) { const f32x4 v = (x[j] * r2) * *(const f32x4*)(coef + D + 4 * lane + 256 * j) + *(const f32x4*)(coef + 2 * D + 4 * lane + 256 * j);
            u32x2 w; w[0] = cvt_pk_bf16(v[0], v[1]); w[1] = cvt_pk_bf16(v[2], v[3]); *(u32x2*)(hr + 4 * lane + 256 * j) = w; }
    }
}
template <class CP>
DEV void rowop_stream(const RowopArgs& a, CP coef, const int gw, const int NGW, const int lane) {
    for (int m = gw; m < S; m += NGW) {
        f32x4 x[8], y[8];
        if (a.xin16) { const bf16_t* xr = (const bf16_t*)a.xin_lat + (size_t)m * D;
#pragma unroll
            for (int j = 0; j < 8; ++j) { const u32x2 w = __builtin_nontemporal_load((const u32x2*)(xr + 4 * lane + 256 * j)); x[j] = (f32x4){bf_lo(w[0]), bf_hi(w[0]), bf_lo(w[1]), bf_hi(w[1])}; }
        } else { const float* xr = a.xin_lat + (size_t)m * D;
#pragma unroll
            for (int j = 0; j < 8; ++j) x[j] = ld4(xr + 4 * lane + 256 * j);
        }
#pragma unroll
        for (int j = 0; j < 8; ++j) y[j] = (f32x4){0.f, 0.f, 0.f, 0.f};
        if (a.ly >= 0) { const bf16_t* yr = a.y + (size_t)m * D;
#pragma unroll
            for (int j = 0; j < 8; ++j) { const u32x2 w = __builtin_nontemporal_load((const u32x2*)(yr + 4 * lane + 256 * j)); y[j] = (f32x4){bf_lo(w[0]), bf_hi(w[0]), bf_lo(w[1]), bf_hi(w[1])}; } }
        rowop_row(a, 0, coef, m, x, y, lane);
    }
}
#ifndef HOST_EMU
template <class CP, class LP>
DEV void rowop_ctx(const RowopArgs& a, CP coef, LP red, const int vcu, const int G, const int wave, const int lane) {
    const bool hasy = a.ly >= 0, hash = a.lh >= 0;
    for (int r = vcu; r < a.nctx; r += G) {
        const int col = 256 * wave + 4 * lane;
        f32x4 x;
        if (a.xin16) { const u32x2 w = *(const u32x2*)((const bf16_t*)a.xin_ctx + (size_t)r * D + col); x = (f32x4){bf_lo(w[0]), bf_hi(w[0]), bf_lo(w[1]), bf_hi(w[1])}; }
        else x = ld4(a.xin_ctx + (size_t)r * D + col);
        if (hasy) {
            const bf16_t* yp = a.ypart + (size_t)r * D + col;
            f32x4 y = (f32x4){0.f, 0.f, 0.f, 0.f};
#pragma unroll 11
            for (int pp = 0; pp < a.nypart; ++pp) { const u32x2 w = *(const u32x2*)(yp + (size_t)pp * 256 * D); y = y + (f32x4){bf_lo(w[0]), bf_hi(w[0]), bf_lo(w[1]), bf_hi(w[1])}; }
            const float ss = wave_sum((y[0] * y[0] + y[1] * y[1]) + (y[2] * y[2] + y[3] * y[3]));
            if (lane == 0) red[wave] = ss;
            __syncthreads();
            float tot = 0.f;
#pragma unroll
            for (int w8 = 0; w8 < 8; ++w8) tot += red[w8];
            const float r1 = rsq_f(tot * (1.0f / D) + EPS);
            x = x + *(const f32x4*)(coef + col) * (y * r1);
        }
        if (a.xout_ctx) { if (a.xout16) { u32x2 w; w[0] = cvt_pk_bf16(x[0], x[1]); w[1] = cvt_pk_bf16(x[2], x[3]); *(u32x2*)((bf16_t*)a.xout_ctx + (size_t)r * D + col) = w; } else *(f32x4*)(a.xout_ctx + (size_t)r * D + col) = x; }
        if (hash) {
            const float ss = wave_sum((x[0] * x[0] + x[1] * x[1]) + (x[2] * x[2] + x[3] * x[3]));
            if (lane == 0) red[16 + wave] = ss;
            __syncthreads();
            float tot = 0.f;
#pragma unroll
            for (int w8 = 0; w8 < 8; ++w8) tot += red[16 + w8];
            const float r2 = rsq_f(tot * (1.0f / D) + EPS);
            const f32x4 v = (x * r2) * *(const f32x4*)(coef + D + col) + *(const f32x4*)(coef + 2 * D + col);
            u32x2 w; w[0] = cvt_pk_bf16(v[0], v[1]); w[1] = cvt_pk_bf16(v[2], v[3]); *(u32x2*)(a.h + (size_t)(S + r) * D + col) = w;
        }
        __syncthreads();
    }
}
#endif

DEV void conv_loadz(const bf16_t* P, int t, int c, float (&z)[8]) {
    const u32x4 cg = *(const u32x4*)(P + (size_t)t * ABIN + 1024 + c), u = *(const u32x4*)(P + (size_t)t * ABIN + 2048 + c);
#pragma unroll
    for (int e = 0; e < 4; ++e) { z[2 * e] = bf_lo(cg[e]) * bf_lo(u[e]); z[2 * e + 1] = bf_hi(cg[e]) * bf_hi(u[e]); }
}
DEV void conv_task(const bf16_t* P, bf16_t* YAB, const float* convw, int task, int lane) {
    const int half = task & 1, t0 = (task >> 1) * 8, c = half * 512 + lane * 8;
    u32x4 cgv[10], uv[10], bgv[8];
#pragma unroll
    for (int k = 0; k < 10; ++k) {
        const int t = t0 - 1 + k;
        const bool ok = !((k == 0 && (t0 == 0 || t0 == S)) || (k == 9 && (t0 + 8 == S || t0 + 8 == MTOK)));
        const int tt = ok ? t : t0;
        cgv[k] = *(const u32x4*)(P + (size_t)tt * ABIN + 1024 + c); uv[k] = *(const u32x4*)(P + (size_t)tt * ABIN + 2048 + c);
        if (!ok) { cgv[k] = (u32x4){0u, 0u, 0u, 0u}; }
    }
#pragma unroll
    for (int k = 0; k < 8; ++k) bgv[k] = *(const u32x4*)(P + (size_t)(t0 + k) * ABIN + c);
    float w0[8], w1[8], w2[8];
#pragma unroll
    for (int e = 0; e < 8; ++e) { w0[e] = convw[c + e]; w1[e] = convw[1024 + c + e]; w2[e] = convw[2048 + c + e]; }
#pragma unroll
    for (int k = 0; k < 8; ++k) {
        float o[8];
#pragma unroll
        for (int e = 0; e < 8; ++e) {
            const int d = e >> 1;
            const float zp = (e & 1) ? bf_hi(cgv[k][d]) * bf_hi(uv[k][d]) : bf_lo(cgv[k][d]) * bf_lo(uv[k][d]);
            const float zc = (e & 1) ? bf_hi(cgv[k + 1][d]) * bf_hi(uv[k + 1][d]) : bf_lo(cgv[k + 1][d]) * bf_lo(uv[k + 1][d]);
            const float zn = (e & 1) ? bf_hi(cgv[k + 2][d]) * bf_hi(uv[k + 2][d]) : bf_lo(cgv[k + 2][d]) * bf_lo(uv[k + 2][d]);
            const float b = (e & 1) ? bf_hi(bgv[k][d]) : bf_lo(bgv[k][d]);
            o[e] = b * (w0[e] * zp + w1[e] * zc + w2[e] * zn);
        }
        u32x4 w; w[0] = cvt_pk_bf16(o[0], o[1]); w[1] = cvt_pk_bf16(o[2], o[3]); w[2] = cvt_pk_bf16(o[4], o[5]); w[3] = cvt_pk_bf16(o[6], o[7]);
        *(u32x4*)(YAB + (size_t)(t0 + k) * D + c) = w;
    }
}

DEV int chunk_row(int cidx) { return cidx < 2 ? S + 128 * cidx : 128 * (cidx - 2); }
DEV void r1_task(const bf16_t* P, float* KVt, float lg2, int cidx, int head, int dir, int quad, int lane) {
    const int i = lane & 15, g = lane >> 4;
    const int dk0 = 64 * (quad >> 1), dv0 = 64 * (quad & 1);
    const bf16_t* Kp = P + (size_t)chunk_row(cidx) * ABIN + 4096 + head * 128 + dk0 + 4 * i;
    const bf16_t* Vp = P + (size_t)chunk_row(cidx) * ABIN + 5120 + head * 128 + dv0 + 4 * i;
    f32x4 acc[4][4];
#pragma unroll
    for (int a = 0; a < 4; ++a)
#pragma unroll
        for (int b = 0; b < 4; ++b) acc[a][b] = (f32x4){0.f, 0.f, 0.f, 0.f};
#pragma unroll 1
    for (int s = 0; s < 4; ++s) {
        u32x2 kd[8], vd[8]; float w[8];
#pragma unroll
        for (int jj = 0; jj < 8; ++jj) {
            const int tj = 32 * s + 8 * g + jj;
            kd[jj] = *(const u32x2*)(Kp + (size_t)tj * ABIN); vd[jj] = *(const u32x2*)(Vp + (size_t)tj * ABIN);
            w[jj] = ex2(lg2 * (float)(dir == 0 ? 127 - tj : tj));
        }
        bf16x8 af[4], bfr[4];
#pragma unroll
        for (int mt = 0; mt < 4; ++mt) {
            u32x4 wd;
#pragma unroll
            for (int q = 0; q < 4; ++q) {
                const unsigned X = kd[2 * q][mt >> 1], Y = kd[2 * q + 1][mt >> 1];
                const float lo = ((mt & 1) ? bf_hi(X) : bf_lo(X)) * w[2 * q], hi = ((mt & 1) ? bf_hi(Y) : bf_lo(Y)) * w[2 * q + 1];
                wd[q] = cvt_pk_bf16(lo, hi);
            }
            af[mt] = __builtin_bit_cast(bf16x8, wd);
        }
#pragma unroll
        for (int nt = 0; nt < 4; ++nt) {
            u32x4 wd;
#pragma unroll
            for (int q = 0; q < 4; ++q) {
                const unsigned X = vd[2 * q][nt >> 1], Y = vd[2 * q + 1][nt >> 1];
                wd[q] = (nt & 1) ? ((X >> 16) | (Y & 0xffff0000u)) : ((X & 0xffffu) | (Y << 16));
            }
            bfr[nt] = __builtin_bit_cast(bf16x8, wd);
        }
#pragma unroll
        for (int mt = 0; mt < 4; ++mt)
#pragma unroll
            for (int nt = 0; nt < 4; ++nt) acc[mt][nt] = mfma16(af[mt], bfr[nt], acc[mt][nt]);
    }
    float* out = KVt + ((((size_t)cidx * 8 + head) * 2 + dir) * 128) * 128;
#pragma unroll
    for (int nt = 0; nt < 4; ++nt)
#pragma unroll
        for (int reg = 0; reg < 4; ++reg) {
            const int dv = dv0 + 4 * i + nt, dk = dk0 + 16 * g + 4 * reg;
            *(f32x4*)(out + (size_t)dv * 128 + dk) = (f32x4){acc[0][nt][reg], acc[1][nt][reg], acc[2][nt][reg], acc[3][nt][reg]};
        }
}
DEV void r2_item(const bf16_t* KVt, bf16_t* St, const float* decay_exp, int iab, int item) {
    const int hd = __builtin_amdgcn_readfirstlane(item >> 13), e = (item & 8191) * 2, head = hd >> 1, dir = hd & 1;
    const float cd = exp2f(128.0f * lg2gamma(decay_exp, iab, dir, head));
    float s0 = 0.f, s1 = 0.f;
    unsigned kv[66];
#pragma unroll
    for (int k = 0; k < 66; ++k) { const int c = dir == 0 ? k : (k < 2 ? 1 - k : 67 - k); kv[k] = *(const unsigned*)(KVt + (((size_t)c * 8 + head) * 2 + dir) * 16384 + e); }
#pragma unroll
    for (int k = 0; k < 66; ++k) { const int c = dir == 0 ? k : (k < 2 ? 1 - k : 67 - k);
        *(unsigned*)(St + (((size_t)c * 8 + head) * 2 + dir) * 16384 + e) = cvt_pk_bf16(s0, s1);
        s0 = s0 * cd + bf_lo(kv[k]); s1 = s1 * cd + bf_hi(kv[k]); }
}
DEV void r3_task(const bf16_t* P, const bf16_t* St, bf16_t* YAB, float lg2f, float lg2b, int cidx, int head, int qb, int lane) {
    const int i = lane & 15, g = lane >> 4, qi = 16 * qb + i, rowbase = chunk_row(cidx);
    const bf16_t* Prow = P + (size_t)rowbase * ABIN;
    bf16x8 qf[4];
#pragma unroll
    for (int s = 0; s < 4; ++s) qf[s] = *(const bf16x8*)(Prow + (size_t)qi * ABIN + 3072 + head * 128 + 32 * s + 8 * g);
    f32x4 sacc[8];
#pragma unroll
    for (int mt = 0; mt < 8; ++mt) {
        f32x4 a = (f32x4){0.f, 0.f, 0.f, 0.f};
#pragma unroll
        for (int s = 0; s < 4; ++s) { const bf16x8 kf = *(const bf16x8*)(Prow + (size_t)(16 * mt + i) * ABIN + 4096 + head * 128 + 32 * s + 8 * g); a = mfma16(kf, qf[s], a); }
        sacc[mt] = a;
    }
#pragma unroll
    for (int mt = 0; mt < 8; ++mt)
#pragma unroll
        for (int reg = 0; reg < 4; ++reg) {
            const int diff = qi - (16 * mt + 4 * g + reg);
            const float d = diff > 0 ? ex2((float)diff * lg2f) : (diff < 0 ? ex2((float)(-diff) * lg2b) : 2.0f);
            sacc[mt][reg] *= d;
        }
    bf16x8 pf[4];
#pragma unroll
    for (int s = 0; s < 4; ++s) {
        u32x4 w; w[0] = cvt_pk_bf16(sacc[2 * s][0], sacc[2 * s][1]); w[1] = cvt_pk_bf16(sacc[2 * s][2], sacc[2 * s][3]);
        w[2] = cvt_pk_bf16(sacc[2 * s + 1][0], sacc[2 * s + 1][1]); w[3] = cvt_pk_bf16(sacc[2 * s + 1][2], sacc[2 * s + 1][3]);
        pf[s] = __builtin_bit_cast(bf16x8, w);
    }
    f32x4 oacc[8];
#pragma unroll
    for (int mt = 0; mt < 8; ++mt) oacc[mt] = (f32x4){0.f, 0.f, 0.f, 0.f};
#pragma unroll
    for (int s = 0; s < 4; ++s) {
        u32x4 vd[8];
#pragma unroll
        for (int jj = 0; jj < 8; ++jj) { const int key = 32 * s + (jj < 4 ? 4 * g + jj : 16 + 4 * g + jj - 4); vd[jj] = *(const u32x4*)(Prow + (size_t)key * ABIN + 5120 + head * 128 + 8 * i); }
#pragma unroll
        for (int mt = 0; mt < 8; ++mt) oacc[mt] = mfma16(extract8(vd, mt), pf[s], oacc[mt]);
    }
#pragma unroll
    for (int dir = 0; dir < 2; ++dir) {
        f32x4 tacc[8];
#pragma unroll
        for (int mt = 0; mt < 8; ++mt) tacc[mt] = (f32x4){0.f, 0.f, 0.f, 0.f};
        const bf16_t* Sp = St + ((((size_t)cidx * 8 + head) * 2 + dir) * 128) * 128;
#pragma unroll
        for (int s = 0; s < 4; ++s)
#pragma unroll
            for (int mt = 0; mt < 8; ++mt) { const bf16x8 sf = *(const bf16x8*)(Sp + (size_t)(8 * i + mt) * 128 + 32 * s + 8 * g); tacc[mt] = mfma16(sf, qf[s], tacc[mt]); }
        const float qd = dir == 0 ? ex2((float)(qi + 1) * lg2f) : ex2((float)(128 - qi) * lg2b);
#pragma unroll
        for (int mt = 0; mt < 8; ++mt) oacc[mt] = oacc[mt] + tacc[mt] * qd;
    }
    float ss = 0.f;
#pragma unroll
    for (int mt = 0; mt < 8; ++mt) ss += (oacc[mt][0] * oacc[mt][0] + oacc[mt][1] * oacc[mt][1]) + (oacc[mt][2] * oacc[mt][2] + oacc[mt][3] * oacc[mt][3]);
    ss += shfl_xor_f(ss, 16); ss += shfl_xor_f(ss, 32);
    const float rinv = rsq_f(ss * (1.0f / 128.0f) + EPS);
#pragma unroll
    for (int reg = 0; reg < 4; ++reg) {
        const int dvb = 32 * g + 8 * reg;
        const u32x4 gt = *(const u32x4*)(Prow + (size_t)qi * ABIN + 6144 + head * 128 + dvb);
        float o[8];
#pragma unroll
        for (int mt = 0; mt < 8; ++mt) { const float gv = (mt & 1) ? bf_hi(gt[mt >> 1]) : bf_lo(gt[mt >> 1]); o[mt] = silu_f(gv) * (oacc[mt][reg] * rinv); }
        u32x4 w; w[0] = cvt_pk_bf16(o[0], o[1]); w[1] = cvt_pk_bf16(o[2], o[3]); w[2] = cvt_pk_bf16(o[4], o[5]); w[3] = cvt_pk_bf16(o[6], o[7]);
        *(u32x4*)(YAB + (size_t)(rowbase + qi) * D + 1024 + head * 128 + dvb) = w;
    }
}

struct AttnTile { bf16x8 qf[4]; f32x4 oacc[8]; float m_run, l_run; };
DEV void attn_tile_init(AttnTile& t, const bf16_t* P, int qtok, int h, int g) {
#pragma unroll
    for (int s = 0; s < 4; ++s) t.qf[s] = *(const bf16x8*)(P + (size_t)qtok * QKV + h * 128 + 32 * s + 8 * g);
#pragma unroll
    for (int mt = 0; mt < 8; ++mt) t.oacc[mt] = (f32x4){0.f, 0.f, 0.f, 0.f};
    t.m_run = -5e29f; t.l_run = 0.f;
}
template <class RP>
DEV void attn_tile_step(AttnTile& t, f32x4 (&sa)[2], const u32x4 (&vd)[8], const bool win, const bool rowok, RP rpbrow, const int kc0, const int c, const int sc, const int g) {
    float bm = -1e30f;
#pragma unroll
    for (int mt = 0; mt < 2; ++mt)
#pragma unroll
        for (int reg = 0; reg < 4; ++reg) {
            float v = sa[mt][reg] * HSCALE;
            if (win) {
                const int kcol = kc0 + 16 * mt + 4 * g + reg;
                const bool valid = rowok && kcol >= sc && kcol < sc + 16;
                const float bias = rpbrow[valid ? kcol - c + 15 : 0];
                v = valid ? v + bias : -1e30f;
            }
            sa[mt][reg] = v; bm = fmaxf(bm, v);
        }
    bm = fmaxf(bm, shfl_xor_f(bm, 16)); bm = fmaxf(bm, shfl_xor_f(bm, 32));
    const float m_new = fmaxf(t.m_run, bm);
    const float alpha = ex2((t.m_run - m_new) * LOG2E);
    t.m_run = m_new;
    float ps = 0.f;
#pragma unroll
    for (int mt = 0; mt < 2; ++mt)
#pragma unroll
        for (int reg = 0; reg < 4; ++reg) { const float pv = ex2((sa[mt][reg] - m_new) * LOG2E); sa[mt][reg] = pv; ps += pv; }
    t.l_run = t.l_run * alpha + ps;
#pragma unroll
    for (int mt = 0; mt < 8; ++mt) t.oacc[mt] = t.oacc[mt] * alpha;
    u32x4 pw; pw[0] = cvt_pk_bf16(sa[0][0], sa[0][1]); pw[1] = cvt_pk_bf16(sa[0][2], sa[0][3]); pw[2] = cvt_pk_bf16(sa[1][0], sa[1][1]); pw[3] = cvt_pk_bf16(sa[1][2], sa[1][3]);
    const bf16x8 pf = __builtin_bit_cast(bf16x8, pw);
#pragma unroll
    for (int mt = 0; mt < 8; ++mt) t.oacc[mt] = mfma16(extract8(vd, mt), pf, t.oacc[mt]);
}
template <class RP>
DEV bf16x8 attn_tile_soft(AttnTile& t, f32x4 (&sa)[2], const bool win, const bool rowok, RP rpbrow, const int kc0, const int c, const int sc, const int g) {
    float bm = -1e30f;
#pragma unroll
    for (int mt = 0; mt < 2; ++mt)
#pragma unroll
        for (int reg = 0; reg < 4; ++reg) {
            float v = sa[mt][reg] * HSCALE;
            if (win) {
                const int kcol = kc0 + 16 * mt + 4 * g + reg;
                const bool valid = rowok && kcol >= sc && kcol < sc + 16;
                const float bias = rpbrow[valid ? kcol - c + 15 : 0];
                v = valid ? v + bias : -1e30f;
            }
            sa[mt][reg] = v; bm = fmaxf(bm, v);
        }
    bm = fmaxf(bm, shfl_xor_f(bm, 16)); bm = fmaxf(bm, shfl_xor_f(bm, 32));
    const float m_new = fmaxf(t.m_run, bm);
    const float alpha = ex2((t.m_run - m_new) * LOG2E);
    t.m_run = m_new;
    float ps = 0.f;
#pragma unroll
    for (int mt = 0; mt < 2; ++mt)
#pragma unroll
        for (int reg = 0; reg < 4; ++reg) { const float pv = ex2((sa[mt][reg] - m_new) * LOG2E); sa[mt][reg] = pv; ps += pv; }
    t.l_run = t.l_run * alpha + ps;
#pragma unroll
    for (int mt = 0; mt < 8; ++mt) t.oacc[mt] = t.oacc[mt] * alpha;
    u32x4 pw; pw[0] = cvt_pk_bf16(sa[0][0], sa[0][1]); pw[1] = cvt_pk_bf16(sa[0][2], sa[0][3]); pw[2] = cvt_pk_bf16(sa[1][0], sa[1][1]); pw[3] = cvt_pk_bf16(sa[1][2], sa[1][3]);
    return __builtin_bit_cast(bf16x8, pw);
}
DEV void attn_tile_store(AttnTile& t, bf16_t* YAB, int qtok, int h, int g) {
    float l = t.l_run; l += shfl_xor_f(l, 16); l += shfl_xor_f(l, 32);
    const float inv = 1.0f / l;
#pragma unroll
    for (int reg = 0; reg < 4; ++reg) {
        const int dvb = 32 * g + 8 * reg;
        u32x4 w;
#pragma unroll
        for (int q = 0; q < 4; ++q) w[q] = cvt_pk_bf16(t.oacc[2 * q][reg] * inv, t.oacc[2 * q + 1][reg] * inv);
        *(u32x4*)(YAB + (size_t)qtok * D + h * 128 + dvb) = w;
    }
}
DEV void attn_scores2(const bf16_t* P, int kb, int h, int i, int g, const AttnTile& ta, const AttnTile& tb, const bool doA, const bool doB, f32x4 (&saA)[2], f32x4 (&saB)[2], u32x4 (&vd)[8]) {
#pragma unroll
    for (int jj = 0; jj < 8; ++jj) { const int key = kb + (jj < 4 ? 4 * g + jj : 16 + 4 * g + jj - 4); vd[jj] = *(const u32x4*)(P + (size_t)key * QKV + 4096 + h * 128 + 8 * i); }
#pragma unroll
    for (int mt = 0; mt < 2; ++mt) {
        bf16x8 kf[4];
#pragma unroll
        for (int s = 0; s < 4; ++s) kf[s] = *(const bf16x8*)(P + (size_t)(kb + 16 * mt + i) * QKV + 2048 + h * 128 + 32 * s + 8 * g);
        f32x4 a = (f32x4){0.f, 0.f, 0.f, 0.f}, b = a;
        if (doA) {
#pragma unroll
            for (int s = 0; s < 4; ++s) a = mfma16(kf[s], ta.qf[s], a);
        }
        if (doB) {
#pragma unroll
            for (int s = 0; s < 4; ++s) b = mfma16(kf[s], tb.qf[s], b);
        }
        saA[mt] = a; saB[mt] = b;
        SCHED_FENCE();
    }
}
template <bool WIN>
DEV void attn_task2(const bf16_t* P, bf16_t* YAB, const float* rpb, int h, int qtokA0, int qtokB0, int rA, int c0, int kc0, int lane) {
    const int i = lane & 15, g = lane >> 4;
    AttnTile ta, tb;
    attn_tile_init(ta, P, qtokA0 + i, h, g); attn_tile_init(tb, P, qtokB0 + i, h, g);
    const int c = c0 + i, sc = c - 8 < 0 ? 0 : (c - 8 > 48 ? 48 : c - 8);
    if (WIN) {
        const int rB = rA + 1;
        const int srA = rA - 4 < 0 ? 0 : (rA - 4 > 120 ? 120 : rA - 4), srB = rB - 4 < 0 ? 0 : (rB - 4 > 120 ? 120 : rB - 4);
        for (int kr = srA; kr < srB + 8; ++kr) {
            f32x4 saA[2], saB[2]; u32x4 vd[8];
            const bool doA = kr < srA + 8, doB = kr >= srB;
            attn_scores2(P, kr * 64 + kc0, h, i, g, ta, tb, doA, doB, saA, saB, vd);
            if (doA) attn_tile_step(ta, saA, vd, true, true, rpb + (h * 15 + (kr - rA + 7)) * 31, kc0, c, sc, g);
            if (doB) attn_tile_step(tb, saB, vd, true, true, rpb + (h * 15 + (kr - rB + 7)) * 31, kc0, c, sc, g);
        }
    }
    for (int b = 0; b < 8; ++b) {
        f32x4 saA[2], saB[2]; u32x4 vd[8];
        attn_scores2(P, S + 32 * b, h, i, g, ta, tb, true, true, saA, saB, vd);
        attn_tile_step(ta, saA, vd, false, true, rpb, 0, 0, 0, g);
        attn_tile_step(tb, saB, vd, false, true, rpb, 0, 0, 0, g);
    }
    attn_tile_store(ta, YAB, qtokA0 + i, h, g); attn_tile_store(tb, YAB, qtokB0 + i, h, g);
}

struct Unit { int pm, pn, ks, nt, kofs; };
struct EpiY {
    static constexpr bool PERM = true, AFTER_DRAIN = false;
    bf16_t* Yb; int ldc; bf16_t* Cpart;
    DEV void operator()(const f32x4 (&acc)[2][2][4][2], const Unit& u, int wr, int wc, int fr, int fq) const {
        bf16_t* base = u.ks >= 0 ? Cpart + (size_t)u.ks * 256 * ldc : Yb + (size_t)u.pm * 256 * ldc;
        base += (size_t)(wr * 64 + fr) * ldc + u.pn * 256 + wc * 32 + 8 * fq;
#pragma unroll
        for (int ai = 0; ai < 2; ++ai)
#pragma unroll
            for (int m = 0; m < 4; ++m) { bf16_t* rowp = base + (size_t)(ai * 128 + m * 16) * ldc;
#pragma unroll
                for (int bj = 0; bj < 2; ++bj) { const f32x4 v0 = acc[ai][bj][m][0], v1 = acc[ai][bj][m][1];
                    u32x4 w; w[0] = cvt_pk_bf16(v0[0], v0[1]); w[1] = cvt_pk_bf16(v0[2], v0[3]); w[2] = cvt_pk_bf16(v1[0], v1[1]); w[3] = cvt_pk_bf16(v1[2], v1[3]);
                    *(u32x4*)(rowp + bj * 128) = w; } }
    }
};
struct EpiBf16 {
    static constexpr bool PERM = true, AFTER_DRAIN = false;
    bf16_t* O; int ldc;
    DEV void operator()(const f32x4 (&acc)[2][2][4][2], const Unit& u, int wr, int wc, int fr, int fq) const {
        const int row0 = u.pm * 256 + wr * 64 + fr, col0 = u.pn * 256 + wc * 32 + 8 * fq;
#pragma unroll
        for (int ai = 0; ai < 2; ++ai)
#pragma unroll
            for (int m = 0; m < 4; ++m) { bf16_t* rowp = O + (size_t)(row0 + ai * 128 + m * 16) * ldc + col0;
#pragma unroll
                for (int bj = 0; bj < 2; ++bj) { const f32x4 v0 = acc[ai][bj][m][0], v1 = acc[ai][bj][m][1];
                    u32x4 w; w[0] = cvt_pk_bf16(v0[0], v0[1]); w[1] = cvt_pk_bf16(v0[2], v0[3]); w[2] = cvt_pk_bf16(v1[0], v1[1]); w[3] = cvt_pk_bf16(v1[2], v1[3]);
                    *(u32x4*)(rowp + bj * 128) = w; } }
    }
};
struct EpiInProj {
    static constexpr bool PERM = true, AFTER_DRAIN = false;
    bf16_t* O; const f32x2* rope;
    DEV void operator()(const f32x4 (&acc)[2][2][4][2], const Unit& u, int wr, int wc, int fr, int fq) const {
        const int row0 = u.pm * 256 + wr * 64 + fr, col0 = u.pn * 256 + wc * 32 + 8 * fq;
        const bool isk = u.pn >= 16 && u.pn < 20, isq = u.pn >= 12 && u.pn < 16, dorope = (isq || isk) && u.pm < 32;
        const float sc = isk ? HSCALE : 1.0f;
#pragma unroll
        for (int ai = 0; ai < 2; ++ai)
#pragma unroll
            for (int m = 0; m < 4; ++m) { const int row = row0 + ai * 128 + m * 16; bf16_t* rowp = O + (size_t)row * ABIN + col0;
                f32x4 cs01 = (f32x4){1.f, 0.f, 1.f, 0.f}, cs23 = cs01, cs45 = cs01, cs67 = cs01;
                if (dorope) { const int pidx = (wc < 2) ? (row >> 6) : 128 + (row & 63); const f32x2* tp = rope + pidx * 32 + 16 * (wc & 1) + 4 * fq;
                    const f32x4 t0 = *(const f32x4*)tp, t1 = *(const f32x4*)(tp + 2); cs01 = t0; cs23 = t0; cs45 = t1; cs67 = t1; }
#pragma unroll
                for (int bj = 0; bj < 2; ++bj) { f32x4 v0 = acc[ai][bj][m][0], v1 = acc[ai][bj][m][1];
                    if (dorope) {
                        const f32x4 a0 = v0, a1 = v1;
                        v0[0] = a0[0] * cs01[0] - a0[1] * cs01[1]; v0[1] = a0[0] * cs01[1] + a0[1] * cs01[0];
                        v0[2] = a0[2] * cs23[2] - a0[3] * cs23[3]; v0[3] = a0[2] * cs23[3] + a0[3] * cs23[2];
                        v1[0] = a1[0] * cs45[0] - a1[1] * cs45[1]; v1[1] = a1[0] * cs45[1] + a1[1] * cs45[0];
                        v1[2] = a1[2] * cs67[2] - a1[3] * cs67[3]; v1[3] = a1[2] * cs67[3] + a1[3] * cs67[2];
                    }
                    v0 = v0 * sc; v1 = v1 * sc;
                    u32x4 w; w[0] = cvt_pk_bf16(v0[0], v0[1]); w[1] = cvt_pk_bf16(v0[2], v0[3]); w[2] = cvt_pk_bf16(v1[0], v1[1]); w[3] = cvt_pk_bf16(v1[2], v1[3]);
                    *(u32x4*)(rowp + bj * 128) = w; } }
    }
};
struct EpiSwiglu {
    static constexpr bool PERM = true, AFTER_DRAIN = false;
    bf16_t* O;
    DEV void operator()(const f32x4 (&acc)[2][2][4][2], const Unit& u, int wr, int wc, int fr, int fq) const {
        const int row0 = u.pm * 256 + wr * 64 + fr, col0 = u.pn * 128 + wc * 32 + 8 * fq;
#pragma unroll
        for (int ai = 0; ai < 2; ++ai)
#pragma unroll
            for (int m = 0; m < 4; ++m) { bf16_t* rowp = O + (size_t)(row0 + ai * 128 + m * 16) * FFH + col0;
                const f32x4 g0 = acc[ai][0][m][0], g1 = acc[ai][0][m][1], u0 = acc[ai][1][m][0], u1 = acc[ai][1][m][1];
                u32x4 w; w[0] = cvt_pk_bf16(silu_f(g0[0]) * u0[0], silu_f(g0[1]) * u0[1]); w[1] = cvt_pk_bf16(silu_f(g0[2]) * u0[2], silu_f(g0[3]) * u0[3]);
                w[2] = cvt_pk_bf16(silu_f(g1[0]) * u1[0], silu_f(g1[1]) * u1[1]); w[3] = cvt_pk_bf16(silu_f(g1[2]) * u1[2], silu_f(g1[3]) * u1[3]);
                *(u32x4*)rowp = w; }
    }
};

#ifndef HOST_EMU
namespace pg8 {
#define PG8_LAS __attribute__((address_space(3)))
constexpr int BM = 256, BK = 64, HALF = 128, HTB = HALF * BK * 2, STAGE_BYTES = 8 * HTB, NXCD = 8, WGM = 8;
__host__ __device__ __forceinline__ int lds_byte(int r, int c) { const int st = (r >> 4) * 2 + (c >> 5), rr = r & 15, cc = c & 31, ob = rr * 64 + cc * 2; return st * 1024 + (ob ^ (((ob >> 9) & 1) << 5)); }
__host__ __device__ __forceinline__ void stage_rc(int b, int& R, int& C) { const int st = b / 1024, sb = b % 1024, swz = sb ^ (((sb >> 9) & 1) << 5); R = (st >> 1) * 16 + swz / 64; C = (st & 1) * 32 + (swz % 64) / 2; }
__host__ __device__ __forceinline__ int perm32(int rho) { const int n = rho >> 4, i = rho & 15; return 8 * (i >> 2) + 4 * n + (i & 3); }
struct Gemm { const bf16_t* A; const bf16_t* Bt; int M, N, K; };
struct StaticOrder {
    int nM, nN, nwg, G, c, ntK;
    __host__ __device__ __forceinline__ void init(int M, int N, int K, int G_, int c_) { nM = M / BM; nN = N / BM; nwg = nM * nN; G = G_; c = c_; ntK = K / BK; }
    __host__ __device__ __forceinline__ void map(int wgid, Unit& u) const {
        { const int q = nwg / NXCD, r = nwg % NXCD, xcd = wgid % NXCD, off = wgid / NXCD; wgid = (xcd < r ? xcd * (q + 1) : r * (q + 1) + (xcd - r) * q) + off; }
        const int nig = WGM * nN, gid = wgid / nig, fm = gid * WGM, gsz = (nM - fm) < WGM ? (nM - fm) : WGM;
        u.pm = fm + ((wgid % nig) % gsz); u.pn = (wgid % nig) / gsz; u.ks = -1; u.nt = ntK; u.kofs = 0;
    }
    __host__ __device__ __forceinline__ bool next(int i, Unit& u) const { const long L = (long)i * G + c; if (L >= nwg) return false; map((int)L, u); return true; }
    __device__ __forceinline__ void a_ready(const Unit&) const {}
    __device__ __forceinline__ void done(const Unit&) const {}
};
struct MixedOrder {
    StaticOrder base; int nsplit, pmx, ntS, nNx;
    __host__ __device__ __forceinline__ void init(int M, int N, int K, int G_, int c_, int pmx_, int nsplit_) { base.init(M, N, K, G_, c_); pmx = pmx_; nsplit = nsplit_; ntS = nsplit_ ? (K / BK) / nsplit_ : 0; nNx = N / BM; }
    __host__ __device__ __forceinline__ bool next(int i, Unit& u) const {
        const long L = (long)i * base.G + base.c;
        if (L < base.nwg) { base.map((int)L, u); return true; }
        const long L2 = L - base.nwg; if (L2 >= (long)nsplit * nNx) return false;
        u.pm = pmx; u.pn = (int)(L2 % nNx); u.ks = (int)(L2 / nNx); u.nt = ntS; u.kofs = u.ks * ntS * BK * 2; return true;
    }
    __device__ __forceinline__ void a_ready(const Unit&) const {}
    __device__ __forceinline__ void done(const Unit&) const {}
};
template <class Epi, class Sched, bool ALIGN_EPI = false, bool SP2 = false>
__device__ __forceinline__ void gemm_phase(PG8_LAS unsigned char* lds, const Gemm g, const Sched& S, const Epi& E, const int tid) {
    const int wid = __builtin_amdgcn_readfirstlane(tid >> 6), lane = tid & 63, wr = wid >> 2, wc = wid & 3, fr = lane & 15, fq = lane >> 4;
    const int K = g.K;
    unsigned voffA[2], voffB[2];
#pragma unroll
    for (int i = 0; i < 2; ++i) { int R, C; stage_rc(tid * 16 + i * 8192, R, C); const int Rb = Epi::PERM ? ((R & ~31) + perm32(R & 31)) : R;
        voffA[i] = (unsigned)(R * K + C) * 2u; voffB[i] = (unsigned)(Rb * K + C) * 2u; }
    const size_t kstep = (size_t)(BK * 2);
    const size_t hstep = (size_t)HALF * K * 2;
    const size_t tstep = 2 * hstep;
    const unsigned ldsw = (unsigned)wid * 1024u;
    const int aoff = lds_byte(wr * 64 + fr, fq * 8), boff = lds_byte(wc * 32 + fr, fq * 8);
#define PG8_SA(b, h) (((b) * 2 + (h)) * HTB)
#define PG8_SB(b, h) ((4 + (b) * 2 + (h)) * HTB)
#define PG8_STAGE(bufoff, gbase, voff) do { _Pragma("unroll") for (int _i = 0; _i < 2; ++_i) \
        __builtin_amdgcn_global_load_lds((const unsigned*)((const char*)(gbase) + (voff)[_i]), (PG8_LAS unsigned*)(lds + (bufoff) + ldsw + _i * 8192), 16, 0, 0); } while (0)
#define PG8_LDA(dst, b, h) do { _Pragma("unroll") for (int m = 0; m < 4; ++m) _Pragma("unroll") for (int k = 0; k < 2; ++k) dst[m][k] = *(const PG8_LAS bf16x8*)(lds + PG8_SA(b, h) + aoff + m * 2048 + k * 1024); } while (0)
#define PG8_LDB(dst, b, h) do { _Pragma("unroll") for (int n = 0; n < 2; ++n) _Pragma("unroll") for (int k = 0; k < 2; ++k) dst[n][k] = *(const PG8_LAS bf16x8*)(lds + PG8_SB(b, h) + boff + n * 2048 + k * 1024); } while (0)
#define PG8_MMA(ai, bj, At, Bt) do { __builtin_amdgcn_s_setprio(1); _Pragma("unroll") for (int m = 0; m < 4; ++m) _Pragma("unroll") for (int n = 0; n < 2; ++n) _Pragma("unroll") for (int k = 0; k < 2; ++k) \
        acc[ai][bj][m][n] = __builtin_amdgcn_mfma_f32_16x16x32_bf16(Bt[n][k], At[m][k], acc[ai][bj][m][n], 0, 0, 0); __builtin_amdgcn_s_setprio(0); } while (0)
#define PG8_WAIT_V(n) asm volatile("s_waitcnt vmcnt(" #n ")" ::: "memory")
#define PG8_WAIT_L(n) asm volatile("s_waitcnt lgkmcnt(" #n ")" ::: "memory")
#define PG8_BAR __builtin_amdgcn_s_barrier()
#define PG8_SCHED __builtin_amdgcn_sched_barrier(0)
    Unit cur, nxt; int ui = 0;
    if (!S.next(0, cur)) return;
    f32x4 acc[2][2][4][2];
#pragma unroll
    for (int a = 0; a < 2; ++a)
#pragma unroll
        for (int b = 0; b < 2; ++b)
#pragma unroll
            for (int m = 0; m < 4; ++m)
#pragma unroll
                for (int n = 0; n < 2; ++n) acc[a][b][m][n] = (f32x4){0.f, 0.f, 0.f, 0.f};
    bf16x8 At[4][2], B0[2][2], B1[2][2];
    const char* cA = (const char*)g.A + (size_t)cur.pm * tstep + cur.kofs; const char* cB = (const char*)g.Bt + (size_t)cur.pn * tstep + cur.kofs;
    S.a_ready(cur);
    if constexpr (SP2) {
        PG8_STAGE(PG8_SB(0, 0), cB, voffB); PG8_STAGE(PG8_SB(0, 1), cB + hstep, voffB); PG8_STAGE(PG8_SA(0, 0), cA, voffA); PG8_STAGE(PG8_SA(0, 1), cA + hstep, voffA);
        if (wr == 1) PG8_BAR;
        PG8_WAIT_V(2); PG8_BAR;
        PG8_STAGE(PG8_SB(1, 0), cB + kstep, voffB); PG8_STAGE(PG8_SA(1, 0), cA + kstep, voffA); PG8_STAGE(PG8_SB(1, 1), cB + hstep + kstep, voffB);
        PG8_WAIT_V(6); PG8_BAR;
    } else {
        PG8_STAGE(PG8_SB(0, 0), cB, voffB); PG8_STAGE(PG8_SA(0, 0), cA, voffA); PG8_STAGE(PG8_SB(0, 1), cB + hstep, voffB); PG8_STAGE(PG8_SA(0, 1), cA + hstep, voffA);
        if (wr == 1) PG8_BAR;
        PG8_WAIT_V(4); PG8_BAR;
        PG8_STAGE(PG8_SB(1, 0), cB + kstep, voffB); PG8_STAGE(PG8_SA(1, 0), cA + kstep, voffA); PG8_STAGE(PG8_SB(1, 1), cB + hstep + kstep, voffB);
        PG8_WAIT_V(6); PG8_BAR;
    }
    for (;;) {
        const bool has_next = S.next(ui + 1, nxt);
        const char* nA = has_next ? (const char*)g.A + (size_t)nxt.pm * tstep + nxt.kofs : cA; const char* nB = has_next ? (const char*)g.Bt + (size_t)nxt.pn * tstep + nxt.kofs : cB;
        const int nt = cur.nt;
        for (int t = 0; t < nt; t += 2) {
            const bool last = (t == nt - 2);
            const char* a1 = cA + (size_t)(t + 1) * kstep;
            const char* a2 = last ? nA : cA + (size_t)(t + 2) * kstep; const char* b2 = last ? nB : cB + (size_t)(t + 2) * kstep;
            const char* a3 = a2 + kstep; const char* b3 = b2 + kstep;
            if (last && has_next) S.a_ready(nxt);
            if constexpr (SP2) {
            PG8_LDB(B0, 0, 0); PG8_LDB(B1, 0, 1); PG8_SCHED; PG8_LDA(At, 0, 0); PG8_STAGE(PG8_SA(1, 1), a1 + hstep, voffA);
            PG8_WAIT_V(8); PG8_WAIT_L(0); PG8_BAR; PG8_MMA(0, 0, At, B0); PG8_MMA(0, 1, At, B1); PG8_BAR; PG8_SCHED;
            PG8_LDA(At, 0, 1); PG8_STAGE(PG8_SB(0, 0), b2, voffB); PG8_STAGE(PG8_SB(0, 1), b2 + hstep, voffB); PG8_STAGE(PG8_SA(0, 0), a2, voffA);
            PG8_WAIT_V(8); PG8_WAIT_L(0); PG8_BAR; PG8_MMA(1, 0, At, B0); PG8_MMA(1, 1, At, B1); PG8_BAR; PG8_SCHED;
            PG8_LDB(B0, 1, 0); PG8_LDB(B1, 1, 1); PG8_SCHED; PG8_LDA(At, 1, 0); PG8_STAGE(PG8_SA(0, 1), a2 + hstep, voffA);
            PG8_WAIT_V(8); PG8_WAIT_L(0); PG8_BAR; PG8_MMA(0, 0, At, B0); PG8_MMA(0, 1, At, B1); PG8_BAR; PG8_SCHED;
            PG8_LDA(At, 1, 1); PG8_STAGE(PG8_SB(1, 0), b3, voffB); PG8_STAGE(PG8_SB(1, 1), b3 + hstep, voffB); PG8_STAGE(PG8_SA(1, 0), a3, voffA);
            PG8_WAIT_V(8); PG8_WAIT_L(0); PG8_BAR; PG8_MMA(1, 0, At, B0); PG8_MMA(1, 1, At, B1); PG8_BAR; PG8_SCHED;
            } else {
            PG8_LDB(B0, 0, 0); PG8_SCHED; PG8_LDA(At, 0, 0); PG8_STAGE(PG8_SA(1, 1), a1 + hstep, voffA);
            PG8_WAIT_L(8); PG8_BAR; PG8_WAIT_L(0); PG8_MMA(0, 0, At, B0); PG8_BAR; PG8_SCHED;
            PG8_LDB(B1, 0, 1); PG8_STAGE(PG8_SB(0, 0), b2, voffB);
            PG8_BAR; PG8_WAIT_L(0); PG8_MMA(0, 1, At, B1); PG8_BAR;
            PG8_LDA(At, 0, 1); PG8_STAGE(PG8_SA(0, 0), a2, voffA);
            PG8_BAR; PG8_WAIT_L(0); PG8_MMA(1, 0, At, B0); PG8_BAR; PG8_SCHED;
            PG8_STAGE(PG8_SB(0, 1), b2 + hstep, voffB);
            PG8_WAIT_V(6); PG8_BAR; PG8_MMA(1, 1, At, B1); PG8_BAR;
            PG8_LDB(B0, 1, 0); PG8_SCHED; PG8_LDA(At, 1, 0); PG8_STAGE(PG8_SA(0, 1), a2 + hstep, voffA);
            PG8_WAIT_L(8); PG8_BAR; PG8_WAIT_L(0); PG8_MMA(0, 0, At, B0); PG8_BAR; PG8_SCHED;
            PG8_LDB(B1, 1, 1); PG8_STAGE(PG8_SB(1, 0), b3, voffB);
            PG8_BAR; PG8_WAIT_L(0); PG8_MMA(0, 1, At, B1); PG8_BAR;
            PG8_LDA(At, 1, 1); PG8_STAGE(PG8_SA(1, 0), a3, voffA);
            PG8_BAR; PG8_WAIT_L(0); PG8_MMA(1, 0, At, B0); PG8_BAR; PG8_SCHED;
            PG8_STAGE(PG8_SB(1, 1), b3 + hstep, voffB);
            PG8_WAIT_V(6); PG8_BAR; PG8_MMA(1, 1, At, B1); PG8_BAR;
            }
        }
        if constexpr (ALIGN_EPI) { if (wr == 0) PG8_BAR; }
        if constexpr (!Epi::AFTER_DRAIN) { E(acc, cur, wr, wc, fr, fq); S.done(cur); }
        if (!has_next) break;
#pragma unroll
        for (int a = 0; a < 2; ++a)
#pragma unroll
            for (int b = 0; b < 2; ++b)
#pragma unroll
                for (int m = 0; m < 4; ++m)
#pragma unroll
                    for (int n = 0; n < 2; ++n) acc[a][b][m][n] = (f32x4){0.f, 0.f, 0.f, 0.f};
        cur = nxt; cA = nA; cB = nB; ++ui;
        if constexpr (ALIGN_EPI) { if (wr == 1) PG8_BAR; }
    }
    PG8_WAIT_V(0);
    if constexpr (!ALIGN_EPI) { if (wr == 0) PG8_BAR; }
    PG8_BAR;
#undef PG8_SA
#undef PG8_SB
#undef PG8_STAGE
#undef PG8_LDA
#undef PG8_LDB
#undef PG8_MMA
#undef PG8_WAIT_V
#undef PG8_WAIT_L
#undef PG8_BAR
#undef PG8_SCHED
}
}
#ifndef PG8_SP2
#define PG8_SP2 true
#endif
#ifndef PG8_ALIGN
#define PG8_ALIGN true
#endif

#define XB_TMO      128
#define XB_XCNT(j)  (256  + 64 * (j))
#define XB_XSUB(j)  (1280 + 64 * (j))
#define XB_XGEN(j)  (2304 + 64 * (j))
#define XB_TOP      3328
#define XB_TOPGEN   3392
#define XCD_BAR_WORDS 3456
#define XB_SPIN_CAP (1u << 18)
__device__ __forceinline__ unsigned xb_ld(unsigned* p)              { return __hip_atomic_load(p, __ATOMIC_RELAXED, __HIP_MEMORY_SCOPE_AGENT); }
__device__ __forceinline__ unsigned xb_add(unsigned* p, unsigned v) { return __hip_atomic_fetch_add(p, v, __ATOMIC_RELAXED, __HIP_MEMORY_SCOPE_AGENT); }
__device__ __forceinline__ unsigned xb_xcc_id() { return (unsigned)__builtin_amdgcn_s_getreg((3 << 11) | 20) & 0xFu; }
#define XB_SPIN(cond, bar) do { unsigned _sp = 0; while (cond) { __builtin_amdgcn_s_sleep(1); \
    if ((++_sp & 255u) == 0u) { if (xb_ld(&(bar)[XB_TMO])) break; if (_sp > XB_SPIN_CAP) { atomicAdd(&(bar)[XB_TMO], 1u); break; } } } } while (0)
struct XcdBarrier { unsigned* bar; unsigned x; volatile LAS unsigned* st; };
__device__ __forceinline__ XcdBarrier xcd_barrier_post(unsigned* bar, volatile LAS unsigned* st) {
    XcdBarrier b; b.bar = bar; b.x = xb_xcc_id(); b.st = st;
    if (threadIdx.x == 0) (void)xb_add(&bar[XB_XCNT(b.x)], 1u);
    return b;
}
__device__ __forceinline__ void xcd_barrier_complete(unsigned* bar, unsigned x, unsigned& nloc, unsigned& nx) {
    const unsigned G = gridDim.x * gridDim.y * gridDim.z;
    unsigned sum, cnt, mine, sp = 0u;
    for (;;) {
        sum = 0u; cnt = 0u; mine = 0u;
#pragma unroll
        for (unsigned j = 0; j < 16; ++j) { const unsigned c = xb_ld(&bar[XB_XCNT(j)]); sum += c; cnt += (c > 0u) ? 1u : 0u; mine = (j == x) ? c : mine; }
        if (sum == G) break;
        __builtin_amdgcn_s_sleep(1);
        if ((++sp & 255u) == 0u) { if (xb_ld(&bar[XB_TMO])) break; if (sp > XB_SPIN_CAP) { atomicAdd(&bar[XB_TMO], 1u); break; } }
    }
    nloc = mine > 0u ? mine : 1u; nx = cnt > 0u ? cnt : 1u;
}
__device__ __forceinline__ void xcd_barrier(const XcdBarrier& b) {
    asm volatile("s_waitcnt vmcnt(0)" ::: "memory");
    __syncthreads();
    if (threadIdx.x == 0) {
        unsigned* bar = b.bar;
        __builtin_amdgcn_s_waitcnt(0);
        unsigned nloc = b.st[0], nx = b.st[1];
        if (nloc == 0u) { xcd_barrier_complete(bar, b.x, nloc, nx); b.st[0] = nloc; b.st[1] = nx; }
        const unsigned old = xb_add(&bar[XB_XSUB(b.x)], 1u);
        const unsigned gen = old / nloc;
        if (old + 1u == (gen + 1u) * nloc) {
            __builtin_amdgcn_fence(__ATOMIC_RELEASE, "agent");
            asm volatile("s_waitcnt vmcnt(0)" ::: "memory");
            const unsigned og = xb_add(&bar[XB_TOP], 1u);
            const unsigned tg = og / nx;
            if (og + 1u == (tg + 1u) * nx) xb_add(&bar[XB_TOPGEN], 1u);
            else XB_SPIN(xb_ld(&bar[XB_TOPGEN]) == tg, bar);
            __builtin_amdgcn_fence(__ATOMIC_ACQUIRE, "agent");
            xb_add(&bar[XB_XGEN(b.x)], 1u);
            asm volatile("s_waitcnt vmcnt(0)" ::: "memory");
        } else {
            XB_SPIN(xb_ld(&bar[XB_XGEN(b.x)]) == gen, bar);
            __builtin_amdgcn_fence(__ATOMIC_ACQUIRE, "agent");
            asm volatile("s_waitcnt vmcnt(0)" ::: "memory");
        }
    }
    __syncthreads();
}

constexpr size_t al256(size_t x) { return (x + 255) & ~(size_t)255; }
constexpr size_t WS_CTL = 0;
constexpr size_t CTL_ZERO_BYTES = 65536;
constexpr size_t WS_MODACC = 2u << 20;
constexpr size_t WS_MODF = (1u << 20) + (512u << 10);
constexpr size_t WS_ROPE = 1u << 20;
constexpr size_t WS_WABIN = 8u << 20;
constexpr size_t SZ_WABIN = (size_t)ABIN * D * 2;
constexpr size_t WS_WABOUT = WS_WABIN + 2 * SZ_WABIN;
constexpr size_t SZ_WSQ = (size_t)D * D * 2;
constexpr size_t WS_WQKV = WS_WABOUT + 2 * SZ_WSQ;
constexpr size_t SZ_WQKV = (size_t)QKV * D * 2;
constexpr size_t WS_WNAOUT = WS_WQKV + 2 * SZ_WQKV;
constexpr size_t WS_WFFIN = WS_WNAOUT + 2 * SZ_WSQ;
constexpr size_t SZ_WFFIN = (size_t)FF2 * D * 2;
constexpr size_t WS_WFFOUT = WS_WFFIN + 4 * SZ_WFFIN;
constexpr size_t SZ_WFFOUT = (size_t)D * FFH * 2;
constexpr size_t WS_X = WS_WFFOUT + 4 * SZ_WFFOUT;
constexpr size_t WS_H = WS_X + (size_t)MTOK * D * 4;
constexpr size_t WS_P = WS_H + (size_t)MTOK * D * 2;
constexpr size_t WS_YAB = WS_P + (size_t)MTOK * ABIN * 2;
constexpr size_t WS_Y = WS_YAB + (size_t)MTOK * D * 2;
constexpr size_t WS_HID = WS_Y + (size_t)MTOK * D * 4;
constexpr size_t WS_KVT = WS_HID + (size_t)MTOK * FFH * 2;
constexpr size_t WS_ST = WS_KVT + (size_t)NCHUNK * 16 * 16384 * 4;
constexpr size_t WS_YC = WS_ST + (size_t)NCHUNK * 16 * 16384 * 2;
constexpr size_t WS_END = WS_YC + (size_t)22 * 256 * D * 4;
constexpr int NSPLIT_OUT = 8, NSPLIT_FFO = 22;
static_assert(WS_WABIN % 256 == 0 && WS_X % 256 == 0 && WS_P % 256 == 0 && WS_KVT % 256 == 0 && WS_ST % 256 == 0, "ws alignment");

constexpr int RING_BYTES = 131072, LDSCTL_OFF = RING_BYTES, MISC_OFF = LDSCTL_OFF + 320, PRM_OFF = LDSCTL_OFF + 1024, LDS_BYTES = 147456;
constexpr int NPHASE = 2 + 9 * DEPTH;

struct Params { const float* in[16]; float* out; unsigned char* ws; int ph_lo, ph_hi, li, pad; };

__device__ __forceinline__ void transpose_item(const float* W, int ldw, int K, bf16_t* Wt, int k0, int n0s, int n0d, LAS float* scr, int lane) {
    const int r = lane >> 3, c4 = (lane & 7) * 4;
    f32x4 v[8];
#pragma unroll
    for (int i = 0; i < 8; ++i) v[i] = __builtin_nontemporal_load((const f32x4*)(W + (size_t)(k0 + 8 * i + r) * ldw + n0s + c4));
#pragma unroll
    for (int i = 0; i < 8; ++i) { LAS float* d = scr + (8 * i + r) * 33 + c4; d[0] = v[i][0]; d[1] = v[i][1]; d[2] = v[i][2]; d[3] = v[i][3]; }
    asm volatile("s_waitcnt lgkmcnt(0)" ::: "memory");
    const int c = lane & 7;
#pragma unroll
    for (int j = 0; j < 4; ++j) { const int n = (lane >> 3) + 8 * j; const LAS float* s = scr + (8 * c) * 33 + n;
        u32x4 o; o[0] = cvt_pk_bf16(s[0 * 33], s[1 * 33]); o[1] = cvt_pk_bf16(s[2 * 33], s[3 * 33]); o[2] = cvt_pk_bf16(s[4 * 33], s[5 * 33]); o[3] = cvt_pk_bf16(s[6 * 33], s[7 * 33]);
        *(u32x4*)(Wt + (size_t)(n0d + n) * K + k0 + 8 * c) = o; }
    asm volatile("s_waitcnt lgkmcnt(0)" ::: "memory");
}
__device__ __forceinline__ void transpose_matrix_item(const float* W, int K, int N, bf16_t* Wt, bool ffperm, int item, LAS float* scr, int lane) {
    const int nblk = N / 32, kb = item / nblk, nb = item % nblk, n0d = 32 * nb;
    int n0s = n0d;
    if (ffperm) { const int t = n0d >> 8, j = n0d & 255; n0s = j < 128 ? 128 * t + j : FFH + 128 * t + (j - 128); }
    transpose_item(W, N, K, Wt, 64 * kb, n0s, n0d, scr, lane);
}

constexpr int I_ABIN = (D / 64) * (ABIN / 32), I_SQ = (D / 64) * (D / 32), I_QKV = (D / 64) * (QKV / 32), I_FFIN = (D / 64) * (FF2 / 32), I_FFOUT = (FFH / 64) * (D / 32);
__device__ __forceinline__ unsigned long long ldptr(LAS const unsigned* prm, int k) {
    const unsigned lo = prm[2 * k], hi = prm[2 * k + 1];
    return ((unsigned long long)(unsigned)__builtin_amdgcn_readfirstlane((int)hi) << 32) | (unsigned)__builtin_amdgcn_readfirstlane((int)lo);
}
__device__ __forceinline__ void cvt_mat(LAS const unsigned* prm, int type, int inst, int idx, LAS float* scr, int lane) {
    const int kin = type == 0 ? 7 : (type == 1 ? 10 : (type == 2 ? 11 : (type == 3 ? 13 : (type == 4 ? 14 : 15))));
    const int K = type == 5 ? FFH : D;
    const int N = type == 0 ? ABIN : (type == 2 ? QKV : (type == 4 ? FF2 : D));
    const size_t woff = type == 0 ? WS_WABIN : (type == 1 ? WS_WABOUT : (type == 2 ? WS_WQKV : (type == 3 ? WS_WNAOUT : (type == 4 ? WS_WFFIN : WS_WFFOUT))));
    const size_t wsz = type == 0 ? SZ_WABIN : (type == 2 ? SZ_WQKV : (type == 4 ? SZ_WFFIN : (type == 5 ? SZ_WFFOUT : SZ_WSQ)));
    const float* src = (const float*)(GAS const float*)ldptr(prm, kin) + (size_t)inst * K * N;
    unsigned char* ws = (unsigned char*)(GAS unsigned char*)ldptr(prm, 17);
    transpose_matrix_item(src, K, N, (bf16_t*)(ws + woff + inst * wsz), type == 4, idx, scr, lane);
}
constexpr int L0_ITEMS = I_ABIN + I_FFOUT;
__device__ __forceinline__ void cvt_l0_item(LAS const unsigned* p, int r, LAS float* scr, int lane) {
    int type, base;
    if (r < I_ABIN) { type = 0; base = 0; } else { type = 5; base = I_ABIN; }
    cvt_mat(p, type, 0, r - base, scr, lane);
}
constexpr int DLA = I_SQ, DL0 = DLA + I_FFIN, DL1 = DL0 + I_QKV, DL2 = DL1 + I_SQ, DL3 = DL2 + I_FFIN, DL4 = DL3 + I_FFOUT, DL5 = DL4 + I_ABIN, DL6 = DL5 + I_SQ, DL7 = DL6 + I_FFIN, DL8 = DL7 + I_FFOUT,
              DL9 = DL8 + I_QKV, DL10 = DL9 + I_SQ, DL11 = DL10 + I_FFIN, DL_END = DL11 + I_FFOUT;
static_assert(DL_END == 89600 && L0_ITEMS == 12800, "deferred list");
__device__ __forceinline__ void cvt_dl_item(LAS const unsigned* p, int gi, LAS float* scr, int lane) {
    int type, inst, base;
    if (gi < DL0) { if (gi < DLA) { type = 1; inst = 0; base = 0; } else { type = 4; inst = 0; base = DLA; } }
    else if (gi < DL4) { if (gi < DL2) { if (gi < DL1) { type = 2; inst = 0; base = DL0; } else { type = 3; inst = 0; base = DL1; } } else { if (gi < DL3) { type = 4; inst = 1; base = DL2; } else { type = 5; inst = 1; base = DL3; } } }
    else if (gi < DL8) { if (gi < DL6) { if (gi < DL5) { type = 0; inst = 1; base = DL4; } else { type = 1; inst = 1; base = DL5; } } else { if (gi < DL7) { type = 4; inst = 2; base = DL6; } else { type = 5; inst = 2; base = DL7; } } }
    else { if (gi < DL10) { if (gi < DL9) { type = 2; inst = 1; base = DL8; } else { type = 3; inst = 1; base = DL9; } } else { if (gi < DL11) { type = 4; inst = 3; base = DL10; } else { type = 5; inst = 3; base = DL11; } } }
    cvt_mat(p, type, inst, gi - base, scr, lane);
}
__device__ __forceinline__ void ada_item(LAS const unsigned* prm, int l, int nc, int kp, int tid) {
    if (tid < 384) {
        const int n = nc * 1536 + 4 * tid;
        f32x4 aL = (f32x4){0.f, 0.f, 0.f, 0.f}, aC = aL;
        const float* wp = (const float*)(GAS const float*)ldptr(prm, 4) + ((size_t)l * D + kp * 128) * (6 * D) + n;
        const float* cl_p = (const float*)(GAS const float*)ldptr(prm, 1) + kp * 128; const float* cc_p = (const float*)(GAS const float*)ldptr(prm, 3) + kp * 128;
        float* modacc = (float*)((unsigned char*)(GAS unsigned char*)ldptr(prm, 17) + WS_MODACC);
        const int l32 = tid & 31;
#pragma unroll 1
        for (int k0 = 0; k0 < 128; k0 += 32) {
            f32x4 w[32];
#pragma unroll
            for (int j = 0; j < 32; ++j) w[j] = __builtin_nontemporal_load((const f32x4*)(wp + (size_t)(k0 + j) * (6 * D)));
            const float clv = cl_p[k0 + l32], ccv = cc_p[k0 + l32];
            const float slv = clv / (1.0f + __expf(-clv)), scv = ccv / (1.0f + __expf(-ccv));
#pragma unroll
            for (int j = 0; j < 32; ++j) { const float sl = __builtin_bit_cast(float, __builtin_amdgcn_readlane(__builtin_bit_cast(int, slv), j)), sc = __builtin_bit_cast(float, __builtin_amdgcn_readlane(__builtin_bit_cast(int, scv), j));
                aL = aL + w[j] * sl; aC = aC + w[j] * sc; }
        }
        *(f32x4*)(modacc + (size_t)kp * MODPART + (size_t)(l * 2 + 0) * 6 * D + n) = aL;
        *(f32x4*)(modacc + (size_t)kp * MODPART + (size_t)(l * 2 + 1) * 6 * D + n) = aC;
    }
}
__device__ __forceinline__ void r1_block_task(const bf16_t* P, float* KVt, LAS unsigned char* lds, float lg2, int cidx, int head, int wave, int lane) {
    const int i = lane & 15, g = lane >> 4, dir = wave >> 2, quad = wave & 3;
    const int dk0 = 64 * (quad >> 1), dv0 = 64 * (quad & 1);
    const bf16_t* Prow = P + (size_t)chunk_row(cidx) * ABIN;
#pragma unroll
    for (int r = 0; r < 2; ++r)
#pragma unroll
        for (int j = 0; j < 4; ++j) {
            const int p = (j * 8 + wave) * 64 + lane, row = p >> 4, c = (p & 15) ^ (row & 15);
            const bf16_t* src = Prow + (size_t)row * ABIN + (r == 0 ? 4096 : 5120) + head * 128 + c * 8;
            __builtin_amdgcn_global_load_lds((const unsigned*)src, (LAS unsigned*)(lds + r * 32768 + (j * 8 + wave) * 1024), 16, 0, 0);
        }
    asm volatile("s_waitcnt vmcnt(0)" ::: "memory");
    asm volatile("s_waitcnt lgkmcnt(0)" ::: "memory"); __builtin_amdgcn_s_barrier(); asm volatile("" ::: "memory");
    int kbo[8], vbo[8];
#pragma unroll
    for (int jj = 0; jj < 8; ++jj) { const int tl = 8 * g + jj;
        kbo[jj] = tl * 256 + (((dk0 >> 3) + (i >> 1)) ^ (tl & 15)) * 16 + 8 * (i & 1);
        vbo[jj] = 32768 + tl * 256 + (((dv0 >> 3) + (i >> 1)) ^ (tl & 15)) * 16 + 8 * (i & 1); }
    f32x4 acc[4][4];
#pragma unroll
    for (int a = 0; a < 4; ++a)
#pragma unroll
        for (int b = 0; b < 4; ++b) acc[a][b] = (f32x4){0.f, 0.f, 0.f, 0.f};
#pragma unroll
    for (int s = 0; s < 4; ++s) {
        u32x2 kd[8], vd[8]; float w[8];
#pragma unroll
        for (int jj = 0; jj < 8; ++jj) {
            const int tj = 32 * s + 8 * g + jj;
            kd[jj] = *(LAS const u32x2*)(lds + kbo[jj] + 8192 * s); vd[jj] = *(LAS const u32x2*)(lds + vbo[jj] + 8192 * s);
            w[jj] = ex2(lg2 * (float)(dir == 0 ? 127 - tj : tj));
        }
        bf16x8 af[4], bfr[4];
#pragma unroll
        for (int mt = 0; mt < 4; ++mt) {
            u32x4 wd;
#pragma unroll
            for (int q = 0; q < 4; ++q) {
                const unsigned X = kd[2 * q][mt >> 1], Y = kd[2 * q + 1][mt >> 1];
                const float lo = ((mt & 1) ? bf_hi(X) : bf_lo(X)) * w[2 * q], hi = ((mt & 1) ? bf_hi(Y) : bf_lo(Y)) * w[2 * q + 1];
                wd[q] = cvt_pk_bf16(lo, hi);
            }
            af[mt] = __builtin_bit_cast(bf16x8, wd);
        }
#pragma unroll
        for (int nt = 0; nt < 4; ++nt) {
            u32x4 wd;
#pragma unroll
            for (int q = 0; q < 4; ++q) {
                const unsigned X = vd[2 * q][nt >> 1], Y = vd[2 * q + 1][nt >> 1];
                wd[q] = (nt & 1) ? ((X >> 16) | (Y & 0xffff0000u)) : ((X & 0xffffu) | (Y << 16));
            }
            bfr[nt] = __builtin_bit_cast(bf16x8, wd);
        }
#pragma unroll
        for (int mt = 0; mt < 4; ++mt)
#pragma unroll
            for (int nt = 0; nt < 4; ++nt) acc[mt][nt] = mfma16(af[mt], bfr[nt], acc[mt][nt]);
        SCHED_FENCE();
    }
    asm volatile("s_waitcnt lgkmcnt(0)" ::: "memory"); __builtin_amdgcn_s_barrier(); asm volatile("" ::: "memory");
    float* out = KVt + ((((size_t)cidx * 8 + head) * 2 + dir) * 128) * 128;
#pragma unroll
    for (int nt = 0; nt < 4; ++nt)
#pragma unroll
        for (int reg = 0; reg < 4; ++reg) {
            const int dv = dv0 + 4 * i + nt, dk = dk0 + 16 * g + 4 * reg;
            *(f32x4*)(out + (size_t)dv * 128 + dk) = (f32x4){acc[0][nt][reg], acc[1][nt][reg], acc[2][nt][reg], acc[3][nt][reg]};
        }
}

__device__ __forceinline__ void r1_issue_set(const bf16_t* Prow, LAS unsigned char* setp, const int head, const int wave, const int lane) {
#pragma unroll
    for (int r = 0; r < 2; ++r)
#pragma unroll
        for (int j = 0; j < 4; ++j) {
            const int p = (j * 8 + wave) * 64 + lane, row = p >> 4, c = (p & 15) ^ (row & 15);
            const bf16_t* src = Prow + (size_t)row * ABIN + (r == 0 ? 4096 : 5120) + head * 128 + c * 8;
            __builtin_amdgcn_global_load_lds((const unsigned*)src, (LAS unsigned*)(setp + r * 32768 + (j * 8 + wave) * 1024), 16, 0, 0);
        }
}
__device__ __forceinline__ void r1_phase_pipelined(const bf16_t* P, float* KVt, LAS unsigned char* lds, const float* decay_exp, const int iab, const int vcu, const int G, const int wave, const int lane) {
    const int i = lane & 15, g = lane >> 4, dir = wave >> 2, quad = wave & 3;
    const int dk0 = 64 * (quad >> 1), dv0 = 64 * (quad & 1);
    int bt = vcu; if (bt >= NCHUNK * 8) return;
    int kbo[8], vbo[8];
#pragma unroll
    for (int jj = 0; jj < 8; ++jj) { const int tl = 8 * g + jj;
        kbo[jj] = tl * 256 + (((dk0 >> 3) + (i >> 1)) ^ (tl & 15)) * 16 + 8 * (i & 1);
        vbo[jj] = 32768 + tl * 256 + (((dv0 >> 3) + (i >> 1)) ^ (tl & 15)) * 16 + 8 * (i & 1); }
    r1_issue_set(P + (size_t)chunk_row(bt >> 3) * ABIN, lds, bt & 7, wave, lane);
    for (int k = 0;; ++k) {
        const int cidx = bt >> 3, head = bt & 7, nbt = bt + G;
        const bool has_next = nbt < NCHUNK * 8;
        const float lg2 = lg2gamma(decay_exp, iab, dir, head);
        LAS const unsigned char* setp = lds + (k & 1) * 65536;
        if (has_next) { r1_issue_set(P + (size_t)chunk_row(nbt >> 3) * ABIN, lds + ((k + 1) & 1) * 65536, nbt & 7, wave, lane); asm volatile("s_waitcnt vmcnt(8)" ::: "memory"); }
        else asm volatile("s_waitcnt vmcnt(0)" ::: "memory");
        asm volatile("s_waitcnt lgkmcnt(0)" ::: "memory"); __builtin_amdgcn_s_barrier(); asm volatile("" ::: "memory");
        f32x4 acc[4][4];
#pragma unroll
        for (int a = 0; a < 4; ++a)
#pragma unroll
            for (int b = 0; b < 4; ++b) acc[a][b] = (f32x4){0.f, 0.f, 0.f, 0.f};
#pragma unroll
        for (int s = 0; s < 4; ++s) {
            u32x2 kd[8], vd[8]; float w[8];
#pragma unroll
            for (int jj = 0; jj < 8; ++jj) {
                const int tj = 32 * s + 8 * g + jj;
                kd[jj] = *(LAS const u32x2*)(setp + kbo[jj] + 8192 * s); vd[jj] = *(LAS const u32x2*)(setp + vbo[jj] + 8192 * s);
                w[jj] = ex2(lg2 * (float)(dir == 0 ? 127 - tj : tj));
            }
            bf16x8 af[4], bfr[4];
#pragma unroll
            for (int mt = 0; mt < 4; ++mt) {
                u32x4 wd;
#pragma unroll
                for (int q = 0; q < 4; ++q) {
                    const unsigned X = kd[2 * q][mt >> 1], Y = kd[2 * q + 1][mt >> 1];
                    const float lo = ((mt & 1) ? bf_hi(X) : bf_lo(X)) * w[2 * q], hi = ((mt & 1) ? bf_hi(Y) : bf_lo(Y)) * w[2 * q + 1];
                    wd[q] = cvt_pk_bf16(lo, hi);
                }
                af[mt] = __builtin_bit_cast(bf16x8, wd);
            }
#pragma unroll
            for (int nt = 0; nt < 4; ++nt) {
                u32x4 wd;
#pragma unroll
                for (int q = 0; q < 4; ++q) {
                    const unsigned X = vd[2 * q][nt >> 1], Y = vd[2 * q + 1][nt >> 1];
                    wd[q] = (nt & 1) ? ((X >> 16) | (Y & 0xffff0000u)) : ((X & 0xffffu) | (Y << 16));
                }
                bfr[nt] = __builtin_bit_cast(bf16x8, wd);
            }
#pragma unroll
            for (int mt = 0; mt < 4; ++mt)
#pragma unroll
                for (int nt = 0; nt < 4; ++nt) acc[mt][nt] = mfma16(af[mt], bfr[nt], acc[mt][nt]);
            SCHED_FENCE();
        }
        asm volatile("s_waitcnt lgkmcnt(0)" ::: "memory"); __builtin_amdgcn_s_barrier(); asm volatile("" ::: "memory");
        bf16_t* out = (bf16_t*)KVt + ((((size_t)cidx * 8 + head) * 2 + dir) * 128) * 128;
#pragma unroll
        for (int nt = 0; nt < 4; ++nt)
#pragma unroll
            for (int reg = 0; reg < 4; ++reg) {
                const int dv = dv0 + 4 * i + nt, dk = dk0 + 16 * g + 4 * reg;
                u32x2 w; w[0] = cvt_pk_bf16(acc[0][nt][reg], acc[1][nt][reg]); w[1] = cvt_pk_bf16(acc[2][nt][reg], acc[3][nt][reg]);
                *(u32x2*)(out + (size_t)dv * 128 + dk) = w;
            }
        if (!has_next) break;
        bt = nbt;
    }
}

__device__ __forceinline__ void r3_block_task(const bf16_t* P, const bf16_t* St, bf16_t* YAB, LAS unsigned char* lds, float lg2f, float lg2b, int cidx, int head, int wave, int lane) {
    const int i = lane & 15, g = lane >> 4, qi = 16 * wave + i, rowbase = chunk_row(cidx);
    const bf16_t* Prow = P + (size_t)rowbase * ABIN;
    bf16x8 qf[4];
#pragma unroll
    for (int s = 0; s < 4; ++s) qf[s] = *(const bf16x8*)(Prow + (size_t)qi * ABIN + 3072 + head * 128 + 32 * s + 8 * g);
#pragma unroll
    for (int r = 0; r < 4; ++r)
#pragma unroll
        for (int j = 0; j < 4; ++j) {
            const int p = (j * 8 + wave) * 64 + lane, row = p >> 4, c = (p & 15) ^ (r < 2 ? (row & 15) : ((row >> 3) & 15));
            const bf16_t* src = r == 0 ? Prow + (size_t)row * ABIN + 4096 + head * 128 + c * 8 : (r == 1 ? Prow + (size_t)row * ABIN + 5120 + head * 128 + c * 8
                                : St + ((((size_t)cidx * 8 + head) * 2 + (r - 2)) * 128 + row) * 128 + c * 8);
            __builtin_amdgcn_global_load_lds((const unsigned*)src, (LAS unsigned*)(lds + r * 32768 + (j * 8 + wave) * 1024), 16, 0, 0);
        }
    asm volatile("s_waitcnt vmcnt(0)" ::: "memory");
    asm volatile("s_waitcnt lgkmcnt(0)" ::: "memory"); __builtin_amdgcn_s_barrier(); asm volatile("" ::: "memory");
    int kb[4], sb[4], vb[8];
#pragma unroll
    for (int s = 0; s < 4; ++s) { kb[s] = i * 256 + ((4 * s + g) ^ i) * 16; sb[s] = 65536 + i * 2048 + ((4 * s + g) ^ i) * 16; }
#pragma unroll
    for (int jj = 0; jj < 8; ++jj) { const int kk = jj < 4 ? 4 * g + jj : 16 + 4 * g + jj - 4; vb[jj] = 32768 + kk * 256 + (i ^ (kk & 15)) * 16; }
    f32x4 sacc[8];
#pragma unroll
    for (int mt = 0; mt < 8; ++mt) {
        f32x4 a = (f32x4){0.f, 0.f, 0.f, 0.f};
#pragma unroll
        for (int s = 0; s < 4; ++s) { const bf16x8 kf = *(LAS const bf16x8*)(lds + kb[s] + 4096 * mt); a = mfma16(kf, qf[s], a); }
        sacc[mt] = a;
        if (mt & 1) SCHED_FENCE();
    }
#pragma unroll
    for (int mt = 0; mt < 8; ++mt)
#pragma unroll
        for (int reg = 0; reg < 4; ++reg) {
            const int diff = qi - (16 * mt + 4 * g + reg);
            const float d = diff > 0 ? ex2((float)diff * lg2f) : (diff < 0 ? ex2((float)(-diff) * lg2b) : 2.0f);
            sacc[mt][reg] *= d;
        }
    bf16x8 pf[4];
#pragma unroll
    for (int s = 0; s < 4; ++s) {
        u32x4 w; w[0] = cvt_pk_bf16(sacc[2 * s][0], sacc[2 * s][1]); w[1] = cvt_pk_bf16(sacc[2 * s][2], sacc[2 * s][3]);
        w[2] = cvt_pk_bf16(sacc[2 * s + 1][0], sacc[2 * s + 1][1]); w[3] = cvt_pk_bf16(sacc[2 * s + 1][2], sacc[2 * s + 1][3]);
        pf[s] = __builtin_bit_cast(bf16x8, w);
    }
    f32x4 oacc[8];
#pragma unroll
    for (int mt = 0; mt < 8; ++mt) oacc[mt] = (f32x4){0.f, 0.f, 0.f, 0.f};
#pragma unroll
    for (int s = 0; s < 4; ++s) {
        u32x4 vd[8];
#pragma unroll
        for (int jj = 0; jj < 8; ++jj) vd[jj] = *(LAS const u32x4*)(lds + vb[jj] + 8192 * s);
#pragma unroll
        for (int mt = 0; mt < 8; ++mt) oacc[mt] = mfma16(extract8(vd, mt), pf[s], oacc[mt]);
        SCHED_FENCE();
    }
#pragma unroll
    for (int dir = 0; dir < 2; ++dir) {
        f32x4 tacc[8];
#pragma unroll
        for (int mt = 0; mt < 8; ++mt) tacc[mt] = (f32x4){0.f, 0.f, 0.f, 0.f};
#pragma unroll
        for (int s = 0; s < 4; ++s) {
#pragma unroll
            for (int mt = 0; mt < 8; ++mt) { const bf16x8 sf = *(LAS const bf16x8*)(lds + sb[s] + 256 * mt + 32768 * dir); tacc[mt] = mfma16(sf, qf[s], tacc[mt]); }
            SCHED_FENCE();
        }
        const float qd = dir == 0 ? ex2((float)(qi + 1) * lg2f) : ex2((float)(128 - qi) * lg2b);
#pragma unroll
        for (int mt = 0; mt < 8; ++mt) oacc[mt] = oacc[mt] + tacc[mt] * qd;
    }
    asm volatile("s_waitcnt lgkmcnt(0)" ::: "memory"); __builtin_amdgcn_s_barrier(); asm volatile("" ::: "memory");
    float ss = 0.f;
#pragma unroll
    for (int mt = 0; mt < 8; ++mt) ss += (oacc[mt][0] * oacc[mt][0] + oacc[mt][1] * oacc[mt][1]) + (oacc[mt][2] * oacc[mt][2] + oacc[mt][3] * oacc[mt][3]);
    ss += shfl_xor_f(ss, 16); ss += shfl_xor_f(ss, 32);
    const float rinv = rsq_f(ss * (1.0f / 128.0f) + EPS);
#pragma unroll
    for (int reg = 0; reg < 4; ++reg) {
        const int dvb = 32 * g + 8 * reg;
        const u32x4 gt = *(const u32x4*)(Prow + (size_t)qi * ABIN + 6144 + head * 128 + dvb);
        float o[8];
#pragma unroll
        for (int mt = 0; mt < 8; ++mt) { const float gv = (mt & 1) ? bf_hi(gt[mt >> 1]) : bf_lo(gt[mt >> 1]); o[mt] = silu_f(gv) * (oacc[mt][reg] * rinv); }
        u32x4 w; w[0] = cvt_pk_bf16(o[0], o[1]); w[1] = cvt_pk_bf16(o[2], o[3]); w[2] = cvt_pk_bf16(o[4], o[5]); w[3] = cvt_pk_bf16(o[6], o[7]);
        *(u32x4*)(YAB + (size_t)(rowbase + qi) * D + 1024 + head * 128 + dvb) = w;
    }
}

__device__ __forceinline__ void r3_issue_regions(const bf16_t* Prow, const bf16_t* Stb, LAS unsigned char* lds, const int head, const int rlo, const int wave, const int lane) {
#pragma unroll
    for (int rr = 0; rr < 2; ++rr)
#pragma unroll
        for (int j = 0; j < 4; ++j) {
            const int r = rlo + rr;
            const int p = (j * 8 + wave) * 64 + lane, row = p >> 4, c = (p & 15) ^ (r < 2 ? (row & 15) : ((row >> 3) & 15));
            const bf16_t* src = r == 0 ? Prow + (size_t)row * ABIN + 4096 + head * 128 + c * 8 : (r == 1 ? Prow + (size_t)row * ABIN + 5120 + head * 128 + c * 8
                                : Stb + ((size_t)(r - 2) * 128 + row) * 128 + c * 8);
            __builtin_amdgcn_global_load_lds((const unsigned*)src, (LAS unsigned*)(lds + r * 32768 + (j * 8 + wave) * 1024), 16, 0, 0);
        }
}
__device__ __forceinline__ void r3_phase_pipelined(const bf16_t* P, const bf16_t* St, bf16_t* YAB, LAS unsigned char* lds, const float* decay_exp, const int iab, const int vcu, const int G, const int wave, const int lane) {
    const int i = lane & 15, g = lane >> 4;
    int bt = vcu; if (bt >= NCHUNK * 8) return;
    int kb[4], sb[4], vb[8];
#pragma unroll
    for (int s = 0; s < 4; ++s) { kb[s] = i * 256 + ((4 * s + g) ^ i) * 16; sb[s] = 65536 + i * 2048 + ((4 * s + g) ^ i) * 16; }
#pragma unroll
    for (int jj = 0; jj < 8; ++jj) { const int kk = jj < 4 ? 4 * g + jj : 16 + 4 * g + jj - 4; vb[jj] = 32768 + kk * 256 + (i ^ (kk & 15)) * 16; }
    bf16x8 qn[4];
    {   const int cidx = bt >> 3, head = bt & 7; const bf16_t* Prow = P + (size_t)chunk_row(cidx) * ABIN;
#pragma unroll
        for (int s = 0; s < 4; ++s) qn[s] = *(const bf16x8*)(Prow + (size_t)(16 * wave + i) * ABIN + 3072 + head * 128 + 32 * s + 8 * g);
        const bf16_t* Stb = St + (((size_t)cidx * 8 + head) * 2) * 16384;
        r3_issue_regions(Prow, Stb, lds, head, 0, wave, lane); r3_issue_regions(Prow, Stb, lds, head, 2, wave, lane); }
    for (;;) {
        const int cidx = bt >> 3, head = bt & 7, qi = 16 * wave + i, rowbase = chunk_row(cidx), nbt = bt + G;
        const bool has_next = nbt < NCHUNK * 8;
        const bf16_t* Prow = P + (size_t)rowbase * ABIN;
        const float lg2f = lg2gamma(decay_exp, iab, 0, head), lg2b = lg2gamma(decay_exp, iab, 1, head);
        bf16x8 qf[4];
#pragma unroll
        for (int s = 0; s < 4; ++s) qf[s] = qn[s];
        asm volatile("s_waitcnt vmcnt(8)" ::: "memory");
        asm volatile("s_waitcnt lgkmcnt(0)" ::: "memory"); __builtin_amdgcn_s_barrier(); asm volatile("" ::: "memory");
        f32x4 sacc[8];
#pragma unroll
        for (int mt = 0; mt < 8; ++mt) {
            f32x4 a = (f32x4){0.f, 0.f, 0.f, 0.f};
#pragma unroll
            for (int s = 0; s < 4; ++s) { const bf16x8 kf = *(LAS const bf16x8*)(lds + kb[s] + 4096 * mt); a = mfma16(kf, qf[s], a); }
            sacc[mt] = a;
            if (mt & 1) SCHED_FENCE();
        }
#pragma unroll
        for (int mt = 0; mt < 8; ++mt)
#pragma unroll
            for (int reg = 0; reg < 4; ++reg) {
                const int diff = qi - (16 * mt + 4 * g + reg);
                const float d = diff > 0 ? ex2((float)diff * lg2f) : (diff < 0 ? ex2((float)(-diff) * lg2b) : 2.0f);
                sacc[mt][reg] *= d;
            }
        bf16x8 pf[4];
#pragma unroll
        for (int s = 0; s < 4; ++s) {
            u32x4 w; w[0] = cvt_pk_bf16(sacc[2 * s][0], sacc[2 * s][1]); w[1] = cvt_pk_bf16(sacc[2 * s][2], sacc[2 * s][3]);
            w[2] = cvt_pk_bf16(sacc[2 * s + 1][0], sacc[2 * s + 1][1]); w[3] = cvt_pk_bf16(sacc[2 * s + 1][2], sacc[2 * s + 1][3]);
            pf[s] = __builtin_bit_cast(bf16x8, w);
        }
        f32x4 oacc[8];
#pragma unroll
        for (int mt = 0; mt < 8; ++mt) oacc[mt] = (f32x4){0.f, 0.f, 0.f, 0.f};
#pragma unroll
        for (int s = 0; s < 4; ++s) {
            u32x4 vd[8];
#pragma unroll
            for (int jj = 0; jj < 8; ++jj) vd[jj] = *(LAS const u32x4*)(lds + vb[jj] + 8192 * s);
#pragma unroll
            for (int mt = 0; mt < 8; ++mt) oacc[mt] = mfma16(extract8(vd, mt), pf[s], oacc[mt]);
            SCHED_FENCE();
        }
        asm volatile("s_waitcnt lgkmcnt(0)" ::: "memory"); __builtin_amdgcn_s_barrier(); asm volatile("" ::: "memory");
        if (has_next) {
            const int ncidx = nbt >> 3, nhead = nbt & 7; const bf16_t* nProw = P + (size_t)chunk_row(ncidx) * ABIN;
#pragma unroll
            for (int s = 0; s < 4; ++s) qn[s] = *(const bf16x8*)(nProw + (size_t)(16 * wave + i) * ABIN + 3072 + nhead * 128 + 32 * s + 8 * g);
            r3_issue_regions(nProw, St, lds, nhead, 0, wave, lane);
            asm volatile("s_waitcnt vmcnt(8)" ::: "memory");
        } else asm volatile("s_waitcnt vmcnt(0)" ::: "memory");
        asm volatile("s_waitcnt lgkmcnt(0)" ::: "memory"); __builtin_amdgcn_s_barrier(); asm volatile("" ::: "memory");
#pragma unroll
        for (int dir = 0; dir < 2; ++dir) {
            f32x4 tacc[8];
#pragma unroll
            for (int mt = 0; mt < 8; ++mt) tacc[mt] = (f32x4){0.f, 0.f, 0.f, 0.f};
#pragma unroll
            for (int s = 0; s < 4; ++s) {
#pragma unroll
                for (int mt = 0; mt < 8; ++mt) { const bf16x8 sf = *(LAS const bf16x8*)(lds + sb[s] + 256 * mt + 32768 * dir); tacc[mt] = mfma16(sf, qf[s], tacc[mt]); }
                SCHED_FENCE();
            }
            const float qd = dir == 0 ? ex2((float)(qi + 1) * lg2f) : ex2((float)(128 - qi) * lg2b);
#pragma unroll
            for (int mt = 0; mt < 8; ++mt) oacc[mt] = oacc[mt] + tacc[mt] * qd;
        }
        asm volatile("s_waitcnt lgkmcnt(0)" ::: "memory"); __builtin_amdgcn_s_barrier(); asm volatile("" ::: "memory");
        float ss = 0.f;
#pragma unroll
        for (int mt = 0; mt < 8; ++mt) ss += (oacc[mt][0] * oacc[mt][0] + oacc[mt][1] * oacc[mt][1]) + (oacc[mt][2] * oacc[mt][2] + oacc[mt][3] * oacc[mt][3]);
        ss += shfl_xor_f(ss, 16); ss += shfl_xor_f(ss, 32);
        const float rinv = rsq_f(ss * (1.0f / 128.0f) + EPS);
#pragma unroll
        for (int reg = 0; reg < 4; ++reg) {
            const int dvb = 32 * g + 8 * reg;
            const u32x4 gt = *(const u32x4*)(Prow + (size_t)qi * ABIN + 6144 + head * 128 + dvb);
            float o[8];
#pragma unroll
            for (int mt = 0; mt < 8; ++mt) { const float gv = (mt & 1) ? bf_hi(gt[mt >> 1]) : bf_lo(gt[mt >> 1]); o[mt] = silu_f(gv) * (oacc[mt][reg] * rinv); }
            u32x4 w; w[0] = cvt_pk_bf16(o[0], o[1]); w[1] = cvt_pk_bf16(o[2], o[3]); w[2] = cvt_pk_bf16(o[4], o[5]); w[3] = cvt_pk_bf16(o[6], o[7]);
            *(u32x4*)(YAB + (size_t)(rowbase + qi) * D + 1024 + head * 128 + dvb) = w;
        }
        if (!has_next) break;
        { const int ncidx = nbt >> 3, nhead = nbt & 7; const bf16_t* nProw = P + (size_t)chunk_row(ncidx) * ABIN;
          r3_issue_regions(nProw, St + (((size_t)ncidx * 8 + nhead) * 2) * 16384, lds, nhead, 2, wave, lane); }
        bt = nbt;
    }
}

__device__ __forceinline__ void na_stage_issue(const bf16_t* P, LAS unsigned char* slot, int tok0, int h, int wave, int lane) {
#pragma unroll
    for (int j = 0; j < 2; ++j) {
        const int p = (j * 8 + wave) * 64 + lane, key = p >> 4, c = (p & 15) ^ (key & 15);
        const bf16_t* src = P + (size_t)(tok0 + key) * QKV + 2048 + h * 128 + c * 8;
        __builtin_amdgcn_global_load_lds((const unsigned*)src, (LAS unsigned*)(slot + (j * 8 + wave) * 1024), 16, 0, 0);
        __builtin_amdgcn_global_load_lds((const unsigned*)(src + 2048), (LAS unsigned*)(slot + 16384 + (j * 8 + wave) * 1024), 16, 0, 0);
    }
}
__device__ __forceinline__ void na_half_step(AttnTile& ta, AttnTile& tb, LAS const unsigned char* slot, const int k0, const bool okA, const bool okB, const bool win,
                                             LAS const float* brA, LAS const float* brB, const int kc0, const int c, const int sc, const int i, const int g) {
    f32x4 saA[2], saB[2];
#pragma unroll
    for (int mt = 0; mt < 2; ++mt) {
        const int k = k0 + 16 * mt + i;
        bf16x8 kf[4];
#pragma unroll
        for (int s = 0; s < 4; ++s) kf[s] = *(LAS const bf16x8*)(slot + ((k << 4) + ((4 * s + g) ^ (k & 15))) * 16);
        f32x4 a = (f32x4){0.f, 0.f, 0.f, 0.f}, b = a;
#pragma unroll
        for (int s = 0; s < 4; ++s) { a = mfma16(kf[s], ta.qf[s], a); b = mfma16(kf[s], tb.qf[s], b); }
        saA[mt] = a; saB[mt] = b;
    }
    const bf16x8 pfA = attn_tile_soft(ta, saA, win, okA, brA, kc0, c, sc, g);
    const bf16x8 pfB = attn_tile_soft(tb, saB, win, okB, brB, kc0, c, sc, g);
    u32x4 vd[8];
#pragma unroll
    for (int jj = 0; jj < 8; ++jj) { const int k = k0 + (jj < 4 ? 4 * g + jj : 16 + 4 * g + jj - 4); vd[jj] = *(LAS const u32x4*)(slot + 16384 + ((k << 4) + (i ^ (k & 15))) * 16); }
#pragma unroll
    for (int mt = 0; mt < 8; ++mt) { const bf16x8 vf = extract8(vd, mt); ta.oacc[mt] = mfma16(vf, pfA, ta.oacc[mt]); tb.oacc[mt] = mfma16(vf, pfB, tb.oacc[mt]); }
}
__device__ __forceinline__ void na_block_task(const bf16_t* P, bf16_t* YAB, const float* rpbh, LAS unsigned char* lds, const int h, const int r0, const int tid, const int wave, const int lane) {
    const int i = lane & 15, g = lane >> 4, cgp = wave & 3, pair = wave >> 2;
    const int rA = r0 + 2 * pair, rB = rA + 1, c0 = 16 * cgp, kc0 = cgp == 0 ? 0 : (cgp == 1 ? 8 : (cgp == 2 ? 24 : 32));
    const int c = c0 + i, sc = c - 8 < 0 ? 0 : (c - 8 > 48 ? 48 : c - 8);
    const int srA = rA - 4 < 0 ? 0 : (rA - 4 > 120 ? 120 : rA - 4), srB = rB - 4 < 0 ? 0 : (rB - 4 > 120 ? 120 : rB - 4);
    const int srmin = r0 - 4 < 0 ? 0 : (r0 - 4 > 120 ? 120 : r0 - 4), srlast = r0 - 1 < 0 ? 0 : (r0 - 1 > 120 ? 120 : r0 - 1);
    const int nkr = srlast + 8 - srmin, nsw = (nkr + 1) >> 1, nst = nsw + 2;
    LAS float* bias = (LAS float*)(lds + LDSCTL_OFF + 2048);
    if (tid < 465) bias[tid] = rpbh[tid];
    AttnTile ta, tb;
    attn_tile_init(ta, P, rA * 64 + c0 + i, h, g); attn_tile_init(tb, P, rB * 64 + c0 + i, h, g);
    asm volatile("s_waitcnt vmcnt(0)" ::: "memory");
#define NA_ROWOFF(idx) (nkr == 11 ? ((idx) < 4 ? (((idx) & 1) ? 9 + ((idx) >> 1) : ((idx) >> 1)) : (idx) - 2) : (idx))
#define NA_ISSUE2(stg, slotp) do { const int s_ = (stg); \
        const int t0_ = s_ < nsw ? (srmin + NA_ROWOFF(2 * s_)) * 64 : S + 128 * (s_ - nsw); \
        const int t1_ = s_ < nsw ? (srmin + (2 * s_ + 1 < nkr ? NA_ROWOFF(2 * s_ + 1) : NA_ROWOFF(2 * s_))) * 64 : S + 128 * (s_ - nsw) + 64; \
        na_stage_issue(P, (slotp), t0_, h, wave, lane); na_stage_issue(P, (slotp) + 32768, t1_, h, wave, lane); } while (0)
    NA_ISSUE2(0, lds);
    for (int st = 0; st < nst; ++st) {
        if (st + 1 < nst) {
            NA_ISSUE2(st + 1, lds + ((st + 1) & 1) * 65536);
            asm volatile("s_waitcnt vmcnt(8)" ::: "memory");
        } else asm volatile("s_waitcnt vmcnt(0)" ::: "memory");
        asm volatile("s_waitcnt lgkmcnt(0)" ::: "memory"); __builtin_amdgcn_s_barrier(); asm volatile("" ::: "memory");
        const bool win = st < nsw;
#pragma unroll 1
        for (int sub = 0; sub < 2; ++sub) {
            LAS const unsigned char* slot = lds + (st & 1) * 65536 + sub * 32768;
            const int kr = srmin + NA_ROWOFF(2 * st + sub);
            if (win && 2 * st + sub >= nkr) break;
            const bool doA = !win || (kr >= srA && kr < srA + 8), doB = !win || (kr >= srB && kr < srB + 8);
            if (!doA && !doB) continue;
            const int nh = win ? 1 : 2;
#pragma unroll 1
            for (int hf = 0; hf < nh; ++hf)
                na_half_step(ta, tb, slot, win ? kc0 : 32 * hf, doA, doB, win, bias + (win && doA ? (kr - rA + 7) * 31 : 0), bias + (win && doB ? (kr - rB + 7) * 31 : 0), kc0, c, sc, i, g);
        }
        asm volatile("s_waitcnt lgkmcnt(0)" ::: "memory"); __builtin_amdgcn_s_barrier(); asm volatile("" ::: "memory");
    }
#undef NA_ISSUE2
#undef NA_ROWOFF
    attn_tile_store(ta, YAB, rA * 64 + c0 + i, h, g); attn_tile_store(tb, YAB, rB * 64 + c0 + i, h, g);
}

#ifndef MK_MODE
#define MK_MODE 1
#endif
__global__ void __launch_bounds__(512, 2) mega_fwd(Params p) {
    extern __shared__ __attribute__((aligned(16))) unsigned char lds_raw[];
    LAS unsigned char* lds = (LAS unsigned char*)lds_raw;
    const int G_k = gridDim.x, bx_k = blockIdx.x;
#define SITE_COORDS pt_t0_ = (PT_SITE >= 0) ? wall_clock64() : 0ull; int tid = threadIdx.x; asm volatile("" : "+v"(tid)); int Gl_ = G_k, bxl_ = bx_k; asm volatile("" : "+s"(Gl_), "+s"(bxl_)); const int G = Gl_, bx = bxl_, NGW = G * 8; (void)NGW; const int lane = tid & 63, wave = __builtin_amdgcn_readfirstlane(tid >> 6); \
    const int vcu = (bx & 7) * (G >> 3) + (bx >> 3); const int gw = vcu * 8 + wave;     (void)lane; (void)gw; (void)vcu; \
    LAS const unsigned* prm = (LAS const unsigned*)(lds + PRM_OFF); asm volatile("" : "+v"(prm)); unsigned char* ws = (unsigned char*)(GAS unsigned char*)ldptr(prm, 17); (void)ws; \
    float* modacc = (float*)(ws + WS_MODACC); f32x2* rope = (f32x2*)(ws + WS_ROPE); float* X = (float*)(ws + WS_X); bf16_t* H = (bf16_t*)(ws + WS_H); bf16_t* P = (bf16_t*)(ws + WS_P); bf16_t* YAB = (bf16_t*)(ws + WS_YAB); \
    float* Y = (float*)(ws + WS_Y); bf16_t* HID = (bf16_t*)(ws + WS_P)  ; float* KVT = (float*)(ws + WS_Y)  ; bf16_t* ST = (bf16_t*)(ws + WS_Y + (size_t)NCHUNK * 16 * 16384 * 2); float* YC = (float*)(ws + WS_YC); \
    (void)modacc; (void)rope; (void)X; (void)H; (void)P; (void)YAB; (void)Y; (void)HID; (void)KVT; (void)ST; (void)YC
#define INP(k) ((const float*)(GAS const float*)ldptr(prm, (k)))
    volatile LAS unsigned* MISC = (volatile LAS unsigned*)(lds + MISC_OFF);
    { const int tid = threadIdx.x; for (int u = tid; u < (LDS_BYTES - LDSCTL_OFF) / 4; u += 512) ((LAS unsigned*)(lds + LDSCTL_OFF))[u] = 0u; }
    __syncthreads();
    if (threadIdx.x == 0) { LAS unsigned long long* q = (LAS unsigned long long*)(lds + PRM_OFF);
        q[0] = (unsigned long long)p.in[0]; q[1] = (unsigned long long)p.in[1]; q[2] = (unsigned long long)p.in[2]; q[3] = (unsigned long long)p.in[3];
        q[4] = (unsigned long long)p.in[4]; q[5] = (unsigned long long)p.in[5]; q[6] = (unsigned long long)p.in[6]; q[7] = (unsigned long long)p.in[7];
        q[8] = (unsigned long long)p.in[8]; q[9] = (unsigned long long)p.in[9]; q[10] = (unsigned long long)p.in[10]; q[11] = (unsigned long long)p.in[11];
        q[12] = (unsigned long long)p.in[12]; q[13] = (unsigned long long)p.in[13]; q[14] = (unsigned long long)p.in[14]; q[15] = (unsigned long long)p.in[15];
        q[16] = (unsigned long long)p.out; q[17] = (unsigned long long)p.ws; }
    __syncthreads();
    const int lo = MK_MODE == 1 ? 0 : p.ph_lo, hi = MK_MODE == 1 ? NPHASE : p.ph_hi;
    const bool multi = (hi - lo) > 1;
    XcdBarrier bar; bar.bar = (unsigned*)(p.ws + WS_CTL) + p.li * 4096; bar.x = 0; bar.st = nullptr;
    if (multi) bar = xcd_barrier_post((unsigned*)(p.ws + WS_CTL) + p.li * 4096, MISC + 8);
#ifndef SITE_MASK
#define SITE_MASK 0xffff
#endif
#define EN(i) (((SITE_MASK) >> (i)) & 1)
#ifndef REPEAT_MASK
#define REPEAT_MASK 0
#endif
#if REPEAT_MASK != 0
    int rmask_ = REPEAT_MASK; asm volatile("" : "+s"(rmask_));
#define REP(i) ((rmask_ >> (i)) & 1)
#else
#define REP(i) 0
#endif
#define IN(k) (lo <= (k) && (k) < hi)
#ifndef DEFER_CVT
#define DEFER_CVT 1
#endif
#define DEFER_SLOT(rk_, nblk_, lo_, hi_) do { if (DEFER_CVT && G == 256) {     const int rk = (rk_); if (rk >= 0) { LAS float* scr_ = (LAS float*)(lds + wave * 16384); \
        for (int gi = (lo_) + rk * 8 + wave; gi < (hi_); gi += (nblk_) * 8) cvt_dl_item(prm, gi, scr_, lane); } __syncthreads(); } } while (0)
#define DEFER_ADA(rk_, lo_, hi_) do { if (DEFER_CVT && G == 256) { const int ai_ = (lo_) + (rk_); if ((rk_) >= 0 && ai_ < (hi_)) ada_item(prm, 1 + (ai_ >> 7), (ai_ >> 4) & 7, ai_ & 15, tid); } } while (0)
#define MODF_FINALIZE(l0_, l1_) do { for (int it = (vcu * 512 + tid); it < ((l1_) - (l0_)) * 2 * 6 * (D / 4); it += G * 512) { const int col = 4 * (it & 511), j6 = (it >> 9) % 6, ls = 2 * (l0_) + it / (512 * 6); \
        *(f32x4*)((float*)(ws + WS_MODF) + (size_t)(ls * 6 + j6) * D + col) = modvec_partials(modacc, INP(5), ls >> 1, ls & 1, j6, col); } } while (0)
#define ROWOP_RUN(a0) do { RowopArgs ra_ = (a0); if (rep_ + 1 < nrep_) { ra_.xout_lat = (float*)(ws + WS_END); ra_.xout_ctx = ra_.xout_lat + (size_t)S * D; ra_.h = (bf16_t*)(ws + WS_END + (size_t)MTOK * D * 4); } LAS float* cf0 = (LAS float*)lds; LAS float* cf1 = (LAS float*)(lds + 24576); \
        rowop_coefs(ra_, 0, cf0, tid); if (ra_.nctx) rowop_coefs(ra_, 1, cf1, tid); __syncthreads(); \
        if (ra_.nctx) rowop_ctx(ra_, cf1, (LAS float*)(lds + 49152), vcu, G, wave, lane); \
        rowop_stream(ra_, cf0, gw, NGW, lane); __syncthreads(); } while (0)
#ifndef DOUBLE_BAR
#define DOUBLE_BAR 0
#endif
#ifndef PT_SITE
#define PT_SITE -1
#endif
#ifndef PT_BLOCK
#define PT_BLOCK 0
#endif
#ifndef IDLE_Q
#define IDLE_Q 40.0f
#endif
#ifndef IDLE_PROBE
#define IDLE_PROBE 0
#endif
    unsigned long long idle_acc_ = 0ull, pt_t0_ = 0ull, pt_acc_ = 0ull; int pt_cur_ = -1; (void)pt_t0_; (void)pt_acc_; (void)pt_cur_;
#define SEAM(k, knext) do { if (PT_SITE >= 0) { if (pt_cur_ == PT_SITE) pt_acc_ += wall_clock64() - pt_t0_; pt_cur_ = -1; } if (IN(k) && IN(knext)) { unsigned long long t0_ = 0ull; if (IDLE_PROBE) t0_ = wall_clock64(); { XcdBarrier b_ = bar; asm volatile("" : "+s"(b_.x)); xcd_barrier(b_); if (DOUBLE_BAR) xcd_barrier(b_); } \
        if (IDLE_PROBE == 1 || (IDLE_PROBE >= 2 && IDLE_PROBE < 100 && (k) >= 2 && ((k) - 2) % 9 == IDLE_PROBE - 2) || (IDLE_PROBE >= 100 && (k) == IDLE_PROBE - 100)) idle_acc_ += wall_clock64() - t0_; } } while (0)

    for (int nrep_ = 1 + REP(0), rep_ = 0; rep_ < nrep_; ++rep_) if (EN(0) && IN(0) && ((pt_cur_ = 0), true)) {
        SITE_COORDS;
        LAS float* scr = (LAS float*)(lds + wave * 16384);
        if (DEFER_CVT && G == 256) {
            constexpr int L0_ADA_SHARE = 2048;
            if (vcu < 128) { ada_item(prm, 0, vcu >> 4, vcu & 15, tid); for (int it = L0_ITEMS - L0_ADA_SHARE + vcu * 8 + wave; it < L0_ITEMS; it += 1024) cvt_l0_item(prm, it, scr, lane); }
            else for (int it = (vcu - 128) * 8 + wave; it < L0_ITEMS - L0_ADA_SHARE; it += 1024) cvt_l0_item(prm, it, scr, lane);
        } else {
            for (int it = gw; it < L0_ITEMS; it += NGW) cvt_l0_item(prm, it, scr, lane);
            for (int it = gw; it < DL_END; it += NGW) cvt_dl_item(prm, it, scr, lane);
            for (int it = vcu; it < 4 * 128; it += G) ada_item(prm, it >> 7, (it >> 4) & 7, it & 15, tid);
        }
        for (int idx = bx * 512 + tid; idx < 192 * 32; idx += G * 512) {
            const int pi = idx >> 5, f = idx & 31; const float pos = (float)(pi < 128 ? pi : pi - 128);
            const float ang = pos * powf(10000.0f, -(float)f / 32.0f);
            rope[idx] = (f32x2){cosf(ang), sinf(ang)};
        }
    }
    SEAM(0, 1);
    for (int nrep_ = 1 + REP(1), rep_ = 0; rep_ < nrep_; ++rep_) if (EN(1) && IN(1) && ((pt_cur_ = 1), true)) {
        SITE_COORDS;
        RowopArgs a; a.y = nullptr; a.xin_lat = INP(0); a.xin_ctx = INP(2); a.xout_lat = nullptr; a.xout_ctx = nullptr; a.xin16 = 0; a.xout16 = 0;     a.h = H; a.modacc = modacc; a.ada_b = INP(5); a.norm_g = INP(6);
        a.ly = -1; a.jg_y = 0; a.jgate = 0; a.lh = 0; a.jg_h = 0; a.jshift = 0; a.jscale = 1; a.nctx = NCTX; a.ypart = nullptr; a.nypart = 0; a.modf = nullptr;
        if (DEFER_CVT && G == 256) MODF_FINALIZE(0, 1); else MODF_FINALIZE(0, 4);
        ROWOP_RUN(a);
    }
    SEAM(1, 2);
    for (int layer = 0; layer < DEPTH; ++layer) {
        const int pb = 2 + 9 * layer, iab = layer >> 1;
        const bool even = (layer & 1) == 0, last = layer == DEPTH - 1;
        const int Mrows = last ? S : MTOK;
        if (even) {
            for (int nrep_ = 1 + REP(2), rep_ = 0; rep_ < nrep_; ++rep_) if (EN(2) && IN(pb + 0) && ((pt_cur_ = 2), true)) {
                SITE_COORDS;
                if (rep_ == 0) { if (layer == 0) { DEFER_ADA(bx - 156, 0, 100); DEFER_SLOT(bx - 156, 100, 0, 6400); } else { DEFER_ADA(bx - 156, 268, 368); DEFER_SLOT(bx - 156, 100, 46784, 53184); } }
                pg8::Gemm g{H, (const bf16_t*)(ws + WS_WABIN + iab * SZ_WABIN), MTOK, ABIN, D}; pg8::StaticOrder So; So.init(MTOK, ABIN, D, G, bx);
                EpiInProj E{P, rope};
                pg8::gemm_phase<EpiInProj, pg8::StaticOrder, PG8_ALIGN, PG8_SP2>(lds, g, So, E, tid);
            }
            SEAM(pb + 0, pb + 1);
            for (int nrep_ = 1 + REP(3), rep_ = 0; rep_ < nrep_; ++rep_) if (EN(3) && IN(pb + 1) && ((pt_cur_ = 3), true)) {
                SITE_COORDS;
                if (rep_ == 0) { if (layer == 0) DEFER_SLOT(vcu - 16, 240, 6400, 12160); else DEFER_SLOT(vcu - 16, 240, 53184, 58944); }
                r1_phase_pipelined(P, KVT, lds, INP(9), iab, vcu, G, wave, lane);
                { const int cw0 = G == 256 ? (vcu - 16) * 8 + wave : gw, cwn = G == 256 ? 240 * 8 : NGW;
                  if (cw0 >= 0) for (int t = cw0; t < (MTOK / 8) * 2; t += cwn) conv_task(P, YAB, INP(8) + (size_t)iab * 3 * 1024, t, lane); }
            }
            SEAM(pb + 1, pb + 2);
            for (int nrep_ = 1 + REP(4), rep_ = 0; rep_ < nrep_; ++rep_) if (EN(4) && IN(pb + 2) && ((pt_cur_ = 4), true)) {
                SITE_COORDS;
                for (int it = vcu * 512 + tid; it < 131072; it += G * 512) r2_item((const bf16_t*)KVT, ST, INP(9), iab, it);
            }
            SEAM(pb + 2, pb + 3);
            for (int nrep_ = 1 + REP(5), rep_ = 0; rep_ < nrep_; ++rep_) if (EN(5) && IN(pb + 3) && ((pt_cur_ = 5), true)) {
                SITE_COORDS;
                if (rep_ == 0) { if (layer == 0) DEFER_SLOT(vcu - 16, 240, 12160, 19840); else DEFER_SLOT(vcu - 16, 240, 58944, 66624); }
                r3_phase_pipelined(P, ST, YAB, lds, INP(9), iab, vcu, G, wave, lane);
            }
            SEAM(pb + 3, pb + 4);
        } else {
            for (int nrep_ = 1 + REP(6), rep_ = 0; rep_ < nrep_; ++rep_) if (EN(6) && IN(pb + 0) && ((pt_cur_ = 6), true)) {
                SITE_COORDS;
                if (rep_ == 0) { if (layer == 1) DEFER_SLOT(bx - 24, 232, 25888, 40736); else DEFER_SLOT(bx - 24, 232, 72672, 87520); }
                pg8::Gemm g{H, (const bf16_t*)(ws + WS_WQKV + iab * SZ_WQKV), MTOK, QKV, D}; pg8::StaticOrder So; So.init(MTOK, QKV, D, G, bx);
                EpiBf16 E{P, QKV};
                pg8::gemm_phase<EpiBf16, pg8::StaticOrder, PG8_ALIGN, PG8_SP2>(lds, g, So, E, tid);
            }
            SEAM(pb + 0, pb + 1);
            for (int nrep_ = 1 + REP(7), rep_ = 0; rep_ < nrep_; ++rep_) if (EN(7) && IN(pb + 1) && ((pt_cur_ = 7), true)) {
                SITE_COORDS;
                const float* rpb = INP(12) + (size_t)iab * 16 * 15 * 31;
                for (int bt = vcu; bt < 512; bt += G) {
                    const int h = bt >> 5, rq = bt & 31;
                    na_block_task(P, YAB, rpb + h * 465, lds, h, 4 * rq, tid, wave, lane);
                }
                if (!last) for (int t = gw; t < 128; t += NGW) attn_task2<false>(P, YAB, rpb, t >> 3, S + 32 * (t & 7), S + 32 * (t & 7) + 16, 0, 0, 0, lane);
            }
            SEAM(pb + 1, pb + 4);
        }
        for (int nrep_ = 1 + REP(8), rep_ = 0; rep_ < nrep_; ++rep_) if (EN(8) && IN(pb + 4) && ((pt_cur_ = 8), true)) {
            SITE_COORDS;
            const bf16_t* wt = even ? (const bf16_t*)(ws + WS_WABOUT + iab * SZ_WSQ) : (const bf16_t*)(ws + WS_WNAOUT + iab * SZ_WSQ);
            pg8::Gemm g{YAB, wt, MTOK, D, D}; pg8::MixedOrder So; So.init(S, D, D, G, bx, 32, last ? 0 : NSPLIT_OUT);
            EpiY E{(bf16_t*)Y, D, (bf16_t*)YC};
            pg8::gemm_phase<EpiY, pg8::MixedOrder, PG8_ALIGN, PG8_SP2>(lds, g, So, E, tid);
        }
        SEAM(pb + 4, pb + 5);
        for (int nrep_ = 1 + REP(9), rep_ = 0; rep_ < nrep_; ++rep_) if (EN(9) && IN(pb + 5) && ((pt_cur_ = 9), true)) {
            SITE_COORDS;
            RowopArgs a; a.y = (const bf16_t*)Y; a.xin_lat = layer == 0 ? INP(0) : X; a.xin_ctx = layer == 0 ? INP(2) : (const float*)((const bf16_t*)X + (size_t)S * D); a.xout_lat = X; a.xout_ctx = (float*)((bf16_t*)X + (size_t)S * D); a.xin16 = layer == 0 ? 0 : 1; a.xout16 = 1;     a.h = H; a.modacc = modacc; a.ada_b = INP(5); a.norm_g = INP(6);
            a.ly = layer; a.jg_y = 1; a.jgate = 2; a.lh = layer; a.jg_h = 2; a.jshift = 3; a.jscale = 4; a.nctx = last ? 0 : NCTX; a.ypart = (const bf16_t*)YC; a.nypart = NSPLIT_OUT; a.modf = (const float*)(ws + WS_MODF);
            ROWOP_RUN(a);
        }
        SEAM(pb + 5, pb + 6);
        for (int nrep_ = 1 + REP(10), rep_ = 0; rep_ < nrep_; ++rep_) if (EN(10) && IN(pb + 6) && ((pt_cur_ = 10), true)) {
            SITE_COORDS;
            if (rep_ == 0) { if (layer == 0) { DEFER_ADA(bx - 172, 100, 184); DEFER_SLOT(bx - 172, 84, 19840, 25888); } else if (layer == 1) { DEFER_ADA(bx - 172, 184, 268); DEFER_SLOT(bx - 172, 84, 40736, 46784); } else if (layer == 2) { DEFER_ADA(bx - 172, 368, 384); DEFER_SLOT(bx - 172, 84, 66624, 72672); } else DEFER_SLOT(bx - 128, 128, 87520, DL_END); }
            pg8::Gemm g{H, (const bf16_t*)(ws + WS_WFFIN + layer * SZ_WFFIN), Mrows, FF2, D}; pg8::StaticOrder So; So.init(Mrows, FF2, D, G, bx);
            EpiSwiglu E{HID};
            pg8::gemm_phase<EpiSwiglu, pg8::StaticOrder, PG8_ALIGN, PG8_SP2>(lds, g, So, E, tid);
        }
        SEAM(pb + 6, pb + 7);
        for (int nrep_ = 1 + REP(11), rep_ = 0; rep_ < nrep_; ++rep_) if (EN(11) && IN(pb + 7) && ((pt_cur_ = 11), true)) {
            SITE_COORDS;
            if (rep_ == 0 && !last && DEFER_CVT && G == 256) MODF_FINALIZE(layer + 1, layer + 2);
            pg8::Gemm g{HID, (const bf16_t*)(ws + WS_WFFOUT + layer * SZ_WFFOUT), MTOK, D, FFH}; pg8::MixedOrder So; So.init(S, D, FFH, G, bx, 32, last ? 0 : NSPLIT_FFO);
            EpiY E{(bf16_t*)Y, D, (bf16_t*)YC};
            pg8::gemm_phase<EpiY, pg8::MixedOrder, PG8_ALIGN, PG8_SP2>(lds, g, So, E, tid);
        }
        SEAM(pb + 7, pb + 8);
        for (int nrep_ = 1 + REP(12), rep_ = 0; rep_ < nrep_; ++rep_) if (EN(12) && IN(pb + 8) && ((pt_cur_ = 12), true)) {
            SITE_COORDS;
            RowopArgs a; a.y = (const bf16_t*)Y; a.xin_lat = X; a.xin_ctx = (const float*)((const bf16_t*)X + (size_t)S * D); a.xout_lat = last ? (float*)(GAS float*)ldptr(prm, 16) : X; a.xout_ctx = last ? nullptr : (float*)((bf16_t*)X + (size_t)S * D); a.xin16 = 1; a.xout16 = last ? 0 : 1; a.h = H; a.modacc = modacc; a.ada_b = INP(5); a.norm_g = INP(6);
            a.ly = layer; a.jg_y = 3; a.jgate = 5; a.lh = last ? -1 : layer + 1; a.jg_h = 0; a.jshift = 0; a.jscale = 1; a.nctx = last ? 0 : NCTX; a.ypart = (const bf16_t*)YC; a.nypart = NSPLIT_FFO; a.modf = (const float*)(ws + WS_MODF);
            ROWOP_RUN(a);
        }
        if (!last) SEAM(pb + 8, pb + 9);
    }
    if (PT_SITE >= 0) { if (blockIdx.x == PT_BLOCK && threadIdx.x == 0) { const float us = (float)((double)pt_acc_ * 0.01); p.out[0] = 1000.0f * IDLE_Q * floorf(us / IDLE_Q + 0.5f); } }
    if (IDLE_PROBE) {
        unsigned long long* acc = (unsigned long long*)(p.ws + WS_CTL + 32768);
        if (threadIdx.x == 0) atomicAdd(acc, idle_acc_);
        xcd_barrier(bar);
        if (blockIdx.x == 0 && threadIdx.x == 0) { const unsigned long long tot = __hip_atomic_load(acc, __ATOMIC_RELAXED, __HIP_MEMORY_SCOPE_AGENT); const float us = (float)((double)tot / (double)G_k * 0.01); p.out[0] = 1000.0f * IDLE_Q * floorf(us / IDLE_Q + 0.5f); }
    }
#undef IN
#undef SEAM
}

extern "C" void kernel_launch(void* const* d_in, const int* in_sizes, int n_in, void* d_out, int out_size, void* d_ws, size_t ws_size, hipStream_t stream) {
    static int grid = 0;
    if (grid == 0) {
        if (n_in != 16 || out_size != S * D || ws_size < WS_END) { fprintf(stderr, "kernel_launch: unexpected shapes (n_in %d out %d ws %zu need %zu)\n", n_in, out_size, ws_size, (size_t)WS_END); grid = -1; return; }
        int dev = 0, cus = 0, per_cu = 0;
        if (hipGetDevice(&dev) != hipSuccess || hipDeviceGetAttribute(&cus, hipDeviceAttributeMultiprocessorCount, dev) != hipSuccess) { grid = -1; return; }
        if (hipFuncSetAttribute((const void*)mega_fwd, hipFuncAttributeMaxDynamicSharedMemorySize, LDS_BYTES) != hipSuccess) { fprintf(stderr, "kernel_launch: hipFuncSetAttribute failed\n"); grid = -1; return; }
        if (hipOccupancyMaxActiveBlocksPerMultiprocessor(&per_cu, (const void*)mega_fwd, 512, LDS_BYTES) != hipSuccess || per_cu < 1) fprintf(stderr, "kernel_launch: occupancy query says %d\n", per_cu);
        (void)hipGetLastError();
        grid = cus;
    }
    if (grid < 0) return;
    if (hipMemsetAsync((char*)d_ws + WS_CTL, 0, CTL_ZERO_BYTES, stream) != hipSuccess) { fprintf(stderr, "kernel_launch: memset failed\n"); return; }
    Params a{};
    for (int i = 0; i < 16; ++i) a.in[i] = (const float*)d_in[i];
    a.out = (float*)d_out; a.ws = (unsigned char*)d_ws; a.pad = 0;
#if MK_MODE == 1
    a.ph_lo = 0; a.ph_hi = NPHASE; a.li = 0;
    hipLaunchKernelGGL(mega_fwd, dim3(grid), dim3(512), LDS_BYTES, stream, a);
#else
    for (int ph = 0; ph < NPHASE; ++ph) {
        if (ph >= 2) { const int layer = (ph - 2) / 9, slot = (ph - 2) % 9; if ((layer & 1) && (slot == 2 || slot == 3)) continue; }
        a.ph_lo = ph; a.ph_hi = ph + 1; a.li = 0;
        hipLaunchKernelGGL(mega_fwd, dim3(grid), dim3(512), LDS_BYTES, stream, a);
    }
#endif
    const hipError_t le = hipPeekAtLastError();
    if (le != hipSuccess) fprintf(stderr, "kernel_launch: launch failed: %s\n", hipGetErrorName(le));
}
#endif
```

```cpp
#ifndef HOST_EMU
#include <hip/hip_runtime.h>
#include <cstdio>
#include <cstdint>
#define DEV __device__ __forceinline__
#define HDEV __host__ __device__ __forceinline__
#define LAS __attribute__((address_space(3)))
#define GAS __attribute__((address_space(1)))
#endif

typedef unsigned short bf16_t;
typedef short bf16x8 __attribute__((ext_vector_type(8)));
typedef float f32x4 __attribute__((ext_vector_type(4)));
typedef float f32x2 __attribute__((ext_vector_type(2)));
typedef unsigned u32x4 __attribute__((ext_vector_type(4)));
typedef unsigned u32x2 __attribute__((ext_vector_type(2)));

#ifndef HOST_EMU
#define SCHED_FENCE() __builtin_amdgcn_sched_barrier(0)
DEV f32x4 mfma16(bf16x8 a, bf16x8 b, f32x4 c) { return __builtin_amdgcn_mfma_f32_16x16x32_bf16(a, b, c, 0, 0, 0); }
DEV float shfl_xor_f(float v, int m) { return __shfl_xor(v, m); }
DEV unsigned cvt_pk_bf16(float lo, float hi) { unsigned r; asm("v_cvt_pk_bf16_f32 %0, %1, %2" : "=v"(r) : "v"(lo), "v"(hi)); return r; }
DEV float ex2(float x) { return __builtin_amdgcn_exp2f(x); }
DEV float rcp_f(float x) { return __builtin_amdgcn_rcpf(x); }
DEV float rsq_f(float x) { return 1.0f / sqrtf(x); }
DEV void atomic_add_f(float* p, float v) { (void)__hip_atomic_fetch_add(p, v, __ATOMIC_RELAXED, __HIP_MEMORY_SCOPE_AGENT); }
#endif

namespace cfg {
constexpr int D = 2048, S = 8192, NCTX = 256, MTOK = 8448, DEPTH = 4;
constexpr int ABIN = 7168, FFH = 5632, FF2 = 11264, QKV = 6144;
constexpr int NCHUNK = 66;
constexpr float EPS = 1e-6f;
constexpr float HSCALE = 0.08838834764831845f;
constexpr float LOG2E = 1.4426950408889634f;
}
using namespace cfg;

DEV float bf_lo(unsigned w) { return __builtin_bit_cast(float, w << 16); }
DEV float bf_hi(unsigned w) { return __builtin_bit_cast(float, w & 0xffff0000u); }
DEV float wave_sum(float v) {
#pragma unroll
    for (int o = 1; o < 64; o <<= 1) v += shfl_xor_f(v, o);
    return v;
}
DEV float silu_f(float x) { return x * rcp_f(1.0f + ex2(-x * LOG2E)); }
DEV float lg2gamma(const float* decay_exp, int iab, int dir, int head) {
    const float e = decay_exp[(iab * 2 + dir) * 8 + head];
    return log1pf(-exp2f(-e)) * LOG2E;
}
DEV bf16x8 extract8(const u32x4 (&vd)[8], int mt) {
    u32x4 w;
#pragma unroll
    for (int q = 0; q < 4; ++q) {
        const unsigned X = vd[2 * q][mt >> 1], Y = vd[2 * q + 1][mt >> 1];
        w[q] = (mt & 1) ? ((X >> 16) | (Y & 0xffff0000u)) : ((X & 0xffffu) | (Y << 16));
    }
    return __builtin_bit_cast(bf16x8, w);
}

struct RowopArgs {
    const bf16_t* y;
    const float* xin_lat; const float* xin_ctx;
    float* xout_lat; float* xout_ctx;
    bf16_t* h;
    const float* modacc; const float* ada_b; const float* norm_g;
    const float* modf;
    int ly, jg_y, jgate, lh, jg_h, jshift, jscale, nctx;
    int xin16, xout16;
    const bf16_t* ypart; int nypart;
};
DEV f32x4 ld4(const float* p) { return *(const f32x4*)p; }
constexpr int MODPART = 4 * 2 * 6 * 2048;
DEV f32x4 modvec_partials(const float* modacc, const float* ada_b, int l, int s, int j, int col) {
    const float* q = modacc + (size_t)((l * 2 + s) * 6 + j) * D + col;
    f32x4 r = ld4(ada_b + (size_t)l * 6 * D + j * D + col);
#pragma unroll
    for (int kp = 0; kp < 16; ++kp) r = r + ld4(q + (size_t)kp * MODPART);
    return r;
}
DEV f32x4 modvec(const RowopArgs& a, int l, int s, int j, int col) {
    if (a.modf) return ld4(a.modf + (size_t)((l * 2 + s) * 6 + j) * D + col);
    return modvec_partials(a.modacc, a.ada_b, l, s, j, col);
}
template <class CP>
DEV void rowop_coefs(const RowopArgs& a, const int s, CP coef, const int tid) {
    const int col = 4 * tid;
    f32x4 A = (f32x4){0.f, 0.f, 0.f, 0.f}, B = A, SH = A;
    if (a.ly >= 0) A = modvec(a, a.ly, s, a.jgate, col) * ld4(a.norm_g + (size_t)(a.ly * 4 + a.jg_y) * D + col);
    if (a.lh >= 0) { B = ld4(a.norm_g + (size_t)(a.lh * 4 + a.jg_h) * D + col) * (modvec(a, a.lh, s, a.jscale, col) + 1.0f); SH = modvec(a, a.lh, s, a.jshift, col); }
    *(f32x4*)(coef + col) = A; *(f32x4*)(coef + D + col) = B; *(f32x4*)(coef + 2 * D + col) = SH;
}
template <class CP>
DEV void rowop_row(const RowopArgs& a, const int s, CP coef, const int m, f32x4 (&x)[8], const f32x4 (&y)[8], const int lane) {
    const bool hasy = a.ly >= 0, hash = a.lh >= 0;
    if (hasy) {
        float ss = 0.f;
#pragma unroll
        for (int j = 0; j < 8; ++j) ss += (y[j][0] * y[j][0] + y[j][1] * y[j][1]) + (y[j][2] * y[j][2] + y[j][3] * y[j][3]);
        const float r1 = rsq_f(wave_sum(ss) * (1.0f / D) + EPS);
#pragma unroll
        for (int j = 0; j < 8; ++j) x[j] = x[j] + *(const f32x4*)(coef + 4 * lane + 256 * j) * (y[j] * r1);
    }
    float* xb = (s == 0) ? a.xout_lat : a.xout_ctx; const size_t xrow = (size_t)((s == 0) ? m : m - S) * D;
    if (xb) {
        if (a.xout16) { bf16_t* xo = (bf16_t*)xb + xrow;
#pragma unroll
            for (int j = 0; j < 8; ++j) { u32x2 w; w[0] = cvt_pk_bf16(x[j][0], x[j][1]); w[1] = cvt_pk_bf16(x[j][2], x[j][3]); __builtin_nontemporal_store(w, (u32x2*)(xo + 4 * lane + 256 * j)); }
        } else { float* xo = xb + xrow;
#pragma unroll
            for (int j = 0; j < 8; ++j) __builtin_nontemporal_store(x[j], (f32x4*)(xo + 4 * lane + 256 * j));
        }
    }
    if (hash) {
        float ss = 0.f;
#pragma unroll
        for (int j = 0; j < 8; ++j) ss += (x[j][0] * x[j][0] + x[j][1] * x[j][1]) + (x[j][2] * x[j][2] + x[j][3] * x[j][3]);
        const float r2 = rsq_f(wave_sum(ss) * (1.0f / D) + EPS);
        bf16_t* hr = a.h + (size_t)m * D;
#pragma unroll
        for (int j = 0; j < 8; ++j) { const f32x4 v = (x[j] * r2) * *(const f32x4*)(coef + D + 4 * lane + 256 * j) + *(const f32x4*)(coef + 2 * D + 4 * lane + 256 * j);
            u32x2 w; w[0] = cvt_pk_bf16(v[0], v[1]); w[1] = cvt_pk_bf16(v[2], v[3]); __builtin_nontemporal_store(w, (u32x2*)(hr + 4 * lane + 256 * j)); }
    }
}
template <class CP>
DEV void rowop_stream(const RowopArgs& a, CP coef, const int gw, const int NGW, const int lane) {
    for (int m = gw; m < S; m += NGW) {
        f32x4 x[8], y[8];
        if (a.xin16) { const bf16_t* xr = (const bf16_t*)a.xin_lat + (size_t)m * D;
#pragma unroll
            for (int j = 0; j < 8; ++j) { const u32x2 w = __builtin_nontemporal_load((const u32x2*)(xr + 4 * lane + 256 * j)); x[j] = (f32x4){bf_lo(w[0]), bf_hi(w[0]), bf_lo(w[1]), bf_hi(w[1])}; }
        } else { const float* xr = a.xin_lat + (size_t)m * D;
#pragma unroll
            for (int j = 0; j < 8; ++j) x[j] = __builtin_nontemporal_load((const f32x4*)(xr + 4 * lane + 256 * j));
        }
#pragma unroll
        for (int j = 0; j < 8; ++j) y[j] = (f32x4){0.f, 0.f, 0.f, 0.f};
        if (a.ly >= 0) { const bf16_t* yr = a.y + (size_t)m * D;
#pragma unroll
            for (int j = 0; j < 8; ++j) { const u32x2 w = __builtin_nontemporal_load((const u32x2*)(yr + 4 * lane + 256 * j)); y[j] = (f32x4){bf_lo(w[0]), bf_hi(w[0]), bf_lo(w[1]), bf_hi(w[1])}; } }
        rowop_row(a, 0, coef, m, x, y, lane);
    }
}
#ifndef HOST_EMU
template <class CP, class LP>
DEV void rowop_ctx(const RowopArgs& a, CP coef, LP red, const int vcu, const int G, const int wave, const int lane) {
    const bool hasy = a.ly >= 0, hash = a.lh >= 0;
    for (int r = vcu; r < a.nctx; r += G) {
        const int col = 256 * wave + 4 * lane;
        f32x4 x;
        if (a.xin16) { const u32x2 w = *(const u32x2*)((const bf16_t*)a.xin_ctx + (size_t)r * D + col); x = (f32x4){bf_lo(w[0]), bf_hi(w[0]), bf_lo(w[1]), bf_hi(w[1])}; }
        else x = ld4(a.xin_ctx + (size_t)r * D + col);
        if (hasy) {
            const bf16_t* yp = a.ypart + (size_t)r * D + col;
            f32x4 y = (f32x4){0.f, 0.f, 0.f, 0.f};
#pragma unroll 11
            for (int pp = 0; pp < a.nypart; ++pp) { const u32x2 w = *(const u32x2*)(yp + (size_t)pp * 256 * D); y = y + (f32x4){bf_lo(w[0]), bf_hi(w[0]), bf_lo(w[1]), bf_hi(w[1])}; }
            const float ss = wave_sum((y[0] * y[0] + y[1] * y[1]) + (y[2] * y[2] + y[3] * y[3]));
            if (lane == 0) red[wave] = ss;
            __syncthreads();
            float tot = 0.f;
#pragma unroll
            for (int w8 = 0; w8 < 8; ++w8) tot += red[w8];
            const float r1 = rsq_f(tot * (1.0f / D) + EPS);
            x = x + *(const f32x4*)(coef + col) * (y * r1);
        }
        if (a.xout_ctx) { if (a.xout16) { u32x2 w; w[0] = cvt_pk_bf16(x[0], x[1]); w[1] = cvt_pk_bf16(x[2], x[3]); *(u32x2*)((bf16_t*)a.xout_ctx + (size_t)r * D + col) = w; } else *(f32x4*)(a.xout_ctx + (size_t)r * D + col) = x; }
        if (hash) {
            const float ss = wave_sum((x[0] * x[0] + x[1] * x[1]) + (x[2] * x[2] + x[3] * x[3]));
            if (lane == 0) red[16 + wave] = ss;
            __syncthreads();
            float tot = 0.f;
#pragma unroll
            for (int w8 = 0; w8 < 8; ++w8) tot += red[16 + w8];
            const float r2 = rsq_f(tot * (1.0f / D) + EPS);
            const f32x4 v = (x * r2) * *(const f32x4*)(coef + D + col) + *(const f32x4*)(coef + 2 * D + col);
            u32x2 w; w[0] = cvt_pk_bf16(v[0], v[1]); w[1] = cvt_pk_bf16(v[2], v[3]); *(u32x2*)(a.h + (size_t)(S + r) * D + col) = w;
        }
        __syncthreads();
    }
}
#endif

DEV void conv_loadz(const bf16_t* P, int t, int c, float (&z)[8]) {
    const u32x4 cg = *(const u32x4*)(P + (size_t)t * ABIN + 1024 + c), u = *(const u32x4*)(P + (size_t)t * ABIN + 2048 + c);
#pragma unroll
    for (int e = 0; e < 4; ++e) { z[2 * e] = bf_lo(cg[e]) * bf_lo(u[e]); z[2 * e + 1] = bf_hi(cg[e]) * bf_hi(u[e]); }
}
DEV void conv_task(const bf16_t* P, bf16_t* YAB, const float* convw, int task, int lane) {
    const int half = task & 1, t0 = (task >> 1) * 8, c = half * 512 + lane * 8;
    u32x4 cgv[10], uv[10], bgv[8];
#pragma unroll
    for (int k = 0; k < 10; ++k) {
        const int t = t0 - 1 + k;
        const bool ok = !((k == 0 && (t0 == 0 || t0 == S)) || (k == 9 && (t0 + 8 == S || t0 + 8 == MTOK)));
        const int tt = ok ? t : t0;
        cgv[k] = *(const u32x4*)(P + (size_t)tt * ABIN + 1024 + c); uv[k] = *(const u32x4*)(P + (size_t)tt * ABIN + 2048 + c);
        if (!ok) { cgv[k] = (u32x4){0u, 0u, 0u, 0u}; }
    }
#pragma unroll
    for (int k = 0; k < 8; ++k) bgv[k] = *(const u32x4*)(P + (size_t)(t0 + k) * ABIN + c);
    float w0[8], w1[8], w2[8];
#pragma unroll
    for (int e = 0; e < 8; ++e) { w0[e] = convw[c + e]; w1[e] = convw[1024 + c + e]; w2[e] = convw[2048 + c + e]; }
#pragma unroll
    for (int k = 0; k < 8; ++k) {
        float o[8];
#pragma unroll
        for (int e = 0; e < 8; ++e) {
            const int d = e >> 1;
            const float zp = (e & 1) ? bf_hi(cgv[k][d]) * bf_hi(uv[k][d]) : bf_lo(cgv[k][d]) * bf_lo(uv[k][d]);
            const float zc = (e & 1) ? bf_hi(cgv[k + 1][d]) * bf_hi(uv[k + 1][d]) : bf_lo(cgv[k + 1][d]) * bf_lo(uv[k + 1][d]);
            const float zn = (e & 1) ? bf_hi(cgv[k + 2][d]) * bf_hi(uv[k + 2][d]) : bf_lo(cgv[k + 2][d]) * bf_lo(uv[k + 2][d]);
            const float b = (e & 1) ? bf_hi(bgv[k][d]) : bf_lo(bgv[k][d]);
            o[e] = b * (w0[e] * zp + w1[e] * zc + w2[e] * zn);
        }
        u32x4 w; w[0] = cvt_pk_bf16(o[0], o[1]); w[1] = cvt_pk_bf16(o[2], o[3]); w[2] = cvt_pk_bf16(o[4], o[5]); w[3] = cvt_pk_bf16(o[6], o[7]);
        *(u32x4*)(YAB + (size_t)(t0 + k) * D + c) = w;
    }
}

DEV int chunk_row(int cidx) { return cidx < 2 ? S + 128 * cidx : 128 * (cidx - 2); }
DEV void r1_task(const bf16_t* P, float* KVt, float lg2, int cidx, int head, int dir, int quad, int lane) {
    const int i = lane & 15, g = lane >> 4;
    const int dk0 = 64 * (quad >> 1), dv0 = 64 * (quad & 1);
    const bf16_t* Kp = P + (size_t)chunk_row(cidx) * ABIN + 4096 + head * 128 + dk0 + 4 * i;
    const bf16_t* Vp = P + (size_t)chunk_row(cidx) * ABIN + 5120 + head * 128 + dv0 + 4 * i;
    f32x4 acc[4][4];
#pragma unroll
    for (int a = 0; a < 4; ++a)
#pragma unroll
        for (int b = 0; b < 4; ++b) acc[a][b] = (f32x4){0.f, 0.f, 0.f, 0.f};
#pragma unroll 1
    for (int s = 0; s < 4; ++s) {
        u32x2 kd[8], vd[8]; float w[8];
#pragma unroll
        for (int jj = 0; jj < 8; ++jj) {
            const int tj = 32 * s + 8 * g + jj;
            kd[jj] = *(const u32x2*)(Kp + (size_t)tj * ABIN); vd[jj] = *(const u32x2*)(Vp + (size_t)tj * ABIN);
            w[jj] = ex2(lg2 * (float)(dir == 0 ? 127 - tj : tj));
        }
        bf16x8 af[4], bfr[4];
#pragma unroll
        for (int mt = 0; mt < 4; ++mt) {
            u32x4 wd;
#pragma unroll
            for (int q = 0; q < 4; ++q) {
                const unsigned X = kd[2 * q][mt >> 1], Y = kd[2 * q + 1][mt >> 1];
                const float lo = ((mt & 1) ? bf_hi(X) : bf_lo(X)) * w[2 * q], hi = ((mt & 1) ? bf_hi(Y) : bf_lo(Y)) * w[2 * q + 1];
                wd[q] = cvt_pk_bf16(lo, hi);
            }
            af[mt] = __builtin_bit_cast(bf16x8, wd);
        }
#pragma unroll
        for (int nt = 0; nt < 4; ++nt) {
            u32x4 wd;
#pragma unroll
            for (int q = 0; q < 4; ++q) {
                const unsigned X = vd[2 * q][nt >> 1], Y = vd[2 * q + 1][nt >> 1];
                wd[q] = (nt & 1) ? ((X >> 16) | (Y & 0xffff0000u)) : ((X & 0xffffu) | (Y << 16));
            }
            bfr[nt] = __builtin_bit_cast(bf16x8, wd);
        }
#pragma unroll
        for (int mt = 0; mt < 4; ++mt)
#pragma unroll
            for (int nt = 0; nt < 4; ++nt) acc[mt][nt] = mfma16(af[mt], bfr[nt], acc[mt][nt]);
    }
    float* out = KVt + ((((size_t)cidx * 8 + head) * 2 + dir) * 128) * 128;
#pragma unroll
    for (int nt = 0; nt < 4; ++nt)
#pragma unroll
        for (int reg = 0; reg < 4; ++reg) {
            const int dv = dv0 + 4 * i + nt, dk = dk0 + 16 * g + 4 * reg;
            *(f32x4*)(out + (size_t)dv * 128 + dk) = (f32x4){acc[0][nt][reg], acc[1][nt][reg], acc[2][nt][reg], acc[3][nt][reg]};
        }
}
DEV void r2_item(const bf16_t* KVt, bf16_t* St, const float* decay_exp, int iab, int item) {
    const int hd = __builtin_amdgcn_readfirstlane(item >> 13), e = (item & 8191) * 2, head = hd >> 1, dir = hd & 1;
    const float cd = exp2f(128.0f * lg2gamma(decay_exp, iab, dir, head));
    float s0 = 0.f, s1 = 0.f;
    unsigned kv[66];
#pragma unroll
    for (int k = 0; k < 66; ++k) { const int c = dir == 0 ? k : (k < 2 ? 1 - k : 67 - k); kv[k] = *(const unsigned*)(KVt + (((size_t)c * 8 + head) * 2 + dir) * 16384 + e); }
#pragma unroll
    for (int k = 0; k < 66; ++k) { const int c = dir == 0 ? k : (k < 2 ? 1 - k : 67 - k);
        __builtin_nontemporal_store(cvt_pk_bf16(s0, s1), (unsigned*)(St + (((size_t)c * 8 + head) * 2 + dir) * 16384 + e));
        s0 = s0 * cd + bf_lo(kv[k]); s1 = s1 * cd + bf_hi(kv[k]); }
}
DEV void r3_task(const bf16_t* P, const bf16_t* St, bf16_t* YAB, float lg2f, float lg2b, int cidx, int head, int qb, int lane) {
    const int i = lane & 15, g = lane >> 4, qi = 16 * qb + i, rowbase = chunk_row(cidx);
    const bf16_t* Prow = P + (size_t)rowbase * ABIN;
    bf16x8 qf[4];
#pragma unroll
    for (int s = 0; s < 4; ++s) qf[s] = *(const bf16x8*)(Prow + (size_t)qi * ABIN + 3072 + head * 128 + 32 * s + 8 * g);
    f32x4 sacc[8];
#pragma unroll
    for (int mt = 0; mt < 8; ++mt) {
        f32x4 a = (f32x4){0.f, 0.f, 0.f, 0.f};
#pragma unroll
        for (int s = 0; s < 4; ++s) { const bf16x8 kf = *(const bf16x8*)(Prow + (size_t)(16 * mt + i) * ABIN + 4096 + head * 128 + 32 * s + 8 * g); a = mfma16(kf, qf[s], a); }
        sacc[mt] = a;
    }
#pragma unroll
    for (int mt = 0; mt < 8; ++mt)
#pragma unroll
        for (int reg = 0; reg < 4; ++reg) {
            const int diff = qi - (16 * mt + 4 * g + reg);
            const float d = diff > 0 ? ex2((float)diff * lg2f) : (diff < 0 ? ex2((float)(-diff) * lg2b) : 2.0f);
            sacc[mt][reg] *= d;
        }
    bf16x8 pf[4];
#pragma unroll
    for (int s = 0; s < 4; ++s) {
        u32x4 w; w[0] = cvt_pk_bf16(sacc[2 * s][0], sacc[2 * s][1]); w[1] = cvt_pk_bf16(sacc[2 * s][2], sacc[2 * s][3]);
        w[2] = cvt_pk_bf16(sacc[2 * s + 1][0], sacc[2 * s + 1][1]); w[3] = cvt_pk_bf16(sacc[2 * s + 1][2], sacc[2 * s + 1][3]);
        pf[s] = __builtin_bit_cast(bf16x8, w);
    }
    f32x4 oacc[8];
#pragma unroll
    for (int mt = 0; mt < 8; ++mt) oacc[mt] = (f32x4){0.f, 0.f, 0.f, 0.f};
#pragma unroll
    for (int s = 0; s < 4; ++s) {
        u32x4 vd[8];
#pragma unroll
        for (int jj = 0; jj < 8; ++jj) { const int key = 32 * s + (jj < 4 ? 4 * g + jj : 16 + 4 * g + jj - 4); vd[jj] = *(const u32x4*)(Prow + (size_t)key * ABIN + 5120 + head * 128 + 8 * i); }
#pragma unroll
        for (int mt = 0; mt < 8; ++mt) oacc[mt] = mfma16(extract8(vd, mt), pf[s], oacc[mt]);
    }
#pragma unroll
    for (int dir = 0; dir < 2; ++dir) {
        f32x4 tacc[8];
#pragma unroll
        for (int mt = 0; mt < 8; ++mt) tacc[mt] = (f32x4){0.f, 0.f, 0.f, 0.f};
        const bf16_t* Sp = St + ((((size_t)cidx * 8 + head) * 2 + dir) * 128) * 128;
#pragma unroll
        for (int s = 0; s < 4; ++s)
#pragma unroll
            for (int mt = 0; mt < 8; ++mt) { const bf16x8 sf = *(const bf16x8*)(Sp + (size_t)(8 * i + mt) * 128 + 32 * s + 8 * g); tacc[mt] = mfma16(sf, qf[s], tacc[mt]); }
        const float qd = dir == 0 ? ex2((float)(qi + 1) * lg2f) : ex2((float)(128 - qi) * lg2b);
#pragma unroll
        for (int mt = 0; mt < 8; ++mt) oacc[mt] = oacc[mt] + tacc[mt] * qd;
    }
    float ss = 0.f;
#pragma unroll
    for (int mt = 0; mt < 8; ++mt) ss += (oacc[mt][0] * oacc[mt][0] + oacc[mt][1] * oacc[mt][1]) + (oacc[mt][2] * oacc[mt][2] + oacc[mt][3] * oacc[mt][3]);
    ss += shfl_xor_f(ss, 16); ss += shfl_xor_f(ss, 32);
    const float rinv = rsq_f(ss * (1.0f / 128.0f) + EPS);
#pragma unroll
    for (int reg = 0; reg < 4; ++reg) {
        const int dvb = 32 * g + 8 * reg;
        const u32x4 gt = *(const u32x4*)(Prow + (size_t)qi * ABIN + 6144 + head * 128 + dvb);
        float o[8];
#pragma unroll
        for (int mt = 0; mt < 8; ++mt) { const float gv = (mt & 1) ? bf_hi(gt[mt >> 1]) : bf_lo(gt[mt >> 1]); o[mt] = silu_f(gv) * (oacc[mt][reg] * rinv); }
        u32x4 w; w[0] = cvt_pk_bf16(o[0], o[1]); w[1] = cvt_pk_bf16(o[2], o[3]); w[2] = cvt_pk_bf16(o[4], o[5]); w[3] = cvt_pk_bf16(o[6], o[7]);
        *(u32x4*)(YAB + (size_t)(rowbase + qi) * D + 1024 + head * 128 + dvb) = w;
    }
}

struct AttnTile { bf16x8 qf[4]; f32x4 oacc[8]; float m_run, l_run; };
DEV void attn_tile_init(AttnTile& t, const bf16_t* P, int qtok, int h, int g) {
#pragma unroll
    for (int s = 0; s < 4; ++s) t.qf[s] = *(const bf16x8*)(P + (size_t)qtok * QKV + h * 128 + 32 * s + 8 * g);
#pragma unroll
    for (int mt = 0; mt < 8; ++mt) t.oacc[mt] = (f32x4){0.f, 0.f, 0.f, 0.f};
    t.m_run = -5e29f; t.l_run = 0.f;
}
template <class RP>
DEV void attn_tile_step(AttnTile& t, f32x4 (&sa)[2], const u32x4 (&vd)[8], const bool win, const bool rowok, RP rpbrow, const int kc0, const int c, const int sc, const int g) {
    float bm = -1e30f;
#pragma unroll
    for (int mt = 0; mt < 2; ++mt)
#pragma unroll
        for (int reg = 0; reg < 4; ++reg) {
            float v = sa[mt][reg] * HSCALE;
            if (win) {
                const int kcol = kc0 + 16 * mt + 4 * g + reg;
                const bool valid = rowok && kcol >= sc && kcol < sc + 16;
                const float bias = rpbrow[valid ? kcol - c + 15 : 0];
                v = valid ? v + bias : -1e30f;
            }
            sa[mt][reg] = v; bm = fmaxf(bm, v);
        }
    bm = fmaxf(bm, shfl_xor_f(bm, 16)); bm = fmaxf(bm, shfl_xor_f(bm, 32));
    const float m_new = fmaxf(t.m_run, bm);
    const float alpha = ex2((t.m_run - m_new) * LOG2E);
    t.m_run = m_new;
    float ps = 0.f;
#pragma unroll
    for (int mt = 0; mt < 2; ++mt)
#pragma unroll
        for (int reg = 0; reg < 4; ++reg) { const float pv = ex2((sa[mt][reg] - m_new) * LOG2E); sa[mt][reg] = pv; ps += pv; }
    t.l_run = t.l_run * alpha + ps;
#pragma unroll
    for (int mt = 0; mt < 8; ++mt) t.oacc[mt] = t.oacc[mt] * alpha;
    u32x4 pw; pw[0] = cvt_pk_bf16(sa[0][0], sa[0][1]); pw[1] = cvt_pk_bf16(sa[0][2], sa[0][3]); pw[2] = cvt_pk_bf16(sa[1][0], sa[1][1]); pw[3] = cvt_pk_bf16(sa[1][2], sa[1][3]);
    const bf16x8 pf = __builtin_bit_cast(bf16x8, pw);
#pragma unroll
    for (int mt = 0; mt < 8; ++mt) t.oacc[mt] = mfma16(extract8(vd, mt), pf, t.oacc[mt]);
}
template <class RP>
DEV bf16x8 attn_tile_soft(AttnTile& t, f32x4 (&sa)[2], const bool win, const bool rowok, RP rpbrow, const int kc0, const int c, const int sc, const int g) {
    float bm = -1e30f;
#pragma unroll
    for (int mt = 0; mt < 2; ++mt)
#pragma unroll
        for (int reg = 0; reg < 4; ++reg) {
            float v = sa[mt][reg] * HSCALE;
            if (win) {
                const int kcol = kc0 + 16 * mt + 4 * g + reg;
                const bool valid = rowok && kcol >= sc && kcol < sc + 16;
                const float bias = rpbrow[valid ? kcol - c + 15 : 0];
                v = valid ? v + bias : -1e30f;
            }
            sa[mt][reg] = v; bm = fmaxf(bm, v);
        }
    bm = fmaxf(bm, shfl_xor_f(bm, 16)); bm = fmaxf(bm, shfl_xor_f(bm, 32));
    const float m_new = fmaxf(t.m_run, bm);
    const float alpha = ex2((t.m_run - m_new) * LOG2E);
    t.m_run = m_new;
    float ps = 0.f;
#pragma unroll
    for (int mt = 0; mt < 2; ++mt)
#pragma unroll
        for (int reg = 0; reg < 4; ++reg) { const float pv = ex2((sa[mt][reg] - m_new) * LOG2E); sa[mt][reg] = pv; ps += pv; }
    t.l_run = t.l_run * alpha + ps;
#pragma unroll
    for (int mt = 0; mt < 8; ++mt) t.oacc[mt] = t.oacc[mt] * alpha;
    u32x4 pw; pw[0] = cvt_pk_bf16(sa[0][0], sa[0][1]); pw[1] = cvt_pk_bf16(sa[0][2], sa[0][3]); pw[2] = cvt_pk_bf16(sa[1][0], sa[1][1]); pw[3] = cvt_pk_bf16(sa[1][2], sa[1][3]);
    return __builtin_bit_cast(bf16x8, pw);
}
DEV void attn_tile_store(AttnTile& t, bf16_t* YAB, int qtok, int h, int g) {
    float l = t.l_run; l += shfl_xor_f(l, 16); l += shfl_xor_f(l, 32);
    const float inv = 1.0f / l;
#pragma unroll
    for (int reg = 0; reg < 4; ++reg) {
        const int dvb = 32 * g + 8 * reg;
        u32x4 w;
#pragma unroll
        for (int q = 0; q < 4; ++q) w[q] = cvt_pk_bf16(t.oacc[2 * q][reg] * inv, t.oacc[2 * q + 1][reg] * inv);
        *(u32x4*)(YAB + (size_t)qtok * D + h * 128 + dvb) = w;
    }
}
DEV void attn_scores2(const bf16_t* P, int kb, int h, int i, int g, const AttnTile& ta, const AttnTile& tb, const bool doA, const bool doB, f32x4 (&saA)[2], f32x4 (&saB)[2], u32x4 (&vd)[8]) {
#pragma unroll
    for (int jj = 0; jj < 8; ++jj) { const int key = kb + (jj < 4 ? 4 * g + jj : 16 + 4 * g + jj - 4); vd[jj] = *(const u32x4*)(P + (size_t)key * QKV + 4096 + h * 128 + 8 * i); }
#pragma unroll
    for (int mt = 0; mt < 2; ++mt) {
        bf16x8 kf[4];
#pragma unroll
        for (int s = 0; s < 4; ++s) kf[s] = *(const bf16x8*)(P + (size_t)(kb + 16 * mt + i) * QKV + 2048 + h * 128 + 32 * s + 8 * g);
        f32x4 a = (f32x4){0.f, 0.f, 0.f, 0.f}, b = a;
        if (doA) {
#pragma unroll
            for (int s = 0; s < 4; ++s) a = mfma16(kf[s], ta.qf[s], a);
        }
        if (doB) {
#pragma unroll
            for (int s = 0; s < 4; ++s) b = mfma16(kf[s], tb.qf[s], b);
        }
        saA[mt] = a; saB[mt] = b;
        SCHED_FENCE();
    }
}
template <bool WIN>
DEV void attn_task2(const bf16_t* P, bf16_t* YAB, const float* rpb, int h, int qtokA0, int qtokB0, int rA, int c0, int kc0, int lane) {
    const int i = lane & 15, g = lane >> 4;
    AttnTile ta, tb;
    attn_tile_init(ta, P, qtokA0 + i, h, g); attn_tile_init(tb, P, qtokB0 + i, h, g);
    const int c = c0 + i, sc = c - 8 < 0 ? 0 : (c - 8 > 48 ? 48 : c - 8);
    if (WIN) {
        const int rB = rA + 1;
        const int srA = rA - 4 < 0 ? 0 : (rA - 4 > 120 ? 120 : rA - 4), srB = rB - 4 < 0 ? 0 : (rB - 4 > 120 ? 120 : rB - 4);
        for (int kr = srA; kr < srB + 8; ++kr) {
            f32x4 saA[2], saB[2]; u32x4 vd[8];
            const bool doA = kr < srA + 8, doB = kr >= srB;
            attn_scores2(P, kr * 64 + kc0, h, i, g, ta, tb, doA, doB, saA, saB, vd);
            if (doA) attn_tile_step(ta, saA, vd, true, true, rpb + (h * 15 + (kr - rA + 7)) * 31, kc0, c, sc, g);
            if (doB) attn_tile_step(tb, saB, vd, true, true, rpb + (h * 15 + (kr - rB + 7)) * 31, kc0, c, sc, g);
        }
    }
    for (int b = 0; b < 8; ++b) {
        f32x4 saA[2], saB[2]; u32x4 vd[8];
        attn_scores2(P, S + 32 * b, h, i, g, ta, tb, true, true, saA, saB, vd);
        attn_tile_step(ta, saA, vd, false, true, rpb, 0, 0, 0, g);
        attn_tile_step(tb, saB, vd, false, true, rpb, 0, 0, 0, g);
    }
    attn_tile_store(ta, YAB, qtokA0 + i, h, g); attn_tile_store(tb, YAB, qtokB0 + i, h, g);
}

struct Unit { int pm, pn, ks, nt, kofs; };
struct EpiY {
    static constexpr bool PERM = true, AFTER_DRAIN = false;
    bf16_t* Yb; int ldc; bf16_t* Cpart;
    DEV void operator()(const f32x4 (&acc)[2][2][4][2], const Unit& u, int wr, int wc, int fr, int fq) const {
        bf16_t* base = u.ks >= 0 ? Cpart + (size_t)u.ks * 256 * ldc : Yb + (size_t)u.pm * 256 * ldc;
        base += (size_t)(wr * 64 + fr) * ldc + u.pn * 256 + wc * 32 + 8 * fq;
#pragma unroll
        for (int ai = 0; ai < 2; ++ai)
#pragma unroll
            for (int m = 0; m < 4; ++m) { bf16_t* rowp = base + (size_t)(ai * 128 + m * 16) * ldc;
#pragma unroll
                for (int bj = 0; bj < 2; ++bj) { const f32x4 v0 = acc[ai][bj][m][0], v1 = acc[ai][bj][m][1];
                    u32x4 w; w[0] = cvt_pk_bf16(v0[0], v0[1]); w[1] = cvt_pk_bf16(v0[2], v0[3]); w[2] = cvt_pk_bf16(v1[0], v1[1]); w[3] = cvt_pk_bf16(v1[2], v1[3]);
                    *(u32x4*)(rowp + bj * 128) = w; } }
    }
};
struct EpiBf16 {
    static constexpr bool PERM = true, AFTER_DRAIN = false;
    bf16_t* O; int ldc;
    DEV void operator()(const f32x4 (&acc)[2][2][4][2], const Unit& u, int wr, int wc, int fr, int fq) const {
        const int row0 = u.pm * 256 + wr * 64 + fr, col0 = u.pn * 256 + wc * 32 + 8 * fq;
#pragma unroll
        for (int ai = 0; ai < 2; ++ai)
#pragma unroll
            for (int m = 0; m < 4; ++m) { bf16_t* rowp = O + (size_t)(row0 + ai * 128 + m * 16) * ldc + col0;
#pragma unroll
                for (int bj = 0; bj < 2; ++bj) { const f32x4 v0 = acc[ai][bj][m][0], v1 = acc[ai][bj][m][1];
                    u32x4 w; w[0] = cvt_pk_bf16(v0[0], v0[1]); w[1] = cvt_pk_bf16(v0[2], v0[3]); w[2] = cvt_pk_bf16(v1[0], v1[1]); w[3] = cvt_pk_bf16(v1[2], v1[3]);
                    *(u32x4*)(rowp + bj * 128) = w; } }
    }
};
struct EpiInProj {
    static constexpr bool PERM = true, AFTER_DRAIN = false;
    bf16_t* O; const f32x2* rope;
    DEV void operator()(const f32x4 (&acc)[2][2][4][2], const Unit& u, int wr, int wc, int fr, int fq) const {
        const int row0 = u.pm * 256 + wr * 64 + fr, col0 = u.pn * 256 + wc * 32 + 8 * fq;
        const bool isk = u.pn >= 16 && u.pn < 20, isq = u.pn >= 12 && u.pn < 16, dorope = (isq || isk) && u.pm < 32;
        const float sc = isk ? HSCALE : 1.0f;
#pragma unroll
        for (int ai = 0; ai < 2; ++ai)
#pragma unroll
            for (int m = 0; m < 4; ++m) { const int row = row0 + ai * 128 + m * 16; bf16_t* rowp = O + (size_t)row * ABIN + col0;
                f32x4 cs01 = (f32x4){1.f, 0.f, 1.f, 0.f}, cs23 = cs01, cs45 = cs01, cs67 = cs01;
                if (dorope) { const int pidx = (wc < 2) ? (row >> 6) : 128 + (row & 63); const f32x2* tp = rope + pidx * 32 + 16 * (wc & 1) + 4 * fq;
                    const f32x4 t0 = *(const f32x4*)tp, t1 = *(const f32x4*)(tp + 2); cs01 = t0; cs23 = t0; cs45 = t1; cs67 = t1; }
#pragma unroll
                for (int bj = 0; bj < 2; ++bj) { f32x4 v0 = acc[ai][bj][m][0], v1 = acc[ai][bj][m][1];
                    if (dorope) {
                        const f32x4 a0 = v0, a1 = v1;
                        v0[0] = a0[0] * cs01[0] - a0[1] * cs01[1]; v0[1] = a0[0] * cs01[1] + a0[1] * cs01[0];
                        v0[2] = a0[2] * cs23[2] - a0[3] * cs23[3]; v0[3] = a0[2] * cs23[3] + a0[3] * cs23[2];
                        v1[0] = a1[0] * cs45[0] - a1[1] * cs45[1]; v1[1] = a1[0] * cs45[1] + a1[1] * cs45[0];
                        v1[2] = a1[2] * cs67[2] - a1[3] * cs67[3]; v1[3] = a1[2] * cs67[3] + a1[3] * cs67[2];
                    }
                    v0 = v0 * sc; v1 = v1 * sc;
                    u32x4 w; w[0] = cvt_pk_bf16(v0[0], v0[1]); w[1] = cvt_pk_bf16(v0[2], v0[3]); w[2] = cvt_pk_bf16(v1[0], v1[1]); w[3] = cvt_pk_bf16(v1[2], v1[3]);
                    *(u32x4*)(rowp + bj * 128) = w; } }
    }
};
struct EpiSwiglu {
    static constexpr bool PERM = true, AFTER_DRAIN = false;
    bf16_t* O;
    DEV void operator()(const f32x4 (&acc)[2][2][4][2], const Unit& u, int wr, int wc, int fr, int fq) const {
        const int row0 = u.pm * 256 + wr * 64 + fr, col0 = u.pn * 128 + wc * 32 + 8 * fq;
#pragma unroll
        for (int ai = 0; ai < 2; ++ai)
#pragma unroll
            for (int m = 0; m < 4; ++m) { bf16_t* rowp = O + (size_t)(row0 + ai * 128 + m * 16) * FFH + col0;
                const f32x4 g0 = acc[ai][0][m][0], g1 = acc[ai][0][m][1], u0 = acc[ai][1][m][0], u1 = acc[ai][1][m][1];
                u32x4 w; w[0] = cvt_pk_bf16(silu_f(g0[0]) * u0[0], silu_f(g0[1]) * u0[1]); w[1] = cvt_pk_bf16(silu_f(g0[2]) * u0[2], silu_f(g0[3]) * u0[3]);
                w[2] = cvt_pk_bf16(silu_f(g1[0]) * u1[0], silu_f(g1[1]) * u1[1]); w[3] = cvt_pk_bf16(silu_f(g1[2]) * u1[2], silu_f(g1[3]) * u1[3]);
                *(u32x4*)rowp = w; }
    }
};

#ifndef HOST_EMU
namespace pg8 {
#define PG8_LAS __attribute__((address_space(3)))
constexpr int BM = 256, BK = 64, HALF = 128, HTB = HALF * BK * 2, STAGE_BYTES = 8 * HTB, NXCD = 8, WGM = 8;
__host__ __device__ __forceinline__ int lds_byte(int r, int c) { const int st = (r >> 4) * 2 + (c >> 5), rr = r & 15, cc = c & 31, ob = rr * 64 + cc * 2; return st * 1024 + (ob ^ (((ob >> 9) & 1) << 5)); }
__host__ __device__ __forceinline__ void stage_rc(int b, int& R, int& C) { const int st = b / 1024, sb = b % 1024, swz = sb ^ (((sb >> 9) & 1) << 5); R = (st >> 1) * 16 + swz / 64; C = (st & 1) * 32 + (swz % 64) / 2; }
__host__ __device__ __forceinline__ int perm32(int rho) { const int n = rho >> 4, i = rho & 15; return 8 * (i >> 2) + 4 * n + (i & 3); }
struct Gemm { const bf16_t* A; const bf16_t* Bt; int M, N, K; };
struct StaticOrder {
    int nM, nN, nwg, G, c, ntK;
    __host__ __device__ __forceinline__ void init(int M, int N, int K, int G_, int c_) { nM = M / BM; nN = N / BM; nwg = nM * nN; G = G_; c = c_; ntK = K / BK; }
    __host__ __device__ __forceinline__ void map(int wgid, Unit& u) const {
        { const int q = nwg / NXCD, r = nwg % NXCD, xcd = wgid % NXCD, off = wgid / NXCD; wgid = (xcd < r ? xcd * (q + 1) : r * (q + 1) + (xcd - r) * q) + off; }
        const int nig = WGM * nN, gid = wgid / nig, fm = gid * WGM, gsz = (nM - fm) < WGM ? (nM - fm) : WGM;
        u.pm = fm + ((wgid % nig) % gsz); u.pn = (wgid % nig) / gsz; u.ks = -1; u.nt = ntK; u.kofs = 0;
    }
    __host__ __device__ __forceinline__ bool next(int i, Unit& u) const { const long L = (long)i * G + c; if (L >= nwg) return false; map((int)L, u); return true; }
    __device__ __forceinline__ void a_ready(const Unit&) const {}
    __device__ __forceinline__ void done(const Unit&) const {}
};
struct MixedOrder {
    StaticOrder base; int nsplit, pmx, ntS, nNx;
    __host__ __device__ __forceinline__ void init(int M, int N, int K, int G_, int c_, int pmx_, int nsplit_) { base.init(M, N, K, G_, c_); pmx = pmx_; nsplit = nsplit_; ntS = nsplit_ ? (K / BK) / nsplit_ : 0; nNx = N / BM; }
    __host__ __device__ __forceinline__ bool next(int i, Unit& u) const {
        const long L = (long)i * base.G + base.c;
        if (L < base.nwg) { base.map((int)L, u); return true; }
        const long L2 = L - base.nwg; if (L2 >= (long)nsplit * nNx) return false;
        u.pm = pmx; u.pn = (int)(L2 % nNx); u.ks = (int)(L2 / nNx); u.nt = ntS; u.kofs = u.ks * ntS * BK * 2; return true;
    }
    __device__ __forceinline__ void a_ready(const Unit&) const {}
    __device__ __forceinline__ void done(const Unit&) const {}
};
template <class Epi, class Sched, bool ALIGN_EPI = false, bool SP2 = false>
__device__ __forceinline__ void gemm_phase(PG8_LAS unsigned char* lds, const Gemm g, const Sched& S, const Epi& E, const int tid) {
    const int wid = __builtin_amdgcn_readfirstlane(tid >> 6), lane = tid & 63, wr = wid >> 2, wc = wid & 3, fr = lane & 15, fq = lane >> 4;
    const int K = g.K;
    unsigned voffA[2], voffB[2];
#pragma unroll
    for (int i = 0; i < 2; ++i) { int R, C; stage_rc(tid * 16 + i * 8192, R, C); const int Rb = Epi::PERM ? ((R & ~31) + perm32(R & 31)) : R;
        voffA[i] = (unsigned)(R * K + C) * 2u; voffB[i] = (unsigned)(Rb * K + C) * 2u; }
    const size_t kstep = (size_t)(BK * 2);
    const size_t hstep = (size_t)HALF * K * 2;
    const size_t tstep = 2 * hstep;
    const unsigned ldsw = (unsigned)wid * 1024u;
    const int aoff = lds_byte(wr * 64 + fr, fq * 8), boff = lds_byte(wc * 32 + fr, fq * 8);
#define PG8_SA(b, h) (((b) * 2 + (h)) * HTB)
#define PG8_SB(b, h) ((4 + (b) * 2 + (h)) * HTB)
#define PG8_STAGE(bufoff, gbase, voff) do { _Pragma("unroll") for (int _i = 0; _i < 2; ++_i) \
        __builtin_amdgcn_global_load_lds((const unsigned*)((const char*)(gbase) + (voff)[_i]), (PG8_LAS unsigned*)(lds + (bufoff) + ldsw + _i * 8192), 16, 0, 0); } while (0)
#define PG8_LDA(dst, b, h) do { _Pragma("unroll") for (int m = 0; m < 4; ++m) _Pragma("unroll") for (int k = 0; k < 2; ++k) dst[m][k] = *(const PG8_LAS bf16x8*)(lds + PG8_SA(b, h) + aoff + m * 2048 + k * 1024); } while (0)
#define PG8_LDB(dst, b, h) do { _Pragma("unroll") for (int n = 0; n < 2; ++n) _Pragma("unroll") for (int k = 0; k < 2; ++k) dst[n][k] = *(const PG8_LAS bf16x8*)(lds + PG8_SB(b, h) + boff + n * 2048 + k * 1024); } while (0)
#define PG8_MMA(ai, bj, At, Bt) do { __builtin_amdgcn_s_setprio(1); _Pragma("unroll") for (int m = 0; m < 4; ++m) _Pragma("unroll") for (int n = 0; n < 2; ++n) _Pragma("unroll") for (int k = 0; k < 2; ++k) \
        acc[ai][bj][m][n] = __builtin_amdgcn_mfma_f32_16x16x32_bf16(Bt[n][k], At[m][k], acc[ai][bj][m][n], 0, 0, 0); __builtin_amdgcn_s_setprio(0); } while (0)
#define PG8_WAIT_V(n) asm volatile("s_waitcnt vmcnt(" #n ")" ::: "memory")
#define PG8_WAIT_L(n) asm volatile("s_waitcnt lgkmcnt(" #n ")" ::: "memory")
#define PG8_BAR __builtin_amdgcn_s_barrier()
#define PG8_SCHED __builtin_amdgcn_sched_barrier(0)
    Unit cur, nxt; int ui = 0;
    if (!S.next(0, cur)) return;
    f32x4 acc[2][2][4][2];
#pragma unroll
    for (int a = 0; a < 2; ++a)
#pragma unroll
        for (int b = 0; b < 2; ++b)
#pragma unroll
            for (int m = 0; m < 4; ++m)
#pragma unroll
                for (int n = 0; n < 2; ++n) acc[a][b][m][n] = (f32x4){0.f, 0.f, 0.f, 0.f};
    bf16x8 At[4][2], B0[2][2], B1[2][2];
    const char* cA = (const char*)g.A + (size_t)cur.pm * tstep + cur.kofs; const char* cB = (const char*)g.Bt + (size_t)cur.pn * tstep + cur.kofs;
    S.a_ready(cur);
    if constexpr (SP2) {
        PG8_STAGE(PG8_SB(0, 0), cB, voffB); PG8_STAGE(PG8_SB(0, 1), cB + hstep, voffB); PG8_STAGE(PG8_SA(0, 0), cA, voffA); PG8_STAGE(PG8_SA(0, 1), cA + hstep, voffA);
        if (wr == 1) PG8_BAR;
        PG8_WAIT_V(2); PG8_BAR;
        PG8_STAGE(PG8_SB(1, 0), cB + kstep, voffB); PG8_STAGE(PG8_SA(1, 0), cA + kstep, voffA); PG8_STAGE(PG8_SB(1, 1), cB + hstep + kstep, voffB);
        PG8_WAIT_V(6); PG8_BAR;
    } else {
        PG8_STAGE(PG8_SB(0, 0), cB, voffB); PG8_STAGE(PG8_SA(0, 0), cA, voffA); PG8_STAGE(PG8_SB(0, 1), cB + hstep, voffB); PG8_STAGE(PG8_SA(0, 1), cA + hstep, voffA);
        if (wr == 1) PG8_BAR;
        PG8_WAIT_V(4); PG8_BAR;
        PG8_STAGE(PG8_SB(1, 0), cB + kstep, voffB); PG8_STAGE(PG8_SA(1, 0), cA + kstep, voffA); PG8_STAGE(PG8_SB(1, 1), cB + hstep + kstep, voffB);
        PG8_WAIT_V(6); PG8_BAR;
    }
    for (;;) {
        const bool has_next = S.next(ui + 1, nxt);
        const char* nA = has_next ? (const char*)g.A + (size_t)nxt.pm * tstep + nxt.kofs : cA; const char* nB = has_next ? (const char*)g.Bt + (size_t)nxt.pn * tstep + nxt.kofs : cB;
        const int nt = cur.nt;
        for (int t = 0; t < nt; t += 2) {
            const bool last = (t == nt - 2);
            const char* a1 = cA + (size_t)(t + 1) * kstep;
            const char* a2 = last ? nA : cA + (size_t)(t + 2) * kstep; const char* b2 = last ? nB : cB + (size_t)(t + 2) * kstep;
            const char* a3 = a2 + kstep; const char* b3 = b2 + kstep;
            if (last && has_next) S.a_ready(nxt);
            if constexpr (SP2) {
            PG8_LDB(B0, 0, 0); PG8_LDB(B1, 0, 1); PG8_SCHED; PG8_LDA(At, 0, 0); PG8_STAGE(PG8_SA(1, 1), a1 + hstep, voffA);
            PG8_WAIT_V(8); PG8_WAIT_L(0); PG8_BAR; PG8_MMA(0, 0, At, B0); PG8_MMA(0, 1, At, B1); PG8_BAR; PG8_SCHED;
            PG8_LDA(At, 0, 1); PG8_STAGE(PG8_SB(0, 0), b2, voffB); PG8_STAGE(PG8_SB(0, 1), b2 + hstep, voffB); PG8_STAGE(PG8_SA(0, 0), a2, voffA);
            PG8_WAIT_V(8); PG8_WAIT_L(0); PG8_BAR; PG8_MMA(1, 0, At, B0); PG8_MMA(1, 1, At, B1); PG8_BAR; PG8_SCHED;
            PG8_LDB(B0, 1, 0); PG8_LDB(B1, 1, 1); PG8_SCHED; PG8_LDA(At, 1, 0); PG8_STAGE(PG8_SA(0, 1), a2 + hstep, voffA);
            PG8_WAIT_V(8); PG8_WAIT_L(0); PG8_BAR; PG8_MMA(0, 0, At, B0); PG8_MMA(0, 1, At, B1); PG8_BAR; PG8_SCHED;
            PG8_LDA(At, 1, 1); PG8_STAGE(PG8_SB(1, 0), b3, voffB); PG8_STAGE(PG8_SB(1, 1), b3 + hstep, voffB); PG8_STAGE(PG8_SA(1, 0), a3, voffA);
            PG8_WAIT_V(8); PG8_WAIT_L(0); PG8_BAR; PG8_MMA(1, 0, At, B0); PG8_MMA(1, 1, At, B1); PG8_BAR; PG8_SCHED;
            } else {
            PG8_LDB(B0, 0, 0); PG8_SCHED; PG8_LDA(At, 0, 0); PG8_STAGE(PG8_SA(1, 1), a1 + hstep, voffA);
            PG8_WAIT_L(8); PG8_BAR; PG8_WAIT_L(0); PG8_MMA(0, 0, At, B0); PG8_BAR; PG8_SCHED;
            PG8_LDB(B1, 0, 1); PG8_STAGE(PG8_SB(0, 0), b2, voffB);
            PG8_BAR; PG8_WAIT_L(0); PG8_MMA(0, 1, At, B1); PG8_BAR;
            PG8_LDA(At, 0, 1); PG8_STAGE(PG8_SA(0, 0), a2, voffA);
            PG8_BAR; PG8_WAIT_L(0); PG8_MMA(1, 0, At, B0); PG8_BAR; PG8_SCHED;
            PG8_STAGE(PG8_SB(0, 1), b2 + hstep, voffB);
            PG8_WAIT_V(6); PG8_BAR; PG8_MMA(1, 1, At, B1); PG8_BAR;
            PG8_LDB(B0, 1, 0); PG8_SCHED; PG8_LDA(At, 1, 0); PG8_STAGE(PG8_SA(0, 1), a2 + hstep, voffA);
            PG8_WAIT_L(8); PG8_BAR; PG8_WAIT_L(0); PG8_MMA(0, 0, At, B0); PG8_BAR; PG8_SCHED;
            PG8_LDB(B1, 1, 1); PG8_STAGE(PG8_SB(1, 0), b3, voffB);
            PG8_BAR; PG8_WAIT_L(0); PG8_MMA(0, 1, At, B1); PG8_BAR;
            PG8_LDA(At, 1, 1); PG8_STAGE(PG8_SA(1, 0), a3, voffA);
            PG8_BAR; PG8_WAIT_L(0); PG8_MMA(1, 0, At, B0); PG8_BAR; PG8_SCHED;
            PG8_STAGE(PG8_SB(1, 1), b3 + hstep, voffB);
            PG8_WAIT_V(6); PG8_BAR; PG8_MMA(1, 1, At, B1); PG8_BAR;
            }
        }
        if constexpr (ALIGN_EPI) { if (wr == 0) PG8_BAR; }
        if constexpr (!Epi::AFTER_DRAIN) { E(acc, cur, wr, wc, fr, fq); S.done(cur); }
        if (!has_next) break;
#pragma unroll
        for (int a = 0; a < 2; ++a)
#pragma unroll
            for (int b = 0; b < 2; ++b)
#pragma unroll
                for (int m = 0; m < 4; ++m)
#pragma unroll
                    for (int n = 0; n < 2; ++n) acc[a][b][m][n] = (f32x4){0.f, 0.f, 0.f, 0.f};
        cur = nxt; cA = nA; cB = nB; ++ui;
        if constexpr (ALIGN_EPI) { if (wr == 1) PG8_BAR; }
    }
    PG8_WAIT_V(0);
    if constexpr (!ALIGN_EPI) { if (wr == 0) PG8_BAR; }
    PG8_BAR;
#undef PG8_SA
#undef PG8_SB
#undef PG8_STAGE
#undef PG8_LDA
#undef PG8_LDB
#undef PG8_MMA
#undef PG8_WAIT_V
#undef PG8_WAIT_L
#undef PG8_BAR
#undef PG8_SCHED
}
}
#ifndef PG8_SP2
#define PG8_SP2 true
#endif
#ifndef PG8_ALIGN
#define PG8_ALIGN true
#endif

#define XB_TMO      128
#define XB_XCNT(j)  (256  + 64 * (j))
#define XB_XSUB(j)  (1280 + 64 * (j))
#define XB_XGEN(j)  (2304 + 64 * (j))
#define XB_TOP      3328
#define XB_TOPGEN   3392
#define XCD_BAR_WORDS 3456
#define XB_SPIN_CAP (1u << 18)
__device__ __forceinline__ unsigned xb_ld(unsigned* p)              { return __hip_atomic_load(p, __ATOMIC_RELAXED, __HIP_MEMORY_SCOPE_AGENT); }
__device__ __forceinline__ unsigned xb_add(unsigned* p, unsigned v) { return __hip_atomic_fetch_add(p, v, __ATOMIC_RELAXED, __HIP_MEMORY_SCOPE_AGENT); }
__device__ __forceinline__ unsigned xb_xcc_id() { return (unsigned)__builtin_amdgcn_s_getreg((3 << 11) | 20) & 0xFu; }
#define XB_SPIN(cond, bar) do { unsigned _sp = 0; while (cond) { __builtin_amdgcn_s_sleep(1); \
    if ((++_sp & 255u) == 0u) { if (xb_ld(&(bar)[XB_TMO])) break; if (_sp > XB_SPIN_CAP) { atomicAdd(&(bar)[XB_TMO], 1u); break; } } } } while (0)
struct XcdBarrier { unsigned* bar; unsigned x; volatile LAS unsigned* st; };
__device__ __forceinline__ XcdBarrier xcd_barrier_post(unsigned* bar, volatile LAS unsigned* st) {
    XcdBarrier b; b.bar = bar; b.x = xb_xcc_id(); b.st = st;
    if (threadIdx.x == 0) (void)xb_add(&bar[XB_XCNT(b.x)], 1u);
    return b;
}
__device__ __forceinline__ void xcd_barrier_complete(unsigned* bar, unsigned x, unsigned& nloc, unsigned& nx) {
    const unsigned G = gridDim.x * gridDim.y * gridDim.z;
    unsigned sum, cnt, mine, sp = 0u;
    for (;;) {
        sum = 0u; cnt = 0u; mine = 0u;
#pragma unroll
        for (unsigned j = 0; j < 16; ++j) { const unsigned c = xb_ld(&bar[XB_XCNT(j)]); sum += c; cnt += (c > 0u) ? 1u : 0u; mine = (j == x) ? c : mine; }
        if (sum == G) break;
        __builtin_amdgcn_s_sleep(1);
        if ((++sp & 255u) == 0u) { if (xb_ld(&bar[XB_TMO])) break; if (sp > XB_SPIN_CAP) { atomicAdd(&bar[XB_TMO], 1u); break; } }
    }
    nloc = mine > 0u ? mine : 1u; nx = cnt > 0u ? cnt : 1u;
}
__device__ __forceinline__ void xcd_barrier(const XcdBarrier& b) {
    asm volatile("s_waitcnt vmcnt(0)" ::: "memory");
    __syncthreads();
    if (threadIdx.x == 0) {
        unsigned* bar = b.bar;
        __builtin_amdgcn_s_waitcnt(0);
        unsigned nloc = b.st[0], nx = b.st[1];
        if (nloc == 0u) { xcd_barrier_complete(bar, b.x, nloc, nx); b.st[0] = nloc; b.st[1] = nx; }
        const unsigned old = xb_add(&bar[XB_XSUB(b.x)], 1u);
        const unsigned gen = old / nloc;
        if (old + 1u == (gen + 1u) * nloc) {
            __builtin_amdgcn_fence(__ATOMIC_RELEASE, "agent");
            asm volatile("s_waitcnt vmcnt(0)" ::: "memory");
            const unsigned og = xb_add(&bar[XB_TOP], 1u);
            const unsigned tg = og / nx;
            if (og + 1u == (tg + 1u) * nx) xb_add(&bar[XB_TOPGEN], 1u);
            else XB_SPIN(xb_ld(&bar[XB_TOPGEN]) == tg, bar);
            __builtin_amdgcn_fence(__ATOMIC_ACQUIRE, "agent");
            xb_add(&bar[XB_XGEN(b.x)], 1u);
            asm volatile("s_waitcnt vmcnt(0)" ::: "memory");
        } else {
            XB_SPIN(xb_ld(&bar[XB_XGEN(b.x)]) == gen, bar);
            __builtin_amdgcn_fence(__ATOMIC_ACQUIRE, "agent");
            asm volatile("s_waitcnt vmcnt(0)" ::: "memory");
        }
    }
    __syncthreads();
}

constexpr size_t al256(size_t x) { return (x + 255) & ~(size_t)255; }
constexpr size_t WS_CTL = 0;
constexpr size_t CTL_ZERO_BYTES = 65536;
constexpr size_t WS_MODACC = 2u << 20;
constexpr size_t WS_MODF = (1u << 20) + (512u << 10);
constexpr size_t WS_ROPE = 1u << 20;
constexpr size_t WS_WABIN = 8u << 20;
constexpr size_t SZ_WABIN = (size_t)ABIN * D * 2;
constexpr size_t WS_WABOUT = WS_WABIN + 2 * SZ_WABIN;
constexpr size_t SZ_WSQ = (size_t)D * D * 2;
constexpr size_t WS_WQKV = WS_WABOUT + 2 * SZ_WSQ;
constexpr size_t SZ_WQKV = (size_t)QKV * D * 2;
constexpr size_t WS_WNAOUT = WS_WQKV + 2 * SZ_WQKV;
constexpr size_t WS_WFFIN = WS_WNAOUT + 2 * SZ_WSQ;
constexpr size_t SZ_WFFIN = (size_t)FF2 * D * 2;
constexpr size_t WS_WFFOUT = WS_WFFIN + 4 * SZ_WFFIN;
constexpr size_t SZ_WFFOUT = (size_t)D * FFH * 2;
constexpr size_t WS_X = WS_WFFOUT + 4 * SZ_WFFOUT;
constexpr size_t WS_H = WS_X + (size_t)MTOK * D * 4;
constexpr size_t WS_P = WS_H + (size_t)MTOK * D * 2;
constexpr size_t WS_YAB = WS_P + (size_t)MTOK * ABIN * 2;
constexpr size_t WS_Y = WS_YAB + (size_t)MTOK * D * 2;
constexpr size_t WS_HID = WS_Y + (size_t)MTOK * D * 4;
constexpr size_t WS_KVT = WS_HID + (size_t)MTOK * FFH * 2;
constexpr size_t WS_ST = WS_KVT + (size_t)NCHUNK * 16 * 16384 * 4;
constexpr size_t WS_YC = WS_ST + (size_t)NCHUNK * 16 * 16384 * 2;
constexpr size_t WS_END = WS_YC + (size_t)22 * 256 * D * 4;
constexpr int NSPLIT_OUT = 8, NSPLIT_FFO = 22;
static_assert(WS_WABIN % 256 == 0 && WS_X % 256 == 0 && WS_P % 256 == 0 && WS_KVT % 256 == 0 && WS_ST % 256 == 0, "ws alignment");

constexpr int RING_BYTES = 131072, LDSCTL_OFF = RING_BYTES, MISC_OFF = LDSCTL_OFF + 320, PRM_OFF = LDSCTL_OFF + 1024, LDS_BYTES = 147456;
constexpr int NPHASE = 2 + 9 * DEPTH;

struct Params { const float* in[16]; float* out; unsigned char* ws; int ph_lo, ph_hi, li, pad; };

__device__ __forceinline__ void transpose_item(const float* W, int ldw, int K, bf16_t* Wt, int k0, int n0s, int n0d, LAS float* scr, int lane) {
    const int r = lane >> 3, c4 = (lane & 7) * 4;
    f32x4 v[8];
#pragma unroll
    for (int i = 0; i < 8; ++i) v[i] = __builtin_nontemporal_load((const f32x4*)(W + (size_t)(k0 + 8 * i + r) * ldw + n0s + c4));
#pragma unroll
    for (int i = 0; i < 8; ++i) { LAS float* d = scr + (8 * i + r) * 33 + c4; d[0] = v[i][0]; d[1] = v[i][1]; d[2] = v[i][2]; d[3] = v[i][3]; }
    asm volatile("s_waitcnt lgkmcnt(0)" ::: "memory");
    const int c = lane & 7;
#pragma unroll
    for (int j = 0; j < 4; ++j) { const int n = (lane >> 3) + 8 * j; const LAS float* s = scr + (8 * c) * 33 + n;
        u32x4 o; o[0] = cvt_pk_bf16(s[0 * 33], s[1 * 33]); o[1] = cvt_pk_bf16(s[2 * 33], s[3 * 33]); o[2] = cvt_pk_bf16(s[4 * 33], s[5 * 33]); o[3] = cvt_pk_bf16(s[6 * 33], s[7 * 33]);
        *(u32x4*)(Wt + (size_t)(n0d + n) * K + k0 + 8 * c) = o; }
    asm volatile("s_waitcnt lgkmcnt(0)" ::: "memory");
}
__device__ __forceinline__ void transpose_matrix_item(const float* W, int K, int N, bf16_t* Wt, bool ffperm, int item, LAS float* scr, int lane) {
    const int nblk = N / 32, kb = item / nblk, nb = item % nblk, n0d = 32 * nb;
    int n0s = n0d;
    if (ffperm) { const int t = n0d >> 8, j = n0d & 255; n0s = j < 128 ? 128 * t + j : FFH + 128 * t + (j - 128); }
    transpose_item(W, N, K, Wt, 64 * kb, n0s, n0d, scr, lane);
}

constexpr int I_ABIN = (D / 64) * (ABIN / 32), I_SQ = (D / 64) * (D / 32), I_QKV = (D / 64) * (QKV / 32), I_FFIN = (D / 64) * (FF2 / 32), I_FFOUT = (FFH / 64) * (D / 32);
__device__ __forceinline__ unsigned long long ldptr(LAS const unsigned* prm, int k) {
    const unsigned lo = prm[2 * k], hi = prm[2 * k + 1];
    return ((unsigned long long)(unsigned)__builtin_amdgcn_readfirstlane((int)hi) << 32) | (unsigned)__builtin_amdgcn_readfirstlane((int)lo);
}
__device__ __forceinline__ void cvt_mat(LAS const unsigned* prm, int type, int inst, int idx, LAS float* scr, int lane) {
    const int kin = type == 0 ? 7 : (type == 1 ? 10 : (type == 2 ? 11 : (type == 3 ? 13 : (type == 4 ? 14 : 15))));
    const int K = type == 5 ? FFH : D;
    const int N = type == 0 ? ABIN : (type == 2 ? QKV : (type == 4 ? FF2 : D));
    const size_t woff = type == 0 ? WS_WABIN : (type == 1 ? WS_WABOUT : (type == 2 ? WS_WQKV : (type == 3 ? WS_WNAOUT : (type == 4 ? WS_WFFIN : WS_WFFOUT))));
    const size_t wsz = type == 0 ? SZ_WABIN : (type == 2 ? SZ_WQKV : (type == 4 ? SZ_WFFIN : (type == 5 ? SZ_WFFOUT : SZ_WSQ)));
    const float* src = (const float*)(GAS const float*)ldptr(prm, kin) + (size_t)inst * K * N;
    unsigned char* ws = (unsigned char*)(GAS unsigned char*)ldptr(prm, 17);
    transpose_matrix_item(src, K, N, (bf16_t*)(ws + woff + inst * wsz), type == 4, idx, scr, lane);
}
constexpr int L0_ITEMS = I_ABIN + I_FFOUT;
__device__ __forceinline__ void cvt_l0_item(LAS const unsigned* p, int r, LAS float* scr, int lane) {
    int type, base;
    if (r < I_ABIN) { type = 0; base = 0; } else { type = 5; base = I_ABIN; }
    cvt_mat(p, type, 0, r - base, scr, lane);
}
constexpr int DLA = I_SQ, DL0 = DLA + I_FFIN, DL1 = DL0 + I_QKV, DL2 = DL1 + I_SQ, DL3 = DL2 + I_FFIN, DL4 = DL3 + I_FFOUT, DL5 = DL4 + I_ABIN, DL6 = DL5 + I_SQ, DL7 = DL6 + I_FFIN, DL8 = DL7 + I_FFOUT,
              DL9 = DL8 + I_QKV, DL10 = DL9 + I_SQ, DL11 = DL10 + I_FFIN, DL_END = DL11 + I_FFOUT;
static_assert(DL_END == 89600 && L0_ITEMS == 12800, "deferred list");
__device__ __forceinline__ void cvt_dl_item(LAS const unsigned* p, int gi, LAS float* scr, int lane) {
    int type, inst, base;
    if (gi < DL0) { if (gi < DLA) { type = 1; inst = 0; base = 0; } else { type = 4; inst = 0; base = DLA; } }
    else if (gi < DL4) { if (gi < DL2) { if (gi < DL1) { type = 2; inst = 0; base = DL0; } else { type = 3; inst = 0; base = DL1; } } else { if (gi < DL3) { type = 4; inst = 1; base = DL2; } else { type = 5; inst = 1; base = DL3; } } }
    else if (gi < DL8) { if (gi < DL6) { if (gi < DL5) { type = 0; inst = 1; base = DL4; } else { type = 1; inst = 1; base = DL5; } } else { if (gi < DL7) { type = 4; inst = 2; base = DL6; } else { type = 5; inst = 2; base = DL7; } } }
    else { if (gi < DL10) { if (gi < DL9) { type = 2; inst = 1; base = DL8; } else { type = 3; inst = 1; base = DL9; } } else { if (gi < DL11) { type = 4; inst = 3; base = DL10; } else { type = 5; inst = 3; base = DL11; } } }
    cvt_mat(p, type, inst, gi - base, scr, lane);
}
__device__ __forceinline__ void ada_item(LAS const unsigned* prm, int l, int nc, int kp, int tid) {
    if (tid < 384) {
        const int n = nc * 1536 + 4 * tid;
        f32x4 aL = (f32x4){0.f, 0.f, 0.f, 0.f}, aC = aL;
        const float* wp = (const float*)(GAS const float*)ldptr(prm, 4) + ((size_t)l * D + kp * 128) * (6 * D) + n;
        const float* cl_p = (const float*)(GAS const float*)ldptr(prm, 1) + kp * 128; const float* cc_p = (const float*)(GAS const float*)ldptr(prm, 3) + kp * 128;
        float* modacc = (float*)((unsigned char*)(GAS unsigned char*)ldptr(prm, 17) + WS_MODACC);
        const int l32 = tid & 31;
#pragma unroll 1
        for (int k0 = 0; k0 < 128; k0 += 32) {
            f32x4 w[32];
#pragma unroll
            for (int j = 0; j < 32; ++j) w[j] = __builtin_nontemporal_load((const f32x4*)(wp + (size_t)(k0 + j) * (6 * D)));
            const float clv = cl_p[k0 + l32], ccv = cc_p[k0 + l32];
            const float slv = clv / (1.0f + __expf(-clv)), scv = ccv / (1.0f + __expf(-ccv));
#pragma unroll
            for (int j = 0; j < 32; ++j) { const float sl = __builtin_bit_cast(float, __builtin_amdgcn_readlane(__builtin_bit_cast(int, slv), j)), sc = __builtin_bit_cast(float, __builtin_amdgcn_readlane(__builtin_bit_cast(int, scv), j));
                aL = aL + w[j] * sl; aC = aC + w[j] * sc; }
        }
        *(f32x4*)(modacc + (size_t)kp * MODPART + (size_t)(l * 2 + 0) * 6 * D + n) = aL;
        *(f32x4*)(modacc + (size_t)kp * MODPART + (size_t)(l * 2 + 1) * 6 * D + n) = aC;
    }
}
__device__ __forceinline__ void r1_block_task(const bf16_t* P, float* KVt, LAS unsigned char* lds, float lg2, int cidx, int head, int wave, int lane) {
    const int i = lane & 15, g = lane >> 4, dir = wave >> 2, quad = wave & 3;
    const int dk0 = 64 * (quad >> 1), dv0 = 64 * (quad & 1);
    const bf16_t* Prow = P + (size_t)chunk_row(cidx) * ABIN;
#pragma unroll
    for (int r = 0; r < 2; ++r)
#pragma unroll
        for (int j = 0; j < 4; ++j) {
            const int p = (j * 8 + wave) * 64 + lane, row = p >> 4, c = (p & 15) ^ (row & 15);
            const bf16_t* src = Prow + (size_t)row * ABIN + (r == 0 ? 4096 : 5120) + head * 128 + c * 8;
            __builtin_amdgcn_global_load_lds((const unsigned*)src, (LAS unsigned*)(lds + r * 32768 + (j * 8 + wave) * 1024), 16, 0, 0);
        }
    asm volatile("s_waitcnt vmcnt(0)" ::: "memory");
    asm volatile("s_waitcnt lgkmcnt(0)" ::: "memory"); __builtin_amdgcn_s_barrier(); asm volatile("" ::: "memory");
    int kbo[8], vbo[8];
#pragma unroll
    for (int jj = 0; jj < 8; ++jj) { const int tl = 8 * g + jj;
        kbo[jj] = tl * 256 + (((dk0 >> 3) + (i >> 1)) ^ (tl & 15)) * 16 + 8 * (i & 1);
        vbo[jj] = 32768 + tl * 256 + (((dv0 >> 3) + (i >> 1)) ^ (tl & 15)) * 16 + 8 * (i & 1); }
    f32x4 acc[4][4];
#pragma unroll
    for (int a = 0; a < 4; ++a)
#pragma unroll
        for (int b = 0; b < 4; ++b) acc[a][b] = (f32x4){0.f, 0.f, 0.f, 0.f};
#pragma unroll
    for (int s = 0; s < 4; ++s) {
        u32x2 kd[8], vd[8]; float w[8];
#pragma unroll
        for (int jj = 0; jj < 8; ++jj) {
            const int tj = 32 * s + 8 * g + jj;
            kd[jj] = *(LAS const u32x2*)(lds + kbo[jj] + 8192 * s); vd[jj] = *(LAS const u32x2*)(lds + vbo[jj] + 8192 * s);
            w[jj] = ex2(lg2 * (float)(dir == 0 ? 127 - tj : tj));
        }
        bf16x8 af[4], bfr[4];
#pragma unroll
        for (int mt = 0; mt < 4; ++mt) {
            u32x4 wd;
#pragma unroll
            for (int q = 0; q < 4; ++q) {
                const unsigned X = kd[2 * q][mt >> 1], Y = kd[2 * q + 1][mt >> 1];
                const float lo = ((mt & 1) ? bf_hi(X) : bf_lo(X)) * w[2 * q], hi = ((mt & 1) ? bf_hi(Y) : bf_lo(Y)) * w[2 * q + 1];
                wd[q] = cvt_pk_bf16(lo, hi);
            }
            af[mt] = __builtin_bit_cast(bf16x8, wd);
        }
#pragma unroll
        for (int nt = 0; nt < 4; ++nt) {
            u32x4 wd;
#pragma unroll
            for (int q = 0; q < 4; ++q) {
                const unsigned X = vd[2 * q][nt >> 1], Y = vd[2 * q + 1][nt >> 1];
                wd[q] = (nt & 1) ? ((X >> 16) | (Y & 0xffff0000u)) : ((X & 0xffffu) | (Y << 16));
            }
            bfr[nt] = __builtin_bit_cast(bf16x8, wd);
        }
#pragma unroll
        for (int mt = 0; mt < 4; ++mt)
#pragma unroll
            for (int nt = 0; nt < 4; ++nt) acc[mt][nt] = mfma16(af[mt], bfr[nt], acc[mt][nt]);
        SCHED_FENCE();
    }
    asm volatile("s_waitcnt lgkmcnt(0)" ::: "memory"); __builtin_amdgcn_s_barrier(); asm volatile("" ::: "memory");
    float* out = KVt + ((((size_t)cidx * 8 + head) * 2 + dir) * 128) * 128;
#pragma unroll
    for (int nt = 0; nt < 4; ++nt)
#pragma unroll
        for (int reg = 0; reg < 4; ++reg) {
            const int dv = dv0 + 4 * i + nt, dk = dk0 + 16 * g + 4 * reg;
            *(f32x4*)(out + (size_t)dv * 128 + dk) = (f32x4){acc[0][nt][reg], acc[1][nt][reg], acc[2][nt][reg], acc[3][nt][reg]};
        }
}

__device__ __forceinline__ void r1_issue_set(const bf16_t* Prow, LAS unsigned char* setp, const int head, const int wave, const int lane) {
#pragma unroll
    for (int r = 0; r < 2; ++r)
#pragma unroll
        for (int j = 0; j < 4; ++j) {
            const int p = (j * 8 + wave) * 64 + lane, row = p >> 4, c = (p & 15) ^ (row & 15);
            const bf16_t* src = Prow + (size_t)row * ABIN + (r == 0 ? 4096 : 5120) + head * 128 + c * 8;
            __builtin_amdgcn_global_load_lds((const unsigned*)src, (LAS unsigned*)(setp + r * 32768 + (j * 8 + wave) * 1024), 16, 0, 0);
        }
}
__device__ __forceinline__ void r1_phase_pipelined(const bf16_t* P, float* KVt, LAS unsigned char* lds, const float* decay_exp, const int iab, const int vcu, const int G, const int wave, const int lane) {
    const int i = lane & 15, g = lane >> 4, dir = wave >> 2, quad = wave & 3;
    const int dk0 = 64 * (quad >> 1), dv0 = 64 * (quad & 1);
    int bt = vcu; if (bt >= NCHUNK * 8) return;
    int kbo[8], vbo[8];
#pragma unroll
    for (int jj = 0; jj < 8; ++jj) { const int tl = 8 * g + jj;
        kbo[jj] = tl * 256 + (((dk0 >> 3) + (i >> 1)) ^ (tl & 15)) * 16 + 8 * (i & 1);
        vbo[jj] = 32768 + tl * 256 + (((dv0 >> 3) + (i >> 1)) ^ (tl & 15)) * 16 + 8 * (i & 1); }
    r1_issue_set(P + (size_t)chunk_row(bt >> 3) * ABIN, lds, bt & 7, wave, lane);
    for (int k = 0;; ++k) {
        const int cidx = bt >> 3, head = bt & 7, nbt = bt + G;
        const bool has_next = nbt < NCHUNK * 8;
        const float lg2 = lg2gamma(decay_exp, iab, dir, head);
        LAS const unsigned char* setp = lds + (k & 1) * 65536;
        if (has_next) { r1_issue_set(P + (size_t)chunk_row(nbt >> 3) * ABIN, lds + ((k + 1) & 1) * 65536, nbt & 7, wave, lane); asm volatile("s_waitcnt vmcnt(8)" ::: "memory"); }
        else asm volatile("s_waitcnt vmcnt(0)" ::: "memory");
        asm volatile("s_waitcnt lgkmcnt(0)" ::: "memory"); __builtin_amdgcn_s_barrier(); asm volatile("" ::: "memory");
        f32x4 acc[4][4];
#pragma unroll
        for (int a = 0; a < 4; ++a)
#pragma unroll
            for (int b = 0; b < 4; ++b) acc[a][b] = (f32x4){0.f, 0.f, 0.f, 0.f};
#pragma unroll
        for (int s = 0; s < 4; ++s) {
            u32x2 kd[8], vd[8]; float w[8];
#pragma unroll
            for (int jj = 0; jj < 8; ++jj) {
                const int tj = 32 * s + 8 * g + jj;
                kd[jj] = *(LAS const u32x2*)(setp + kbo[jj] + 8192 * s); vd[jj] = *(LAS const u32x2*)(setp + vbo[jj] + 8192 * s);
                w[jj] = ex2(lg2 * (float)(dir == 0 ? 127 - tj : tj));
            }
            bf16x8 af[4], bfr[4];
#pragma unroll
            for (int mt = 0; mt < 4; ++mt) {
                u32x4 wd;
#pragma unroll
                for (int q = 0; q < 4; ++q) {
                    const unsigned X = kd[2 * q][mt >> 1], Y = kd[2 * q + 1][mt >> 1];
                    const float lo = ((mt & 1) ? bf_hi(X) : bf_lo(X)) * w[2 * q], hi = ((mt & 1) ? bf_hi(Y) : bf_lo(Y)) * w[2 * q + 1];
                    wd[q] = cvt_pk_bf16(lo, hi);
                }
                af[mt] = __builtin_bit_cast(bf16x8, wd);
            }
#pragma unroll
            for (int nt = 0; nt < 4; ++nt) {
                u32x4 wd;
#pragma unroll
                for (int q = 0; q < 4; ++q) {
                    const unsigned X = vd[2 * q][nt >> 1], Y = vd[2 * q + 1][nt >> 1];
                    wd[q] = (nt & 1) ? ((X >> 16) | (Y & 0xffff0000u)) : ((X & 0xffffu) | (Y << 16));
                }
                bfr[nt] = __builtin_bit_cast(bf16x8, wd);
            }
#pragma unroll
            for (int mt = 0; mt < 4; ++mt)
#pragma unroll
                for (int nt = 0; nt < 4; ++nt) acc[mt][nt] = mfma16(af[mt], bfr[nt], acc[mt][nt]);
            SCHED_FENCE();
        }
        asm volatile("s_waitcnt lgkmcnt(0)" ::: "memory"); __builtin_amdgcn_s_barrier(); asm volatile("" ::: "memory");
        bf16_t* out = (bf16_t*)KVt + ((((size_t)cidx * 8 + head) * 2 + dir) * 128) * 128;
#pragma unroll
        for (int nt = 0; nt < 4; ++nt)
#pragma unroll
            for (int reg = 0; reg < 4; ++reg) {
                const int dv = dv0 + 4 * i + nt, dk = dk0 + 16 * g + 4 * reg;
                u32x2 w; w[0] = cvt_pk_bf16(acc[0][nt][reg], acc[1][nt][reg]); w[1] = cvt_pk_bf16(acc[2][nt][reg], acc[3][nt][reg]);
                __builtin_nontemporal_store(w, (u32x2*)(out + (size_t)dv * 128 + dk));
            }
        if (!has_next) break;
        bt = nbt;
    }
}

__device__ __forceinline__ void r3_block_task(const bf16_t* P, const bf16_t* St, bf16_t* YAB, LAS unsigned char* lds, float lg2f, float lg2b, int cidx, int head, int wave, int lane) {
    const int i = lane & 15, g = lane >> 4, qi = 16 * wave + i, rowbase = chunk_row(cidx);
    const bf16_t* Prow = P + (size_t)rowbase * ABIN;
    bf16x8 qf[4];
#pragma unroll
    for (int s = 0; s < 4; ++s) qf[s] = *(const bf16x8*)(Prow + (size_t)qi * ABIN + 3072 + head * 128 + 32 * s + 8 * g);
#pragma unroll
    for (int r = 0; r < 4; ++r)
#pragma unroll
        for (int j = 0; j < 4; ++j) {
            const int p = (j * 8 + wave) * 64 + lane, row = p >> 4, c = (p & 15) ^ (r < 2 ? (row & 15) : ((row >> 3) & 15));
            const bf16_t* src = r == 0 ? Prow + (size_t)row * ABIN + 4096 + head * 128 + c * 8 : (r == 1 ? Prow + (size_t)row * ABIN + 5120 + head * 128 + c * 8
                                : St + ((((size_t)cidx * 8 + head) * 2 + (r - 2)) * 128 + row) * 128 + c * 8);
            __builtin_amdgcn_global_load_lds((const unsigned*)src, (LAS unsigned*)(lds + r * 32768 + (j * 8 + wave) * 1024), 16, 0, 0);
        }
    asm volatile("s_waitcnt vmcnt(0)" ::: "memory");
    asm volatile("s_waitcnt lgkmcnt(0)" ::: "memory"); __builtin_amdgcn_s_barrier(); asm volatile("" ::: "memory");
    int kb[4], sb[4], vb[8];
#pragma unroll
    for (int s = 0; s < 4; ++s) { kb[s] = i * 256 + ((4 * s + g) ^ i) * 16; sb[s] = 65536 + i * 2048 + ((4 * s + g) ^ i) * 16; }
#pragma unroll
    for (int jj = 0; jj < 8; ++jj) { const int kk = jj < 4 ? 4 * g + jj : 16 + 4 * g + jj - 4; vb[jj] = 32768 + kk * 256 + (i ^ (kk & 15)) * 16; }
    f32x4 sacc[8];
#pragma unroll
    for (int mt = 0; mt < 8; ++mt) {
        f32x4 a = (f32x4){0.f, 0.f, 0.f, 0.f};
#pragma unroll
        for (int s = 0; s < 4; ++s) { const bf16x8 kf = *(LAS const bf16x8*)(lds + kb[s] + 4096 * mt); a = mfma16(kf, qf[s], a); }
        sacc[mt] = a;
        if (mt & 1) SCHED_FENCE();
    }
#pragma unroll
    for (int mt = 0; mt < 8; ++mt)
#pragma unroll
        for (int reg = 0; reg < 4; ++reg) {
            const int diff = qi - (16 * mt + 4 * g + reg);
            const float d = diff > 0 ? ex2((float)diff * lg2f) : (diff < 0 ? ex2((float)(-diff) * lg2b) : 2.0f);
            sacc[mt][reg] *= d;
        }
    bf16x8 pf[4];
#pragma unroll
    for (int s = 0; s < 4; ++s) {
        u32x4 w; w[0] = cvt_pk_bf16(sacc[2 * s][0], sacc[2 * s][1]); w[1] = cvt_pk_bf16(sacc[2 * s][2], sacc[2 * s][3]);
        w[2] = cvt_pk_bf16(sacc[2 * s + 1][0], sacc[2 * s + 1][1]); w[3] = cvt_pk_bf16(sacc[2 * s + 1][2], sacc[2 * s + 1][3]);
        pf[s] = __builtin_bit_cast(bf16x8, w);
    }
    f32x4 oacc[8];
#pragma unroll
    for (int mt = 0; mt < 8; ++mt) oacc[mt] = (f32x4){0.f, 0.f, 0.f, 0.f};
#pragma unroll
    for (int s = 0; s < 4; ++s) {
        u32x4 vd[8];
#pragma unroll
        for (int jj = 0; jj < 8; ++jj) vd[jj] = *(LAS const u32x4*)(lds + vb[jj] + 8192 * s);
#pragma unroll
        for (int mt = 0; mt < 8; ++mt) oacc[mt] = mfma16(extract8(vd, mt), pf[s], oacc[mt]);
        SCHED_FENCE();
    }
#pragma unroll
    for (int dir = 0; dir < 2; ++dir) {
        f32x4 tacc[8];
#pragma unroll
        for (int mt = 0; mt < 8; ++mt) tacc[mt] = (f32x4){0.f, 0.f, 0.f, 0.f};
#pragma unroll
        for (int s = 0; s < 4; ++s) {
#pragma unroll
            for (int mt = 0; mt < 8; ++mt) { const bf16x8 sf = *(LAS const bf16x8*)(lds + sb[s] + 256 * mt + 32768 * dir); tacc[mt] = mfma16(sf, qf[s], tacc[mt]); }
            SCHED_FENCE();
        }
        const float qd = dir == 0 ? ex2((float)(qi + 1) * lg2f) : ex2((float)(128 - qi) * lg2b);
#pragma unroll
        for (int mt = 0; mt < 8; ++mt) oacc[mt] = oacc[mt] + tacc[mt] * qd;
    }
    asm volatile("s_waitcnt lgkmcnt(0)" ::: "memory"); __builtin_amdgcn_s_barrier(); asm volatile("" ::: "memory");
    float ss = 0.f;
#pragma unroll
    for (int mt = 0; mt < 8; ++mt) ss += (oacc[mt][0] * oacc[mt][0] + oacc[mt][1] * oacc[mt][1]) + (oacc[mt][2] * oacc[mt][2] + oacc[mt][3] * oacc[mt][3]);
    ss += shfl_xor_f(ss, 16); ss += shfl_xor_f(ss, 32);
    const float rinv = rsq_f(ss * (1.0f / 128.0f) + EPS);
#pragma unroll
    for (int reg = 0; reg < 4; ++reg) {
        const int dvb = 32 * g + 8 * reg;
        const u32x4 gt = *(const u32x4*)(Prow + (size_t)qi * ABIN + 6144 + head * 128 + dvb);
        float o[8];
#pragma unroll
        for (int mt = 0; mt < 8; ++mt) { const float gv = (mt & 1) ? bf_hi(gt[mt >> 1]) : bf_lo(gt[mt >> 1]); o[mt] = silu_f(gv) * (oacc[mt][reg] * rinv); }
        u32x4 w; w[0] = cvt_pk_bf16(o[0], o[1]); w[1] = cvt_pk_bf16(o[2], o[3]); w[2] = cvt_pk_bf16(o[4], o[5]); w[3] = cvt_pk_bf16(o[6], o[7]);
        *(u32x4*)(YAB + (size_t)(rowbase + qi) * D + 1024 + head * 128 + dvb) = w;
    }
}

__device__ __forceinline__ void r3_issue_regions(const bf16_t* Prow, const bf16_t* Stb, LAS unsigned char* lds, const int head, const int rlo, const int wave, const int lane) {
#pragma unroll
    for (int rr = 0; rr < 2; ++rr)
#pragma unroll
        for (int j = 0; j < 4; ++j) {
            const int r = rlo + rr;
            const int p = (j * 8 + wave) * 64 + lane, row = p >> 4, c = (p & 15) ^ (r < 2 ? (row & 15) : ((row >> 3) & 15));
            const bf16_t* src = r == 0 ? Prow + (size_t)row * ABIN + 4096 + head * 128 + c * 8 : (r == 1 ? Prow + (size_t)row * ABIN + 5120 + head * 128 + c * 8
                                : Stb + ((size_t)(r - 2) * 128 + row) * 128 + c * 8);
            __builtin_amdgcn_global_load_lds((const unsigned*)src, (LAS unsigned*)(lds + r * 32768 + (j * 8 + wave) * 1024), 16, 0, 0);
        }
}
__device__ __forceinline__ void r3_phase_pipelined(const bf16_t* P, const bf16_t* St, bf16_t* YAB, LAS unsigned char* lds, const float* decay_exp, const int iab, const int vcu, const int G, const int wave, const int lane) {
    const int i = lane & 15, g = lane >> 4;
    int bt = vcu; if (bt >= NCHUNK * 8) return;
    int kb[4], sb[4], vb[8];
#pragma unroll
    for (int s = 0; s < 4; ++s) { kb[s] = i * 256 + ((4 * s + g) ^ i) * 16; sb[s] = 65536 + i * 2048 + ((4 * s + g) ^ i) * 16; }
#pragma unroll
    for (int jj = 0; jj < 8; ++jj) { const int kk = jj < 4 ? 4 * g + jj : 16 + 4 * g + jj - 4; vb[jj] = 32768 + kk * 256 + (i ^ (kk & 15)) * 16; }
    bf16x8 qn[4];
    {   const int cidx = bt >> 3, head = bt & 7; const bf16_t* Prow = P + (size_t)chunk_row(cidx) * ABIN;
#pragma unroll
        for (int s = 0; s < 4; ++s) qn[s] = *(const bf16x8*)(Prow + (size_t)(16 * wave + i) * ABIN + 3072 + head * 128 + 32 * s + 8 * g);
        const bf16_t* Stb = St + (((size_t)cidx * 8 + head) * 2) * 16384;
        r3_issue_regions(Prow, Stb, lds, head, 0, wave, lane); r3_issue_regions(Prow, Stb, lds, head, 2, wave, lane); }
    for (;;) {
        const int cidx = bt >> 3, head = bt & 7, qi = 16 * wave + i, rowbase = chunk_row(cidx), nbt = bt + G;
        const bool has_next = nbt < NCHUNK * 8;
        const bf16_t* Prow = P + (size_t)rowbase * ABIN;
        const float lg2f = lg2gamma(decay_exp, iab, 0, head), lg2b = lg2gamma(decay_exp, iab, 1, head);
        bf16x8 qf[4];
#pragma unroll
        for (int s = 0; s < 4; ++s) qf[s] = qn[s];
        asm volatile("s_waitcnt vmcnt(8)" ::: "memory");
        asm volatile("s_waitcnt lgkmcnt(0)" ::: "memory"); __builtin_amdgcn_s_barrier(); asm volatile("" ::: "memory");
        f32x4 sacc[8];
#pragma unroll
        for (int mt = 0; mt < 8; ++mt) {
            f32x4 a = (f32x4){0.f, 0.f, 0.f, 0.f};
#pragma unroll
            for (int s = 0; s < 4; ++s) { const bf16x8 kf = *(LAS const bf16x8*)(lds + kb[s] + 4096 * mt); a = mfma16(kf, qf[s], a); }
            sacc[mt] = a;
            if (mt & 1) SCHED_FENCE();
        }
#pragma unroll
        for (int mt = 0; mt < 8; ++mt)
#pragma unroll
            for (int reg = 0; reg < 4; ++reg) {
                const int diff = qi - (16 * mt + 4 * g + reg);
                const float d = diff > 0 ? ex2((float)diff * lg2f) : (diff < 0 ? ex2((float)(-diff) * lg2b) : 2.0f);
                sacc[mt][reg] *= d;
            }
        bf16x8 pf[4];
#pragma unroll
        for (int s = 0; s < 4; ++s) {
            u32x4 w; w[0] = cvt_pk_bf16(sacc[2 * s][0], sacc[2 * s][1]); w[1] = cvt_pk_bf16(sacc[2 * s][2], sacc[2 * s][3]);
            w[2] = cvt_pk_bf16(sacc[2 * s + 1][0], sacc[2 * s + 1][1]); w[3] = cvt_pk_bf16(sacc[2 * s + 1][2], sacc[2 * s + 1][3]);
            pf[s] = __builtin_bit_cast(bf16x8, w);
        }
        f32x4 oacc[8];
#pragma unroll
        for (int mt = 0; mt < 8; ++mt) oacc[mt] = (f32x4){0.f, 0.f, 0.f, 0.f};
#pragma unroll
        for (int s = 0; s < 4; ++s) {
            u32x4 vd[8];
#pragma unroll
            for (int jj = 0; jj < 8; ++jj) vd[jj] = *(LAS const u32x4*)(lds + vb[jj] + 8192 * s);
#pragma unroll
            for (int mt = 0; mt < 8; ++mt) oacc[mt] = mfma16(extract8(vd, mt), pf[s], oacc[mt]);
            SCHED_FENCE();
        }
        asm volatile("s_waitcnt lgkmcnt(0)" ::: "memory"); __builtin_amdgcn_s_barrier(); asm volatile("" ::: "memory");
        if (has_next) {
            const int ncidx = nbt >> 3, nhead = nbt & 7; const bf16_t* nProw = P + (size_t)chunk_row(ncidx) * ABIN;
#pragma unroll
            for (int s = 0; s < 4; ++s) qn[s] = *(const bf16x8*)(nProw + (size_t)(16 * wave + i) * ABIN + 3072 + nhead * 128 + 32 * s + 8 * g);
            r3_issue_regions(nProw, St, lds, nhead, 0, wave, lane);
            asm volatile("s_waitcnt vmcnt(8)" ::: "memory");
        } else asm volatile("s_waitcnt vmcnt(0)" ::: "memory");
        asm volatile("s_waitcnt lgkmcnt(0)" ::: "memory"); __builtin_amdgcn_s_barrier(); asm volatile("" ::: "memory");
#pragma unroll
        for (int dir = 0; dir < 2; ++dir) {
            f32x4 tacc[8];
#pragma unroll
            for (int mt = 0; mt < 8; ++mt) tacc[mt] = (f32x4){0.f, 0.f, 0.f, 0.f};
#pragma unroll
            for (int s = 0; s < 4; ++s) {
#pragma unroll
                for (int mt = 0; mt < 8; ++mt) { const bf16x8 sf = *(LAS const bf16x8*)(lds + sb[s] + 256 * mt + 32768 * dir); tacc[mt] = mfma16(sf, qf[s], tacc[mt]); }
                SCHED_FENCE();
            }
            const float qd = dir == 0 ? ex2((float)(qi + 1) * lg2f) : ex2((float)(128 - qi) * lg2b);
#pragma unroll
            for (int mt = 0; mt < 8; ++mt) oacc[mt] = oacc[mt] + tacc[mt] * qd;
        }
        asm volatile("s_waitcnt lgkmcnt(0)" ::: "memory"); __builtin_amdgcn_s_barrier(); asm volatile("" ::: "memory");
        float ss = 0.f;
#pragma unroll
        for (int mt = 0; mt < 8; ++mt) ss += (oacc[mt][0] * oacc[mt][0] + oacc[mt][1] * oacc[mt][1]) + (oacc[mt][2] * oacc[mt][2] + oacc[mt][3] * oacc[mt][3]);
        ss += shfl_xor_f(ss, 16); ss += shfl_xor_f(ss, 32);
        const float rinv = rsq_f(ss * (1.0f / 128.0f) + EPS);
#pragma unroll
        for (int reg = 0; reg < 4; ++reg) {
            const int dvb = 32 * g + 8 * reg;
            const u32x4 gt = *(const u32x4*)(Prow + (size_t)qi * ABIN + 6144 + head * 128 + dvb);
            float o[8];
#pragma unroll
            for (int mt = 0; mt < 8; ++mt) { const float gv = (mt & 1) ? bf_hi(gt[mt >> 1]) : bf_lo(gt[mt >> 1]); o[mt] = silu_f(gv) * (oacc[mt][reg] * rinv); }
            u32x4 w; w[0] = cvt_pk_bf16(o[0], o[1]); w[1] = cvt_pk_bf16(o[2], o[3]); w[2] = cvt_pk_bf16(o[4], o[5]); w[3] = cvt_pk_bf16(o[6], o[7]);
            *(u32x4*)(YAB + (size_t)(rowbase + qi) * D + 1024 + head * 128 + dvb) = w;
        }
        if (!has_next) break;
        { const int ncidx = nbt >> 3, nhead = nbt & 7; const bf16_t* nProw = P + (size_t)chunk_row(ncidx) * ABIN;
          r3_issue_regions(nProw, St + (((size_t)ncidx * 8 + nhead) * 2) * 16384, lds, nhead, 2, wave, lane); }
        bt = nbt;
    }
}

__device__ __forceinline__ void na_stage_issue(const bf16_t* P, LAS unsigned char* slot, int tok0, int h, int wave, int lane) {
#pragma unroll
    for (int j = 0; j < 2; ++j) {
        const int p = (j * 8 + wave) * 64 + lane, key = p >> 4, c = (p & 15) ^ (key & 15);
        const bf16_t* src = P + (size_t)(tok0 + key) * QKV + 2048 + h * 128 + c * 8;
        __builtin_amdgcn_global_load_lds((const unsigned*)src, (LAS unsigned*)(slot + (j * 8 + wave) * 1024), 16, 0, 0);
        __builtin_amdgcn_global_load_lds((const unsigned*)(src + 2048), (LAS unsigned*)(slot + 16384 + (j * 8 + wave) * 1024), 16, 0, 0);
    }
}
__device__ __forceinline__ void na_half_step(AttnTile& ta, AttnTile& tb, LAS const unsigned char* slot, const int k0, const bool okA, const bool okB, const bool win,
                                             LAS const float* brA, LAS const float* brB, const int kc0, const int c, const int sc, const int i, const int g) {
    f32x4 saA[2], saB[2];
#pragma unroll
    for (int mt = 0; mt < 2; ++mt) {
        const int k = k0 + 16 * mt + i;
        bf16x8 kf[4];
#pragma unroll
        for (int s = 0; s < 4; ++s) kf[s] = *(LAS const bf16x8*)(slot + ((k << 4) + ((4 * s + g) ^ (k & 15))) * 16);
        f32x4 a = (f32x4){0.f, 0.f, 0.f, 0.f}, b = a;
#pragma unroll
        for (int s = 0; s < 4; ++s) { a = mfma16(kf[s], ta.qf[s], a); b = mfma16(kf[s], tb.qf[s], b); }
        saA[mt] = a; saB[mt] = b;
    }
    const bf16x8 pfA = attn_tile_soft(ta, saA, win, okA, brA, kc0, c, sc, g);
    const bf16x8 pfB = attn_tile_soft(tb, saB, win, okB, brB, kc0, c, sc, g);
    u32x4 vd[8];
#pragma unroll
    for (int jj = 0; jj < 8; ++jj) { const int k = k0 + (jj < 4 ? 4 * g + jj : 16 + 4 * g + jj - 4); vd[jj] = *(LAS const u32x4*)(slot + 16384 + ((k << 4) + (i ^ (k & 15))) * 16); }
#pragma unroll
    for (int mt = 0; mt < 8; ++mt) { const bf16x8 vf = extract8(vd, mt); ta.oacc[mt] = mfma16(vf, pfA, ta.oacc[mt]); tb.oacc[mt] = mfma16(vf, pfB, tb.oacc[mt]); }
}
__device__ __forceinline__ void na_block_task(const bf16_t* P, bf16_t* YAB, const float* rpbh, LAS unsigned char* lds, const int h, const int r0, const int tid, const int wave, const int lane) {
    const int i = lane & 15, g = lane >> 4, cgp = wave & 3, pair = wave >> 2;
    const int rA = r0 + 2 * pair, rB = rA + 1, c0 = 16 * cgp, kc0 = cgp == 0 ? 0 : (cgp == 1 ? 8 : (cgp == 2 ? 24 : 32));
    const int c = c0 + i, sc = c - 8 < 0 ? 0 : (c - 8 > 48 ? 48 : c - 8);
    const int srA = rA - 4 < 0 ? 0 : (rA - 4 > 120 ? 120 : rA - 4), srB = rB - 4 < 0 ? 0 : (rB - 4 > 120 ? 120 : rB - 4);
    const int srmin = r0 - 4 < 0 ? 0 : (r0 - 4 > 120 ? 120 : r0 - 4), srlast = r0 - 1 < 0 ? 0 : (r0 - 1 > 120 ? 120 : r0 - 1);
    const int nkr = srlast + 8 - srmin, nsw = (nkr + 1) >> 1, nst = nsw + 2;
    LAS float* bias = (LAS float*)(lds + LDSCTL_OFF + 2048);
    if (tid < 465) bias[tid] = rpbh[tid];
    AttnTile ta, tb;
    attn_tile_init(ta, P, rA * 64 + c0 + i, h, g); attn_tile_init(tb, P, rB * 64 + c0 + i, h, g);
    asm volatile("s_waitcnt vmcnt(0)" ::: "memory");
#define NA_ROWOFF(idx) (nkr == 11 ? ((idx) < 4 ? (((idx) & 1) ? 9 + ((idx) >> 1) : ((idx) >> 1)) : (idx) - 2) : (idx))
#define NA_ISSUE2(stg, slotp) do { const int s_ = (stg); \
        const int t0_ = s_ < nsw ? (srmin + NA_ROWOFF(2 * s_)) * 64 : S + 128 * (s_ - nsw); \
        const int t1_ = s_ < nsw ? (srmin + (2 * s_ + 1 < nkr ? NA_ROWOFF(2 * s_ + 1) : NA_ROWOFF(2 * s_))) * 64 : S + 128 * (s_ - nsw) + 64; \
        na_stage_issue(P, (slotp), t0_, h, wave, lane); na_stage_issue(P, (slotp) + 32768, t1_, h, wave, lane); } while (0)
    NA_ISSUE2(0, lds);
    for (int st = 0; st < nst; ++st) {
        if (st + 1 < nst) {
            NA_ISSUE2(st + 1, lds + ((st + 1) & 1) * 65536);
            asm volatile("s_waitcnt vmcnt(8)" ::: "memory");
        } else asm volatile("s_waitcnt vmcnt(0)" ::: "memory");
        asm volatile("s_waitcnt lgkmcnt(0)" ::: "memory"); __builtin_amdgcn_s_barrier(); asm volatile("" ::: "memory");
        const bool win = st < nsw;
#pragma unroll 1
        for (int sub = 0; sub < 2; ++sub) {
            LAS const unsigned char* slot = lds + (st & 1) * 65536 + sub * 32768;
            const int kr = srmin + NA_ROWOFF(2 * st + sub);
            if (win && 2 * st + sub >= nkr) break;
            const bool doA = !win || (kr >= srA && kr < srA + 8), doB = !win || (kr >= srB && kr < srB + 8);
            if (!doA && !doB) continue;
            const int nh = win ? 1 : 2;
#pragma unroll 1
            for (int hf = 0; hf < nh; ++hf)
                na_half_step(ta, tb, slot, win ? kc0 : 32 * hf, doA, doB, win, bias + (win && doA ? (kr - rA + 7) * 31 : 0), bias + (win && doB ? (kr - rB + 7) * 31 : 0), kc0, c, sc, i, g);
        }
        asm volatile("s_waitcnt lgkmcnt(0)" ::: "memory"); __builtin_amdgcn_s_barrier(); asm volatile("" ::: "memory");
    }
#undef NA_ISSUE2
#undef NA_ROWOFF
    attn_tile_store(ta, YAB, rA * 64 + c0 + i, h, g); attn_tile_store(tb, YAB, rB * 64 + c0 + i, h, g);
}

#ifndef MK_MODE
#define MK_MODE 1
#endif
__global__ void __launch_bounds__(512, 2) mega_fwd(Params p) {
    extern __shared__ __attribute__((aligned(16))) unsigned char lds_raw[];
    LAS unsigned char* lds = (LAS unsigned char*)lds_raw;
    const int G_k = gridDim.x, bx_k = blockIdx.x;
#define SITE_COORDS pt_t0_ = (PT_SITE >= 0) ? wall_clock64() : 0ull; int tid = threadIdx.x; asm volatile("" : "+v"(tid)); int Gl_ = G_k, bxl_ = bx_k; asm volatile("" : "+s"(Gl_), "+s"(bxl_)); const int G = Gl_, bx = bxl_, NGW = G * 8; (void)NGW; const int lane = tid & 63, wave = __builtin_amdgcn_readfirstlane(tid >> 6); \
    const int vcu = (bx & 7) * (G >> 3) + (bx >> 3); const int gw = vcu * 8 + wave;     (void)lane; (void)gw; (void)vcu; \
    LAS const unsigned* prm = (LAS const unsigned*)(lds + PRM_OFF); asm volatile("" : "+v"(prm)); unsigned char* ws = (unsigned char*)(GAS unsigned char*)ldptr(prm, 17); (void)ws; \
    float* modacc = (float*)(ws + WS_MODACC); f32x2* rope = (f32x2*)(ws + WS_ROPE); float* X = (float*)(ws + WS_X); bf16_t* H = (bf16_t*)(ws + WS_H); bf16_t* P = (bf16_t*)(ws + WS_P); bf16_t* YAB = (bf16_t*)(ws + WS_YAB); \
    float* Y = (float*)(ws + WS_Y); bf16_t* HID = (bf16_t*)(ws + WS_P)  ; float* KVT = (float*)(ws + WS_Y)  ; bf16_t* ST = (bf16_t*)(ws + WS_Y + (size_t)NCHUNK * 16 * 16384 * 2); float* YC = (float*)(ws + WS_YC); \
    (void)modacc; (void)rope; (void)X; (void)H; (void)P; (void)YAB; (void)Y; (void)HID; (void)KVT; (void)ST; (void)YC
#define INP(k) ((const float*)(GAS const float*)ldptr(prm, (k)))
    volatile LAS unsigned* MISC = (volatile LAS unsigned*)(lds + MISC_OFF);
    { const int tid = threadIdx.x; for (int u = tid; u < (LDS_BYTES - LDSCTL_OFF) / 4; u += 512) ((LAS unsigned*)(lds + LDSCTL_OFF))[u] = 0u; }
    __syncthreads();
    if (threadIdx.x == 0) { LAS unsigned long long* q = (LAS unsigned long long*)(lds + PRM_OFF);
        q[0] = (unsigned long long)p.in[0]; q[1] = (unsigned long long)p.in[1]; q[2] = (unsigned long long)p.in[2]; q[3] = (unsigned long long)p.in[3];
        q[4] = (unsigned long long)p.in[4]; q[5] = (unsigned long long)p.in[5]; q[6] = (unsigned long long)p.in[6]; q[7] = (unsigned long long)p.in[7];
        q[8] = (unsigned long long)p.in[8]; q[9] = (unsigned long long)p.in[9]; q[10] = (unsigned long long)p.in[10]; q[11] = (unsigned long long)p.in[11];
        q[12] = (unsigned long long)p.in[12]; q[13] = (unsigned long long)p.in[13]; q[14] = (unsigned long long)p.in[14]; q[15] = (unsigned long long)p.in[15];
        q[16] = (unsigned long long)p.out; q[17] = (unsigned long long)p.ws; }
    __syncthreads();
    const int lo = MK_MODE == 1 ? 0 : p.ph_lo, hi = MK_MODE == 1 ? NPHASE : p.ph_hi;
    const bool multi = (hi - lo) > 1;
    XcdBarrier bar; bar.bar = (unsigned*)(p.ws + WS_CTL) + p.li * 4096; bar.x = 0; bar.st = nullptr;
    if (multi) bar = xcd_barrier_post((unsigned*)(p.ws + WS_CTL) + p.li * 4096, MISC + 8);
#ifndef SITE_MASK
#define SITE_MASK 0xffff
#endif
#define EN(i) (((SITE_MASK) >> (i)) & 1)
#ifndef REPEAT_MASK
#define REPEAT_MASK 0
#endif
#if REPEAT_MASK != 0
    int rmask_ = REPEAT_MASK; asm volatile("" : "+s"(rmask_));
#define REP(i) ((rmask_ >> (i)) & 1)
#else
#define REP(i) 0
#endif
#define IN(k) (lo <= (k) && (k) < hi)
#ifndef DEFER_CVT
#define DEFER_CVT 1
#endif
#define DEFER_SLOT(rk_, nblk_, lo_, hi_) do { if (DEFER_CVT && G == 256) {     const int rk = (rk_); if (rk >= 0) { LAS float* scr_ = (LAS float*)(lds + wave * 16384); \
        for (int gi = (lo_) + rk * 8 + wave; gi < (hi_); gi += (nblk_) * 8) cvt_dl_item(prm, gi, scr_, lane); } __syncthreads(); } } while (0)
#define DEFER_ADA(rk_, lo_, hi_) do { if (DEFER_CVT && G == 256) { const int ai_ = (lo_) + (rk_); if ((rk_) >= 0 && ai_ < (hi_)) ada_item(prm, 1 + (ai_ >> 7), (ai_ >> 4) & 7, ai_ & 15, tid); } } while (0)
#define MODF_FINALIZE(l0_, l1_) do { for (int it = (vcu * 512 + tid); it < ((l1_) - (l0_)) * 2 * 6 * (D / 4); it += G * 512) { const int col = 4 * (it & 511), j6 = (it >> 9) % 6, ls = 2 * (l0_) + it / (512 * 6); \
        *(f32x4*)((float*)(ws + WS_MODF) + (size_t)(ls * 6 + j6) * D + col) = modvec_partials(modacc, INP(5), ls >> 1, ls & 1, j6, col); } } while (0)
#define ROWOP_RUN(a0) do { RowopArgs ra_ = (a0); if (rep_ + 1 < nrep_) { ra_.xout_lat = (float*)(ws + WS_END); ra_.xout_ctx = ra_.xout_lat + (size_t)S * D; ra_.h = (bf16_t*)(ws + WS_END + (size_t)MTOK * D * 4); } LAS float* cf0 = (LAS float*)lds; LAS float* cf1 = (LAS float*)(lds + 24576); \
        rowop_coefs(ra_, 0, cf0, tid); if (ra_.nctx) rowop_coefs(ra_, 1, cf1, tid); __syncthreads(); \
        if (ra_.nctx) rowop_ctx(ra_, cf1, (LAS float*)(lds + 49152), vcu, G, wave, lane); \
        rowop_stream(ra_, cf0, gw, NGW, lane); __syncthreads(); } while (0)
#ifndef DOUBLE_BAR
#define DOUBLE_BAR 0
#endif
#ifndef PT_SITE
#define PT_SITE -1
#endif
#ifndef PT_BLOCK
#define PT_BLOCK 0
#endif
#ifndef IDLE_Q
#define IDLE_Q 40.0f
#endif
#ifndef IDLE_PROBE
#define IDLE_PROBE 0
#endif
    unsigned long long idle_acc_ = 0ull, pt_t0_ = 0ull, pt_acc_ = 0ull; int pt_cur_ = -1; (void)pt_t0_; (void)pt_acc_; (void)pt_cur_;
#define SEAM(k, knext) do { if (PT_SITE >= 0) { if (pt_cur_ == PT_SITE) pt_acc_ += wall_clock64() - pt_t0_; pt_cur_ = -1; } if (IN(k) && IN(knext)) { unsigned long long t0_ = 0ull; if (IDLE_PROBE) t0_ = wall_clock64(); { XcdBarrier b_ = bar; asm volatile("" : "+s"(b_.x)); xcd_barrier(b_); if (DOUBLE_BAR) xcd_barrier(b_); } \
        if (IDLE_PROBE == 1 || (IDLE_PROBE >= 2 && IDLE_PROBE < 100 && (k) >= 2 && ((k) - 2) % 9 == IDLE_PROBE - 2) || (IDLE_PROBE >= 100 && (k) == IDLE_PROBE - 100)) idle_acc_ += wall_clock64() - t0_; } } while (0)

    for (int nrep_ = 1 + REP(0), rep_ = 0; rep_ < nrep_; ++rep_) if (EN(0) && IN(0) && ((pt_cur_ = 0), true)) {
        SITE_COORDS;
        LAS float* scr = (LAS float*)(lds + wave * 16384);
        if (DEFER_CVT && G == 256) {
            constexpr int L0_ADA_SHARE = 2048;
            if (vcu < 128) { ada_item(prm, 0, vcu >> 4, vcu & 15, tid); for (int it = L0_ITEMS - L0_ADA_SHARE + vcu * 8 + wave; it < L0_ITEMS; it += 1024) cvt_l0_item(prm, it, scr, lane); }
            else for (int it = (vcu - 128) * 8 + wave; it < L0_ITEMS - L0_ADA_SHARE; it += 1024) cvt_l0_item(prm, it, scr, lane);
        } else {
            for (int it = gw; it < L0_ITEMS; it += NGW) cvt_l0_item(prm, it, scr, lane);
            for (int it = gw; it < DL_END; it += NGW) cvt_dl_item(prm, it, scr, lane);
            for (int it = vcu; it < 4 * 128; it += G) ada_item(prm, it >> 7, (it >> 4) & 7, it & 15, tid);
        }
        for (int idx = bx * 512 + tid; idx < 192 * 32; idx += G * 512) {
            const int pi = idx >> 5, f = idx & 31; const float pos = (float)(pi < 128 ? pi : pi - 128);
            const float ang = pos * powf(10000.0f, -(float)f / 32.0f);
            rope[idx] = (f32x2){cosf(ang), sinf(ang)};
        }
    }
    SEAM(0, 1);
    for (int nrep_ = 1 + REP(1), rep_ = 0; rep_ < nrep_; ++rep_) if (EN(1) && IN(1) && ((pt_cur_ = 1), true)) {
        SITE_COORDS;
        RowopArgs a; a.y = nullptr; a.xin_lat = INP(0); a.xin_ctx = INP(2); a.xout_lat = nullptr; a.xout_ctx = nullptr; a.xin16 = 0; a.xout16 = 0;     a.h = H; a.modacc = modacc; a.ada_b = INP(5); a.norm_g = INP(6);
        a.ly = -1; a.jg_y = 0; a.jgate = 0; a.lh = 0; a.jg_h = 0; a.jshift = 0; a.jscale = 1; a.nctx = NCTX; a.ypart = nullptr; a.nypart = 0; a.modf = nullptr;
        if (DEFER_CVT && G == 256) MODF_FINALIZE(0, 1); else MODF_FINALIZE(0, 4);
        ROWOP_RUN(a);
    }
    SEAM(1, 2);
    for (int layer = 0; layer < DEPTH; ++layer) {
        const int pb = 2 + 9 * layer, iab = layer >> 1;
        const bool even = (layer & 1) == 0, last = layer == DEPTH - 1;
        const int Mrows = last ? S : MTOK;
        if (even) {
            for (int nrep_ = 1 + REP(2), rep_ = 0; rep_ < nrep_; ++rep_) if (EN(2) && IN(pb + 0) && ((pt_cur_ = 2), true)) {
                SITE_COORDS;
                if (rep_ == 0) { if (layer == 0) { DEFER_ADA(bx - 156, 0, 100); DEFER_SLOT(bx - 156, 100, 0, 6400); } else { DEFER_ADA(bx - 156, 268, 368); DEFER_SLOT(bx - 156, 100, 46784, 53184); } }
                pg8::Gemm g{H, (const bf16_t*)(ws + WS_WABIN + iab * SZ_WABIN), MTOK, ABIN, D}; pg8::StaticOrder So; So.init(MTOK, ABIN, D, G, bx);
                EpiInProj E{P, rope};
                pg8::gemm_phase<EpiInProj, pg8::StaticOrder, PG8_ALIGN, PG8_SP2>(lds, g, So, E, tid);
            }
            SEAM(pb + 0, pb + 1);
            for (int nrep_ = 1 + REP(3), rep_ = 0; rep_ < nrep_; ++rep_) if (EN(3) && IN(pb + 1) && ((pt_cur_ = 3), true)) {
                SITE_COORDS;
                if (rep_ == 0) { if (layer == 0) DEFER_SLOT(vcu - 16, 240, 6400, 12160); else DEFER_SLOT(vcu - 16, 240, 53184, 58944); }
                r1_phase_pipelined(P, KVT, lds, INP(9), iab, vcu, G, wave, lane);
                { const int cw0 = G == 256 ? (vcu - 16) * 8 + wave : gw, cwn = G == 256 ? 240 * 8 : NGW;
                  if (cw0 >= 0) for (int t = cw0; t < (MTOK / 8) * 2; t += cwn) conv_task(P, YAB, INP(8) + (size_t)iab * 3 * 1024, t, lane); }
            }
            SEAM(pb + 1, pb + 2);
            for (int nrep_ = 1 + REP(4), rep_ = 0; rep_ < nrep_; ++rep_) if (EN(4) && IN(pb + 2) && ((pt_cur_ = 4), true)) {
                SITE_COORDS;
                for (int it = vcu * 512 + tid; it < 131072; it += G * 512) r2_item((const bf16_t*)KVT, ST, INP(9), iab, it);
            }
            SEAM(pb + 2, pb + 3);
            for (int nrep_ = 1 + REP(5), rep_ = 0; rep_ < nrep_; ++rep_) if (EN(5) && IN(pb + 3) && ((pt_cur_ = 5), true)) {
                SITE_COORDS;
                if (rep_ == 0) { if (layer == 0) DEFER_SLOT(vcu - 16, 240, 12160, 19840); else DEFER_SLOT(vcu - 16, 240, 58944, 66624); }
                r3_phase_pipelined(P, ST, YAB, lds, INP(9), iab, vcu, G, wave, lane);
            }
            SEAM(pb + 3, pb + 4);
        } else {
            for (int nrep_ = 1 + REP(6), rep_ = 0; rep_ < nrep_; ++rep_) if (EN(6) && IN(pb + 0) && ((pt_cur_ = 6), true)) {
                SITE_COORDS;
                if (rep_ == 0) { if (layer == 1) DEFER_SLOT(bx - 24, 232, 25888, 40736); else DEFER_SLOT(bx - 24, 232, 72672, 87520); }
                pg8::Gemm g{H, (const bf16_t*)(ws + WS_WQKV + iab * SZ_WQKV), MTOK, QKV, D}; pg8::StaticOrder So; So.init(MTOK, QKV, D, G, bx);
                EpiBf16 E{P, QKV};
                pg8::gemm_phase<EpiBf16, pg8::StaticOrder, PG8_ALIGN, PG8_SP2>(lds, g, So, E, tid);
            }
            SEAM(pb + 0, pb + 1);
            for (int nrep_ = 1 + REP(7), rep_ = 0; rep_ < nrep_; ++rep_) if (EN(7) && IN(pb + 1) && ((pt_cur_ = 7), true)) {
                SITE_COORDS;
                const float* rpb = INP(12) + (size_t)iab * 16 * 15 * 31;
                for (int bt = vcu; bt < 512; bt += G) {
                    const int h = bt >> 5, rq = bt & 31;
                    na_block_task(P, YAB, rpb + h * 465, lds, h, 4 * rq, tid, wave, lane);
                }
                if (!last) for (int t = gw; t < 128; t += NGW) attn_task2<false>(P, YAB, rpb, t >> 3, S + 32 * (t & 7), S + 32 * (t & 7) + 16, 0, 0, 0, lane);
            }
            SEAM(pb + 1, pb + 4);
        }
        for (int nrep_ = 1 + REP(8), rep_ = 0; rep_ < nrep_; ++rep_) if (EN(8) && IN(pb + 4) && ((pt_cur_ = 8), true)) {
            SITE_COORDS;
            const bf16_t* wt = even ? (const bf16_t*)(ws + WS_WABOUT + iab * SZ_WSQ) : (const bf16_t*)(ws + WS_WNAOUT + iab * SZ_WSQ);
            pg8::Gemm g{YAB, wt, MTOK, D, D}; pg8::MixedOrder So; So.init(S, D, D, G, bx, 32, last ? 0 : NSPLIT_OUT);
            EpiY E{(bf16_t*)Y, D, (bf16_t*)YC};
            pg8::gemm_phase<EpiY, pg8::MixedOrder, PG8_ALIGN, PG8_SP2>(lds, g, So, E, tid);
        }
        SEAM(pb + 4, pb + 5);
        for (int nrep_ = 1 + REP(9), rep_ = 0; rep_ < nrep_; ++rep_) if (EN(9) && IN(pb + 5) && ((pt_cur_ = 9), true)) {
            SITE_COORDS;
            RowopArgs a; a.y = (const bf16_t*)Y; a.xin_lat = layer == 0 ? INP(0) : X; a.xin_ctx = layer == 0 ? INP(2) : (const float*)((const bf16_t*)X + (size_t)S * D); a.xout_lat = X; a.xout_ctx = (float*)((bf16_t*)X + (size_t)S * D); a.xin16 = layer == 0 ? 0 : 1; a.xout16 = 1;     a.h = H; a.modacc = modacc; a.ada_b = INP(5); a.norm_g = INP(6);
            a.ly = layer; a.jg_y = 1; a.jgate = 2; a.lh = layer; a.jg_h = 2; a.jshift = 3; a.jscale = 4; a.nctx = last ? 0 : NCTX; a.ypart = (const bf16_t*)YC; a.nypart = NSPLIT_OUT; a.modf = (const float*)(ws + WS_MODF);
            ROWOP_RUN(a);
        }
        SEAM(pb + 5, pb + 6);
        for (int nrep_ = 1 + REP(10), rep_ = 0; rep_ < nrep_; ++rep_) if (EN(10) && IN(pb + 6) && ((pt_cur_ = 10), true)) {
            SITE_COORDS;
            if (rep_ == 0) { if (layer == 0) { DEFER_ADA(bx - 172, 100, 184); DEFER_SLOT(bx - 172, 84, 19840, 25888); } else if (layer == 1) { DEFER_ADA(bx - 172, 184, 268); DEFER_SLOT(bx - 172, 84, 40736, 46784); } else if (layer == 2) { DEFER_ADA(bx - 172, 368, 384); DEFER_SLOT(bx - 172, 84, 66624, 72672); } else DEFER_SLOT(bx - 128, 128, 87520, DL_END); }
            pg8::Gemm g{H, (const bf16_t*)(ws + WS_WFFIN + layer * SZ_WFFIN), Mrows, FF2, D}; pg8::StaticOrder So; So.init(Mrows, FF2, D, G, bx);
            EpiSwiglu E{HID};
            pg8::gemm_phase<EpiSwiglu, pg8::StaticOrder, PG8_ALIGN, PG8_SP2>(lds, g, So, E, tid);
        }
        SEAM(pb + 6, pb + 7);
        for (int nrep_ = 1 + REP(11), rep_ = 0; rep_ < nrep_; ++rep_) if (EN(11) && IN(pb + 7) && ((pt_cur_ = 11), true)) {
            SITE_COORDS;
            if (rep_ == 0 && !last && DEFER_CVT && G == 256) MODF_FINALIZE(layer + 1, layer + 2);
            pg8::Gemm g{HID, (const bf16_t*)(ws + WS_WFFOUT + layer * SZ_WFFOUT), MTOK, D, FFH}; pg8::MixedOrder So; So.init(S, D, FFH, G, bx, 32, last ? 0 : NSPLIT_FFO);
            EpiY E{(bf16_t*)Y, D, (bf16_t*)YC};
            pg8::gemm_phase<EpiY, pg8::MixedOrder, PG8_ALIGN, PG8_SP2>(lds, g, So, E, tid);
        }
        SEAM(pb + 7, pb + 8);
        for (int nrep_ = 1 + REP(12), rep_ = 0; rep_ < nrep_; ++rep_) if (EN(12) && IN(pb + 8) && ((pt_cur_ = 12), true)) {
            SITE_COORDS;
            RowopArgs a; a.y = (const bf16_t*)Y; a.xin_lat = X; a.xin_ctx = (const float*)((const bf16_t*)X + (size_t)S * D); a.xout_lat = last ? (float*)(GAS float*)ldptr(prm, 16) : X; a.xout_ctx = last ? nullptr : (float*)((bf16_t*)X + (size_t)S * D); a.xin16 = 1; a.xout16 = last ? 0 : 1; a.h = H; a.modacc = modacc; a.ada_b = INP(5); a.norm_g = INP(6);
            a.ly = layer; a.jg_y = 3; a.jgate = 5; a.lh = last ? -1 : layer + 1; a.jg_h = 0; a.jshift = 0; a.jscale = 1; a.nctx = last ? 0 : NCTX; a.ypart = (const bf16_t*)YC; a.nypart = NSPLIT_FFO; a.modf = (const float*)(ws + WS_MODF);
            ROWOP_RUN(a);
        }
        if (!last) SEAM(pb + 8, pb + 9);
    }
    if (PT_SITE >= 0) { if (blockIdx.x == PT_BLOCK && threadIdx.x == 0) { const float us = (float)((double)pt_acc_ * 0.01); p.out[0] = 1000.0f * IDLE_Q * floorf(us / IDLE_Q + 0.5f); } }
    if (IDLE_PROBE) {
        unsigned long long* acc = (unsigned long long*)(p.ws + WS_CTL + 32768);
        if (threadIdx.x == 0) atomicAdd(acc, idle_acc_);
        xcd_barrier(bar);
        if (blockIdx.x == 0 && threadIdx.x == 0) { const unsigned long long tot = __hip_atomic_load(acc, __ATOMIC_RELAXED, __HIP_MEMORY_SCOPE_AGENT); const float us = (float)((double)tot / (double)G_k * 0.01); p.out[0] = 1000.0f * IDLE_Q * floorf(us / IDLE_Q + 0.5f); }
    }
#undef IN
#undef SEAM
}

extern "C" void kernel_launch(void* const* d_in, const int* in_sizes, int n_in, void* d_out, int out_size, void* d_ws, size_t ws_size, hipStream_t stream) {
    static int grid = 0;
    if (grid == 0) {
        if (n_in != 16 || out_size != S * D || ws_size < WS_END) { fprintf(stderr, "kernel_launch: unexpected shapes (n_in %d out %d ws %zu need %zu)\n", n_in, out_size, ws_size, (size_t)WS_END); grid = -1; return; }
        int dev = 0, cus = 0, per_cu = 0;
        if (hipGetDevice(&dev) != hipSuccess || hipDeviceGetAttribute(&cus, hipDeviceAttributeMultiprocessorCount, dev) != hipSuccess) { grid = -1; return; }
        if (hipFuncSetAttribute((const void*)mega_fwd, hipFuncAttributeMaxDynamicSharedMemorySize, LDS_BYTES) != hipSuccess) { fprintf(stderr, "kernel_launch: hipFuncSetAttribute failed\n"); grid = -1; return; }
        if (hipOccupancyMaxActiveBlocksPerMultiprocessor(&per_cu, (const void*)mega_fwd, 512, LDS_BYTES) != hipSuccess || per_cu < 1) fprintf(stderr, "kernel_launch: occupancy query says %d\n", per_cu);
        (void)hipGetLastError();
        grid = cus;
    }
    if (grid < 0) return;
    if (hipMemsetAsync((char*)d_ws + WS_CTL, 0, CTL_ZERO_BYTES, stream) != hipSuccess) { fprintf(stderr, "kernel_launch: memset failed\n"); return; }
    Params a{};
    for (int i = 0; i < 16; ++i) a.in[i] = (const float*)d_in[i];
    a.out = (float*)d_out; a.ws = (unsigned char*)d_ws; a.pad = 0;
#if MK_MODE == 1
    a.ph_lo = 0; a.ph_hi = NPHASE; a.li = 0;
    hipLaunchKernelGGL(mega_fwd, dim3(grid), dim3(512), LDS_BYTES, stream, a);
#else
    for (int ph = 0; ph < NPHASE; ++ph) {
        if (ph >= 2) { const int layer = (ph - 2) / 9, slot = (ph - 2) % 9; if ((layer & 1) && (slot == 2 || slot == 3)) continue; }
        a.ph_lo = ph; a.ph_hi = ph + 1; a.li = 0;
        hipLaunchKernelGGL(mega_fwd, dim3(grid), dim3(512), LDS_BYTES, stream, a);
    }
#endif
    const hipError_t le = hipPeekAtLastError();
    if (le != hipSuccess) fprintf(stderr, "kernel_launch: launch failed: %s\n", hipGetErrorName(le));
}
#endif
```

```cpp
#ifndef HOST_EMU
#include <hip/hip_runtime.h>
#include <cstdio>
#include <cstdint>
#define DEV __device__ __forceinline__
#define HDEV __host__ __device__ __forceinline__
#define LAS __attribute__((address_space(3)))
#define GAS __attribute__((address_space(1)))
#endif

typedef unsigned short bf16_t;
typedef short bf16x8 __attribute__((ext_vector_type(8)));
typedef float f32x4 __attribute__((ext_vector_type(4)));
typedef float f32x2 __attribute__((ext_vector_type(2)));
typedef unsigned u32x4 __attribute__((ext_vector_type(4)));
typedef unsigned u32x2 __attribute__((ext_vector_type(2)));

#ifndef HOST_EMU
#define SCHED_FENCE() __builtin_amdgcn_sched_barrier(0)
DEV f32x4 mfma16(bf16x8 a, bf16x8 b, f32x4 c) { return __builtin_amdgcn_mfma_f32_16x16x32_bf16(a, b, c, 0, 0, 0); }
DEV float shfl_xor_f(float v, int m) { return __shfl_xor(v, m); }
DEV unsigned cvt_pk_bf16(float lo, float hi) { unsigned r; asm("v_cvt_pk_bf16_f32 %0, %1, %2" : "=v"(r) : "v"(lo), "v"(hi)); return r; }
DEV float ex2(float x) { return __builtin_amdgcn_exp2f(x); }
DEV float rcp_f(float x) { return __builtin_amdgcn_rcpf(x); }
DEV float rsq_f(float x) { return 1.0f / sqrtf(x); }
DEV void atomic_add_f(float* p, float v) { (void)__hip_atomic_fetch_add(p, v, __ATOMIC_RELAXED, __HIP_MEMORY_SCOPE_AGENT); }
#endif

namespace cfg {
constexpr int D = 2048, S = 8192, NCTX = 256, MTOK = 8448, DEPTH = 4;
constexpr int ABIN = 7168, FFH = 5632, FF2 = 11264, QKV = 6144;
constexpr int NCHUNK = 66;
constexpr float EPS = 1e-6f;
constexpr float HSCALE = 0.08838834764831845f;
constexpr float LOG2E = 1.4426950408889634f;
}
using namespace cfg;

DEV float bf_lo(unsigned w) { return __builtin_bit_cast(float, w << 16); }
DEV float bf_hi(unsigned w) { return __builtin_bit_cast(float, w & 0xffff0000u); }
DEV float wave_sum(float v) {
#pragma unroll
    for (int o = 1; o < 64; o <<= 1) v += shfl_xor_f(v, o);
    return v;
}
DEV float silu_f(float x) { return x * rcp_f(1.0f + ex2(-x * LOG2E)); }
DEV float lg2gamma(const float* decay_exp, int iab, int dir, int head) {
    const float e = decay_exp[(iab * 2 + dir) * 8 + head];
    return log1pf(-exp2f(-e)) * LOG2E;
}
DEV bf16x8 extract8(const u32x4 (&vd)[8], int mt) {
    u32x4 w;
#pragma unroll
    for (int q = 0; q < 4; ++q) {
        const unsigned X = vd[2 * q][mt >> 1], Y = vd[2 * q + 1][mt >> 1];
        w[q] = (mt & 1) ? ((X >> 16) | (Y & 0xffff0000u)) : ((X & 0xffffu) | (Y << 16));
    }
    return __builtin_bit_cast(bf16x8, w);
}

struct RowopArgs {
    const bf16_t* y;
    const float* xin_lat; const float* xin_ctx;
    float* xout_lat; float* xout_ctx;
    bf16_t* h;
    const float* modacc; const float* ada_b; const float* norm_g;
    const float* modf;
    int ly, jg_y, jgate, lh, jg_h, jshift, jscale, nctx;
    int xin16, xout16;
    const bf16_t* ypart; int nypart;
};
DEV f32x4 ld4(const float* p) { return *(const f32x4*)p; }
constexpr int MODPART = 4 * 2 * 6 * 2048;
DEV f32x4 modvec_partials(const float* modacc, const float* ada_b, int l, int s, int j, int col) {
    const float* q = modacc + (size_t)((l * 2 + s) * 6 + j) * D + col;
    f32x4 r = ld4(ada_b + (size_t)l * 6 * D + j * D + col);
#pragma unroll
    for (int kp = 0; kp < 16; ++kp) r = r + ld4(q + (size_t)kp * MODPART);
    return r;
}
DEV f32x4 modvec(const RowopArgs& a, int l, int s, int j, int col) {
    if (a.modf) return ld4(a.modf + (size_t)((l * 2 + s) * 6 + j) * D + col);
    return modvec_partials(a.modacc, a.ada_b, l, s, j, col);
}
template <class CP>
DEV void rowop_coefs(const RowopArgs& a, const int s, CP coef, const int tid) {
    const int col = 4 * tid;
    f32x4 A = (f32x4){0.f, 0.f, 0.f, 0.f}, B = A, SH = A;
    if (a.ly >= 0) A = modvec(a, a.ly, s, a.jgate, col) * ld4(a.norm_g + (size_t)(a.ly * 4 + a.jg_y) * D + col);
    if (a.lh >= 0) { B = ld4(a.norm_g + (size_t)(a.lh * 4 + a.jg_h) * D + col) * (modvec(a, a.lh, s, a.jscale, col) + 1.0f); SH = modvec(a, a.lh, s, a.jshift, col); }
    *(f32x4*)(coef + col) = A; *(f32x4*)(coef + D + col) = B; *(f32x4*)(coef + 2 * D + col) = SH;
}
template <class CP>
DEV void rowop_row(const RowopArgs& a, const int s, CP coef, const int m, f32x4 (&x)[8], const f32x4 (&y)[8], const int lane) {
    const bool hasy = a.ly >= 0, hash = a.lh >= 0;
    if (hasy) {
        float ss = 0.f;
#pragma unroll
        for (int j = 0; j < 8; ++j) ss += (y[j][0] * y[j][0] + y[j][1] * y[j][1]) + (y[j][2] * y[j][2] + y[j][3] * y[j][3]);
        const float r1 = rsq_f(wave_sum(ss) * (1.0f / D) + EPS);
#pragma unroll
        for (int j = 0; j < 8; ++j) x[j] = x[j] + *(const f32x4*)(coef + 4 * lane + 256 * j) * (y[j] * r1);
    }
    float* xb = (s == 0) ? a.xout_lat : a.xout_ctx; const size_t xrow = (size_t)((s == 0) ? m : m - S) * D;
    if (xb) {
        if (a.xout16) { bf16_t* xo = (bf16_t*)xb + xrow;
#pragma unroll
            for (int j = 0; j < 8; ++j) { u32x2 w; w[0] = cvt_pk_bf16(x[j][0], x[j][1]); w[1] = cvt_pk_bf16(x[j][2], x[j][3]); __builtin_nontemporal_store(w, (u32x2*)(xo + 4 * lane + 256 * j)); }
        } else { float* xo = xb + xrow;
#pragma unroll
            for (int j = 0; j < 8; ++j) __builtin_nontemporal_store(x[j], (f32x4*)(xo + 4 * lane + 256 * j));
        }
    }
    if (hash) {
        float ss = 0.f;
#pragma unroll
        for (int j = 0; j < 8; ++j) ss += (x[j][0] * x[j][0] + x[j][1] * x[j][1]) + (x[j][2] * x[j][2] + x[j][3] * x[j][3]);
        const float r2 = rsq_f(wave_sum(ss) * (1.0f / D) + EPS);
        bf16_t* hr = a.h + (size_t)m * D;
#pragma unroll
        for (int j = 0; j < 8; ++j) { const f32x4 v = (x[j] * r2) * *(const f32x4*)(coef + D + 4 * lane + 256 * j) + *(const f32x4*)(coef + 2 * D + 4 * lane + 256 * j);
            u32x2 w; w[0] = cvt_pk_bf16(v[0], v[1]); w[1] = cvt_pk_bf16(v[2], v[3]); __builtin_nontemporal_store(w, (u32x2*)(hr + 4 * lane + 256 * j)); }
    }
}
template <class CP>
DEV void rowop_stream(const RowopArgs& a, CP coef, const int gw, const int NGW, const int lane) {
    for (int m = gw; m < S; m += NGW) {
        f32x4 x[8], y[8];
        if (a.xin16) { const bf16_t* xr = (const bf16_t*)a.xin_lat + (size_t)m * D;
#pragma unroll
            for (int j = 0; j < 8; ++j) { const u32x2 w = __builtin_nontemporal_load((const u32x2*)(xr + 4 * lane + 256 * j)); x[j] = (f32x4){bf_lo(w[0]), bf_hi(w[0]), bf_lo(w[1]), bf_hi(w[1])}; }
        } else { const float* xr = a.xin_lat + (size_t)m * D;
#pragma unroll
            for (int j = 0; j < 8; ++j) x[j] = ld4(xr + 4 * lane + 256 * j);
        }
#pragma unroll
        for (int j = 0; j < 8; ++j) y[j] = (f32x4){0.f, 0.f, 0.f, 0.f};
        if (a.ly >= 0) { const bf16_t* yr = a.y + (size_t)m * D;
#pragma unroll
            for (int j = 0; j < 8; ++j) { const u32x2 w = __builtin_nontemporal_load((const u32x2*)(yr + 4 * lane + 256 * j)); y[j] = (f32x4){bf_lo(w[0]), bf_hi(w[0]), bf_lo(w[1]), bf_hi(w[1])}; } }
        rowop_row(a, 0, coef, m, x, y, lane);
    }
}
#ifndef HOST_EMU
template <class CP, class LP>
DEV void rowop_ctx(const RowopArgs& a, CP coef, LP red, const int vcu, const int G, const int wave, const int lane) {
    const bool hasy = a.ly >= 0, hash = a.lh >= 0;
    for (int r = vcu; r < a.nctx; r += G) {
        const int col = 256 * wave + 4 * lane;
        f32x4 x;
        if (a.xin16) { const u32x2 w = *(const u32x2*)((const bf16_t*)a.xin_ctx + (size_t)r * D + col); x = (f32x4){bf_lo(w[0]), bf_hi(w[0]), bf_lo(w[1]), bf_hi(w[1])}; }
        else x = ld4(a.xin_ctx + (size_t)r * D + col);
        if (hasy) {
            const bf16_t* yp = a.ypart + (size_t)r * D + col;
            f32x4 y = (f32x4){0.f, 0.f, 0.f, 0.f};
#pragma unroll 11
            for (int pp = 0; pp < a.nypart; ++pp) { const u32x2 w = *(const u32x2*)(yp + (size_t)pp * 256 * D); y = y + (f32x4){bf_lo(w[0]), bf_hi(w[0]), bf_lo(w[1]), bf_hi(w[1])}; }
            const float ss = wave_sum((y[0] * y[0] + y[1] * y[1]) + (y[2] * y[2] + y[3] * y[3]));
            if (lane == 0) red[wave] = ss;
            __syncthreads();
            float tot = 0.f;
#pragma unroll
            for (int w8 = 0; w8 < 8; ++w8) tot += red[w8];
            const float r1 = rsq_f(tot * (1.0f / D) + EPS);
            x = x + *(const f32x4*)(coef + col) * (y * r1);
        }
        if (a.xout_ctx) { if (a.xout16) { u32x2 w; w[0] = cvt_pk_bf16(x[0], x[1]); w[1] = cvt_pk_bf16(x[2], x[3]); *(u32x2*)((bf16_t*)a.xout_ctx + (size_t)r * D + col) = w; } else *(f32x4*)(a.xout_ctx + (size_t)r * D + col) = x; }
        if (hash) {
            const float ss = wave_sum((x[0] * x[0] + x[1] * x[1]) + (x[2] * x[2] + x[3] * x[3]));
            if (lane == 0) red[16 + wave] = ss;
            __syncthreads();
            float tot = 0.f;
#pragma unroll
            for (int w8 = 0; w8 < 8; ++w8) tot += red[16 + w8];
            const float r2 = rsq_f(tot * (1.0f / D) + EPS);
            const f32x4 v = (x * r2) * *(const f32x4*)(coef + D + col) + *(const f32x4*)(coef + 2 * D + col);
            u32x2 w; w[0] = cvt_pk_bf16(v[0], v[1]); w[1] = cvt_pk_bf16(v[2], v[3]); *(u32x2*)(a.h + (size_t)(S + r) * D + col) = w;
        }
        __syncthreads();
    }
}
#endif

DEV void conv_loadz(const bf16_t* P, int t, int c, float (&z)[8]) {
    const u32x4 cg = *(const u32x4*)(P + (size_t)t * ABIN + 1024 + c), u = *(const u32x4*)(P + (size_t)t * ABIN + 2048 + c);
#pragma unroll
    for (int e = 0; e < 4; ++e) { z[2 * e] = bf_lo(cg[e]) * bf_lo(u[e]); z[2 * e + 1] = bf_hi(cg[e]) * bf_hi(u[e]); }
}
DEV void conv_task(const bf16_t* P, bf16_t* YAB, const float* convw, int task, int lane) {
    const int half = task & 1, t0 = (task >> 1) * 8, c = half * 512 + lane * 8;
    u32x4 cgv[10], uv[10], bgv[8];
#pragma unroll
    for (int k = 0; k < 10; ++k) {
        const int t = t0 - 1 + k;
        const bool ok = !((k == 0 && (t0 == 0 || t0 == S)) || (k == 9 && (t0 + 8 == S || t0 + 8 == MTOK)));
        const int tt = ok ? t : t0;
        cgv[k] = *(const u32x4*)(P + (size_t)tt * ABIN + 1024 + c); uv[k] = *(const u32x4*)(P + (size_t)tt * ABIN + 2048 + c);
        if (!ok) { cgv[k] = (u32x4){0u, 0u, 0u, 0u}; }
    }
#pragma unroll
    for (int k = 0; k < 8; ++k) bgv[k] = *(const u32x4*)(P + (size_t)(t0 + k) * ABIN + c);
    float w0[8], w1[8], w2[8];
#pragma unroll
    for (int e = 0; e < 8; ++e) { w0[e] = convw[c + e]; w1[e] = convw[1024 + c + e]; w2[e] = convw[2048 + c + e]; }
#pragma unroll
    for (int k = 0; k < 8; ++k) {
        float o[8];
#pragma unroll
        for (int e = 0; e < 8; ++e) {
            const int d = e >> 1;
            const float zp = (e & 1) ? bf_hi(cgv[k][d]) * bf_hi(uv[k][d]) : bf_lo(cgv[k][d]) * bf_lo(uv[k][d]);
            const float zc = (e & 1) ? bf_hi(cgv[k + 1][d]) * bf_hi(uv[k + 1][d]) : bf_lo(cgv[k + 1][d]) * bf_lo(uv[k + 1][d]);
            const float zn = (e & 1) ? bf_hi(cgv[k + 2][d]) * bf_hi(uv[k + 2][d]) : bf_lo(cgv[k + 2][d]) * bf_lo(uv[k + 2][d]);
            const float b = (e & 1) ? bf_hi(bgv[k][d]) : bf_lo(bgv[k][d]);
            o[e] = b * (w0[e] * zp + w1[e] * zc + w2[e] * zn);
        }
        u32x4 w; w[0] = cvt_pk_bf16(o[0], o[1]); w[1] = cvt_pk_bf16(o[2], o[3]); w[2] = cvt_pk_bf16(o[4], o[5]); w[3] = cvt_pk_bf16(o[6], o[7]);
        *(u32x4*)(YAB + (size_t)(t0 + k) * D + c) = w;
    }
}

DEV int chunk_row(int cidx) { return cidx < 2 ? S + 128 * cidx : 128 * (cidx - 2); }
DEV void r1_task(const bf16_t* P, float* KVt, float lg2, int cidx, int head, int dir, int quad, int lane) {
    const int i = lane & 15, g = lane >> 4;
    const int dk0 = 64 * (quad >> 1), dv0 = 64 * (quad & 1);
    const bf16_t* Kp = P + (size_t)chunk_row(cidx) * ABIN + 4096 + head * 128 + dk0 + 4 * i;
    const bf16_t* Vp = P + (size_t)chunk_row(cidx) * ABIN + 5120 + head * 128 + dv0 + 4 * i;
    f32x4 acc[4][4];
#pragma unroll
    for (int a = 0; a < 4; ++a)
#pragma unroll
        for (int b = 0; b < 4; ++b) acc[a][b] = (f32x4){0.f, 0.f, 0.f, 0.f};
#pragma unroll 1
    for (int s = 0; s < 4; ++s) {
        u32x2 kd[8], vd[8]; float w[8];
#pragma unroll
        for (int jj = 0; jj < 8; ++jj) {
            const int tj = 32 * s + 8 * g + jj;
            kd[jj] = *(const u32x2*)(Kp + (size_t)tj * ABIN); vd[jj] = *(const u32x2*)(Vp + (size_t)tj * ABIN);
            w[jj] = ex2(lg2 * (float)(dir == 0 ? 127 - tj : tj));
        }
        bf16x8 af[4], bfr[4];
#pragma unroll
        for (int mt = 0; mt < 4; ++mt) {
            u32x4 wd;
#pragma unroll
            for (int q = 0; q < 4; ++q) {
                const unsigned X = kd[2 * q][mt >> 1], Y = kd[2 * q + 1][mt >> 1];
                const float lo = ((mt & 1) ? bf_hi(X) : bf_lo(X)) * w[2 * q], hi = ((mt & 1) ? bf_hi(Y) : bf_lo(Y)) * w[2 * q + 1];
                wd[q] = cvt_pk_bf16(lo, hi);
            }
            af[mt] = __builtin_bit_cast(bf16x8, wd);
        }
#pragma unroll
        for (int nt = 0; nt < 4; ++nt) {
            u32x4 wd;
#pragma unroll
            for (int q = 0; q < 4; ++q) {
                const unsigned X = vd[2 * q][nt >> 1], Y = vd[2 * q + 1][nt >> 1];
                wd[q] = (nt & 1) ? ((X >> 16) | (Y & 0xffff0000u)) : ((X & 0xffffu) | (Y << 16));
            }
            bfr[nt] = __builtin_bit_cast(bf16x8, wd);
        }
#pragma unroll
        for (int mt = 0; mt < 4; ++mt)
#pragma unroll
            for (int nt = 0; nt < 4; ++nt) acc[mt][nt] = mfma16(af[mt], bfr[nt], acc[mt][nt]);
    }
    float* out = KVt + ((((size_t)cidx * 8 + head) * 2 + dir) * 128) * 128;
#pragma unroll
    for (int nt = 0; nt < 4; ++nt)
#pragma unroll
        for (int reg = 0; reg < 4; ++reg) {
            const int dv = dv0 + 4 * i + nt, dk = dk0 + 16 * g + 4 * reg;
            *(f32x4*)(out + (size_t)dv * 128 + dk) = (f32x4){acc[0][nt][reg], acc[1][nt][reg], acc[2][nt][reg], acc[3][nt][reg]};
        }
}
DEV void r2_item(const bf16_t* KVt, bf16_t* St, const float* decay_exp, int iab, int item) {
    const int hd = __builtin_amdgcn_readfirstlane(item >> 13), e = (item & 8191) * 2, head = hd >> 1, dir = hd & 1;
    const float cd = exp2f(128.0f * lg2gamma(decay_exp, iab, dir, head));
    float s0 = 0.f, s1 = 0.f;
    unsigned kv[66];
#pragma unroll
    for (int k = 0; k < 66; ++k) { const int c = dir == 0 ? k : (k < 2 ? 1 - k : 67 - k); kv[k] = *(const unsigned*)(KVt + (((size_t)c * 8 + head) * 2 + dir) * 16384 + e); }
#pragma unroll
    for (int k = 0; k < 66; ++k) { const int c = dir == 0 ? k : (k < 2 ? 1 - k : 67 - k);
        *(unsigned*)(St + (((size_t)c * 8 + head) * 2 + dir) * 16384 + e) = cvt_pk_bf16(s0, s1);
        s0 = s0 * cd + bf_lo(kv[k]); s1 = s1 * cd + bf_hi(kv[k]); }
}
DEV void r3_task(const bf16_t* P, const bf16_t* St, bf16_t* YAB, float lg2f, float lg2b, int cidx, int head, int qb, int lane) {
    const int i = lane & 15, g = lane >> 4, qi = 16 * qb + i, rowbase = chunk_row(cidx);
    const bf16_t* Prow = P + (size_t)rowbase * ABIN;
    bf16x8 qf[4];
#pragma unroll
    for (int s = 0; s < 4; ++s) qf[s] = *(const bf16x8*)(Prow + (size_t)qi * ABIN + 3072 + head * 128 + 32 * s + 8 * g);
    f32x4 sacc[8];
#pragma unroll
    for (int mt = 0; mt < 8; ++mt) {
        f32x4 a = (f32x4){0.f, 0.f, 0.f, 0.f};
#pragma unroll
        for (int s = 0; s < 4; ++s) { const bf16x8 kf = *(const bf16x8*)(Prow + (size_t)(16 * mt + i) * ABIN + 4096 + head * 128 + 32 * s + 8 * g); a = mfma16(kf, qf[s], a); }
        sacc[mt] = a;
    }
#pragma unroll
    for (int mt = 0; mt < 8; ++mt)
#pragma unroll
        for (int reg = 0; reg < 4; ++reg) {
            const int diff = qi - (16 * mt + 4 * g + reg);
            const float d = diff > 0 ? ex2((float)diff * lg2f) : (diff < 0 ? ex2((float)(-diff) * lg2b) : 2.0f);
            sacc[mt][reg] *= d;
        }
    bf16x8 pf[4];
#pragma unroll
    for (int s = 0; s < 4; ++s) {
        u32x4 w; w[0] = cvt_pk_bf16(sacc[2 * s][0], sacc[2 * s][1]); w[1] = cvt_pk_bf16(sacc[2 * s][2], sacc[2 * s][3]);
        w[2] = cvt_pk_bf16(sacc[2 * s + 1][0], sacc[2 * s + 1][1]); w[3] = cvt_pk_bf16(sacc[2 * s + 1][2], sacc[2 * s + 1][3]);
        pf[s] = __builtin_bit_cast(bf16x8, w);
    }
    f32x4 oacc[8];
#pragma unroll
    for (int mt = 0; mt < 8; ++mt) oacc[mt] = (f32x4){0.f, 0.f, 0.f, 0.f};
#pragma unroll
    for (int s = 0; s < 4; ++s) {
        u32x4 vd[8];
#pragma unroll
        for (int jj = 0; jj < 8; ++jj) { const int key = 32 * s + (jj < 4 ? 4 * g + jj : 16 + 4 * g + jj - 4); vd[jj] = *(const u32x4*)(Prow + (size_t)key * ABIN + 5120 + head * 128 + 8 * i); }
#pragma unroll
        for (int mt = 0; mt < 8; ++mt) oacc[mt] = mfma16(extract8(vd, mt), pf[s], oacc[mt]);
    }
#pragma unroll
    for (int dir = 0; dir < 2; ++dir) {
        f32x4 tacc[8];
#pragma unroll
        for (int mt = 0; mt < 8; ++mt) tacc[mt] = (f32x4){0.f, 0.f, 0.f, 0.f};
        const bf16_t* Sp = St + ((((size_t)cidx * 8 + head) * 2 + dir) * 128) * 128;
#pragma unroll
        for (int s = 0; s < 4; ++s)
#pragma unroll
            for (int mt = 0; mt < 8; ++mt) { const bf16x8 sf = *(const bf16x8*)(Sp + (size_t)(8 * i + mt) * 128 + 32 * s + 8 * g); tacc[mt] = mfma16(sf, qf[s], tacc[mt]); }
        const float qd = dir == 0 ? ex2((float)(qi + 1) * lg2f) : ex2((float)(128 - qi) * lg2b);
#pragma unroll
        for (int mt = 0; mt < 8; ++mt) oacc[mt] = oacc[mt] + tacc[mt] * qd;
    }
    float ss = 0.f;
#pragma unroll
    for (int mt = 0; mt < 8; ++mt) ss += (oacc[mt][0] * oacc[mt][0] + oacc[mt][1] * oacc[mt][1]) + (oacc[mt][2] * oacc[mt][2] + oacc[mt][3] * oacc[mt][3]);
    ss += shfl_xor_f(ss, 16); ss += shfl_xor_f(ss, 32);
    const float rinv = rsq_f(ss * (1.0f / 128.0f) + EPS);
#pragma unroll
    for (int reg = 0; reg < 4; ++reg) {
        const int dvb = 32 * g + 8 * reg;
        const u32x4 gt = *(const u32x4*)(Prow + (size_t)qi * ABIN + 6144 + head * 128 + dvb);
        float o[8];
#pragma unroll
        for (int mt = 0; mt < 8; ++mt) { const float gv = (mt & 1) ? bf_hi(gt[mt >> 1]) : bf_lo(gt[mt >> 1]); o[mt] = silu_f(gv) * (oacc[mt][reg] * rinv); }
        u32x4 w; w[0] = cvt_pk_bf16(o[0], o[1]); w[1] = cvt_pk_bf16(o[2], o[3]); w[2] = cvt_pk_bf16(o[4], o[5]); w[3] = cvt_pk_bf16(o[6], o[7]);
        *(u32x4*)(YAB + (size_t)(rowbase + qi) * D + 1024 + head * 128 + dvb) = w;
    }
}

struct AttnTile { bf16x8 qf[4]; f32x4 oacc[8]; float m_run, l_run; };
DEV void attn_tile_init(AttnTile& t, const bf16_t* P, int qtok, int h, int g) {
#pragma unroll
    for (int s = 0; s < 4; ++s) t.qf[s] = *(const bf16x8*)(P + (size_t)qtok * QKV + h * 128 + 32 * s + 8 * g);
#pragma unroll
    for (int mt = 0; mt < 8; ++mt) t.oacc[mt] = (f32x4){0.f, 0.f, 0.f, 0.f};
    t.m_run = -5e29f; t.l_run = 0.f;
}
template <class RP>
DEV void attn_tile_step(AttnTile& t, f32x4 (&sa)[2], const u32x4 (&vd)[8], const bool win, const bool rowok, RP rpbrow, const int kc0, const int c, const int sc, const int g) {
    float bm = -1e30f;
#pragma unroll
    for (int mt = 0; mt < 2; ++mt)
#pragma unroll
        for (int reg = 0; reg < 4; ++reg) {
            float v = sa[mt][reg] * HSCALE;
            if (win) {
                const int kcol = kc0 + 16 * mt + 4 * g + reg;
                const bool valid = rowok && kcol >= sc && kcol < sc + 16;
                const float bias = rpbrow[valid ? kcol - c + 15 : 0];
                v = valid ? v + bias : -1e30f;
            }
            sa[mt][reg] = v; bm = fmaxf(bm, v);
        }
    bm = fmaxf(bm, shfl_xor_f(bm, 16)); bm = fmaxf(bm, shfl_xor_f(bm, 32));
    const float m_new = fmaxf(t.m_run, bm);
    const float alpha = ex2((t.m_run - m_new) * LOG2E);
    t.m_run = m_new;
    float ps = 0.f;
#pragma unroll
    for (int mt = 0; mt < 2; ++mt)
#pragma unroll
        for (int reg = 0; reg < 4; ++reg) { const float pv = ex2((sa[mt][reg] - m_new) * LOG2E); sa[mt][reg] = pv; ps += pv; }
    t.l_run = t.l_run * alpha + ps;
#pragma unroll
    for (int mt = 0; mt < 8; ++mt) t.oacc[mt] = t.oacc[mt] * alpha;
    u32x4 pw; pw[0] = cvt_pk_bf16(sa[0][0], sa[0][1]); pw[1] = cvt_pk_bf16(sa[0][2], sa[0][3]); pw[2] = cvt_pk_bf16(sa[1][0], sa[1][1]); pw[3] = cvt_pk_bf16(sa[1][2], sa[1][3]);
    const bf16x8 pf = __builtin_bit_cast(bf16x8, pw);
#pragma unroll
    for (int mt = 0; mt < 8; ++mt) t.oacc[mt] = mfma16(extract8(vd, mt), pf, t.oacc[mt]);
}
template <class RP>
DEV bf16x8 attn_tile_soft(AttnTile& t, f32x4 (&sa)[2], const bool win, const bool rowok, RP rpbrow, const int kc0, const int c, const int sc, const int g) {
    float bm = -1e30f;
#pragma unroll
    for (int mt = 0; mt < 2; ++mt)
#pragma unroll
        for (int reg = 0; reg < 4; ++reg) {
            float v = sa[mt][reg] * HSCALE;
            if (win) {
                const int kcol = kc0 + 16 * mt + 4 * g + reg;
                const bool valid = rowok && kcol >= sc && kcol < sc + 16;
                const float bias = rpbrow[valid ? kcol - c + 15 : 0];
                v = valid ? v + bias : -1e30f;
            }
            sa[mt][reg] = v; bm = fmaxf(bm, v);
        }
    bm = fmaxf(bm, shfl_xor_f(bm, 16)); bm = fmaxf(bm, shfl_xor_f(bm, 32));
    const float m_new = fmaxf(t.m_run, bm);
    const float alpha = ex2((t.m_run - m_new) * LOG2E);
    t.m_run = m_new;
    float ps = 0.f;
#pragma unroll
    for (int mt = 0; mt < 2; ++mt)
#pragma unroll
        for (int reg = 0; reg < 4; ++reg) { const float pv = ex2((sa[mt][reg] - m_new) * LOG2E); sa[mt][reg] = pv; ps += pv; }
    t.l_run = t.l_run * alpha + ps;
#pragma unroll
    for (int mt = 0; mt < 8; ++mt) t.oacc[mt] = t.oacc[mt] * alpha;
    u32x4 pw; pw[0] = cvt_pk_bf16(sa[0][0], sa[0][1]); pw[1] = cvt_pk_bf16(sa[0][2], sa[0][3]); pw[2] = cvt_pk_bf16(sa[1][0], sa[1][1]); pw[3] = cvt_pk_bf16(sa[1][2], sa[1][3]);
    return __builtin_bit_cast(bf16x8, pw);
}
DEV void attn_tile_store(AttnTile& t, bf16_t* YAB, int qtok, int h, int g) {
    float l = t.l_run; l += shfl_xor_f(l, 16); l += shfl_xor_f(l, 32);
    const float inv = 1.0f / l;
#pragma unroll
    for (int reg = 0; reg < 4; ++reg) {
        const int dvb = 32 * g + 8 * reg;
        u32x4 w;
#pragma unroll
        for (int q = 0; q < 4; ++q) w[q] = cvt_pk_bf16(t.oacc[2 * q][reg] * inv, t.oacc[2 * q + 1][reg] * inv);
        *(u32x4*)(YAB + (size_t)qtok * D + h * 128 + dvb) = w;
    }
}
DEV void attn_scores2(const bf16_t* P, int kb, int h, int i, int g, const AttnTile& ta, const AttnTile& tb, const bool doA, const bool doB, f32x4 (&saA)[2], f32x4 (&saB)[2], u32x4 (&vd)[8]) {
#pragma unroll
    for (int jj = 0; jj < 8; ++jj) { const int key = kb + (jj < 4 ? 4 * g + jj : 16 + 4 * g + jj - 4); vd[jj] = *(const u32x4*)(P + (size_t)key * QKV + 4096 + h * 128 + 8 * i); }
#pragma unroll
    for (int mt = 0; mt < 2; ++mt) {
        bf16x8 kf[4];
#pragma unroll
        for (int s = 0; s < 4; ++s) kf[s] = *(const bf16x8*)(P + (size_t)(kb + 16 * mt + i) * QKV + 2048 + h * 128 + 32 * s + 8 * g);
        f32x4 a = (f32x4){0.f, 0.f, 0.f, 0.f}, b = a;
        if (doA) {
#pragma unroll
            for (int s = 0; s < 4; ++s) a = mfma16(kf[s], ta.qf[s], a);
        }
        if (doB) {
#pragma unroll
            for (int s = 0; s < 4; ++s) b = mfma16(kf[s], tb.qf[s], b);
        }
        saA[mt] = a; saB[mt] = b;
        SCHED_FENCE();
    }
}
template <bool WIN>
DEV void attn_task2(const bf16_t* P, bf16_t* YAB, const float* rpb, int h, int qtokA0, int qtokB0, int rA, int c0, int kc0, int lane) {
    const int i = lane & 15, g = lane >> 4;
    AttnTile ta, tb;
    attn_tile_init(ta, P, qtokA0 + i, h, g); attn_tile_init(tb, P, qtokB0 + i, h, g);
    const int c = c0 + i, sc = c - 8 < 0 ? 0 : (c - 8 > 48 ? 48 : c - 8);
    if (WIN) {
        const int rB = rA + 1;
        const int srA = rA - 4 < 0 ? 0 : (rA - 4 > 120 ? 120 : rA - 4), srB = rB - 4 < 0 ? 0 : (rB - 4 > 120 ? 120 : rB - 4);
        for (int kr = srA; kr < srB + 8; ++kr) {
            f32x4 saA[2], saB[2]; u32x4 vd[8];
            const bool doA = kr < srA + 8, doB = kr >= srB;
            attn_scores2(P, kr * 64 + kc0, h, i, g, ta, tb, doA, doB, saA, saB, vd);
            if (doA) attn_tile_step(ta, saA, vd, true, true, rpb + (h * 15 + (kr - rA + 7)) * 31, kc0, c, sc, g);
            if (doB) attn_tile_step(tb, saB, vd, true, true, rpb + (h * 15 + (kr - rB + 7)) * 31, kc0, c, sc, g);
        }
    }
    for (int b = 0; b < 8; ++b) {
        f32x4 saA[2], saB[2]; u32x4 vd[8];
        attn_scores2(P, S + 32 * b, h, i, g, ta, tb, true, true, saA, saB, vd);
        attn_tile_step(ta, saA, vd, false, true, rpb, 0, 0, 0, g);
        attn_tile_step(tb, saB, vd, false, true, rpb, 0, 0, 0, g);
    }
    attn_tile_store(ta, YAB, qtokA0 + i, h, g); attn_tile_store(tb, YAB, qtokB0 + i, h, g);
}

struct Unit { int pm, pn, ks, nt, kofs; };
struct EpiY {
    static constexpr bool PERM = true, AFTER_DRAIN = false;
    bf16_t* Yb; int ldc; bf16_t* Cpart;
    DEV void operator()(const f32x4 (&acc)[2][2][4][2], const Unit& u, int wr, int wc, int fr, int fq) const {
        bf16_t* base = u.ks >= 0 ? Cpart + (size_t)u.ks * 256 * ldc : Yb + (size_t)u.pm * 256 * ldc;
        base += (size_t)(wr * 64 + fr) * ldc + u.pn * 256 + wc * 32 + 8 * fq;
#pragma unroll
        for (int ai = 0; ai < 2; ++ai)
#pragma unroll
            for (int m = 0; m < 4; ++m) { bf16_t* rowp = base + (size_t)(ai * 128 + m * 16) * ldc;
#pragma unroll
                for (int bj = 0; bj < 2; ++bj) { const f32x4 v0 = acc[ai][bj][m][0], v1 = acc[ai][bj][m][1];
                    u32x4 w; w[0] = cvt_pk_bf16(v0[0], v0[1]); w[1] = cvt_pk_bf16(v0[2], v0[3]); w[2] = cvt_pk_bf16(v1[0], v1[1]); w[3] = cvt_pk_bf16(v1[2], v1[3]);
                    *(u32x4*)(rowp + bj * 128) = w; } }
    }
};
struct EpiBf16 {
    static constexpr bool PERM = true, AFTER_DRAIN = false;
    bf16_t* O; int ldc;
    DEV void operator()(const f32x4 (&acc)[2][2][4][2], const Unit& u, int wr, int wc, int fr, int fq) const {
        const int row0 = u.pm * 256 + wr * 64 + fr, col0 = u.pn * 256 + wc * 32 + 8 * fq;
#pragma unroll
        for (int ai = 0; ai < 2; ++ai)
#pragma unroll
            for (int m = 0; m < 4; ++m) { bf16_t* rowp = O + (size_t)(row0 + ai * 128 + m * 16) * ldc + col0;
#pragma unroll
                for (int bj = 0; bj < 2; ++bj) { const f32x4 v0 = acc[ai][bj][m][0], v1 = acc[ai][bj][m][1];
                    u32x4 w; w[0] = cvt_pk_bf16(v0[0], v0[1]); w[1] = cvt_pk_bf16(v0[2], v0[3]); w[2] = cvt_pk_bf16(v1[0], v1[1]); w[3] = cvt_pk_bf16(v1[2], v1[3]);
                    *(u32x4*)(rowp + bj * 128) = w; } }
    }
};
struct EpiInProj {
    static constexpr bool PERM = true, AFTER_DRAIN = false;
    bf16_t* O; const f32x2* rope;
    DEV void operator()(const f32x4 (&acc)[2][2][4][2], const Unit& u, int wr, int wc, int fr, int fq) const {
        const int row0 = u.pm * 256 + wr * 64 + fr, col0 = u.pn * 256 + wc * 32 + 8 * fq;
        const bool isk = u.pn >= 16 && u.pn < 20, isq = u.pn >= 12 && u.pn < 16, dorope = (isq || isk) && u.pm < 32;
        const float sc = isk ? HSCALE : 1.0f;
#pragma unroll
        for (int ai = 0; ai < 2; ++ai)
#pragma unroll
            for (int m = 0; m < 4; ++m) { const int row = row0 + ai * 128 + m * 16; bf16_t* rowp = O + (size_t)row * ABIN + col0;
                f32x4 cs01 = (f32x4){1.f, 0.f, 1.f, 0.f}, cs23 = cs01, cs45 = cs01, cs67 = cs01;
                if (dorope) { const int pidx = (wc < 2) ? (row >> 6) : 128 + (row & 63); const f32x2* tp = rope + pidx * 32 + 16 * (wc & 1) + 4 * fq;
                    const f32x4 t0 = *(const f32x4*)tp, t1 = *(const f32x4*)(tp + 2); cs01 = t0; cs23 = t0; cs45 = t1; cs67 = t1; }
#pragma unroll
                for (int bj = 0; bj < 2; ++bj) { f32x4 v0 = acc[ai][bj][m][0], v1 = acc[ai][bj][m][1];
                    if (dorope) {
                        const f32x4 a0 = v0, a1 = v1;
                        v0[0] = a0[0] * cs01[0] - a0[1] * cs01[1]; v0[1] = a0[0] * cs01[1] + a0[1] * cs01[0];
                        v0[2] = a0[2] * cs23[2] - a0[3] * cs23[3]; v0[3] = a0[2] * cs23[3] + a0[3] * cs23[2];
                        v1[0] = a1[0] * cs45[0] - a1[1] * cs45[1]; v1[1] = a1[0] * cs45[1] + a1[1] * cs45[0];
                        v1[2] = a1[2] * cs67[2] - a1[3] * cs67[3]; v1[3] = a1[2] * cs67[3] + a1[3] * cs67[2];
                    }
                    v0 = v0 * sc; v1 = v1 * sc;
                    u32x4 w; w[0] = cvt_pk_bf16(v0[0], v0[1]); w[1] = cvt_pk_bf16(v0[2], v0[3]); w[2] = cvt_pk_bf16(v1[0], v1[1]); w[3] = cvt_pk_bf16(v1[2], v1[3]);
                    *(u32x4*)(rowp + bj * 128) = w; } }
    }
};
struct EpiSwiglu {
    static constexpr bool PERM = true, AFTER_DRAIN = false;
    bf16_t* O;
    DEV void operator()(const f32x4 (&acc)[2][2][4][2], const Unit& u, int wr, int wc, int fr, int fq) const {
        const int row0 = u.pm * 256 + wr * 64 + fr, col0 = u.pn * 128 + wc * 32 + 8 * fq;
#pragma unroll
        for (int ai = 0; ai < 2; ++ai)
#pragma unroll
            for (int m = 0; m < 4; ++m) { bf16_t* rowp = O + (size_t)(row0 + ai * 128 + m * 16) * FFH + col0;
                const f32x4 g0 = acc[ai][0][m][0], g1 = acc[ai][0][m][1], u0 = acc[ai][1][m][0], u1 = acc[ai][1][m][1];
                u32x4 w; w[0] = cvt_pk_bf16(silu_f(g0[0]) * u0[0], silu_f(g0[1]) * u0[1]); w[1] = cvt_pk_bf16(silu_f(g0[2]) * u0[2], silu_f(g0[3]) * u0[3]);
                w[2] = cvt_pk_bf16(silu_f(g1[0]) * u1[0], silu_f(g1[1]) * u1[1]); w[3] = cvt_pk_bf16(silu_f(g1[2]) * u1[2], silu_f(g1[3]) * u1[3]);
                *(u32x4*)rowp = w; }
    }
};

#ifndef HOST_EMU
namespace pg8 {
#define PG8_LAS __attribute__((address_space(3)))
constexpr int BM = 256, BK = 64, HALF = 128, HTB = HALF * BK * 2, STAGE_BYTES = 8 * HTB, NXCD = 8, WGM = 8;
__host__ __device__ __forceinline__ int lds_byte(int r, int c) { const int st = (r >> 4) * 2 + (c >> 5), rr = r & 15, cc = c & 31, ob = rr * 64 + cc * 2; return st * 1024 + (ob ^ (((ob >> 9) & 1) << 5)); }
__host__ __device__ __forceinline__ void stage_rc(int b, int& R, int& C) { const int st = b / 1024, sb = b % 1024, swz = sb ^ (((sb >> 9) & 1) << 5); R = (st >> 1) * 16 + swz / 64; C = (st & 1) * 32 + (swz % 64) / 2; }
__host__ __device__ __forceinline__ int perm32(int rho) { const int n = rho >> 4, i = rho & 15; return 8 * (i >> 2) + 4 * n + (i & 3); }
struct Gemm { const bf16_t* A; const bf16_t* Bt; int M, N, K; };
struct StaticOrder {
    int nM, nN, nwg, G, c, ntK;
    __host__ __device__ __forceinline__ void init(int M, int N, int K, int G_, int c_) { nM = M / BM; nN = N / BM; nwg = nM * nN; G = G_; c = c_; ntK = K / BK; }
    __host__ __device__ __forceinline__ void map(int wgid, Unit& u) const {
        { const int q = nwg / NXCD, r = nwg % NXCD, xcd = wgid % NXCD, off = wgid / NXCD; wgid = (xcd < r ? xcd * (q + 1) : r * (q + 1) + (xcd - r) * q) + off; }
        const int nig = WGM * nN, gid = wgid / nig, fm = gid * WGM, gsz = (nM - fm) < WGM ? (nM - fm) : WGM;
        u.pm = fm + ((wgid % nig) % gsz); u.pn = (wgid % nig) / gsz; u.ks = -1; u.nt = ntK; u.kofs = 0;
    }
    __host__ __device__ __forceinline__ bool next(int i, Unit& u) const { const long L = (long)i * G + c; if (L >= nwg) return false; map((int)L, u); return true; }
    __device__ __forceinline__ void a_ready(const Unit&) const {}
    __device__ __forceinline__ void done(const Unit&) const {}
};
struct MixedOrder {
    StaticOrder base; int nsplit, pmx, ntS, nNx;
    __host__ __device__ __forceinline__ void init(int M, int N, int K, int G_, int c_, int pmx_, int nsplit_) { base.init(M, N, K, G_, c_); pmx = pmx_; nsplit = nsplit_; ntS = nsplit_ ? (K / BK) / nsplit_ : 0; nNx = N / BM; }
    __host__ __device__ __forceinline__ bool next(int i, Unit& u) const {
        const long L = (long)i * base.G + base.c;
        if (L < base.nwg) { base.map((int)L, u); return true; }
        const long L2 = L - base.nwg; if (L2 >= (long)nsplit * nNx) return false;
        u.pm = pmx; u.pn = (int)(L2 % nNx); u.ks = (int)(L2 / nNx); u.nt = ntS; u.kofs = u.ks * ntS * BK * 2; return true;
    }
    __device__ __forceinline__ void a_ready(const Unit&) const {}
    __device__ __forceinline__ void done(const Unit&) const {}
};
template <class Epi, class Sched, bool ALIGN_EPI = false, bool SP2 = false>
__device__ __forceinline__ void gemm_phase(PG8_LAS unsigned char* lds, const Gemm g, const Sched& S, const Epi& E, const int tid) {
    const int wid = __builtin_amdgcn_readfirstlane(tid >> 6), lane = tid & 63, wr = wid >> 2, wc = wid & 3, fr = lane & 15, fq = lane >> 4;
    const int K = g.K;
    unsigned voffA[2], voffB[2];
#pragma unroll
    for (int i = 0; i < 2; ++i) { int R, C; stage_rc(tid * 16 + i * 8192, R, C); const int Rb = Epi::PERM ? ((R & ~31) + perm32(R & 31)) : R;
        voffA[i] = (unsigned)(R * K + C) * 2u; voffB[i] = (unsigned)(Rb * K + C) * 2u; }
    const size_t kstep = (size_t)(BK * 2);
    const size_t hstep = (size_t)HALF * K * 2;
    const size_t tstep = 2 * hstep;
    const unsigned ldsw = (unsigned)wid * 1024u;
    const int aoff = lds_byte(wr * 64 + fr, fq * 8), boff = lds_byte(wc * 32 + fr, fq * 8);
#define PG8_SA(b, h) (((b) * 2 + (h)) * HTB)
#define PG8_SB(b, h) ((4 + (b) * 2 + (h)) * HTB)
#define PG8_STAGE(bufoff, gbase, voff) do { _Pragma("unroll") for (int _i = 0; _i < 2; ++_i) \
        __builtin_amdgcn_global_load_lds((const unsigned*)((const char*)(gbase) + (voff)[_i]), (PG8_LAS unsigned*)(lds + (bufoff) + ldsw + _i * 8192), 16, 0, 0); } while (0)
#define PG8_LDA(dst, b, h) do { _Pragma("unroll") for (int m = 0; m < 4; ++m) _Pragma("unroll") for (int k = 0; k < 2; ++k) dst[m][k] = *(const PG8_LAS bf16x8*)(lds + PG8_SA(b, h) + aoff + m * 2048 + k * 1024); } while (0)
#define PG8_LDB(dst, b, h) do { _Pragma("unroll") for (int n = 0; n < 2; ++n) _Pragma("unroll") for (int k = 0; k < 2; ++k) dst[n][k] = *(const PG8_LAS bf16x8*)(lds + PG8_SB(b, h) + boff + n * 2048 + k * 1024); } while (0)
#define PG8_MMA(ai, bj, At, Bt) do { __builtin_amdgcn_s_setprio(1); _Pragma("unroll") for (int m = 0; m < 4; ++m) _Pragma("unroll") for (int n = 0; n < 2; ++n) _Pragma("unroll") for (int k = 0; k < 2; ++k) \
        acc[ai][bj][m][n] = __builtin_amdgcn_mfma_f32_16x16x32_bf16(Bt[n][k], At[m][k], acc[ai][bj][m][n], 0, 0, 0); __builtin_amdgcn_s_setprio(0); } while (0)
#define PG8_WAIT_V(n) asm volatile("s_waitcnt vmcnt(" #n ")" ::: "memory")
#define PG8_WAIT_L(n) asm volatile("s_waitcnt lgkmcnt(" #n ")" ::: "memory")
#define PG8_BAR __builtin_amdgcn_s_barrier()
#define PG8_SCHED __builtin_amdgcn_sched_barrier(0)
    Unit cur, nxt; int ui = 0;
    if (!S.next(0, cur)) return;
    f32x4 acc[2][2][4][2];
#pragma unroll
    for (int a = 0; a < 2; ++a)
#pragma unroll
        for (int b = 0; b < 2; ++b)
#pragma unroll
            for (int m = 0; m < 4; ++m)
#pragma unroll
                for (int n = 0; n < 2; ++n) acc[a][b][m][n] = (f32x4){0.f, 0.f, 0.f, 0.f};
    bf16x8 At[4][2], B0[2][2], B1[2][2];
    const char* cA = (const char*)g.A + (size_t)cur.pm * tstep + cur.kofs; const char* cB = (const char*)g.Bt + (size_t)cur.pn * tstep + cur.kofs;
    S.a_ready(cur);
    if constexpr (SP2) {
        PG8_STAGE(PG8_SB(0, 0), cB, voffB); PG8_STAGE(PG8_SB(0, 1), cB + hstep, voffB); PG8_STAGE(PG8_SA(0, 0), cA, voffA); PG8_STAGE(PG8_SA(0, 1), cA + hstep, voffA);
        if (wr == 1) PG8_BAR;
        PG8_WAIT_V(2); PG8_BAR;
        PG8_STAGE(PG8_SB(1, 0), cB + kstep, voffB); PG8_STAGE(PG8_SA(1, 0), cA + kstep, voffA); PG8_STAGE(PG8_SB(1, 1), cB + hstep + kstep, voffB);
        PG8_WAIT_V(6); PG8_BAR;
    } else {
        PG8_STAGE(PG8_SB(0, 0), cB, voffB); PG8_STAGE(PG8_SA(0, 0), cA, voffA); PG8_STAGE(PG8_SB(0, 1), cB + hstep, voffB); PG8_STAGE(PG8_SA(0, 1), cA + hstep, voffA);
        if (wr == 1) PG8_BAR;
        PG8_WAIT_V(4); PG8_BAR;
        PG8_STAGE(PG8_SB(1, 0), cB + kstep, voffB); PG8_STAGE(PG8_SA(1, 0), cA + kstep, voffA); PG8_STAGE(PG8_SB(1, 1), cB + hstep + kstep, voffB);
        PG8_WAIT_V(6); PG8_BAR;
    }
    for (;;) {
        const bool has_next = S.next(ui + 1, nxt);
        const char* nA = has_next ? (const char*)g.A + (size_t)nxt.pm * tstep + nxt.kofs : cA; const char* nB = has_next ? (const char*)g.Bt + (size_t)nxt.pn * tstep + nxt.kofs : cB;
        const int nt = cur.nt;
        for (int t = 0; t < nt; t += 2) {
            const bool last = (t == nt - 2);
            const char* a1 = cA + (size_t)(t + 1) * kstep;
            const char* a2 = last ? nA : cA + (size_t)(t + 2) * kstep; const char* b2 = last ? nB : cB + (size_t)(t + 2) * kstep;
            const char* a3 = a2 + kstep; const char* b3 = b2 + kstep;
            if (last && has_next) S.a_ready(nxt);
            if constexpr (SP2) {
            PG8_LDB(B0, 0, 0); PG8_LDB(B1, 0, 1); PG8_SCHED; PG8_LDA(At, 0, 0); PG8_STAGE(PG8_SA(1, 1), a1 + hstep, voffA);
            PG8_WAIT_V(8); PG8_WAIT_L(0); PG8_BAR; PG8_MMA(0, 0, At, B0); PG8_MMA(0, 1, At, B1); PG8_BAR; PG8_SCHED;
            PG8_LDA(At, 0, 1); PG8_STAGE(PG8_SB(0, 0), b2, voffB); PG8_STAGE(PG8_SB(0, 1), b2 + hstep, voffB); PG8_STAGE(PG8_SA(0, 0), a2, voffA);
            PG8_WAIT_V(8); PG8_WAIT_L(0); PG8_BAR; PG8_MMA(1, 0, At, B0); PG8_MMA(1, 1, At, B1); PG8_BAR; PG8_SCHED;
            PG8_LDB(B0, 1, 0); PG8_LDB(B1, 1, 1); PG8_SCHED; PG8_LDA(At, 1, 0); PG8_STAGE(PG8_SA(0, 1), a2 + hstep, voffA);
            PG8_WAIT_V(8); PG8_WAIT_L(0); PG8_BAR; PG8_MMA(0, 0, At, B0); PG8_MMA(0, 1, At, B1); PG8_BAR; PG8_SCHED;
            PG8_LDA(At, 1, 1); PG8_STAGE(PG8_SB(1, 0), b3, voffB); PG8_STAGE(PG8_SB(1, 1), b3 + hstep, voffB); PG8_STAGE(PG8_SA(1, 0), a3, voffA);
            PG8_WAIT_V(8); PG8_WAIT_L(0); PG8_BAR; PG8_MMA(1, 0, At, B0); PG8_MMA(1, 1, At, B1); PG8_BAR; PG8_SCHED;
            } else {
            PG8_LDB(B0, 0, 0); PG8_SCHED; PG8_LDA(At, 0, 0); PG8_STAGE(PG8_SA(1, 1), a1 + hstep, voffA);
            PG8_WAIT_L(8); PG8_BAR; PG8_WAIT_L(0); PG8_MMA(0, 0, At, B0); PG8_BAR; PG8_SCHED;
            PG8_LDB(B1, 0, 1); PG8_STAGE(PG8_SB(0, 0), b2, voffB);
            PG8_BAR; PG8_WAIT_L(0); PG8_MMA(0, 1, At, B1); PG8_BAR;
            PG8_LDA(At, 0, 1); PG8_STAGE(PG8_SA(0, 0), a2, voffA);
            PG8_BAR; PG8_WAIT_L(0); PG8_MMA(1, 0, At, B0); PG8_BAR; PG8_SCHED;
            PG8_STAGE(PG8_SB(0, 1), b2 + hstep, voffB);
            PG8_WAIT_V(6); PG8_BAR; PG8_MMA(1, 1, At, B1); PG8_BAR;
            PG8_LDB(B0, 1, 0); PG8_SCHED; PG8_LDA(At, 1, 0); PG8_STAGE(PG8_SA(0, 1), a2 + hstep, voffA);
            PG8_WAIT_L(8); PG8_BAR; PG8_WAIT_L(0); PG8_MMA(0, 0, At, B0); PG8_BAR; PG8_SCHED;
            PG8_LDB(B1, 1, 1); PG8_STAGE(PG8_SB(1, 0), b3, voffB);
            PG8_BAR; PG8_WAIT_L(0); PG8_MMA(0, 1, At, B1); PG8_BAR;
            PG8_LDA(At, 1, 1); PG8_STAGE(PG8_SA(1, 0), a3, voffA);
            PG8_BAR; PG8_WAIT_L(0); PG8_MMA(1, 0, At, B0); PG8_BAR; PG8_SCHED;
            PG8_STAGE(PG8_SB(1, 1), b3 + hstep, voffB);
            PG8_WAIT_V(6); PG8_BAR; PG8_MMA(1, 1, At, B1); PG8_BAR;
            }
        }
        if constexpr (ALIGN_EPI) { if (wr == 0) PG8_BAR; }
        if constexpr (!Epi::AFTER_DRAIN) { E(acc, cur, wr, wc, fr, fq); S.done(cur); }
        if (!has_next) break;
#pragma unroll
        for (int a = 0; a < 2; ++a)
#pragma unroll
            for (int b = 0; b < 2; ++b)
#pragma unroll
                for (int m = 0; m < 4; ++m)
#pragma unroll
                    for (int n = 0; n < 2; ++n) acc[a][b][m][n] = (f32x4){0.f, 0.f, 0.f, 0.f};
        cur = nxt; cA = nA; cB = nB; ++ui;
        if constexpr (ALIGN_EPI) { if (wr == 1) PG8_BAR; }
    }
    PG8_WAIT_V(0);
    if constexpr (!ALIGN_EPI) { if (wr == 0) PG8_BAR; }
    PG8_BAR;
#undef PG8_SA
#undef PG8_SB
#undef PG8_STAGE
#undef PG8_LDA
#undef PG8_LDB
#undef PG8_MMA
#undef PG8_WAIT_V
#undef PG8_WAIT_L
#undef PG8_BAR
#undef PG8_SCHED
}
}
#ifndef PG8_SP2
#define PG8_SP2 true
#endif
#ifndef PG8_ALIGN
#define PG8_ALIGN true
#endif

#define XB_TMO      128
#define XB_XCNT(j)  (256  + 64 * (j))
#define XB_XSUB(j)  (1280 + 64 * (j))
#define XB_XGEN(j)  (2304 + 64 * (j))
#define XB_TOP      3328
#define XB_TOPGEN   3392
#define XCD_BAR_WORDS 3456
#define XB_SPIN_CAP (1u << 18)
__device__ __forceinline__ unsigned xb_ld(unsigned* p)              { return __hip_atomic_load(p, __ATOMIC_RELAXED, __HIP_MEMORY_SCOPE_AGENT); }
__device__ __forceinline__ unsigned xb_add(unsigned* p, unsigned v) { return __hip_atomic_fetch_add(p, v, __ATOMIC_RELAXED, __HIP_MEMORY_SCOPE_AGENT); }
__device__ __forceinline__ unsigned xb_xcc_id() { return (unsigned)__builtin_amdgcn_s_getreg((3 << 11) | 20) & 0xFu; }
#define XB_SPIN(cond, bar) do { unsigned _sp = 0; while (cond) { __builtin_amdgcn_s_sleep(1); \
    if ((++_sp & 255u) == 0u) { if (xb_ld(&(bar)[XB_TMO])) break; if (_sp > XB_SPIN_CAP) { atomicAdd(&(bar)[XB_TMO], 1u); break; } } } } while (0)
struct XcdBarrier { unsigned* bar; unsigned x; volatile LAS unsigned* st; };
__device__ __forceinline__ XcdBarrier xcd_barrier_post(unsigned* bar, volatile LAS unsigned* st) {
    XcdBarrier b; b.bar = bar; b.x = xb_xcc_id(); b.st = st;
    if (threadIdx.x == 0) (void)xb_add(&bar[XB_XCNT(b.x)], 1u);
    return b;
}
__device__ __forceinline__ void xcd_barrier_complete(unsigned* bar, unsigned x, unsigned& nloc, unsigned& nx) {
    const unsigned G = gridDim.x * gridDim.y * gridDim.z;
    unsigned sum, cnt, mine, sp = 0u;
    for (;;) {
        sum = 0u; cnt = 0u; mine = 0u;
#pragma unroll
        for (unsigned j = 0; j < 16; ++j) { const unsigned c = xb_ld(&bar[XB_XCNT(j)]); sum += c; cnt += (c > 0u) ? 1u : 0u; mine = (j == x) ? c : mine; }
        if (sum == G) break;
        __builtin_amdgcn_s_sleep(1);
        if ((++sp & 255u) == 0u) { if (xb_ld(&bar[XB_TMO])) break; if (sp > XB_SPIN_CAP) { atomicAdd(&bar[XB_TMO], 1u); break; } }
    }
    nloc = mine > 0u ? mine : 1u; nx = cnt > 0u ? cnt : 1u;
}
__device__ __forceinline__ void xcd_barrier(const XcdBarrier& b) {
    asm volatile("s_waitcnt vmcnt(0)" ::: "memory");
    __syncthreads();
    if (threadIdx.x == 0) {
        unsigned* bar = b.bar;
        __builtin_amdgcn_s_waitcnt(0);
        unsigned nloc = b.st[0], nx = b.st[1];
        if (nloc == 0u) { xcd_barrier_complete(bar, b.x, nloc, nx); b.st[0] = nloc; b.st[1] = nx; }
        const unsigned old = xb_add(&bar[XB_XSUB(b.x)], 1u);
        const unsigned gen = old / nloc;
        if (old + 1u == (gen + 1u) * nloc) {
            __builtin_amdgcn_fence(__ATOMIC_RELEASE, "agent");
            asm volatile("s_waitcnt vmcnt(0)" ::: "memory");
            const unsigned og = xb_add(&bar[XB_TOP], 1u);
            const unsigned tg = og / nx;
            if (og + 1u == (tg + 1u) * nx) xb_add(&bar[XB_TOPGEN], 1u);
            else XB_SPIN(xb_ld(&bar[XB_TOPGEN]) == tg, bar);
            __builtin_amdgcn_fence(__ATOMIC_ACQUIRE, "agent");
            xb_add(&bar[XB_XGEN(b.x)], 1u);
            asm volatile("s_waitcnt vmcnt(0)" ::: "memory");
        } else {
            XB_SPIN(xb_ld(&bar[XB_XGEN(b.x)]) == gen, bar);
            __builtin_amdgcn_fence(__ATOMIC_ACQUIRE, "agent");
            asm volatile("s_waitcnt vmcnt(0)" ::: "memory");
        }
    }
    __syncthreads();
}

constexpr size_t al256(size_t x) { return (x + 255) & ~(size_t)255; }
constexpr size_t WS_CTL = 0;
constexpr size_t CTL_ZERO_BYTES = 65536;
constexpr size_t WS_MODACC = 2u << 20;
constexpr size_t WS_MODF = (1u << 20) + (512u << 10);
constexpr size_t WS_ROPE = 1u << 20;
constexpr size_t WS_WABIN = 8u << 20;
constexpr size_t SZ_WABIN = (size_t)ABIN * D * 2;
constexpr size_t WS_WABOUT = WS_WABIN + 2 * SZ_WABIN;
constexpr size_t SZ_WSQ = (size_t)D * D * 2;
constexpr size_t WS_WQKV = WS_WABOUT + 2 * SZ_WSQ;
constexpr size_t SZ_WQKV = (size_t)QKV * D * 2;
constexpr size_t WS_WNAOUT = WS_WQKV + 2 * SZ_WQKV;
constexpr size_t WS_WFFIN = WS_WNAOUT + 2 * SZ_WSQ;
constexpr size_t SZ_WFFIN = (size_t)FF2 * D * 2;
constexpr size_t WS_WFFOUT = WS_WFFIN + 4 * SZ_WFFIN;
constexpr size_t SZ_WFFOUT = (size_t)D * FFH * 2;
constexpr size_t WS_X = WS_WFFOUT + 4 * SZ_WFFOUT;
constexpr size_t WS_H = WS_X + (size_t)MTOK * D * 4;
constexpr size_t WS_P = WS_H + (size_t)MTOK * D * 2;
constexpr size_t WS_YAB = WS_P + (size_t)MTOK * ABIN * 2;
constexpr size_t WS_Y = WS_YAB + (size_t)MTOK * D * 2;
constexpr size_t WS_HID = WS_Y + (size_t)MTOK * D * 4;
constexpr size_t WS_KVT = WS_HID + (size_t)MTOK * FFH * 2;
constexpr size_t WS_ST = WS_KVT + (size_t)NCHUNK * 16 * 16384 * 4;
constexpr size_t WS_YC = WS_ST + (size_t)NCHUNK * 16 * 16384 * 2;
constexpr size_t WS_END = WS_YC + (size_t)22 * 256 * D * 4;
constexpr int NSPLIT_OUT = 8, NSPLIT_FFO = 22;
static_assert(WS_WABIN % 256 == 0 && WS_X % 256 == 0 && WS_P % 256 == 0 && WS_KVT % 256 == 0 && WS_ST % 256 == 0, "ws alignment");

constexpr int RING_BYTES = 131072, LDSCTL_OFF = RING_BYTES, MISC_OFF = LDSCTL_OFF + 320, PRM_OFF = LDSCTL_OFF + 1024, LDS_BYTES = 147456;
constexpr int NPHASE = 2 + 9 * DEPTH;

struct Params { const float* in[16]; float* out; unsigned char* ws; int ph_lo, ph_hi, li, pad; };

__device__ __forceinline__ void transpose_item(const float* W, int ldw, int K, bf16_t* Wt, int k0, int n0s, int n0d, LAS float* scr, int lane) {
    const int r = lane >> 3, c4 = (lane & 7) * 4;
    f32x4 v[8];
#pragma unroll
    for (int i = 0; i < 8; ++i) v[i] = __builtin_nontemporal_load((const f32x4*)(W + (size_t)(k0 + 8 * i + r) * ldw + n0s + c4));
#pragma unroll
    for (int i = 0; i < 8; ++i) { LAS float* d = scr + (8 * i + r) * 33 + c4; d[0] = v[i][0]; d[1] = v[i][1]; d[2] = v[i][2]; d[3] = v[i][3]; }
    asm volatile("s_waitcnt lgkmcnt(0)" ::: "memory");
    const int c = lane & 7;
#pragma unroll
    for (int j = 0; j < 4; ++j) { const int n = (lane >> 3) + 8 * j; const LAS float* s = scr + (8 * c) * 33 + n;
        u32x4 o; o[0] = cvt_pk_bf16(s[0 * 33], s[1 * 33]); o[1] = cvt_pk_bf16(s[2 * 33], s[3 * 33]); o[2] = cvt_pk_bf16(s[4 * 33], s[5 * 33]); o[3] = cvt_pk_bf16(s[6 * 33], s[7 * 33]);
        *(u32x4*)(Wt + (size_t)(n0d + n) * K + k0 + 8 * c) = o; }
    asm volatile("s_waitcnt lgkmcnt(0)" ::: "memory");
}
__device__ __forceinline__ void transpose_matrix_item(const float* W, int K, int N, bf16_t* Wt, bool ffperm, int item, LAS float* scr, int lane) {
    const int nblk = N / 32, kb = item / nblk, nb = item % nblk, n0d = 32 * nb;
    int n0s = n0d;
    if (ffperm) { const int t = n0d >> 8, j = n0d & 255; n0s = j < 128 ? 128 * t + j : FFH + 128 * t + (j - 128); }
    transpose_item(W, N, K, Wt, 64 * kb, n0s, n0d, scr, lane);
}

constexpr int I_ABIN = (D / 64) * (ABIN / 32), I_SQ = (D / 64) * (D / 32), I_QKV = (D / 64) * (QKV / 32), I_FFIN = (D / 64) * (FF2 / 32), I_FFOUT = (FFH / 64) * (D / 32);
__device__ __forceinline__ unsigned long long ldptr(LAS const unsigned* prm, int k) {
    const unsigned lo = prm[2 * k], hi = prm[2 * k + 1];
    return ((unsigned long long)(unsigned)__builtin_amdgcn_readfirstlane((int)hi) << 32) | (unsigned)__builtin_amdgcn_readfirstlane((int)lo);
}
__device__ __forceinline__ void cvt_mat(LAS const unsigned* prm, int type, int inst, int idx, LAS float* scr, int lane) {
    const int kin = type == 0 ? 7 : (type == 1 ? 10 : (type == 2 ? 11 : (type == 3 ? 13 : (type == 4 ? 14 : 15))));
    const int K = type == 5 ? FFH : D;
    const int N = type == 0 ? ABIN : (type == 2 ? QKV : (type == 4 ? FF2 : D));
    const size_t woff = type == 0 ? WS_WABIN : (type == 1 ? WS_WABOUT : (type == 2 ? WS_WQKV : (type == 3 ? WS_WNAOUT : (type == 4 ? WS_WFFIN : WS_WFFOUT))));
    const size_t wsz = type == 0 ? SZ_WABIN : (type == 2 ? SZ_WQKV : (type == 4 ? SZ_WFFIN : (type == 5 ? SZ_WFFOUT : SZ_WSQ)));
    const float* src = (const float*)(GAS const float*)ldptr(prm, kin) + (size_t)inst * K * N;
    unsigned char* ws = (unsigned char*)(GAS unsigned char*)ldptr(prm, 17);
    transpose_matrix_item(src, K, N, (bf16_t*)(ws + woff + inst * wsz), type == 4, idx, scr, lane);
}
constexpr int L0_ITEMS = I_ABIN + I_FFOUT;
__device__ __forceinline__ void cvt_l0_item(LAS const unsigned* p, int r, LAS float* scr, int lane) {
    int type, base;
    if (r < I_ABIN) { type = 0; base = 0; } else { type = 5; base = I_ABIN; }
    cvt_mat(p, type, 0, r - base, scr, lane);
}
constexpr int DLA = I_SQ, DL0 = DLA + I_FFIN, DL1 = DL0 + I_QKV, DL2 = DL1 + I_SQ, DL3 = DL2 + I_FFIN, DL4 = DL3 + I_FFOUT, DL5 = DL4 + I_ABIN, DL6 = DL5 + I_SQ, DL7 = DL6 + I_FFIN, DL8 = DL7 + I_FFOUT,
              DL9 = DL8 + I_QKV, DL10 = DL9 + I_SQ, DL11 = DL10 + I_FFIN, DL_END = DL11 + I_FFOUT;
static_assert(DL_END == 89600 && L0_ITEMS == 12800, "deferred list");
__device__ __forceinline__ void cvt_dl_item(LAS const unsigned* p, int gi, LAS float* scr, int lane) {
    int type, inst, base;
    if (gi < DL0) { if (gi < DLA) { type = 1; inst = 0; base = 0; } else { type = 4; inst = 0; base = DLA; } }
    else if (gi < DL4) { if (gi < DL2) { if (gi < DL1) { type = 2; inst = 0; base = DL0; } else { type = 3; inst = 0; base = DL1; } } else { if (gi < DL3) { type = 4; inst = 1; base = DL2; } else { type = 5; inst = 1; base = DL3; } } }
    else if (gi < DL8) { if (gi < DL6) { if (gi < DL5) { type = 0; inst = 1; base = DL4; } else { type = 1; inst = 1; base = DL5; } } else { if (gi < DL7) { type = 4; inst = 2; base = DL6; } else { type = 5; inst = 2; base = DL7; } } }
    else { if (gi < DL10) { if (gi < DL9) { type = 2; inst = 1; base = DL8; } else { type = 3; inst = 1; base = DL9; } } else { if (gi < DL11) { type = 4; inst = 3; base = DL10; } else { type = 5; inst = 3; base = DL11; } } }
    cvt_mat(p, type, inst, gi - base, scr, lane);
}
__device__ __forceinline__ void ada_item(LAS const unsigned* prm, int l, int nc, int kp, int tid) {
    if (tid < 384) {
        const int n = nc * 1536 + 4 * tid;
        f32x4 aL = (f32x4){0.f, 0.f, 0.f, 0.f}, aC = aL;
        const float* wp = (const float*)(GAS const float*)ldptr(prm, 4) + ((size_t)l * D + kp * 128) * (6 * D) + n;
        const float* cl_p = (const float*)(GAS const float*)ldptr(prm, 1) + kp * 128; const float* cc_p = (const float*)(GAS const float*)ldptr(prm, 3) + kp * 128;
        float* modacc = (float*)((unsigned char*)(GAS unsigned char*)ldptr(prm, 17) + WS_MODACC);
        const int l32 = tid & 31;
#pragma unroll 1
        for (int k0 = 0; k0 < 128; k0 += 32) {
            f32x4 w[32];
#pragma unroll
            for (int j = 0; j < 32; ++j) w[j] = __builtin_nontemporal_load((const f32x4*)(wp + (size_t)(k0 + j) * (6 * D)));
            const float clv = cl_p[k0 + l32], ccv = cc_p[k0 + l32];
            const float slv = clv / (1.0f + __expf(-clv)), scv = ccv / (1.0f + __expf(-ccv));
#pragma unroll
            for (int j = 0; j < 32; ++j) { const float sl = __builtin_bit_cast(float, __builtin_amdgcn_readlane(__builtin_bit_cast(int, slv), j)), sc = __builtin_bit_cast(float, __builtin_amdgcn_readlane(__builtin_bit_cast(int, scv), j));
                aL = aL + w[j] * sl; aC = aC + w[j] * sc; }
        }
        *(f32x4*)(modacc + (size_t)kp * MODPART + (size_t)(l * 2 + 0) * 6 * D + n) = aL;
        *(f32x4*)(modacc + (size_t)kp * MODPART + (size_t)(l * 2 + 1) * 6 * D + n) = aC;
    }
}
__device__ __forceinline__ void r1_block_task(const bf16_t* P, float* KVt, LAS unsigned char* lds, float lg2, int cidx, int head, int wave, int lane) {
    const int i = lane & 15, g = lane >> 4, dir = wave >> 2, quad = wave & 3;
    const int dk0 = 64 * (quad >> 1), dv0 = 64 * (quad & 1);
    const bf16_t* Prow = P + (size_t)chunk_row(cidx) * ABIN;
#pragma unroll
    for (int r = 0; r < 2; ++r)
#pragma unroll
        for (int j = 0; j < 4; ++j) {
            const int p = (j * 8 + wave) * 64 + lane, row = p >> 4, c = (p & 15) ^ (row & 15);
            const bf16_t* src = Prow + (size_t)row * ABIN + (r == 0 ? 4096 : 5120) + head * 128 + c * 8;
            __builtin_amdgcn_global_load_lds((const unsigned*)src, (LAS unsigned*)(lds + r * 32768 + (j * 8 + wave) * 1024), 16, 0, 0);
        }
    asm volatile("s_waitcnt vmcnt(0)" ::: "memory");
    asm volatile("s_waitcnt lgkmcnt(0)" ::: "memory"); __builtin_amdgcn_s_barrier(); asm volatile("" ::: "memory");
    int kbo[8], vbo[8];
#pragma unroll
    for (int jj = 0; jj < 8; ++jj) { const int tl = 8 * g + jj;
        kbo[jj] = tl * 256 + (((dk0 >> 3) + (i >> 1)) ^ (tl & 15)) * 16 + 8 * (i & 1);
        vbo[jj] = 32768 + tl * 256 + (((dv0 >> 3) + (i >> 1)) ^ (tl & 15)) * 16 + 8 * (i & 1); }
    f32x4 acc[4][4];
#pragma unroll
    for (int a = 0; a < 4; ++a)
#pragma unroll
        for (int b = 0; b < 4; ++b) acc[a][b] = (f32x4){0.f, 0.f, 0.f, 0.f};
#pragma unroll
    for (int s = 0; s < 4; ++s) {
        u32x2 kd[8], vd[8]; float w[8];
#pragma unroll
        for (int jj = 0; jj < 8; ++jj) {
            const int tj = 32 * s + 8 * g + jj;
            kd[jj] = *(LAS const u32x2*)(lds + kbo[jj] + 8192 * s); vd[jj] = *(LAS const u32x2*)(lds + vbo[jj] + 8192 * s);
            w[jj] = ex2(lg2 * (float)(dir == 0 ? 127 - tj : tj));
        }
        bf16x8 af[4], bfr[4];
#pragma unroll
        for (int mt = 0; mt < 4; ++mt) {
            u32x4 wd;
#pragma unroll
            for (int q = 0; q < 4; ++q) {
                const unsigned X = kd[2 * q][mt >> 1], Y = kd[2 * q + 1][mt >> 1];
                const float lo = ((mt & 1) ? bf_hi(X) : bf_lo(X)) * w[2 * q], hi = ((mt & 1) ? bf_hi(Y) : bf_lo(Y)) * w[2 * q + 1];
                wd[q] = cvt_pk_bf16(lo, hi);
            }
            af[mt] = __builtin_bit_cast(bf16x8, wd);
        }
#pragma unroll
        for (int nt = 0; nt < 4; ++nt) {
            u32x4 wd;
#pragma unroll
            for (int q = 0; q < 4; ++q) {
                const unsigned X = vd[2 * q][nt >> 1], Y = vd[2 * q + 1][nt >> 1];
                wd[q] = (nt & 1) ? ((X >> 16) | (Y & 0xffff0000u)) : ((X & 0xffffu) | (Y << 16));
            }
            bfr[nt] = __builtin_bit_cast(bf16x8, wd);
        }
#pragma unroll
        for (int mt = 0; mt < 4; ++mt)
#pragma unroll
            for (int nt = 0; nt < 4; ++nt) acc[mt][nt] = mfma16(af[mt], bfr[nt], acc[mt][nt]);
        SCHED_FENCE();
    }
    asm volatile("s_waitcnt lgkmcnt(0)" ::: "memory"); __builtin_amdgcn_s_barrier(); asm volatile("" ::: "memory");
    float* out = KVt + ((((size_t)cidx * 8 + head) * 2 + dir) * 128) * 128;
#pragma unroll
    for (int nt = 0; nt < 4; ++nt)
#pragma unroll
        for (int reg = 0; reg < 4; ++reg) {
            const int dv = dv0 + 4 * i + nt, dk = dk0 + 16 * g + 4 * reg;
            *(f32x4*)(out + (size_t)dv * 128 + dk) = (f32x4){acc[0][nt][reg], acc[1][nt][reg], acc[2][nt][reg], acc[3][nt][reg]};
        }
}

__device__ __forceinline__ void r1_issue_set(const bf16_t* Prow, LAS unsigned char* setp, const int head, const int wave, const int lane) {
#pragma unroll
    for (int r = 0; r < 2; ++r)
#pragma unroll
        for (int j = 0; j < 4; ++j) {
            const int p = (j * 8 + wave) * 64 + lane, row = p >> 4, c = (p & 15) ^ (row & 15);
            const bf16_t* src = Prow + (size_t)row * ABIN + (r == 0 ? 4096 : 5120) + head * 128 + c * 8;
            __builtin_amdgcn_global_load_lds((const unsigned*)src, (LAS unsigned*)(setp + r * 32768 + (j * 8 + wave) * 1024), 16, 0, 0);
        }
}
__device__ __forceinline__ void r1_phase_pipelined(const bf16_t* P, float* KVt, LAS unsigned char* lds, const float* decay_exp, const int iab, const int vcu, const int G, const int wave, const int lane) {
    const int i = lane & 15, g = lane >> 4, dir = wave >> 2, quad = wave & 3;
    const int dk0 = 64 * (quad >> 1), dv0 = 64 * (quad & 1);
    int bt = vcu; if (bt >= NCHUNK * 8) return;
    int kbo[8], vbo[8];
#pragma unroll
    for (int jj = 0; jj < 8; ++jj) { const int tl = 8 * g + jj;
        kbo[jj] = tl * 256 + (((dk0 >> 3) + (i >> 1)) ^ (tl & 15)) * 16 + 8 * (i & 1);
        vbo[jj] = 32768 + tl * 256 + (((dv0 >> 3) + (i >> 1)) ^ (tl & 15)) * 16 + 8 * (i & 1); }
    r1_issue_set(P + (size_t)chunk_row(bt >> 3) * ABIN, lds, bt & 7, wave, lane);
    for (int k = 0;; ++k) {
        const int cidx = bt >> 3, head = bt & 7, nbt = bt + G;
        const bool has_next = nbt < NCHUNK * 8;
        const float lg2 = lg2gamma(decay_exp, iab, dir, head);
        LAS const unsigned char* setp = lds + (k & 1) * 65536;
        if (has_next) { r1_issue_set(P + (size_t)chunk_row(nbt >> 3) * ABIN, lds + ((k + 1) & 1) * 65536, nbt & 7, wave, lane); asm volatile("s_waitcnt vmcnt(8)" ::: "memory"); }
        else asm volatile("s_waitcnt vmcnt(0)" ::: "memory");
        asm volatile("s_waitcnt lgkmcnt(0)" ::: "memory"); __builtin_amdgcn_s_barrier(); asm volatile("" ::: "memory");
        f32x4 acc[4][4];
#pragma unroll
        for (int a = 0; a < 4; ++a)
#pragma unroll
            for (int b = 0; b < 4; ++b) acc[a][b] = (f32x4){0.f, 0.f, 0.f, 0.f};
#pragma unroll
        for (int s = 0; s < 4; ++s) {
            u32x2 kd[8], vd[8]; float w[8];
#pragma unroll
            for (int jj = 0; jj < 8; ++jj) {
                const int tj = 32 * s + 8 * g + jj;
                kd[jj] = *(LAS const u32x2*)(setp + kbo[jj] + 8192 * s); vd[jj] = *(LAS const u32x2*)(setp + vbo[jj] + 8192 * s);
                w[jj] = ex2(lg2 * (float)(dir == 0 ? 127 - tj : tj));
            }
            bf16x8 af[4], bfr[4];
#pragma unroll
            for (int mt = 0; mt < 4; ++mt) {
                u32x4 wd;
#pragma unroll
                for (int q = 0; q < 4; ++q) {
                    const unsigned X = kd[2 * q][mt >> 1], Y = kd[2 * q + 1][mt >> 1];
                    const float lo = ((mt & 1) ? bf_hi(X) : bf_lo(X)) * w[2 * q], hi = ((mt & 1) ? bf_hi(Y) : bf_lo(Y)) * w[2 * q + 1];
                    wd[q] = cvt_pk_bf16(lo, hi);
                }
                af[mt] = __builtin_bit_cast(bf16x8, wd);
            }
#pragma unroll
            for (int nt = 0; nt < 4; ++nt) {
                u32x4 wd;
#pragma unroll
                for (int q = 0; q < 4; ++q) {
                    const unsigned X = vd[2 * q][nt >> 1], Y = vd[2 * q + 1][nt >> 1];
                    wd[q] = (nt & 1) ? ((X >> 16) | (Y & 0xffff0000u)) : ((X & 0xffffu) | (Y << 16));
                }
                bfr[nt] = __builtin_bit_cast(bf16x8, wd);
            }
#pragma unroll
            for (int mt = 0; mt < 4; ++mt)
#pragma unroll
                for (int nt = 0; nt < 4; ++nt) acc[mt][nt] = mfma16(af[mt], bfr[nt], acc[mt][nt]);
            SCHED_FENCE();
        }
        asm volatile("s_waitcnt lgkmcnt(0)" ::: "memory"); __builtin_amdgcn_s_barrier(); asm volatile("" ::: "memory");
        bf16_t* out = (bf16_t*)KVt + ((((size_t)cidx * 8 + head) * 2 + dir) * 128) * 128;
#pragma unroll
        for (int nt = 0; nt < 4; ++nt)
#pragma unroll
            for (int reg = 0; reg < 4; ++reg) {
                const int dv = dv0 + 4 * i + nt, dk = dk0 + 16 * g + 4 * reg;
                u32x2 w; w[0] = cvt_pk_bf16(acc[0][nt][reg], acc[1][nt][reg]); w[1] = cvt_pk_bf16(acc[2][nt][reg], acc[3][nt][reg]);
                *(u32x2*)(out + (size_t)dv * 128 + dk) = w;
            }
        if (!has_next) break;
        bt = nbt;
    }
}

__device__ __forceinline__ void r3_block_task(const bf16_t* P, const bf16_t* St, bf16_t* YAB, LAS unsigned char* lds, float lg2f, float lg2b, int cidx, int head, int wave, int lane) {
    const int i = lane & 15, g = lane >> 4, qi = 16 * wave + i, rowbase = chunk_row(cidx);
    const bf16_t* Prow = P + (size_t)rowbase * ABIN;
    bf16x8 qf[4];
#pragma unroll
    for (int s = 0; s < 4; ++s) qf[s] = *(const bf16x8*)(Prow + (size_t)qi * ABIN + 3072 + head * 128 + 32 * s + 8 * g);
#pragma unroll
    for (int r = 0; r < 4; ++r)
#pragma unroll
        for (int j = 0; j < 4; ++j) {
            const int p = (j * 8 + wave) * 64 + lane, row = p >> 4, c = (p & 15) ^ (r < 2 ? (row & 15) : ((row >> 3) & 15));
            const bf16_t* src = r == 0 ? Prow + (size_t)row * ABIN + 4096 + head * 128 + c * 8 : (r == 1 ? Prow + (size_t)row * ABIN + 5120 + head * 128 + c * 8
                                : St + ((((size_t)cidx * 8 + head) * 2 + (r - 2)) * 128 + row) * 128 + c * 8);
            __builtin_amdgcn_global_load_lds((const unsigned*)src, (LAS unsigned*)(lds + r * 32768 + (j * 8 + wave) * 1024), 16, 0, 0);
        }
    asm volatile("s_waitcnt vmcnt(0)" ::: "memory");
    asm volatile("s_waitcnt lgkmcnt(0)" ::: "memory"); __builtin_amdgcn_s_barrier(); asm volatile("" ::: "memory");
    int kb[4], sb[4], vb[8];
#pragma unroll
    for (int s = 0; s < 4; ++s) { kb[s] = i * 256 + ((4 * s + g) ^ i) * 16; sb[s] = 65536 + i * 2048 + ((4 * s + g) ^ i) * 16; }
#pragma unroll
    for (int jj = 0; jj < 8; ++jj) { const int kk = jj < 4 ? 4 * g + jj : 16 + 4 * g + jj - 4; vb[jj] = 32768 + kk * 256 + (i ^ (kk & 15)) * 16; }
    f32x4 sacc[8];
#pragma unroll
    for (int mt = 0; mt < 8; ++mt) {
        f32x4 a = (f32x4){0.f, 0.f, 0.f, 0.f};
#pragma unroll
        for (int s = 0; s < 4; ++s) { const bf16x8 kf = *(LAS const bf16x8*)(lds + kb[s] + 4096 * mt); a = mfma16(kf, qf[s], a); }
        sacc[mt] = a;
        if (mt & 1) SCHED_FENCE();
    }
#pragma unroll
    for (int mt = 0; mt < 8; ++mt)
#pragma unroll
        for (int reg = 0; reg < 4; ++reg) {
            const int diff = qi - (16 * mt + 4 * g + reg);
            const float d = diff > 0 ? ex2((float)diff * lg2f) : (diff < 0 ? ex2((float)(-diff) * lg2b) : 2.0f);
            sacc[mt][reg] *= d;
        }
    bf16x8 pf[4];
#pragma unroll
    for (int s = 0; s < 4; ++s) {
        u32x4 w; w[0] = cvt_pk_bf16(sacc[2 * s][0], sacc[2 * s][1]); w[1] = cvt_pk_bf16(sacc[2 * s][2], sacc[2 * s][3]);
        w[2] = cvt_pk_bf16(sacc[2 * s + 1][0], sacc[2 * s + 1][1]); w[3] = cvt_pk_bf16(sacc[2 * s + 1][2], sacc[2 * s + 1][3]);
        pf[s] = __builtin_bit_cast(bf16x8, w);
    }
    f32x4 oacc[8];
#pragma unroll
    for (int mt = 0; mt < 8; ++mt) oacc[mt] = (f32x4){0.f, 0.f, 0.f, 0.f};
#pragma unroll
    for (int s = 0; s < 4; ++s) {
        u32x4 vd[8];
#pragma unroll
        for (int jj = 0; jj < 8; ++jj) vd[jj] = *(LAS const u32x4*)(lds + vb[jj] + 8192 * s);
#pragma unroll
        for (int mt = 0; mt < 8; ++mt) oacc[mt] = mfma16(extract8(vd, mt), pf[s], oacc[mt]);
        SCHED_FENCE();
    }
#pragma unroll
    for (int dir = 0; dir < 2; ++dir) {
        f32x4 tacc[8];
#pragma unroll
        for (int mt = 0; mt < 8; ++mt) tacc[mt] = (f32x4){0.f, 0.f, 0.f, 0.f};
#pragma unroll
        for (int s = 0; s < 4; ++s) {
#pragma unroll
            for (int mt = 0; mt < 8; ++mt) { const bf16x8 sf = *(LAS const bf16x8*)(lds + sb[s] + 256 * mt + 32768 * dir); tacc[mt] = mfma16(sf, qf[s], tacc[mt]); }
            SCHED_FENCE();
        }
        const float qd = dir == 0 ? ex2((float)(qi + 1) * lg2f) : ex2((float)(128 - qi) * lg2b);
#pragma unroll
        for (int mt = 0; mt < 8; ++mt) oacc[mt] = oacc[mt] + tacc[mt] * qd;
    }
    asm volatile("s_waitcnt lgkmcnt(0)" ::: "memory"); __builtin_amdgcn_s_barrier(); asm volatile("" ::: "memory");
    float ss = 0.f;
#pragma unroll
    for (int mt = 0; mt < 8; ++mt) ss += (oacc[mt][0] * oacc[mt][0] + oacc[mt][1] * oacc[mt][1]) + (oacc[mt][2] * oacc[mt][2] + oacc[mt][3] * oacc[mt][3]);
    ss += shfl_xor_f(ss, 16); ss += shfl_xor_f(ss, 32);
    const float rinv = rsq_f(ss * (1.0f / 128.0f) + EPS);
#pragma unroll
    for (int reg = 0; reg < 4; ++reg) {
        const int dvb = 32 * g + 8 * reg;
        const u32x4 gt = *(const u32x4*)(Prow + (size_t)qi * ABIN + 6144 + head * 128 + dvb);
        float o[8];
#pragma unroll
        for (int mt = 0; mt < 8; ++mt) { const float gv = (mt & 1) ? bf_hi(gt[mt >> 1]) : bf_lo(gt[mt >> 1]); o[mt] = silu_f(gv) * (oacc[mt][reg] * rinv); }
        u32x4 w; w[0] = cvt_pk_bf16(o[0], o[1]); w[1] = cvt_pk_bf16(o[2], o[3]); w[2] = cvt_pk_bf16(o[4], o[5]); w[3] = cvt_pk_bf16(o[6], o[7]);
        *(u32x4*)(YAB + (size_t)(rowbase + qi) * D + 1024 + head * 128 + dvb) = w;
    }
}

__device__ __forceinline__ void r3_issue_regions(const bf16_t* Prow, const bf16_t* Stb, LAS unsigned char* lds, const int head, const int rlo, const int wave, const int lane) {
#pragma unroll
    for (int rr = 0; rr < 2; ++rr)
#pragma unroll
        for (int j = 0; j < 4; ++j) {
            const int r = rlo + rr;
            const int p = (j * 8 + wave) * 64 + lane, row = p >> 4, c = (p & 15) ^ (r < 2 ? (row & 15) : ((row >> 3) & 15));
            const bf16_t* src = r == 0 ? Prow + (size_t)row * ABIN + 4096 + head * 128 + c * 8 : (r == 1 ? Prow + (size_t)row * ABIN + 5120 + head * 128 + c * 8
                                : Stb + ((size_t)(r - 2) * 128 + row) * 128 + c * 8);
            __builtin_amdgcn_global_load_lds((const unsigned*)src, (LAS unsigned*)(lds + r * 32768 + (j * 8 + wave) * 1024), 16, 0, 0);
        }
}
__device__ __forceinline__ void r3_phase_pipelined(const bf16_t* P, const bf16_t* St, bf16_t* YAB, LAS unsigned char* lds, const float* decay_exp, const int iab, const int vcu, const int G, const int wave, const int lane) {
    const int i = lane & 15, g = lane >> 4;
    int bt = vcu; if (bt >= NCHUNK * 8) return;
    int kb[4], sb[4], vb[8];
#pragma unroll
    for (int s = 0; s < 4; ++s) { kb[s] = i * 256 + ((4 * s + g) ^ i) * 16; sb[s] = 65536 + i * 2048 + ((4 * s + g) ^ i) * 16; }
#pragma unroll
    for (int jj = 0; jj < 8; ++jj) { const int kk = jj < 4 ? 4 * g + jj : 16 + 4 * g + jj - 4; vb[jj] = 32768 + kk * 256 + (i ^ (kk & 15)) * 16; }
    bf16x8 qn[4];
    {   const int cidx = bt >> 3, head = bt & 7; const bf16_t* Prow = P + (size_t)chunk_row(cidx) * ABIN;
#pragma unroll
        for (int s = 0; s < 4; ++s) qn[s] = *(const bf16x8*)(Prow + (size_t)(16 * wave + i) * ABIN + 3072 + head * 128 + 32 * s + 8 * g);
        const bf16_t* Stb = St + (((size_t)cidx * 8 + head) * 2) * 16384;
        r3_issue_regions(Prow, Stb, lds, head, 0, wave, lane); r3_issue_regions(Prow, Stb, lds, head, 2, wave, lane); }
    for (;;) {
        const int cidx = bt >> 3, head = bt & 7, qi = 16 * wave + i, rowbase = chunk_row(cidx), nbt = bt + G;
        const bool has_next = nbt < NCHUNK * 8;
        const bf16_t* Prow = P + (size_t)rowbase * ABIN;
        const float lg2f = lg2gamma(decay_exp, iab, 0, head), lg2b = lg2gamma(decay_exp, iab, 1, head);
        bf16x8 qf[4];
#pragma unroll
        for (int s = 0; s < 4; ++s) qf[s] = qn[s];
        asm volatile("s_waitcnt vmcnt(8)" ::: "memory");
        asm volatile("s_waitcnt lgkmcnt(0)" ::: "memory"); __builtin_amdgcn_s_barrier(); asm volatile("" ::: "memory");
        f32x4 sacc[8];
#pragma unroll
        for (int mt = 0; mt < 8; ++mt) {
            f32x4 a = (f32x4){0.f, 0.f, 0.f, 0.f};
#pragma unroll
            for (int s = 0; s < 4; ++s) { const bf16x8 kf = *(LAS const bf16x8*)(lds + kb[s] + 4096 * mt); a = mfma16(kf, qf[s], a); }
            sacc[mt] = a;
            if (mt & 1) SCHED_FENCE();
        }
#pragma unroll
        for (int mt = 0; mt < 8; ++mt)
#pragma unroll
            for (int reg = 0; reg < 4; ++reg) {
                const int diff = qi - (16 * mt + 4 * g + reg);
                const float d = diff > 0 ? ex2((float)diff * lg2f) : (diff < 0 ? ex2((float)(-diff) * lg2b) : 2.0f);
                sacc[mt][reg] *= d;
            }
        bf16x8 pf[4];
#pragma unroll
        for (int s = 0; s < 4; ++s) {
            u32x4 w; w[0] = cvt_pk_bf16(sacc[2 * s][0], sacc[2 * s][1]); w[1] = cvt_pk_bf16(sacc[2 * s][2], sacc[2 * s][3]);
            w[2] = cvt_pk_bf16(sacc[2 * s + 1][0], sacc[2 * s + 1][1]); w[3] = cvt_pk_bf16(sacc[2 * s + 1][2], sacc[2 * s + 1][3]);
            pf[s] = __builtin_bit_cast(bf16x8, w);
        }
        f32x4 oacc[8];
#pragma unroll
        for (int mt = 0; mt < 8; ++mt) oacc[mt] = (f32x4){0.f, 0.f, 0.f, 0.f};
#pragma unroll
        for (int s = 0; s < 4; ++s) {
            u32x4 vd[8];
#pragma unroll
            for (int jj = 0; jj < 8; ++jj) vd[jj] = *(LAS const u32x4*)(lds + vb[jj] + 8192 * s);
#pragma unroll
            for (int mt = 0; mt < 8; ++mt) oacc[mt] = mfma16(extract8(vd, mt), pf[s], oacc[mt]);
            SCHED_FENCE();
        }
        asm volatile("s_waitcnt lgkmcnt(0)" ::: "memory"); __builtin_amdgcn_s_barrier(); asm volatile("" ::: "memory");
        if (has_next) {
            const int ncidx = nbt >> 3, nhead = nbt & 7; const bf16_t* nProw = P + (size_t)chunk_row(ncidx) * ABIN;
#pragma unroll
            for (int s = 0; s < 4; ++s) qn[s] = *(const bf16x8*)(nProw + (size_t)(16 * wave + i) * ABIN + 3072 + nhead * 128 + 32 * s + 8 * g);
            r3_issue_regions(nProw, St, lds, nhead, 0, wave, lane);
            asm volatile("s_waitcnt vmcnt(8)" ::: "memory");
        } else asm volatile("s_waitcnt vmcnt(0)" ::: "memory");
        asm volatile("s_waitcnt lgkmcnt(0)" ::: "memory"); __builtin_amdgcn_s_barrier(); asm volatile("" ::: "memory");
#pragma unroll
        for (int dir = 0; dir < 2; ++dir) {
            f32x4 tacc[8];
#pragma unroll
            for (int mt = 0; mt < 8; ++mt) tacc[mt] = (f32x4){0.f, 0.f, 0.f, 0.f};
#pragma unroll
            for (int s = 0; s < 4; ++s) {
#pragma unroll
                for (int mt = 0; mt < 8; ++mt) { const bf16x8 sf = *(LAS const bf16x8*)(lds + sb[s] + 256 * mt + 32768 * dir); tacc[mt] = mfma16(sf, qf[s], tacc[mt]); }
                SCHED_FENCE();
            }
            const float qd = dir == 0 ? ex2((float)(qi + 1) * lg2f) : ex2((float)(128 - qi) * lg2b);
#pragma unroll
            for (int mt = 0; mt < 8; ++mt) oacc[mt] = oacc[mt] + tacc[mt] * qd;
        }
        asm volatile("s_waitcnt lgkmcnt(0)" ::: "memory"); __builtin_amdgcn_s_barrier(); asm volatile("" ::: "memory");
        float ss = 0.f;
#pragma unroll
        for (int mt = 0; mt < 8; ++mt) ss += (oacc[mt][0] * oacc[mt][0] + oacc[mt][1] * oacc[mt][1]) + (oacc[mt][2] * oacc[mt][2] + oacc[mt][3] * oacc[mt][3]);
        ss += shfl_xor_f(ss, 16); ss += shfl_xor_f(ss, 32);
        const float rinv = rsq_f(ss * (1.0f / 128.0f) + EPS);
#pragma unroll
        for (int reg = 0; reg < 4; ++reg) {
            const int dvb = 32 * g + 8 * reg;
            const u32x4 gt = *(const u32x4*)(Prow + (size_t)qi * ABIN + 6144 + head * 128 + dvb);
            float o[8];
#pragma unroll
            for (int mt = 0; mt < 8; ++mt) { const float gv = (mt & 1) ? bf_hi(gt[mt >> 1]) : bf_lo(gt[mt >> 1]); o[mt] = silu_f(gv) * (oacc[mt][reg] * rinv); }
            u32x4 w; w[0] = cvt_pk_bf16(o[0], o[1]); w[1] = cvt_pk_bf16(o[2], o[3]); w[2] = cvt_pk_bf16(o[4], o[5]); w[3] = cvt_pk_bf16(o[6], o[7]);
            *(u32x4*)(YAB + (size_t)(rowbase + qi) * D + 1024 + head * 128 + dvb) = w;
        }
        if (!has_next) break;
        { const int ncidx = nbt >> 3, nhead = nbt & 7; const bf16_t* nProw = P + (size_t)chunk_row(ncidx) * ABIN;
          r3_issue_regions(nProw, St + (((size_t)ncidx * 8 + nhead) * 2) * 16384, lds, nhead, 2, wave, lane); }
        bt = nbt;
    }
}

__device__ __forceinline__ void na_stage_issue(const bf16_t* P, LAS unsigned char* slot, int tok0, int h, int wave, int lane) {
#pragma unroll
    for (int j = 0; j < 2; ++j) {
        const int p = (j * 8 + wave) * 64 + lane, key = p >> 4, c = (p & 15) ^ (key & 15);
        const bf16_t* src = P + (size_t)(tok0 + key) * QKV + 2048 + h * 128 + c * 8;
        __builtin_amdgcn_global_load_lds((const unsigned*)src, (LAS unsigned*)(slot + (j * 8 + wave) * 1024), 16, 0, 0);
        __builtin_amdgcn_global_load_lds((const unsigned*)(src + 2048), (LAS unsigned*)(slot + 16384 + (j * 8 + wave) * 1024), 16, 0, 0);
    }
}
__device__ __forceinline__ void na_half_step(AttnTile& ta, AttnTile& tb, LAS const unsigned char* slot, const int k0, const bool okA, const bool okB, const bool win,
                                             LAS const float* brA, LAS const float* brB, const int kc0, const int c, const int sc, const int i, const int g) {
    f32x4 saA[2], saB[2];
#pragma unroll
    for (int mt = 0; mt < 2; ++mt) {
        const int k = k0 + 16 * mt + i;
        bf16x8 kf[4];
#pragma unroll
        for (int s = 0; s < 4; ++s) kf[s] = *(LAS const bf16x8*)(slot + ((k << 4) + ((4 * s + g) ^ (k & 15))) * 16);
        f32x4 a = (f32x4){0.f, 0.f, 0.f, 0.f}, b = a;
#pragma unroll
        for (int s = 0; s < 4; ++s) { a = mfma16(kf[s], ta.qf[s], a); b = mfma16(kf[s], tb.qf[s], b); }
        saA[mt] = a; saB[mt] = b;
    }
    const bf16x8 pfA = attn_tile_soft(ta, saA, win, okA, brA, kc0, c, sc, g);
    const bf16x8 pfB = attn_tile_soft(tb, saB, win, okB, brB, kc0, c, sc, g);
    u32x4 vd[8];
#pragma unroll
    for (int jj = 0; jj < 8; ++jj) { const int k = k0 + (jj < 4 ? 4 * g + jj : 16 + 4 * g + jj - 4); vd[jj] = *(LAS const u32x4*)(slot + 16384 + ((k << 4) + (i ^ (k & 15))) * 16); }
#pragma unroll
    for (int mt = 0; mt < 8; ++mt) { const bf16x8 vf = extract8(vd, mt); ta.oacc[mt] = mfma16(vf, pfA, ta.oacc[mt]); tb.oacc[mt] = mfma16(vf, pfB, tb.oacc[mt]); }
}
__device__ __forceinline__ void na_block_task(const bf16_t* P, bf16_t* YAB, const float* rpbh, LAS unsigned char* lds, const int h, const int r0, const int tid, const int wave, const int lane) {
    const int i = lane & 15, g = lane >> 4, cgp = wave & 3, pair = wave >> 2;
    const int rA = r0 + 2 * pair, rB = rA + 1, c0 = 16 * cgp, kc0 = cgp == 0 ? 0 : (cgp == 1 ? 8 : (cgp == 2 ? 24 : 32));
    const int c = c0 + i, sc = c - 8 < 0 ? 0 : (c - 8 > 48 ? 48 : c - 8);
    const int srA = rA - 4 < 0 ? 0 : (rA - 4 > 120 ? 120 : rA - 4), srB = rB - 4 < 0 ? 0 : (rB - 4 > 120 ? 120 : rB - 4);
    const int srmin = r0 - 4 < 0 ? 0 : (r0 - 4 > 120 ? 120 : r0 - 4), srlast = r0 - 1 < 0 ? 0 : (r0 - 1 > 120 ? 120 : r0 - 1);
    const int nkr = srlast + 8 - srmin, nsw = (nkr + 1) >> 1, nst = nsw + 2;
    LAS float* bias = (LAS float*)(lds + LDSCTL_OFF + 2048);
    if (tid < 465) bias[tid] = rpbh[tid];
    AttnTile ta, tb;
    attn_tile_init(ta, P, rA * 64 + c0 + i, h, g); attn_tile_init(tb, P, rB * 64 + c0 + i, h, g);
    asm volatile("s_waitcnt vmcnt(0)" ::: "memory");
#define NA_ROWOFF(idx) (nkr == 11 ? ((idx) < 4 ? (((idx) & 1) ? 9 + ((idx) >> 1) : ((idx) >> 1)) : (idx) - 2) : (idx))
#define NA_ISSUE2(stg, slotp) do { const int s_ = (stg); \
        const int t0_ = s_ < nsw ? (srmin + NA_ROWOFF(2 * s_)) * 64 : S + 128 * (s_ - nsw); \
        const int t1_ = s_ < nsw ? (srmin + (2 * s_ + 1 < nkr ? NA_ROWOFF(2 * s_ + 1) : NA_ROWOFF(2 * s_))) * 64 : S + 128 * (s_ - nsw) + 64; \
        na_stage_issue(P, (slotp), t0_, h, wave, lane); na_stage_issue(P, (slotp) + 32768, t1_, h, wave, lane); } while (0)
    NA_ISSUE2(0, lds);
    for (int st = 0; st < nst; ++st) {
        if (st + 1 < nst) {
            NA_ISSUE2(st + 1, lds + ((st + 1) & 1) * 65536);
            asm volatile("s_waitcnt vmcnt(8)" ::: "memory");
        } else asm volatile("s_waitcnt vmcnt(0)" ::: "memory");
        asm volatile("s_waitcnt lgkmcnt(0)" ::: "memory"); __builtin_amdgcn_s_barrier(); asm volatile("" ::: "memory");
        const bool win = st < nsw;
#pragma unroll 1
        for (int sub = 0; sub < 2; ++sub) {
            LAS const unsigned char* slot = lds + (st & 1) * 65536 + sub * 32768;
            const int kr = srmin + NA_ROWOFF(2 * st + sub);
            if (win && 2 * st + sub >= nkr) break;
            const bool doA = !win || (kr >= srA && kr < srA + 8), doB = !win || (kr >= srB && kr < srB + 8);
            if (!doA && !doB) continue;
            const int nh = win ? 1 : 2;
#pragma unroll 1
            for (int hf = 0; hf < nh; ++hf)
                na_half_step(ta, tb, slot, win ? kc0 : 32 * hf, doA, doB, win, bias + (win && doA ? (kr - rA + 7) * 31 : 0), bias + (win && doB ? (kr - rB + 7) * 31 : 0), kc0, c, sc, i, g);
        }
        asm volatile("s_waitcnt lgkmcnt(0)" ::: "memory"); __builtin_amdgcn_s_barrier(); asm volatile("" ::: "memory");
    }
#undef NA_ISSUE2
#undef NA_ROWOFF
    attn_tile_store(ta, YAB, rA * 64 + c0 + i, h, g); attn_tile_store(tb, YAB, rB * 64 + c0 + i, h, g);
}

#ifndef MK_MODE
#define MK_MODE 1
#endif
__global__ void __launch_bounds__(512, 2) mega_fwd(Params p) {
    extern __shared__ __attribute__((aligned(16))) unsigned char lds_raw[];
    LAS unsigned char* lds = (LAS unsigned char*)lds_raw;
    const int G_k = gridDim.x, bx_k = blockIdx.x;
#define SITE_COORDS pt_t0_ = (PT_SITE >= 0) ? wall_clock64() : 0ull; int tid = threadIdx.x; asm volatile("" : "+v"(tid)); int Gl_ = G_k, bxl_ = bx_k; asm volatile("" : "+s"(Gl_), "+s"(bxl_)); const int G = Gl_, bx = bxl_, NGW = G * 8; (void)NGW; const int lane = tid & 63, wave = __builtin_amdgcn_readfirstlane(tid >> 6); \
    const int vcu = (bx & 7) * (G >> 3) + (bx >> 3); const int gw = vcu * 8 + wave;     (void)lane; (void)gw; (void)vcu; \
    LAS const unsigned* prm = (LAS const unsigned*)(lds + PRM_OFF); asm volatile("" : "+v"(prm)); unsigned char* ws = (unsigned char*)(GAS unsigned char*)ldptr(prm, 17); (void)ws; \
    float* modacc = (float*)(ws + WS_MODACC); f32x2* rope = (f32x2*)(ws + WS_ROPE); float* X = (float*)(ws + WS_X); bf16_t* H = (bf16_t*)(ws + WS_H); bf16_t* P = (bf16_t*)(ws + WS_P); bf16_t* YAB = (bf16_t*)(ws + WS_YAB); \
    float* Y = (float*)(ws + WS_Y); bf16_t* HID = (bf16_t*)(ws + WS_P)  ; float* KVT = (float*)(ws + WS_Y)  ; bf16_t* ST = (bf16_t*)(ws + WS_Y + (size_t)NCHUNK * 16 * 16384 * 2); float* YC = (float*)(ws + WS_YC); \
    (void)modacc; (void)rope; (void)X; (void)H; (void)P; (void)YAB; (void)Y; (void)HID; (void)KVT; (void)ST; (void)YC
#define INP(k) ((const float*)(GAS const float*)ldptr(prm, (k)))
    volatile LAS unsigned* MISC = (volatile LAS unsigned*)(lds + MISC_OFF);
    { const int tid = threadIdx.x; for (int u = tid; u < (LDS_BYTES - LDSCTL_OFF) / 4; u += 512) ((LAS unsigned*)(lds + LDSCTL_OFF))[u] = 0u; }
    __syncthreads();
    if (threadIdx.x == 0) { LAS unsigned long long* q = (LAS unsigned long long*)(lds + PRM_OFF);
        q[0] = (unsigned long long)p.in[0]; q[1] = (unsigned long long)p.in[1]; q[2] = (unsigned long long)p.in[2]; q[3] = (unsigned long long)p.in[3];
        q[4] = (unsigned long long)p.in[4]; q[5] = (unsigned long long)p.in[5]; q[6] = (unsigned long long)p.in[6]; q[7] = (unsigned long long)p.in[7];
        q[8] = (unsigned long long)p.in[8]; q[9] = (unsigned long long)p.in[9]; q[10] = (unsigned long long)p.in[10]; q[11] = (unsigned long long)p.in[11];
        q[12] = (unsigned long long)p.in[12]; q[13] = (unsigned long long)p.in[13]; q[14] = (unsigned long long)p.in[14]; q[15] = (unsigned long long)p.in[15];
        q[16] = (unsigned long long)p.out; q[17] = (unsigned long long)p.ws; }
    __syncthreads();
    const int lo = MK_MODE == 1 ? 0 : p.ph_lo, hi = MK_MODE == 1 ? NPHASE : p.ph_hi;
    const bool multi = (hi - lo) > 1;
    XcdBarrier bar; bar.bar = (unsigned*)(p.ws + WS_CTL) + p.li * 4096; bar.x = 0; bar.st = nullptr;
    if (multi) bar = xcd_barrier_post((unsigned*)(p.ws + WS_CTL) + p.li * 4096, MISC + 8);
#ifndef SITE_MASK
#define SITE_MASK 0xffff
#endif
#define EN(i) (((SITE_MASK) >> (i)) & 1)
#ifndef REPEAT_MASK
#define REPEAT_MASK 0
#endif
#if REPEAT_MASK != 0
    int rmask_ = REPEAT_MASK; asm volatile("" : "+s"(rmask_));
#define REP(i) ((rmask_ >> (i)) & 1)
#else
#define REP(i) 0
#endif
#define IN(k) (lo <= (k) && (k) < hi)
#ifndef DEFER_CVT
#define DEFER_CVT 1
#endif
#define DEFER_SLOT(rk_, nblk_, lo_, hi_) do { if (DEFER_CVT && G == 256) {     const int rk = (rk_); if (rk >= 0) { LAS float* scr_ = (LAS float*)(lds + wave * 16384); \
        for (int gi = (lo_) + rk * 8 + wave; gi < (hi_); gi += (nblk_) * 8) cvt_dl_item(prm, gi, scr_, lane); } __syncthreads(); } } while (0)
#define DEFER_ADA(rk_, lo_, hi_) do { if (DEFER_CVT && G == 256) { const int ai_ = (lo_) + (rk_); if ((rk_) >= 0 && ai_ < (hi_)) ada_item(prm, 1 + (ai_ >> 7), (ai_ >> 4) & 7, ai_ & 15, tid); } } while (0)
#define MODF_FINALIZE(l0_, l1_) do { for (int it = (vcu * 512 + tid); it < ((l1_) - (l0_)) * 2 * 6 * (D / 4); it += G * 512) { const int col = 4 * (it & 511), j6 = (it >> 9) % 6, ls = 2 * (l0_) + it / (512 * 6); \
        *(f32x4*)((float*)(ws + WS_MODF) + (size_t)(ls * 6 + j6) * D + col) = modvec_partials(modacc, INP(5), ls >> 1, ls & 1, j6, col); } } while (0)
#define ROWOP_RUN(a0) do { RowopArgs ra_ = (a0); if (rep_ + 1 < nrep_) { ra_.xout_lat = (float*)(ws + WS_END); ra_.xout_ctx = ra_.xout_lat + (size_t)S * D; ra_.h = (bf16_t*)(ws + WS_END + (size_t)MTOK * D * 4); } LAS float* cf0 = (LAS float*)lds; LAS float* cf1 = (LAS float*)(lds + 24576); \
        rowop_coefs(ra_, 0, cf0, tid); if (ra_.nctx) rowop_coefs(ra_, 1, cf1, tid); __syncthreads(); \
        if (ra_.nctx) rowop_ctx(ra_, cf1, (LAS float*)(lds + 49152), vcu, G, wave, lane); \
        rowop_stream(ra_, cf0, gw, NGW, lane); __syncthreads(); } while (0)
#ifndef DOUBLE_BAR
#define DOUBLE_BAR 0
#endif
#ifndef PT_SITE
#define PT_SITE -1
#endif
#ifndef PT_BLOCK
#define PT_BLOCK 0
#endif
#ifndef IDLE_Q
#define IDLE_Q 40.0f
#endif
#ifndef IDLE_PROBE
#define IDLE_PROBE 0
#endif
    unsigned long long idle_acc_ = 0ull, pt_t0_ = 0ull, pt_acc_ = 0ull; int pt_cur_ = -1; (void)pt_t0_; (void)pt_acc_; (void)pt_cur_;
#define SEAM(k, knext) do { if (PT_SITE >= 0) { if (pt_cur_ == PT_SITE) pt_acc_ += wall_clock64() - pt_t0_; pt_cur_ = -1; } if (IN(k) && IN(knext)) { unsigned long long t0_ = 0ull; if (IDLE_PROBE) t0_ = wall_clock64(); { XcdBarrier b_ = bar; asm volatile("" : "+s"(b_.x)); xcd_barrier(b_); if (DOUBLE_BAR) xcd_barrier(b_); } \
        if (IDLE_PROBE == 1 || (IDLE_PROBE >= 2 && IDLE_PROBE < 100 && (k) >= 2 && ((k) - 2) % 9 == IDLE_PROBE - 2) || (IDLE_PROBE >= 100 && (k) == IDLE_PROBE - 100)) idle_acc_ += wall_clock64() - t0_; } } while (0)

    for (int nrep_ = 1 + REP(0), rep_ = 0; rep_ < nrep_; ++rep_) if (EN(0) && IN(0) && ((pt_cur_ = 0), true)) {
        SITE_COORDS;
        LAS float* scr = (LAS float*)(lds + wave * 16384);
        if (DEFER_CVT && G == 256) {
            constexpr int L0_ADA_SHARE = 2048;
            if (vcu < 128) { ada_item(prm, 0, vcu >> 4, vcu & 15, tid); for (int it = L0_ITEMS - L0_ADA_SHARE + vcu * 8 + wave; it < L0_ITEMS; it += 1024) cvt_l0_item(prm, it, scr, lane); }
            else for (int it = (vcu - 128) * 8 + wave; it < L0_ITEMS - L0_ADA_SHARE; it += 1024) cvt_l0_item(prm, it, scr, lane);
        } else {
            for (int it = gw; it < L0_ITEMS; it += NGW) cvt_l0_item(prm, it, scr, lane);
            for (int it = gw; it < DL_END; it += NGW) cvt_dl_item(prm, it, scr, lane);
            for (int it = vcu; it < 4 * 128; it += G) ada_item(prm, it >> 7, (it >> 4) & 7, it & 15, tid);
        }
        for (int idx = bx * 512 + tid; idx < 192 * 32; idx += G * 512) {
            const int pi = idx >> 5, f = idx & 31; const float pos = (float)(pi < 128 ? pi : pi - 128);
            const float ang = pos * powf(10000.0f, -(float)f / 32.0f);
            rope[idx] = (f32x2){cosf(ang), sinf(ang)};
        }
    }
    SEAM(0, 1);
    for (int nrep_ = 1 + REP(1), rep_ = 0; rep_ < nrep_; ++rep_) if (EN(1) && IN(1) && ((pt_cur_ = 1), true)) {
        SITE_COORDS;
        RowopArgs a; a.y = nullptr; a.xin_lat = INP(0); a.xin_ctx = INP(2); a.xout_lat = nullptr; a.xout_ctx = nullptr; a.xin16 = 0; a.xout16 = 0;     a.h = H; a.modacc = modacc; a.ada_b = INP(5); a.norm_g = INP(6);
        a.ly = -1; a.jg_y = 0; a.jgate = 0; a.lh = 0; a.jg_h = 0; a.jshift = 0; a.jscale = 1; a.nctx = NCTX; a.ypart = nullptr; a.nypart = 0; a.modf = nullptr;
        if (DEFER_CVT && G == 256) MODF_FINALIZE(0, 1); else MODF_FINALIZE(0, 4);
        ROWOP_RUN(a);
    }
    SEAM(1, 2);
    for (int layer = 0; layer < DEPTH; ++layer) {
        const int pb = 2 + 9 * layer, iab = layer >> 1;
        const bool even = (layer & 1) == 0, last = layer == DEPTH - 1;
        const int Mrows = last ? S : MTOK;
        if (even) {
            for (int nrep_ = 1 + REP(2), rep_ = 0; rep_ < nrep_; ++rep_) if (EN(2) && IN(pb + 0) && ((pt_cur_ = 2), true)) {
                SITE_COORDS;
                pg8::Gemm g{H, (const bf16_t*)(ws + WS_WABIN + iab * SZ_WABIN), MTOK, ABIN, D}; pg8::StaticOrder So; So.init(MTOK, ABIN, D, G, bx);
                EpiInProj E{P, rope};
                pg8::gemm_phase<EpiInProj, pg8::StaticOrder, PG8_ALIGN, PG8_SP2>(lds, g, So, E, tid);
                if (rep_ == 0) {     if (layer == 0) { DEFER_ADA(bx - 156, 0, 100); DEFER_SLOT(bx - 156, 100, 0, 6400); } else { DEFER_ADA(bx - 156, 268, 368); DEFER_SLOT(bx - 156, 100, 46784, 53184); } }
            }
            SEAM(pb + 0, pb + 1);
            for (int nrep_ = 1 + REP(3), rep_ = 0; rep_ < nrep_; ++rep_) if (EN(3) && IN(pb + 1) && ((pt_cur_ = 3), true)) {
                SITE_COORDS;
                if (rep_ == 0) { if (layer == 0) DEFER_SLOT(vcu - 16, 240, 6400, 12160); else DEFER_SLOT(vcu - 16, 240, 53184, 58944); }
                r1_phase_pipelined(P, KVT, lds, INP(9), iab, vcu, G, wave, lane);
                { const int cw0 = G == 256 ? (vcu - 16) * 8 + wave : gw, cwn = G == 256 ? 240 * 8 : NGW;
                  if (cw0 >= 0) for (int t = cw0; t < (MTOK / 8) * 2; t += cwn) conv_task(P, YAB, INP(8) + (size_t)iab * 3 * 1024, t, lane); }
            }
            SEAM(pb + 1, pb + 2);
            for (int nrep_ = 1 + REP(4), rep_ = 0; rep_ < nrep_; ++rep_) if (EN(4) && IN(pb + 2) && ((pt_cur_ = 4), true)) {
                SITE_COORDS;
                for (int it = vcu * 512 + tid; it < 131072; it += G * 512) r2_item((const bf16_t*)KVT, ST, INP(9), iab, it);
            }
            SEAM(pb + 2, pb + 3);
            for (int nrep_ = 1 + REP(5), rep_ = 0; rep_ < nrep_; ++rep_) if (EN(5) && IN(pb + 3) && ((pt_cur_ = 5), true)) {
                SITE_COORDS;
                if (rep_ == 0) { if (layer == 0) DEFER_SLOT(vcu - 16, 240, 12160, 19840); else DEFER_SLOT(vcu - 16, 240, 58944, 66624); }
                r3_phase_pipelined(P, ST, YAB, lds, INP(9), iab, vcu, G, wave, lane);
            }
            SEAM(pb + 3, pb + 4);
        } else {
            for (int nrep_ = 1 + REP(6), rep_ = 0; rep_ < nrep_; ++rep_) if (EN(6) && IN(pb + 0) && ((pt_cur_ = 6), true)) {
                SITE_COORDS;
                pg8::Gemm g{H, (const bf16_t*)(ws + WS_WQKV + iab * SZ_WQKV), MTOK, QKV, D}; pg8::StaticOrder So; So.init(MTOK, QKV, D, G, bx);
                EpiBf16 E{P, QKV};
                pg8::gemm_phase<EpiBf16, pg8::StaticOrder, PG8_ALIGN, PG8_SP2>(lds, g, So, E, tid);
                if (rep_ == 0) { if (layer == 1) DEFER_SLOT(bx - 24, 232, 25888, 40736); else DEFER_SLOT(bx - 24, 232, 72672, 87520); }
            }
            SEAM(pb + 0, pb + 1);
            for (int nrep_ = 1 + REP(7), rep_ = 0; rep_ < nrep_; ++rep_) if (EN(7) && IN(pb + 1) && ((pt_cur_ = 7), true)) {
                SITE_COORDS;
                const float* rpb = INP(12) + (size_t)iab * 16 * 15 * 31;
                for (int bt = vcu; bt < 512; bt += G) {
                    const int h = bt >> 5, rq = bt & 31;
                    na_block_task(P, YAB, rpb + h * 465, lds, h, 4 * rq, tid, wave, lane);
                }
                if (!last) for (int t = gw; t < 128; t += NGW) attn_task2<false>(P, YAB, rpb, t >> 3, S + 32 * (t & 7), S + 32 * (t & 7) + 16, 0, 0, 0, lane);
            }
            SEAM(pb + 1, pb + 4);
        }
        for (int nrep_ = 1 + REP(8), rep_ = 0; rep_ < nrep_; ++rep_) if (EN(8) && IN(pb + 4) && ((pt_cur_ = 8), true)) {
            SITE_COORDS;
            const bf16_t* wt = even ? (const bf16_t*)(ws + WS_WABOUT + iab * SZ_WSQ) : (const bf16_t*)(ws + WS_WNAOUT + iab * SZ_WSQ);
            pg8::Gemm g{YAB, wt, MTOK, D, D}; pg8::MixedOrder So; So.init(S, D, D, G, bx, 32, last ? 0 : NSPLIT_OUT);
            EpiY E{(bf16_t*)Y, D, (bf16_t*)YC};
            pg8::gemm_phase<EpiY, pg8::MixedOrder, PG8_ALIGN, PG8_SP2>(lds, g, So, E, tid);
        }
        SEAM(pb + 4, pb + 5);
        for (int nrep_ = 1 + REP(9), rep_ = 0; rep_ < nrep_; ++rep_) if (EN(9) && IN(pb + 5) && ((pt_cur_ = 9), true)) {
            SITE_COORDS;
            RowopArgs a; a.y = (const bf16_t*)Y; a.xin_lat = layer == 0 ? INP(0) : X; a.xin_ctx = layer == 0 ? INP(2) : (const float*)((const bf16_t*)X + (size_t)S * D); a.xout_lat = X; a.xout_ctx = (float*)((bf16_t*)X + (size_t)S * D); a.xin16 = layer == 0 ? 0 : 1; a.xout16 = 1;     a.h = H; a.modacc = modacc; a.ada_b = INP(5); a.norm_g = INP(6);
            a.ly = layer; a.jg_y = 1; a.jgate = 2; a.lh = layer; a.jg_h = 2; a.jshift = 3; a.jscale = 4; a.nctx = last ? 0 : NCTX; a.ypart = (const bf16_t*)YC; a.nypart = NSPLIT_OUT; a.modf = (const float*)(ws + WS_MODF);
            ROWOP_RUN(a);
        }
        SEAM(pb + 5, pb + 6);
        for (int nrep_ = 1 + REP(10), rep_ = 0; rep_ < nrep_; ++rep_) if (EN(10) && IN(pb + 6) && ((pt_cur_ = 10), true)) {
            SITE_COORDS;
            pg8::Gemm g{H, (const bf16_t*)(ws + WS_WFFIN + layer * SZ_WFFIN), Mrows, FF2, D}; pg8::StaticOrder So; So.init(Mrows, FF2, D, G, bx);
            EpiSwiglu E{HID};
            pg8::gemm_phase<EpiSwiglu, pg8::StaticOrder, PG8_ALIGN, PG8_SP2>(lds, g, So, E, tid);
            if (rep_ == 0) { if (layer == 0) { DEFER_ADA(bx - 172, 100, 184); DEFER_SLOT(bx - 172, 84, 19840, 25888); } else if (layer == 1) { DEFER_ADA(bx - 172, 184, 268); DEFER_SLOT(bx - 172, 84, 40736, 46784); } else if (layer == 2) { DEFER_ADA(bx - 172, 368, 384); DEFER_SLOT(bx - 172, 84, 66624, 72672); } else DEFER_SLOT(bx - 128, 128, 87520, DL_END); }
        }
        SEAM(pb + 6, pb + 7);
        for (int nrep_ = 1 + REP(11), rep_ = 0; rep_ < nrep_; ++rep_) if (EN(11) && IN(pb + 7) && ((pt_cur_ = 11), true)) {
            SITE_COORDS;
            if (rep_ == 0 && !last && DEFER_CVT && G == 256) MODF_FINALIZE(layer + 1, layer + 2);
            pg8::Gemm g{HID, (const bf16_t*)(ws + WS_WFFOUT + layer * SZ_WFFOUT), MTOK, D, FFH}; pg8::MixedOrder So; So.init(S, D, FFH, G, bx, 32, last ? 0 : NSPLIT_FFO);
            EpiY E{(bf16_t*)Y, D, (bf16_t*)YC};
            pg8::gemm_phase<EpiY, pg8::MixedOrder, PG8_ALIGN, PG8_SP2>(lds, g, So, E, tid);
        }
        SEAM(pb + 7, pb + 8);
        for (int nrep_ = 1 + REP(12), rep_ = 0; rep_ < nrep_; ++rep_) if (EN(12) && IN(pb + 8) && ((pt_cur_ = 12), true)) {
            SITE_COORDS;
            RowopArgs a; a.y = (const bf16_t*)Y; a.xin_lat = X; a.xin_ctx = (const float*)((const bf16_t*)X + (size_t)S * D); a.xout_lat = last ? (float*)(GAS float*)ldptr(prm, 16) : X; a.xout_ctx = last ? nullptr : (float*)((bf16_t*)X + (size_t)S * D); a.xin16 = 1; a.xout16 = last ? 0 : 1; a.h = H; a.modacc = modacc; a.ada_b = INP(5); a.norm_g = INP(6);
            a.ly = layer; a.jg_y = 3; a.jgate = 5; a.lh = last ? -1 : layer + 1; a.jg_h = 0; a.jshift = 0; a.jscale = 1; a.nctx = last ? 0 : NCTX; a.ypart = (const bf16_t*)YC; a.nypart = NSPLIT_FFO; a.modf = (const float*)(ws + WS_MODF);
            ROWOP_RUN(a);
        }
        if (!last) SEAM(pb + 8, pb + 9);
    }
    if (PT_SITE >= 0) { if (blockIdx.x == PT_BLOCK && threadIdx.x == 0) { const float us = (float)((double)pt_acc_ * 0.01); p.out[0] = 1000.0f * IDLE_Q * floorf(us / IDLE_Q + 0.5f); } }
    if (IDLE_PROBE) {
        unsigned long long* acc = (unsigned long long*)(p.ws + WS_CTL + 32768);
        if (threadIdx.x == 0) atomicAdd(acc, idle_acc_);
        xcd_barrier(bar);
        if (blockIdx.x == 0 && threadIdx.x == 0) { const unsigned long long tot = __hip_atomic_load(acc, __ATOMIC_RELAXED, __HIP_MEMORY_SCOPE_AGENT); const float us = (float)((double)tot / (double)G_k * 0.01); p.out[0] = 1000.0f * IDLE_Q * floorf(us / IDLE_Q + 0.5f); }
    }
#undef IN
#undef SEAM
}

extern "C" void kernel_launch(void* const* d_in, const int* in_sizes, int n_in, void* d_out, int out_size, void* d_ws, size_t ws_size, hipStream_t stream) {
    static int grid = 0;
    if (grid == 0) {
        if (n_in != 16 || out_size != S * D || ws_size < WS_END) { fprintf(stderr, "kernel_launch: unexpected shapes (n_in %d out %d ws %zu need %zu)\n", n_in, out_size, ws_size, (size_t)WS_END); grid = -1; return; }
        int dev = 0, cus = 0, per_cu = 0;
        if (hipGetDevice(&dev) != hipSuccess || hipDeviceGetAttribute(&cus, hipDeviceAttributeMultiprocessorCount, dev) != hipSuccess) { grid = -1; return; }
        if (hipFuncSetAttribute((const void*)mega_fwd, hipFuncAttributeMaxDynamicSharedMemorySize, LDS_BYTES) != hipSuccess) { fprintf(stderr, "kernel_launch: hipFuncSetAttribute failed\n"); grid = -1; return; }
        if (hipOccupancyMaxActiveBlocksPerMultiprocessor(&per_cu, (const void*)mega_fwd, 512, LDS_BYTES) != hipSuccess || per_cu < 1) fprintf(stderr, "kernel_launch: occupancy query says %d\n", per_cu);
        (void)hipGetLastError();
        grid = cus;
    }
    if (grid < 0) return;
    if (hipMemsetAsync((char*)d_ws + WS_CTL, 0, CTL_ZERO_BYTES, stream) != hipSuccess) { fprintf(stderr, "kernel_launch: memset failed\n"); return; }
    Params a{};
    for (int i = 0; i < 16; ++i) a.in[i] = (const float*)d_in[i];
    a.out = (float*)d_out; a.ws = (unsigned char*)d_ws; a.pad = 0;
#if MK_MODE == 1
    a.ph_lo = 0; a.ph_hi = NPHASE; a.li = 0;
    hipLaunchKernelGGL(mega_fwd, dim3(grid), dim3(512), LDS_BYTES, stream, a);
#else
    for (int ph = 0; ph < NPHASE; ++ph) {
        if (ph >= 2) { const int layer = (ph - 2) / 9, slot = (ph - 2) % 9; if ((layer & 1) && (slot == 2 || slot == 3)) continue; }
        a.ph_lo = ph; a.ph_hi = ph + 1; a.li = 0;
        hipLaunchKernelGGL(mega_fwd, dim3(grid), dim3(512), LDS_BYTES, stream, a);
    }
#endif
    const hipError_t le = hipPeekAtLastError();
    if (le != hipSuccess) fprintf(stderr, "kernel_launch: launch failed: %s\n", hipGetErrorName(le));
}
#endif
```

```cpp
#ifndef HOST_EMU
#include <hip/hip_runtime.h>
#include <cstdio>
#include <cstdint>
#define DEV __device__ __forceinline__
#define HDEV __host__ __device__ __forceinline__
#define LAS __attribute__((address_space(3)))
#define GAS __attribute__((address_space(1)))
#endif

typedef unsigned short bf16_t;
typedef short bf16x8 __attribute__((ext_vector_type(8)));
typedef float f32x4 __attribute__((ext_vector_type(4)));
typedef float f32x2 __attribute__((ext_vector_type(2)));
typedef unsigned u32x4 __attribute__((ext_vector_type(4)));
typedef unsigned u32x2 __attribute__((ext_vector_type(2)));

#ifndef HOST_EMU
#define SCHED_FENCE() __builtin_amdgcn_sched_barrier(0)
DEV f32x4 mfma16(bf16x8 a, bf16x8 b, f32x4 c) { return __builtin_amdgcn_mfma_f32_16x16x32_bf16(a, b, c, 0, 0, 0); }
DEV float shfl_xor_f(float v, int m) { return __shfl_xor(v, m); }
DEV unsigned cvt_pk_bf16(float lo, float hi) { unsigned r; asm("v_cvt_pk_bf16_f32 %0, %1, %2" : "=v"(r) : "v"(lo), "v"(hi)); return r; }
DEV float ex2(float x) { return __builtin_amdgcn_exp2f(x); }
DEV float rcp_f(float x) { return __builtin_amdgcn_rcpf(x); }
DEV float rsq_f(float x) { return 1.0f / sqrtf(x); }
DEV void atomic_add_f(float* p, float v) { (void)__hip_atomic_fetch_add(p, v, __ATOMIC_RELAXED, __HIP_MEMORY_SCOPE_AGENT); }
#endif

namespace cfg {
constexpr int D = 2048, S = 8192, NCTX = 256, MTOK = 8448, DEPTH = 4;
constexpr int ABIN = 7168, FFH = 5632, FF2 = 11264, QKV = 6144;
constexpr int NCHUNK = 66;
constexpr float EPS = 1e-6f;
constexpr float HSCALE = 0.08838834764831845f;
constexpr float LOG2E = 1.4426950408889634f;
}
using namespace cfg;

DEV float bf_lo(unsigned w) { return __builtin_bit_cast(float, w << 16); }
DEV float bf_hi(unsigned w) { return __builtin_bit_cast(float, w & 0xffff0000u); }
DEV float wave_sum(float v) {
#pragma unroll
    for (int o = 1; o < 64; o <<= 1) v += shfl_xor_f(v, o);
    return v;
}
DEV float silu_f(float x) { return x * rcp_f(1.0f + ex2(-x * LOG2E)); }
DEV float lg2gamma(const float* decay_exp, int iab, int dir, int head) {
    const float e = decay_exp[(iab * 2 + dir) * 8 + head];
    return log1pf(-exp2f(-e)) * LOG2E;
}
DEV bf16x8 extract8(const u32x4 (&vd)[8], int mt) {
    u32x4 w;
#pragma unroll
    for (int q = 0; q < 4; ++q) {
        const unsigned X = vd[2 * q][mt >> 1], Y = vd[2 * q + 1][mt >> 1];
        w[q] = (mt & 1) ? ((X >> 16) | (Y & 0xffff0000u)) : ((X & 0xffffu) | (Y << 16));
    }
    return __builtin_bit_cast(bf16x8, w);
}

struct RowopArgs {
    const bf16_t* y;
    const float* xin_lat; const float* xin_ctx;
    float* xout_lat; float* xout_ctx;
    bf16_t* h;
    const float* modacc; const float* ada_b; const float* norm_g;
    const float* modf;
    int ly, jg_y, jgate, lh, jg_h, jshift, jscale, nctx;
    int xin16, xout16;
    const bf16_t* ypart; int nypart;
};
DEV f32x4 ld4(const float* p) { return *(const f32x4*)p; }
constexpr int MODPART = 4 * 2 * 6 * 2048;
DEV f32x4 modvec_partials(const float* modacc, const float* ada_b, int l, int s, int j, int col) {
    const float* q = modacc + (size_t)((l * 2 + s) * 6 + j) * D + col;
    f32x4 r = ld4(ada_b + (size_t)l * 6 * D + j * D + col);
#pragma unroll
    for (int kp = 0; kp < 16; ++kp) r = r + ld4(q + (size_t)kp * MODPART);
    return r;
}
DEV f32x4 modvec(const RowopArgs& a, int l, int s, int j, int col) {
    if (a.modf) return ld4(a.modf + (size_t)((l * 2 + s) * 6 + j) * D + col);
    return modvec_partials(a.modacc, a.ada_b, l, s, j, col);
}
template <class CP>
DEV void rowop_coefs(const RowopArgs& a, const int s, CP coef, const int tid) {
    const int col = 4 * tid;
    f32x4 A = (f32x4){0.f, 0.f, 0.f, 0.f}, B = A, SH = A;
    if (a.ly >= 0) A = modvec(a, a.ly, s, a.jgate, col) * ld4(a.norm_g + (size_t)(a.ly * 4 + a.jg_y) * D + col);
    if (a.lh >= 0) { B = ld4(a.norm_g + (size_t)(a.lh * 4 + a.jg_h) * D + col) * (modvec(a, a.lh, s, a.jscale, col) + 1.0f); SH = modvec(a, a.lh, s, a.jshift, col); }
    *(f32x4*)(coef + col) = A; *(f32x4*)(coef + D + col) = B; *(f32x4*)(coef + 2 * D + col) = SH;
}
template <class CP>
DEV void rowop_row(const RowopArgs& a, const int s, CP coef, const int m, f32x4 (&x)[8], const f32x4 (&y)[8], const int lane) {
    const bool hasy = a.ly >= 0, hash = a.lh >= 0;
    if (hasy) {
        float ss = 0.f;
#pragma unroll
        for (int j = 0; j < 8; ++j) ss += (y[j][0] * y[j][0] + y[j][1] * y[j][1]) + (y[j][2] * y[j][2] + y[j][3] * y[j][3]);
        const float r1 = rsq_f(wave_sum(ss) * (1.0f / D) + EPS);
#pragma unroll
        for (int j = 0; j < 8; ++j) x[j] = x[j] + *(const f32x4*)(coef + 4 * lane + 256 * j) * (y[j] * r1);
    }
    float* xb = (s == 0) ? a.xout_lat : a.xout_ctx; const size_t xrow = (size_t)((s == 0) ? m : m - S) * D;
    if (xb) {
        if (a.xout16) { bf16_t* xo = (bf16_t*)xb + xrow;
#pragma unroll
            for (int j = 0; j < 8; ++j) { u32x2 w; w[0] = cvt_pk_bf16(x[j][0], x[j][1]); w[1] = cvt_pk_bf16(x[j][2], x[j][3]); __builtin_nontemporal_store(w, (u32x2*)(xo + 4 * lane + 256 * j)); }
        } else { float* xo = xb + xrow;
#pragma unroll
            for (int j = 0; j < 8; ++j) __builtin_nontemporal_store(x[j], (f32x4*)(xo + 4 * lane + 256 * j));
        }
    }
    if (hash) {
        float ss = 0.f;
#pragma unroll
        for (int j = 0; j < 8; ++j) ss += (x[j][0] * x[j][0] + x[j][1] * x[j][1]) + (x[j][2] * x[j][2] + x[j][3] * x[j][3]);
        const float r2 = rsq_f(wave_sum(ss) * (1.0f / D) + EPS);
        bf16_t* hr = a.h + (size_t)m * D;
#pragma unroll
        for (int j = 0; j < 8; ++j) { const f32x4 v = (x[j] * r2) * *(const f32x4*)(coef + D + 4 * lane + 256 * j) + *(const f32x4*)(coef + 2 * D + 4 * lane + 256 * j);
            u32x2 w; w[0] = cvt_pk_bf16(v[0], v[1]); w[1] = cvt_pk_bf16(v[2], v[3]); __builtin_nontemporal_store(w, (u32x2*)(hr + 4 * lane + 256 * j)); }
    }
}
template <class CP>
DEV void rowop_stream(const RowopArgs& a, CP coef, const int gw, const int NGW, const int lane) {
    for (int m = gw; m < S; m += NGW) {
        f32x4 x[8], y[8];
        if (a.xin16) { const bf16_t* xr = (const bf16_t*)a.xin_lat + (size_t)m * D;
#pragma unroll
            for (int j = 0; j < 8; ++j) { const u32x2 w = __builtin_nontemporal_load((const u32x2*)(xr + 4 * lane + 256 * j)); x[j] = (f32x4){bf_lo(w[0]), bf_hi(w[0]), bf_lo(w[1]), bf_hi(w[1])}; }
        } else { const float* xr = a.xin_lat + (size_t)m * D;
#pragma unroll
            for (int j = 0; j < 8; ++j) x[j] = ld4(xr + 4 * lane + 256 * j);
        }
#pragma unroll
        for (int j = 0; j < 8; ++j) y[j] = (f32x4){0.f, 0.f, 0.f, 0.f};
        if (a.ly >= 0) { const bf16_t* yr = a.y + (size_t)m * D;
#pragma unroll
            for (int j = 0; j < 8; ++j) { const u32x2 w = __builtin_nontemporal_load((const u32x2*)(yr + 4 * lane + 256 * j)); y[j] = (f32x4){bf_lo(w[0]), bf_hi(w[0]), bf_lo(w[1]), bf_hi(w[1])}; } }
        rowop_row(a, 0, coef, m, x, y, lane);
    }
}
#ifndef HOST_EMU
template <class CP, class LP>
DEV void rowop_ctx(const RowopArgs& a, CP coef, LP red, const int vcu, const int G, const int wave, const int lane) {
    const bool hasy = a.ly >= 0, hash = a.lh >= 0;
    for (int r = vcu; r < a.nctx; r += G) {
        const int col = 256 * wave + 4 * lane;
        f32x4 x;
        if (a.xin16) { const u32x2 w = *(const u32x2*)((const bf16_t*)a.xin_ctx + (size_t)r * D + col); x = (f32x4){bf_lo(w[0]), bf_hi(w[0]), bf_lo(w[1]), bf_hi(w[1])}; }
        else x = ld4(a.xin_ctx + (size_t)r * D + col);
        if (hasy) {
            const bf16_t* yp = a.ypart + (size_t)r * D + col;
            f32x4 y = (f32x4){0.f, 0.f, 0.f, 0.f};
#pragma unroll 11
            for (int pp = 0; pp < a.nypart; ++pp) { const u32x2 w = *(const u32x2*)(yp + (size_t)pp * 256 * D); y = y + (f32x4){bf_lo(w[0]), bf_hi(w[0]), bf_lo(w[1]), bf_hi(w[1])}; }
            const float ss = wave_sum((y[0] * y[0] + y[1] * y[1]) + (y[2] * y[2] + y[3] * y[3]));
            if (lane == 0) red[wave] = ss;
            __syncthreads();
            float tot = 0.f;
#pragma unroll
            for (int w8 = 0; w8 < 8; ++w8) tot += red[w8];
            const float r1 = rsq_f(tot * (1.0f / D) + EPS);
            x = x + *(const f32x4*)(coef + col) * (y * r1);
        }
        if (a.xout_ctx) { if (a.xout16) { u32x2 w; w[0] = cvt_pk_bf16(x[0], x[1]); w[1] = cvt_pk_bf16(x[2], x[3]); *(u32x2*)((bf16_t*)a.xout_ctx + (size_t)r * D + col) = w; } else *(f32x4*)(a.xout_ctx + (size_t)r * D + col) = x; }
        if (hash) {
            const float ss = wave_sum((x[0] * x[0] + x[1] * x[1]) + (x[2] * x[2] + x[3] * x[3]));
            if (lane == 0) red[16 + wave] = ss;
            __syncthreads();
            float tot = 0.f;
#pragma unroll
            for (int w8 = 0; w8 < 8; ++w8) tot += red[16 + w8];
            const float r2 = rsq_f(tot * (1.0f / D) + EPS);
            const f32x4 v = (x * r2) * *(const f32x4*)(coef + D + col) + *(const f32x4*)(coef + 2 * D + col);
            u32x2 w; w[0] = cvt_pk_bf16(v[0], v[1]); w[1] = cvt_pk_bf16(v[2], v[3]); *(u32x2*)(a.h + (size_t)(S + r) * D + col) = w;
        }
        __syncthreads();
    }
}
#endif

DEV void conv_loadz(const bf16_t* P, int t, int c, float (&z)[8]) {
    const u32x4 cg = *(const u32x4*)(P + (size_t)t * ABIN + 1024 + c), u = *(const u32x4*)(P + (size_t)t * ABIN + 2048 + c);
#pragma unroll
    for (int e = 0; e < 4; ++e) { z[2 * e] = bf_lo(cg[e]) * bf_lo(u[e]); z[2 * e + 1] = bf_hi(cg[e]) * bf_hi(u[e]); }
}
DEV void conv_task(const bf16_t* P, bf16_t* YAB, const float* convw, int task, int lane) {
    const int half = task & 1, t0 = (task >> 1) * 8, c = half * 512 + lane * 8;
    u32x4 cgv[10], uv[10], bgv[8];
#pragma unroll
    for (int k = 0; k < 10; ++k) {
        const int t = t0 - 1 + k;
        const bool ok = !((k == 0 && (t0 == 0 || t0 == S)) || (k == 9 && (t0 + 8 == S || t0 + 8 == MTOK)));
        const int tt = ok ? t : t0;
        cgv[k] = *(const u32x4*)(P + (size_t)tt * ABIN + 1024 + c); uv[k] = *(const u32x4*)(P + (size_t)tt * ABIN + 2048 + c);
        if (!ok) { cgv[k] = (u32x4){0u, 0u, 0u, 0u}; }
    }
#pragma unroll
    for (int k = 0; k < 8; ++k) bgv[k] = *(const u32x4*)(P + (size_t)(t0 + k) * ABIN + c);
    float w0[8], w1[8], w2[8];
#pragma unroll
    for (int e = 0; e < 8; ++e) { w0[e] = convw[c + e]; w1[e] = convw[1024 + c + e]; w2[e] = convw[2048 + c + e]; }
#pragma unroll
    for (int k = 0; k < 8; ++k) {
        float o[8];
#pragma unroll
        for (int e = 0; e < 8; ++e) {
            const int d = e >> 1;
            const float zp = (e & 1) ? bf_hi(cgv[k][d]) * bf_hi(uv[k][d]) : bf_lo(cgv[k][d]) * bf_lo(uv[k][d]);
            const float zc = (e & 1) ? bf_hi(cgv[k + 1][d]) * bf_hi(uv[k + 1][d]) : bf_lo(cgv[k + 1][d]) * bf_lo(uv[k + 1][d]);
            const float zn = (e & 1) ? bf_hi(cgv[k + 2][d]) * bf_hi(uv[k + 2][d]) : bf_lo(cgv[k + 2][d]) * bf_lo(uv[k + 2][d]);
            const float b = (e & 1) ? bf_hi(bgv[k][d]) : bf_lo(bgv[k][d]);
            o[e] = b * (w0[e] * zp + w1[e] * zc + w2[e] * zn);
        }
        u32x4 w; w[0] = cvt_pk_bf16(o[0], o[1]); w[1] = cvt_pk_bf16(o[2], o[3]); w[2] = cvt_pk_bf16(o[4], o[5]); w[3] = cvt_pk_bf16(o[6], o[7]);
        *(u32x4*)(YAB + (size_t)(t0 + k) * D + c) = w;
    }
}

DEV int chunk_row(int cidx) { return cidx < 2 ? S + 128 * cidx : 128 * (cidx - 2); }
DEV void r1_task(const bf16_t* P, float* KVt, float lg2, int cidx, int head, int dir, int quad, int lane) {
    const int i = lane & 15, g = lane >> 4;
    const int dk0 = 64 * (quad >> 1), dv0 = 64 * (quad & 1);
    const bf16_t* Kp = P + (size_t)chunk_row(cidx) * ABIN + 4096 + head * 128 + dk0 + 4 * i;
    const bf16_t* Vp = P + (size_t)chunk_row(cidx) * ABIN + 5120 + head * 128 + dv0 + 4 * i;
    f32x4 acc[4][4];
#pragma unroll
    for (int a = 0; a < 4; ++a)
#pragma unroll
        for (int b = 0; b < 4; ++b) acc[a][b] = (f32x4){0.f, 0.f, 0.f, 0.f};
#pragma unroll 1
    for (int s = 0; s < 4; ++s) {
        u32x2 kd[8], vd[8]; float w[8];
#pragma unroll
        for (int jj = 0; jj < 8; ++jj) {
            const int tj = 32 * s + 8 * g + jj;
            kd[jj] = *(const u32x2*)(Kp + (size_t)tj * ABIN); vd[jj] = *(const u32x2*)(Vp + (size_t)tj * ABIN);
            w[jj] = ex2(lg2 * (float)(dir == 0 ? 127 - tj : tj));
        }
        bf16x8 af[4], bfr[4];
#pragma unroll
        for (int mt = 0; mt < 4; ++mt) {
            u32x4 wd;
#pragma unroll
            for (int q = 0; q < 4; ++q) {
                const unsigned X = kd[2 * q][mt >> 1], Y = kd[2 * q + 1][mt >> 1];
                const float lo = ((mt & 1) ? bf_hi(X) : bf_lo(X)) * w[2 * q], hi = ((mt & 1) ? bf_hi(Y) : bf_lo(Y)) * w[2 * q + 1];
                wd[q] = cvt_pk_bf16(lo, hi);
            }
            af[mt] = __builtin_bit_cast(bf16x8, wd);
        }
#pragma unroll
        for (int nt = 0; nt < 4; ++nt) {
            u32x4 wd;
#pragma unroll
            for (int q = 0; q < 4; ++q) {
                const unsigned X = vd[2 * q][nt >> 1], Y = vd[2 * q + 1][nt >> 1];
                wd[q] = (nt & 1) ? ((X >> 16) | (Y & 0xffff0000u)) : ((X & 0xffffu) | (Y << 16));
            }
            bfr[nt] = __builtin_bit_cast(bf16x8, wd);
        }
#pragma unroll
        for (int mt = 0; mt < 4; ++mt)
#pragma unroll
            for (int nt = 0; nt < 4; ++nt) acc[mt][nt] = mfma16(af[mt], bfr[nt], acc[mt][nt]);
    }
    float* out = KVt + ((((size_t)cidx * 8 + head) * 2 + dir) * 128) * 128;
#pragma unroll
    for (int nt = 0; nt < 4; ++nt)
#pragma unroll
        for (int reg = 0; reg < 4; ++reg) {
            const int dv = dv0 + 4 * i + nt, dk = dk0 + 16 * g + 4 * reg;
            *(f32x4*)(out + (size_t)dv * 128 + dk) = (f32x4){acc[0][nt][reg], acc[1][nt][reg], acc[2][nt][reg], acc[3][nt][reg]};
        }
}
DEV void r2_item(const bf16_t* KVt, bf16_t* St, const float* decay_exp, int iab, int item) {
    const int hd = __builtin_amdgcn_readfirstlane(item >> 13), e = (item & 8191) * 2, head = hd >> 1, dir = hd & 1;
    const float cd = exp2f(128.0f * lg2gamma(decay_exp, iab, dir, head));
    float s0 = 0.f, s1 = 0.f;
    unsigned kv[66];
#pragma unroll
    for (int k = 0; k < 66; ++k) { const int c = dir == 0 ? k : (k < 2 ? 1 - k : 67 - k); kv[k] = *(const unsigned*)(KVt + (((size_t)c * 8 + head) * 2 + dir) * 16384 + e); }
#pragma unroll
    for (int k = 0; k < 66; ++k) { const int c = dir == 0 ? k : (k < 2 ? 1 - k : 67 - k);
        *(unsigned*)(St + (((size_t)c * 8 + head) * 2 + dir) * 16384 + e) = cvt_pk_bf16(s0, s1);
        s0 = s0 * cd + bf_lo(kv[k]); s1 = s1 * cd + bf_hi(kv[k]); }
}
DEV void r3_task(const bf16_t* P, const bf16_t* St, bf16_t* YAB, float lg2f, float lg2b, int cidx, int head, int qb, int lane) {
    const int i = lane & 15, g = lane >> 4, qi = 16 * qb + i, rowbase = chunk_row(cidx);
    const bf16_t* Prow = P + (size_t)rowbase * ABIN;
    bf16x8 qf[4];
#pragma unroll
    for (int s = 0; s < 4; ++s) qf[s] = *(const bf16x8*)(Prow + (size_t)qi * ABIN + 3072 + head * 128 + 32 * s + 8 * g);
    f32x4 sacc[8];
#pragma unroll
    for (int mt = 0; mt < 8; ++mt) {
        f32x4 a = (f32x4){0.f, 0.f, 0.f, 0.f};
#pragma unroll
        for (int s = 0; s < 4; ++s) { const bf16x8 kf = *(const bf16x8*)(Prow + (size_t)(16 * mt + i) * ABIN + 4096 + head * 128 + 32 * s + 8 * g); a = mfma16(kf, qf[s], a); }
        sacc[mt] = a;
    }
#pragma unroll
    for (int mt = 0; mt < 8; ++mt)
#pragma unroll
        for (int reg = 0; reg < 4; ++reg) {
            const int diff = qi - (16 * mt + 4 * g + reg);
            const float d = diff > 0 ? ex2((float)diff * lg2f) : (diff < 0 ? ex2((float)(-diff) * lg2b) : 2.0f);
            sacc[mt][reg] *= d;
        }
    bf16x8 pf[4];
#pragma unroll
    for (int s = 0; s < 4; ++s) {
        u32x4 w; w[0] = cvt_pk_bf16(sacc[2 * s][0], sacc[2 * s][1]); w[1] = cvt_pk_bf16(sacc[2 * s][2], sacc[2 * s][3]);
        w[2] = cvt_pk_bf16(sacc[2 * s + 1][0], sacc[2 * s + 1][1]); w[3] = cvt_pk_bf16(sacc[2 * s + 1][2], sacc[2 * s + 1][3]);
        pf[s] = __builtin_bit_cast(bf16x8, w);
    }
    f32x4 oacc[8];
#pragma unroll
    for (int mt = 0; mt < 8; ++mt) oacc[mt] = (f32x4){0.f, 0.f, 0.f, 0.f};
#pragma unroll
    for (int s = 0; s < 4; ++s) {
        u32x4 vd[8];
#pragma unroll
        for (int jj = 0; jj < 8; ++jj) { const int key = 32 * s + (jj < 4 ? 4 * g + jj : 16 + 4 * g + jj - 4); vd[jj] = *(const u32x4*)(Prow + (size_t)key * ABIN + 5120 + head * 128 + 8 * i); }
#pragma unroll
        for (int mt = 0; mt < 8; ++mt) oacc[mt] = mfma16(extract8(vd, mt), pf[s], oacc[mt]);
    }
#pragma unroll
    for (int dir = 0; dir < 2; ++dir) {
        f32x4 tacc[8];
#pragma unroll
        for (int mt = 0; mt < 8; ++mt) tacc[mt] = (f32x4){0.f, 0.f, 0.f, 0.f};
        const bf16_t* Sp = St + ((((size_t)cidx * 8 + head) * 2 + dir) * 128) * 128;
#pragma unroll
        for (int s = 0; s < 4; ++s)
#pragma unroll
            for (int mt = 0; mt < 8; ++mt) { const bf16x8 sf = *(const bf16x8*)(Sp + (size_t)(8 * i + mt) * 128 + 32 * s + 8 * g); tacc[mt] = mfma16(sf, qf[s], tacc[mt]); }
        const float qd = dir == 0 ? ex2((float)(qi + 1) * lg2f) : ex2((float)(128 - qi) * lg2b);
#pragma unroll
        for (int mt = 0; mt < 8; ++mt) oacc[mt] = oacc[mt] + tacc[mt] * qd;
    }
    float ss = 0.f;
#pragma unroll
    for (int mt = 0; mt < 8; ++mt) ss += (oacc[mt][0] * oacc[mt][0] + oacc[mt][1] * oacc[mt][1]) + (oacc[mt][2] * oacc[mt][2] + oacc[mt][3] * oacc[mt][3]);
    ss += shfl_xor_f(ss, 16); ss += shfl_xor_f(ss, 32);
    const float rinv = rsq_f(ss * (1.0f / 128.0f) + EPS);
#pragma unroll
    for (int reg = 0; reg < 4; ++reg) {
        const int dvb = 32 * g + 8 * reg;
        const u32x4 gt = *(const u32x4*)(Prow + (size_t)qi * ABIN + 6144 + head * 128 + dvb);
        float o[8];
#pragma unroll
        for (int mt = 0; mt < 8; ++mt) { const float gv = (mt & 1) ? bf_hi(gt[mt >> 1]) : bf_lo(gt[mt >> 1]); o[mt] = silu_f(gv) * (oacc[mt][reg] * rinv); }
        u32x4 w; w[0] = cvt_pk_bf16(o[0], o[1]); w[1] = cvt_pk_bf16(o[2], o[3]); w[2] = cvt_pk_bf16(o[4], o[5]); w[3] = cvt_pk_bf16(o[6], o[7]);
        *(u32x4*)(YAB + (size_t)(rowbase + qi) * D + 1024 + head * 128 + dvb) = w;
    }
}

struct AttnTile { bf16x8 qf[4]; f32x4 oacc[8]; float m_run, l_run; };
DEV void attn_tile_init(AttnTile& t, const bf16_t* P, int qtok, int h, int g) {
#pragma unroll
    for (int s = 0; s < 4; ++s) t.qf[s] = *(const bf16x8*)(P + (size_t)qtok * QKV + h * 128 + 32 * s + 8 * g);
#pragma unroll
    for (int mt = 0; mt < 8; ++mt) t.oacc[mt] = (f32x4){0.f, 0.f, 0.f, 0.f};
    t.m_run = -5e29f; t.l_run = 0.f;
}
template <class RP>
DEV void attn_tile_step(AttnTile& t, f32x4 (&sa)[2], const u32x4 (&vd)[8], const bool win, const bool rowok, RP rpbrow, const int kc0, const int c, const int sc, const int g) {
    float bm = -1e30f;
#pragma unroll
    for (int mt = 0; mt < 2; ++mt)
#pragma unroll
        for (int reg = 0; reg < 4; ++reg) {
            float v = sa[mt][reg] * HSCALE;
            if (win) {
                const int kcol = kc0 + 16 * mt + 4 * g + reg;
                const bool valid = rowok && kcol >= sc && kcol < sc + 16;
                const float bias = rpbrow[valid ? kcol - c + 15 : 0];
                v = valid ? v + bias : -1e30f;
            }
            sa[mt][reg] = v; bm = fmaxf(bm, v);
        }
    bm = fmaxf(bm, shfl_xor_f(bm, 16)); bm = fmaxf(bm, shfl_xor_f(bm, 32));
    const float m_new = fmaxf(t.m_run, bm);
    const float alpha = ex2((t.m_run - m_new) * LOG2E);
    t.m_run = m_new;
    float ps = 0.f;
#pragma unroll
    for (int mt = 0; mt < 2; ++mt)
#pragma unroll
        for (int reg = 0; reg < 4; ++reg) { const float pv = ex2((sa[mt][reg] - m_new) * LOG2E); sa[mt][reg] = pv; ps += pv; }
    t.l_run = t.l_run * alpha + ps;
#pragma unroll
    for (int mt = 0; mt < 8; ++mt) t.oacc[mt] = t.oacc[mt] * alpha;
    u32x4 pw; pw[0] = cvt_pk_bf16(sa[0][0], sa[0][1]); pw[1] = cvt_pk_bf16(sa[0][2], sa[0][3]); pw[2] = cvt_pk_bf16(sa[1][0], sa[1][1]); pw[3] = cvt_pk_bf16(sa[1][2], sa[1][3]);
    const bf16x8 pf = __builtin_bit_cast(bf16x8, pw);
#pragma unroll
    for (int mt = 0; mt < 8; ++mt) t.oacc[mt] = mfma16(extract8(vd, mt), pf, t.oacc[mt]);
}
template <class RP>
DEV bf16x8 attn_tile_soft(AttnTile& t, f32x4 (&sa)[2], const bool win, const bool rowok, RP rpbrow, const int kc0, const int c, const int sc, const int g) {
    float bm = -1e30f;
#pragma unroll
    for (int mt = 0; mt < 2; ++mt)
#pragma unroll
        for (int reg = 0; reg < 4; ++reg) {
            float v = sa[mt][reg] * HSCALE;
            if (win) {
                const int kcol = kc0 + 16 * mt + 4 * g + reg;
                const bool valid = rowok && kcol >= sc && kcol < sc + 16;
                const float bias = rpbrow[valid ? kcol - c + 15 : 0];
                v = valid ? v + bias : -1e30f;
            }
            sa[mt][reg] = v; bm = fmaxf(bm, v);
        }
    bm = fmaxf(bm, shfl_xor_f(bm, 16)); bm = fmaxf(bm, shfl_xor_f(bm, 32));
    const float m_new = fmaxf(t.m_run, bm);
    const float alpha = ex2((t.m_run - m_new) * LOG2E);
    t.m_run = m_new;
    float ps = 0.f;
#pragma unroll
    for (int mt = 0; mt < 2; ++mt)
#pragma unroll
        for (int reg = 0; reg < 4; ++reg) { const float pv = ex2((sa[mt][reg] - m_new) * LOG2E); sa[mt][reg] = pv; ps += pv; }
    t.l_run = t.l_run * alpha + ps;
#pragma unroll
    for (int mt = 0; mt < 8; ++mt) t.oacc[mt] = t.oacc[mt] * alpha;
    u32x4 pw; pw[0] = cvt_pk_bf16(sa[0][0], sa[0][1]); pw[1] = cvt_pk_bf16(sa[0][2], sa[0][3]); pw[2] = cvt_pk_bf16(sa[1][0], sa[1][1]); pw[3] = cvt_pk_bf16(sa[1][2], sa[1][3]);
    return __builtin_bit_cast(bf16x8, pw);
}
DEV void attn_tile_store(AttnTile& t, bf16_t* YAB, int qtok, int h, int g) {
    float l = t.l_run; l += shfl_xor_f(l, 16); l += shfl_xor_f(l, 32);
    const float inv = 1.0f / l;
#pragma unroll
    for (int reg = 0; reg < 4; ++reg) {
        const int dvb = 32 * g + 8 * reg;
        u32x4 w;
#pragma unroll
        for (int q = 0; q < 4; ++q) w[q] = cvt_pk_bf16(t.oacc[2 * q][reg] * inv, t.oacc[2 * q + 1][reg] * inv);
        *(u32x4*)(YAB + (size_t)qtok * D + h * 128 + dvb) = w;
    }
}
DEV void attn_scores2(const bf16_t* P, int kb, int h, int i, int g, const AttnTile& ta, const AttnTile& tb, const bool doA, const bool doB, f32x4 (&saA)[2], f32x4 (&saB)[2], u32x4 (&vd)[8]) {
#pragma unroll
    for (int jj = 0; jj < 8; ++jj) { const int key = kb + (jj < 4 ? 4 * g + jj : 16 + 4 * g + jj - 4); vd[jj] = *(const u32x4*)(P + (size_t)key * QKV + 4096 + h * 128 + 8 * i); }
#pragma unroll
    for (int mt = 0; mt < 2; ++mt) {
        bf16x8 kf[4];
#pragma unroll
        for (int s = 0; s < 4; ++s) kf[s] = *(const bf16x8*)(P + (size_t)(kb + 16 * mt + i) * QKV + 2048 + h * 128 + 32 * s + 8 * g);
        f32x4 a = (f32x4){0.f, 0.f, 0.f, 0.f}, b = a;
        if (doA) {
#pragma unroll
            for (int s = 0; s < 4; ++s) a = mfma16(kf[s], ta.qf[s], a);
        }
        if (doB) {
#pragma unroll
            for (int s = 0; s < 4; ++s) b = mfma16(kf[s], tb.qf[s], b);
        }
        saA[mt] = a; saB[mt] = b;
        SCHED_FENCE();
    }
}
template <bool WIN>
DEV void attn_task2(const bf16_t* P, bf16_t* YAB, const float* rpb, int h, int qtokA0, int qtokB0, int rA, int c0, int kc0, int lane) {
    const int i = lane & 15, g = lane >> 4;
    AttnTile ta, tb;
    attn_tile_init(ta, P, qtokA0 + i, h, g); attn_tile_init(tb, P, qtokB0 + i, h, g);
    const int c = c0 + i, sc = c - 8 < 0 ? 0 : (c - 8 > 48 ? 48 : c - 8);
    if (WIN) {
        const int rB = rA + 1;
        const int srA = rA - 4 < 0 ? 0 : (rA - 4 > 120 ? 120 : rA - 4), srB = rB - 4 < 0 ? 0 : (rB - 4 > 120 ? 120 : rB - 4);
        for (int kr = srA; kr < srB + 8; ++kr) {
            f32x4 saA[2], saB[2]; u32x4 vd[8];
            const bool doA = kr < srA + 8, doB = kr >= srB;
            attn_scores2(P, kr * 64 + kc0, h, i, g, ta, tb, doA, doB, saA, saB, vd);
            if (doA) attn_tile_step(ta, saA, vd, true, true, rpb + (h * 15 + (kr - rA + 7)) * 31, kc0, c, sc, g);
            if (doB) attn_tile_step(tb, saB, vd, true, true, rpb + (h * 15 + (kr - rB + 7)) * 31, kc0, c, sc, g);
        }
    }
    for (int b = 0; b < 8; ++b) {
        f32x4 saA[2], saB[2]; u32x4 vd[8];
        attn_scores2(P, S + 32 * b, h, i, g, ta, tb, true, true, saA, saB, vd);
        attn_tile_step(ta, saA, vd, false, true, rpb, 0, 0, 0, g);
        attn_tile_step(tb, saB, vd, false, true, rpb, 0, 0, 0, g);
    }
    attn_tile_store(ta, YAB, qtokA0 + i, h, g); attn_tile_store(tb, YAB, qtokB0 + i, h, g);
}

struct Unit { int pm, pn, ks, nt, kofs; };
struct EpiY {
    static constexpr bool PERM = true, AFTER_DRAIN = false;
    bf16_t* Yb; int ldc; bf16_t* Cpart;
    DEV void operator()(const f32x4 (&acc)[2][2][4][2], const Unit& u, int wr, int wc, int fr, int fq) const {
        bf16_t* base = u.ks >= 0 ? Cpart + (size_t)u.ks * 256 * ldc : Yb + (size_t)u.pm * 256 * ldc;
        base += (size_t)(wr * 64 + fr) * ldc + u.pn * 256 + wc * 32 + 8 * fq;
#pragma unroll
        for (int ai = 0; ai < 2; ++ai)
#pragma unroll
            for (int m = 0; m < 4; ++m) { bf16_t* rowp = base + (size_t)(ai * 128 + m * 16) * ldc;
#pragma unroll
                for (int bj = 0; bj < 2; ++bj) { const f32x4 v0 = acc[ai][bj][m][0], v1 = acc[ai][bj][m][1];
                    u32x4 w; w[0] = cvt_pk_bf16(v0[0], v0[1]); w[1] = cvt_pk_bf16(v0[2], v0[3]); w[2] = cvt_pk_bf16(v1[0], v1[1]); w[3] = cvt_pk_bf16(v1[2], v1[3]);
                    *(u32x4*)(rowp + bj * 128) = w; } }
    }
};
struct EpiBf16 {
    static constexpr bool PERM = true, AFTER_DRAIN = false;
    bf16_t* O; int ldc;
    DEV void operator()(const f32x4 (&acc)[2][2][4][2], const Unit& u, int wr, int wc, int fr, int fq) const {
        const int row0 = u.pm * 256 + wr * 64 + fr, col0 = u.pn * 256 + wc * 32 + 8 * fq;
#pragma unroll
        for (int ai = 0; ai < 2; ++ai)
#pragma unroll
            for (int m = 0; m < 4; ++m) { bf16_t* rowp = O + (size_t)(row0 + ai * 128 + m * 16) * ldc + col0;
#pragma unroll
                for (int bj = 0; bj < 2; ++bj) { const f32x4 v0 = acc[ai][bj][m][0], v1 = acc[ai][bj][m][1];
                    u32x4 w; w[0] = cvt_pk_bf16(v0[0], v0[1]); w[1] = cvt_pk_bf16(v0[2], v0[3]); w[2] = cvt_pk_bf16(v1[0], v1[1]); w[3] = cvt_pk_bf16(v1[2], v1[3]);
                    *(u32x4*)(rowp + bj * 128) = w; } }
    }
};
struct EpiInProj {
    static constexpr bool PERM = true, AFTER_DRAIN = false;
    bf16_t* O; const f32x2* rope;
    DEV void operator()(const f32x4 (&acc)[2][2][4][2], const Unit& u, int wr, int wc, int fr, int fq) const {
        const int row0 = u.pm * 256 + wr * 64 + fr, col0 = u.pn * 256 + wc * 32 + 8 * fq;
        const bool isk = u.pn >= 16 && u.pn < 20, isq = u.pn >= 12 && u.pn < 16, dorope = (isq || isk) && u.pm < 32;
        const float sc = isk ? HSCALE : 1.0f;
#pragma unroll
        for (int ai = 0; ai < 2; ++ai)
#pragma unroll
            for (int m = 0; m < 4; ++m) { const int row = row0 + ai * 128 + m * 16; bf16_t* rowp = O + (size_t)row * ABIN + col0;
                f32x4 cs01 = (f32x4){1.f, 0.f, 1.f, 0.f}, cs23 = cs01, cs45 = cs01, cs67 = cs01;
                if (dorope) { const int pidx = (wc < 2) ? (row >> 6) : 128 + (row & 63); const f32x2* tp = rope + pidx * 32 + 16 * (wc & 1) + 4 * fq;
                    const f32x4 t0 = *(const f32x4*)tp, t1 = *(const f32x4*)(tp + 2); cs01 = t0; cs23 = t0; cs45 = t1; cs67 = t1; }
#pragma unroll
                for (int bj = 0; bj < 2; ++bj) { f32x4 v0 = acc[ai][bj][m][0], v1 = acc[ai][bj][m][1];
                    if (dorope) {
                        const f32x4 a0 = v0, a1 = v1;
                        v0[0] = a0[0] * cs01[0] - a0[1] * cs01[1]; v0[1] = a0[0] * cs01[1] + a0[1] * cs01[0];
                        v0[2] = a0[2] * cs23[2] - a0[3] * cs23[3]; v0[3] = a0[2] * cs23[3] + a0[3] * cs23[2];
                        v1[0] = a1[0] * cs45[0] - a1[1] * cs45[1]; v1[1] = a1[0] * cs45[1] + a1[1] * cs45[0];
                        v1[2] = a1[2] * cs67[2] - a1[3] * cs67[3]; v1[3] = a1[2] * cs67[3] + a1[3] * cs67[2];
                    }
                    v0 = v0 * sc; v1 = v1 * sc;
                    u32x4 w; w[0] = cvt_pk_bf16(v0[0], v0[1]); w[1] = cvt_pk_bf16(v0[2], v0[3]); w[2] = cvt_pk_bf16(v1[0], v1[1]); w[3] = cvt_pk_bf16(v1[2], v1[3]);
                    *(u32x4*)(rowp + bj * 128) = w; } }
    }
};
struct EpiSwiglu {
    static constexpr bool PERM = true, AFTER_DRAIN = false;
    bf16_t* O;
    DEV void operator()(const f32x4 (&acc)[2][2][4][2], const Unit& u, int wr, int wc, int fr, int fq) const {
        const int row0 = u.pm * 256 + wr * 64 + fr, col0 = u.pn * 128 + wc * 32 + 8 * fq;
#pragma unroll
        for (int ai = 0; ai < 2; ++ai)
#pragma unroll
            for (int m = 0; m < 4; ++m) { bf16_t* rowp = O + (size_t)(row0 + ai * 128 + m * 16) * FFH + col0;
                const f32x4 g0 = acc[ai][0][m][0], g1 = acc[ai][0][m][1], u0 = acc[ai][1][m][0], u1 = acc[ai][1][m][1];
                u32x4 w; w[0] = cvt_pk_bf16(silu_f(g0[0]) * u0[0], silu_f(g0[1]) * u0[1]); w[1] = cvt_pk_bf16(silu_f(g0[2]) * u0[2], silu_f(g0[3]) * u0[3]);
                w[2] = cvt_pk_bf16(silu_f(g1[0]) * u1[0], silu_f(g1[1]) * u1[1]); w[3] = cvt_pk_bf16(silu_f(g1[2]) * u1[2], silu_f(g1[3]) * u1[3]);
                *(u32x4*)rowp = w; }
    }
};

#ifndef HOST_EMU
namespace pg8 {
#define PG8_LAS __attribute__((address_space(3)))
constexpr int BM = 256, BK = 64, HALF = 128, HTB = HALF * BK * 2, STAGE_BYTES = 8 * HTB, NXCD = 8, WGM = 8;
__host__ __device__ __forceinline__ int lds_byte(int r, int c) { const int st = (r >> 4) * 2 + (c >> 5), rr = r & 15, cc = c & 31, ob = rr * 64 + cc * 2; return st * 1024 + (ob ^ (((ob >> 9) & 1) << 5)); }
__host__ __device__ __forceinline__ void stage_rc(int b, int& R, int& C) { const int st = b / 1024, sb = b % 1024, swz = sb ^ (((sb >> 9) & 1) << 5); R = (st >> 1) * 16 + swz / 64; C = (st & 1) * 32 + (swz % 64) / 2; }
__host__ __device__ __forceinline__ int perm32(int rho) { const int n = rho >> 4, i = rho & 15; return 8 * (i >> 2) + 4 * n + (i & 3); }
struct Gemm { const bf16_t* A; const bf16_t* Bt; int M, N, K; };
struct StaticOrder {
    int nM, nN, nwg, G, c, ntK;
    __host__ __device__ __forceinline__ void init(int M, int N, int K, int G_, int c_) { nM = M / BM; nN = N / BM; nwg = nM * nN; G = G_; c = c_; ntK = K / BK; }
    __host__ __device__ __forceinline__ void map(int wgid, Unit& u) const {
        { const int q = nwg / NXCD, r = nwg % NXCD, xcd = wgid % NXCD, off = wgid / NXCD; wgid = (xcd < r ? xcd * (q + 1) : r * (q + 1) + (xcd - r) * q) + off; }
        const int nig = WGM * nN, gid = wgid / nig, fm = gid * WGM, gsz = (nM - fm) < WGM ? (nM - fm) : WGM;
        u.pm = fm + ((wgid % nig) % gsz); u.pn = (wgid % nig) / gsz; u.ks = -1; u.nt = ntK; u.kofs = 0;
    }
    __host__ __device__ __forceinline__ bool next(int i, Unit& u) const { const long L = (long)i * G + c; if (L >= nwg) return false; map((int)L, u); return true; }
    __device__ __forceinline__ void a_ready(const Unit&) const {}
    __device__ __forceinline__ void done(const Unit&) const {}
};
struct MixedOrder {
    StaticOrder base; int nsplit, pmx, ntS, nNx;
    __host__ __device__ __forceinline__ void init(int M, int N, int K, int G_, int c_, int pmx_, int nsplit_) { base.init(M, N, K, G_, c_); pmx = pmx_; nsplit = nsplit_; ntS = nsplit_ ? (K / BK) / nsplit_ : 0; nNx = N / BM; }
    __host__ __device__ __forceinline__ bool next(int i, Unit& u) const {
        const long L = (long)i * base.G + base.c;
        if (L < base.nwg) { base.map((int)L, u); return true; }
        const long L2 = L - base.nwg; if (L2 >= (long)nsplit * nNx) return false;
        u.pm = pmx; u.pn = (int)(L2 % nNx); u.ks = (int)(L2 / nNx); u.nt = ntS; u.kofs = u.ks * ntS * BK * 2; return true;
    }
    __device__ __forceinline__ void a_ready(const Unit&) const {}
    __device__ __forceinline__ void done(const Unit&) const {}
};
template <class Epi, class Sched, bool ALIGN_EPI = false, bool SP2 = false>
__device__ __forceinline__ void gemm_phase(PG8_LAS unsigned char* lds, const Gemm g, const Sched& S, const Epi& E, const int tid) {
    const int wid = __builtin_amdgcn_readfirstlane(tid >> 6), lane = tid & 63, wr = wid >> 2, wc = wid & 3, fr = lane & 15, fq = lane >> 4;
    const int K = g.K;
    unsigned voffA[2], voffB[2];
#pragma unroll
    for (int i = 0; i < 2; ++i) { int R, C; stage_rc(tid * 16 + i * 8192, R, C); const int Rb = Epi::PERM ? ((R & ~31) + perm32(R & 31)) : R;
        voffA[i] = (unsigned)(R * K + C) * 2u; voffB[i] = (unsigned)(Rb * K + C) * 2u; }
    const size_t kstep = (size_t)(BK * 2);
    const size_t hstep = (size_t)HALF * K * 2;
    const size_t tstep = 2 * hstep;
    const unsigned ldsw = (unsigned)wid * 1024u;
    const int aoff = lds_byte(wr * 64 + fr, fq * 8), boff = lds_byte(wc * 32 + fr, fq * 8);
#define PG8_SA(b, h) (((b) * 2 + (h)) * HTB)
#define PG8_SB(b, h) ((4 + (b) * 2 + (h)) * HTB)
#define PG8_STAGE(bufoff, gbase, voff) do { _Pragma("unroll") for (int _i = 0; _i < 2; ++_i) \
        __builtin_amdgcn_global_load_lds((const unsigned*)((const char*)(gbase) + (voff)[_i]), (PG8_LAS unsigned*)(lds + (bufoff) + ldsw + _i * 8192), 16, 0, 0); } while (0)
#define PG8_LDA(dst, b, h) do { _Pragma("unroll") for (int m = 0; m < 4; ++m) _Pragma("unroll") for (int k = 0; k < 2; ++k) dst[m][k] = *(const PG8_LAS bf16x8*)(lds + PG8_SA(b, h) + aoff + m * 2048 + k * 1024); } while (0)
#define PG8_LDB(dst, b, h) do { _Pragma("unroll") for (int n = 0; n < 2; ++n) _Pragma("unroll") for (int k = 0; k < 2; ++k) dst[n][k] = *(const PG8_LAS bf16x8*)(lds + PG8_SB(b, h) + boff + n * 2048 + k * 1024); } while (0)
#define PG8_MMA(ai, bj, At, Bt) do { __builtin_amdgcn_s_setprio(1); _Pragma("unroll") for (int m = 0; m < 4; ++m) _Pragma("unroll") for (int n = 0; n < 2; ++n) _Pragma("unroll") for (int k = 0; k < 2; ++k) \
        acc[ai][bj][m][n] = __builtin_amdgcn_mfma_f32_16x16x32_bf16(Bt[n][k], At[m][k], acc[ai][bj][m][n], 0, 0, 0); __builtin_amdgcn_s_setprio(0); } while (0)
#define PG8_WAIT_V(n) asm volatile("s_waitcnt vmcnt(" #n ")" ::: "memory")
#define PG8_WAIT_L(n) asm volatile("s_waitcnt lgkmcnt(" #n ")" ::: "memory")
#define PG8_BAR __builtin_amdgcn_s_barrier()
#define PG8_SCHED __builtin_amdgcn_sched_barrier(0)
    Unit cur, nxt; int ui = 0;
    if (!S.next(0, cur)) return;
    f32x4 acc[2][2][4][2];
#pragma unroll
    for (int a = 0; a < 2; ++a)
#pragma unroll
        for (int b = 0; b < 2; ++b)
#pragma unroll
            for (int m = 0; m < 4; ++m)
#pragma unroll
                for (int n = 0; n < 2; ++n) acc[a][b][m][n] = (f32x4){0.f, 0.f, 0.f, 0.f};
    bf16x8 At[4][2], B0[2][2], B1[2][2];
    const char* cA = (const char*)g.A + (size_t)cur.pm * tstep + cur.kofs; const char* cB = (const char*)g.Bt + (size_t)cur.pn * tstep + cur.kofs;
    S.a_ready(cur);
    if constexpr (SP2) {
        PG8_STAGE(PG8_SB(0, 0), cB, voffB); PG8_STAGE(PG8_SB(0, 1), cB + hstep, voffB); PG8_STAGE(PG8_SA(0, 0), cA, voffA); PG8_STAGE(PG8_SA(0, 1), cA + hstep, voffA);
        if (wr == 1) PG8_BAR;
        PG8_WAIT_V(2); PG8_BAR;
        PG8_STAGE(PG8_SB(1, 0), cB + kstep, voffB); PG8_STAGE(PG8_SA(1, 0), cA + kstep, voffA); PG8_STAGE(PG8_SB(1, 1), cB + hstep + kstep, voffB);
        PG8_WAIT_V(6); PG8_BAR;
    } else {
        PG8_STAGE(PG8_SB(0, 0), cB, voffB); PG8_STAGE(PG8_SA(0, 0), cA, voffA); PG8_STAGE(PG8_SB(0, 1), cB + hstep, voffB); PG8_STAGE(PG8_SA(0, 1), cA + hstep, voffA);
        if (wr == 1) PG8_BAR;
        PG8_WAIT_V(4); PG8_BAR;
        PG8_STAGE(PG8_SB(1, 0), cB + kstep, voffB); PG8_STAGE(PG8_SA(1, 0), cA + kstep, voffA); PG8_STAGE(PG8_SB(1, 1), cB + hstep + kstep, voffB);
        PG8_WAIT_V(6); PG8_BAR;
    }
    for (;;) {
        const bool has_next = S.next(ui + 1, nxt);
        const char* nA = has_next ? (const char*)g.A + (size_t)nxt.pm * tstep + nxt.kofs : cA; const char* nB = has_next ? (const char*)g.Bt + (size_t)nxt.pn * tstep + nxt.kofs : cB;
        const int nt = cur.nt;
        for (int t = 0; t < nt; t += 2) {
            const bool last = (t == nt - 2);
            const char* a1 = cA + (size_t)(t + 1) * kstep;
            const char* a2 = last ? nA : cA + (size_t)(t + 2) * kstep; const char* b2 = last ? nB : cB + (size_t)(t + 2) * kstep;
            const char* a3 = a2 + kstep; const char* b3 = b2 + kstep;
            if (last && has_next) S.a_ready(nxt);
            if constexpr (SP2) {
            PG8_LDB(B0, 0, 0); PG8_LDB(B1, 0, 1); PG8_SCHED; PG8_LDA(At, 0, 0); PG8_STAGE(PG8_SA(1, 1), a1 + hstep, voffA);
            PG8_WAIT_V(8); PG8_WAIT_L(0); PG8_BAR; PG8_MMA(0, 0, At, B0); PG8_MMA(0, 1, At, B1); PG8_BAR; PG8_SCHED;
            PG8_LDA(At, 0, 1); PG8_STAGE(PG8_SB(0, 0), b2, voffB); PG8_STAGE(PG8_SB(0, 1), b2 + hstep, voffB); PG8_STAGE(PG8_SA(0, 0), a2, voffA);
            PG8_WAIT_V(8); PG8_WAIT_L(0); PG8_BAR; PG8_MMA(1, 0, At, B0); PG8_MMA(1, 1, At, B1); PG8_BAR; PG8_SCHED;
            PG8_LDB(B0, 1, 0); PG8_LDB(B1, 1, 1); PG8_SCHED; PG8_LDA(At, 1, 0); PG8_STAGE(PG8_SA(0, 1), a2 + hstep, voffA);
            PG8_WAIT_V(8); PG8_WAIT_L(0); PG8_BAR; PG8_MMA(0, 0, At, B0); PG8_MMA(0, 1, At, B1); PG8_BAR; PG8_SCHED;
            PG8_LDA(At, 1, 1); PG8_STAGE(PG8_SB(1, 0), b3, voffB); PG8_STAGE(PG8_SB(1, 1), b3 + hstep, voffB); PG8_STAGE(PG8_SA(1, 0), a3, voffA);
            PG8_WAIT_V(8); PG8_WAIT_L(0); PG8_BAR; PG8_MMA(1, 0, At, B0); PG8_MMA(1, 1, At, B1); PG8_BAR; PG8_SCHED;
            } else {
            PG8_LDB(B0, 0, 0); PG8_SCHED; PG8_LDA(At, 0, 0); PG8_STAGE(PG8_SA(1, 1), a1 + hstep, voffA);
            PG8_WAIT_L(8); PG8_BAR; PG8_WAIT_L(0); PG8_MMA(0, 0, At, B0); PG8_BAR; PG8_SCHED;
            PG8_LDB(B1, 0, 1); PG8_STAGE(PG8_SB(0, 0), b2, voffB);
            PG8_BAR; PG8_WAIT_L(0); PG8_MMA(0, 1, At, B1); PG8_BAR;
            PG8_LDA(At, 0, 1); PG8_STAGE(PG8_SA(0, 0), a2, voffA);
            PG8_BAR; PG8_WAIT_L(0); PG8_MMA(1, 0, At, B0); PG8_BAR; PG8_SCHED;
            PG8_STAGE(PG8_SB(0, 1), b2 + hstep, voffB);
            PG8_WAIT_V(6); PG8_BAR; PG8_MMA(1, 1, At, B1); PG8_BAR;
            PG8_LDB(B0, 1, 0); PG8_SCHED; PG8_LDA(At, 1, 0); PG8_STAGE(PG8_SA(0, 1), a2 + hstep, voffA);
            PG8_WAIT_L(8); PG8_BAR; PG8_WAIT_L(0); PG8_MMA(0, 0, At, B0); PG8_BAR; PG8_SCHED;
            PG8_LDB(B1, 1, 1); PG8_STAGE(PG8_SB(1, 0), b3, voffB);
            PG8_BAR; PG8_WAIT_L(0); PG8_MMA(0, 1, At, B1); PG8_BAR;
            PG8_LDA(At, 1, 1); PG8_STAGE(PG8_SA(1, 0), a3, voffA);
            PG8_BAR; PG8_WAIT_L(0); PG8_MMA(1, 0, At, B0); PG8_BAR; PG8_SCHED;
            PG8_STAGE(PG8_SB(1, 1), b3 + hstep, voffB);
            PG8_WAIT_V(6); PG8_BAR; PG8_MMA(1, 1, At, B1); PG8_BAR;
            }
        }
        if constexpr (ALIGN_EPI) { if (wr == 0) PG8_BAR; }
        if constexpr (!Epi::AFTER_DRAIN) { E(acc, cur, wr, wc, fr, fq); S.done(cur); }
        if (!has_next) break;
#pragma unroll
        for (int a = 0; a < 2; ++a)
#pragma unroll
            for (int b = 0; b < 2; ++b)
#pragma unroll
                for (int m = 0; m < 4; ++m)
#pragma unroll
                    for (int n = 0; n < 2; ++n) acc[a][b][m][n] = (f32x4){0.f, 0.f, 0.f, 0.f};
        cur = nxt; cA = nA; cB = nB; ++ui;
        if constexpr (ALIGN_EPI) { if (wr == 1) PG8_BAR; }
    }
    PG8_WAIT_V(0);
    if constexpr (!ALIGN_EPI) { if (wr == 0) PG8_BAR; }
    PG8_BAR;
#undef PG8_SA
#undef PG8_SB
#undef PG8_STAGE
#undef PG8_LDA
#undef PG8_LDB
#undef PG8_MMA
#undef PG8_WAIT_V
#undef PG8_WAIT_L
#undef PG8_BAR
#undef PG8_SCHED
}
}
#ifndef PG8_SP2
#define PG8_SP2 true
#endif
#ifndef PG8_ALIGN
#define PG8_ALIGN true
#endif

#define XB_TMO      128
#define XB_XCNT(j)  (256  + 64 * (j))
#define XB_XSUB(j)  (1280 + 64 * (j))
#define XB_XGEN(j)  (2304 + 64 * (j))
#define XB_TOP      3328
#define XB_TOPGEN   3392
#define XCD_BAR_WORDS 3456
#define XB_SPIN_CAP (1u << 18)
__device__ __forceinline__ unsigned xb_ld(unsigned* p)              { return __hip_atomic_load(p, __ATOMIC_RELAXED, __HIP_MEMORY_SCOPE_AGENT); }
__device__ __forceinline__ unsigned xb_add(unsigned* p, unsigned v) { return __hip_atomic_fetch_add(p, v, __ATOMIC_RELAXED, __HIP_MEMORY_SCOPE_AGENT); }
__device__ __forceinline__ unsigned xb_xcc_id() { return (unsigned)__builtin_amdgcn_s_getreg((3 << 11) | 20) & 0xFu; }
#define XB_SPIN(cond, bar) do { unsigned _sp = 0; while (cond) { __builtin_amdgcn_s_sleep(1); \
    if ((++_sp & 255u) == 0u) { if (xb_ld(&(bar)[XB_TMO])) break; if (_sp > XB_SPIN_CAP) { atomicAdd(&(bar)[XB_TMO], 1u); break; } } } } while (0)
struct XcdBarrier { unsigned* bar; unsigned x; volatile LAS unsigned* st; };
__device__ __forceinline__ XcdBarrier xcd_barrier_post(unsigned* bar, volatile LAS unsigned* st) {
    XcdBarrier b; b.bar = bar; b.x = xb_xcc_id(); b.st = st;
    if (threadIdx.x == 0) (void)xb_add(&bar[XB_XCNT(b.x)], 1u);
    return b;
}
__device__ __forceinline__ void xcd_barrier_complete(unsigned* bar, unsigned x, unsigned& nloc, unsigned& nx) {
    const unsigned G = gridDim.x * gridDim.y * gridDim.z;
    unsigned sum, cnt, mine, sp = 0u;
    for (;;) {
        sum = 0u; cnt = 0u; mine = 0u;
#pragma unroll
        for (unsigned j = 0; j < 16; ++j) { const unsigned c = xb_ld(&bar[XB_XCNT(j)]); sum += c; cnt += (c > 0u) ? 1u : 0u; mine = (j == x) ? c : mine; }
        if (sum == G) break;
        __builtin_amdgcn_s_sleep(1);
        if ((++sp & 255u) == 0u) { if (xb_ld(&bar[XB_TMO])) break; if (sp > XB_SPIN_CAP) { atomicAdd(&bar[XB_TMO], 1u); break; } }
    }
    nloc = mine > 0u ? mine : 1u; nx = cnt > 0u ? cnt : 1u;
}
__device__ __forceinline__ void xcd_barrier(const XcdBarrier& b) {
    asm volatile("s_waitcnt vmcnt(0)" ::: "memory");
    __syncthreads();
    if (threadIdx.x == 0) {
        unsigned* bar = b.bar;
        __builtin_amdgcn_s_waitcnt(0);
        unsigned nloc = b.st[0], nx = b.st[1];
        if (nloc == 0u) { xcd_barrier_complete(bar, b.x, nloc, nx); b.st[0] = nloc; b.st[1] = nx; }
        const unsigned old = xb_add(&bar[XB_XSUB(b.x)], 1u);
        const unsigned gen = old / nloc;
        if (old + 1u == (gen + 1u) * nloc) {
            __builtin_amdgcn_fence(__ATOMIC_RELEASE, "agent");
            asm volatile("s_waitcnt vmcnt(0)" ::: "memory");
            const unsigned og = xb_add(&bar[XB_TOP], 1u);
            const unsigned tg = og / nx;
            if (og + 1u == (tg + 1u) * nx) xb_add(&bar[XB_TOPGEN], 1u);
            else XB_SPIN(xb_ld(&bar[XB_TOPGEN]) == tg, bar);
            __builtin_amdgcn_fence(__ATOMIC_ACQUIRE, "agent");
            xb_add(&bar[XB_XGEN(b.x)], 1u);
            asm volatile("s_waitcnt vmcnt(0)" ::: "memory");
        } else {
            XB_SPIN(xb_ld(&bar[XB_XGEN(b.x)]) == gen, bar);
            __builtin_amdgcn_fence(__ATOMIC_ACQUIRE, "agent");
            asm volatile("s_waitcnt vmcnt(0)" ::: "memory");
        }
    }
    __syncthreads();
}

constexpr size_t al256(size_t x) { return (x + 255) & ~(size_t)255; }
constexpr size_t WS_CTL = 0;
constexpr size_t CTL_ZERO_BYTES = 65536;
constexpr size_t WS_MODACC = 2u << 20;
constexpr size_t WS_MODF = (1u << 20) + (512u << 10);
constexpr size_t WS_ROPE = 1u << 20;
constexpr size_t WS_WABIN = 8u << 20;
constexpr size_t SZ_WABIN = (size_t)ABIN * D * 2;
constexpr size_t WS_WABOUT = WS_WABIN + 2 * SZ_WABIN;
constexpr size_t SZ_WSQ = (size_t)D * D * 2;
constexpr size_t WS_WQKV = WS_WABOUT + 2 * SZ_WSQ;
constexpr size_t SZ_WQKV = (size_t)QKV * D * 2;
constexpr size_t WS_WNAOUT = WS_WQKV + 2 * SZ_WQKV;
constexpr size_t WS_WFFIN = WS_WNAOUT + 2 * SZ_WSQ;
constexpr size_t SZ_WFFIN = (size_t)FF2 * D * 2;
constexpr size_t WS_WFFOUT = WS_WFFIN + 4 * SZ_WFFIN;
constexpr size_t SZ_WFFOUT = (size_t)D * FFH * 2;
constexpr size_t WS_X = WS_WFFOUT + 4 * SZ_WFFOUT;
constexpr size_t WS_H = WS_X + (size_t)MTOK * D * 4;
constexpr size_t WS_P = WS_H + (size_t)MTOK * D * 2;
constexpr size_t WS_YAB = WS_P + (size_t)MTOK * ABIN * 2;
constexpr size_t WS_Y = WS_YAB + (size_t)MTOK * D * 2;
constexpr size_t WS_HID = WS_Y + (size_t)MTOK * D * 4;
constexpr size_t WS_KVT = WS_HID + (size_t)MTOK * FFH * 2;
constexpr size_t WS_ST = WS_KVT + (size_t)NCHUNK * 16 * 16384 * 4;
constexpr size_t WS_YC = WS_ST + (size_t)NCHUNK * 16 * 16384 * 2;
constexpr size_t WS_END = WS_YC + (size_t)22 * 256 * D * 4;
constexpr int NSPLIT_OUT = 8, NSPLIT_FFO = 22;
static_assert(WS_WABIN % 256 == 0 && WS_X % 256 == 0 && WS_P % 256 == 0 && WS_KVT % 256 == 0 && WS_ST % 256 == 0, "ws alignment");

constexpr int RING_BYTES = 131072, LDSCTL_OFF = RING_BYTES, MISC_OFF = LDSCTL_OFF + 320, PRM_OFF = LDSCTL_OFF + 1024, LDS_BYTES = 147456;
constexpr int NPHASE = 2 + 9 * DEPTH;

struct Params { const float* in[16]; float* out; unsigned char* ws; int ph_lo, ph_hi, li, pad; };

__device__ __forceinline__ void transpose_item(const float* W, int ldw, int K, bf16_t* Wt, int k0, int n0s, int n0d, LAS float* scr, int lane) {
    const int r = lane >> 3, c4 = (lane & 7) * 4;
    f32x4 v[8];
#pragma unroll
    for (int i = 0; i < 8; ++i) v[i] = __builtin_nontemporal_load((const f32x4*)(W + (size_t)(k0 + 8 * i + r) * ldw + n0s + c4));
#pragma unroll
    for (int i = 0; i < 8; ++i) { LAS float* d = scr + (8 * i + r) * 33 + c4; d[0] = v[i][0]; d[1] = v[i][1]; d[2] = v[i][2]; d[3] = v[i][3]; }
    asm volatile("s_waitcnt lgkmcnt(0)" ::: "memory");
    const int c = lane & 7;
#pragma unroll
    for (int j = 0; j < 4; ++j) { const int n = (lane >> 3) + 8 * j; const LAS float* s = scr + (8 * c) * 33 + n;
        u32x4 o; o[0] = cvt_pk_bf16(s[0 * 33], s[1 * 33]); o[1] = cvt_pk_bf16(s[2 * 33], s[3 * 33]); o[2] = cvt_pk_bf16(s[4 * 33], s[5 * 33]); o[3] = cvt_pk_bf16(s[6 * 33], s[7 * 33]);
        *(u32x4*)(Wt + (size_t)(n0d + n) * K + k0 + 8 * c) = o; }
    asm volatile("s_waitcnt lgkmcnt(0)" ::: "memory");
}
__device__ __forceinline__ void transpose_matrix_item(const float* W, int K, int N, bf16_t* Wt, bool ffperm, int item, LAS float* scr, int lane) {
    const int nblk = N / 32, kb = item / nblk, nb = item % nblk, n0d = 32 * nb;
    int n0s = n0d;
    if (ffperm) { const int t = n0d >> 8, j = n0d & 255; n0s = j < 128 ? 128 * t + j : FFH + 128 * t + (j - 128); }
    transpose_item(W, N, K, Wt, 64 * kb, n0s, n0d, scr, lane);
}

constexpr int I_ABIN = (D / 64) * (ABIN / 32), I_SQ = (D / 64) * (D / 32), I_QKV = (D / 64) * (QKV / 32), I_FFIN = (D / 64) * (FF2 / 32), I_FFOUT = (FFH / 64) * (D / 32);
__device__ __forceinline__ unsigned long long ldptr(LAS const unsigned* prm, int k) {
    const unsigned lo = prm[2 * k], hi = prm[2 * k + 1];
    return ((unsigned long long)(unsigned)__builtin_amdgcn_readfirstlane((int)hi) << 32) | (unsigned)__builtin_amdgcn_readfirstlane((int)lo);
}
__device__ __forceinline__ void cvt_mat(LAS const unsigned* prm, int type, int inst, int idx, LAS float* scr, int lane) {
    const int kin = type == 0 ? 7 : (type == 1 ? 10 : (type == 2 ? 11 : (type == 3 ? 13 : (type == 4 ? 14 : 15))));
    const int K = type == 5 ? FFH : D;
    const int N = type == 0 ? ABIN : (type == 2 ? QKV : (type == 4 ? FF2 : D));
    const size_t woff = type == 0 ? WS_WABIN : (type == 1 ? WS_WABOUT : (type == 2 ? WS_WQKV : (type == 3 ? WS_WNAOUT : (type == 4 ? WS_WFFIN : WS_WFFOUT))));
    const size_t wsz = type == 0 ? SZ_WABIN : (type == 2 ? SZ_WQKV : (type == 4 ? SZ_WFFIN : (type == 5 ? SZ_WFFOUT : SZ_WSQ)));
    const float* src = (const float*)(GAS const float*)ldptr(prm, kin) + (size_t)inst * K * N;
    unsigned char* ws = (unsigned char*)(GAS unsigned char*)ldptr(prm, 17);
    transpose_matrix_item(src, K, N, (bf16_t*)(ws + woff + inst * wsz), type == 4, idx, scr, lane);
}
constexpr int L0_ITEMS = I_ABIN + I_FFOUT;
__device__ __forceinline__ void cvt_l0_item(LAS const unsigned* p, int r, LAS float* scr, int lane) {
    int type, base;
    if (r < I_ABIN) { type = 0; base = 0; } else { type = 5; base = I_ABIN; }
    cvt_mat(p, type, 0, r - base, scr, lane);
}
constexpr int DLA = I_SQ, DL0 = DLA + I_FFIN, DL1 = DL0 + I_QKV, DL2 = DL1 + I_SQ, DL3 = DL2 + I_FFIN, DL4 = DL3 + I_FFOUT, DL5 = DL4 + I_ABIN, DL6 = DL5 + I_SQ, DL7 = DL6 + I_FFIN, DL8 = DL7 + I_FFOUT,
              DL9 = DL8 + I_QKV, DL10 = DL9 + I_SQ, DL11 = DL10 + I_FFIN, DL_END = DL11 + I_FFOUT;
static_assert(DL_END == 89600 && L0_ITEMS == 12800, "deferred list");
__device__ __forceinline__ void cvt_dl_item(LAS const unsigned* p, int gi, LAS float* scr, int lane) {
    int type, inst, base;
    if (gi < DL0) { if (gi < DLA) { type = 1; inst = 0; base = 0; } else { type = 4; inst = 0; base = DLA; } }
    else if (gi < DL4) { if (gi < DL2) { if (gi < DL1) { type = 2; inst = 0; base = DL0; } else { type = 3; inst = 0; base = DL1; } } else { if (gi < DL3) { type = 4; inst = 1; base = DL2; } else { type = 5; inst = 1; base = DL3; } } }
    else if (gi < DL8) { if (gi < DL6) { if (gi < DL5) { type = 0; inst = 1; base = DL4; } else { type = 1; inst = 1; base = DL5; } } else { if (gi < DL7) { type = 4; inst = 2; base = DL6; } else { type = 5; inst = 2; base = DL7; } } }
    else { if (gi < DL10) { if (gi < DL9) { type = 2; inst = 1; base = DL8; } else { type = 3; inst = 1; base = DL9; } } else { if (gi < DL11) { type = 4; inst = 3; base = DL10; } else { type = 5; inst = 3; base = DL11; } } }
    cvt_mat(p, type, inst, gi - base, scr, lane);
}
__device__ __forceinline__ void ada_item(LAS const unsigned* prm, int l, int nc, int kp, int tid) {
    if (tid < 384) {
        const int n = nc * 1536 + 4 * tid;
        f32x4 aL = (f32x4){0.f, 0.f, 0.f, 0.f}, aC = aL;
        const float* wp = (const float*)(GAS const float*)ldptr(prm, 4) + ((size_t)l * D + kp * 128) * (6 * D) + n;
        const float* cl_p = (const float*)(GAS const float*)ldptr(prm, 1) + kp * 128; const float* cc_p = (const float*)(GAS const float*)ldptr(prm, 3) + kp * 128;
        float* modacc = (float*)((unsigned char*)(GAS unsigned char*)ldptr(prm, 17) + WS_MODACC);
        const int l32 = tid & 31;
#pragma unroll 1
        for (int k0 = 0; k0 < 128; k0 += 32) {
            f32x4 w[32];
#pragma unroll
            for (int j = 0; j < 32; ++j) w[j] = __builtin_nontemporal_load((const f32x4*)(wp + (size_t)(k0 + j) * (6 * D)));
            const float clv = cl_p[k0 + l32], ccv = cc_p[k0 + l32];
            const float slv = clv / (1.0f + __expf(-clv)), scv = ccv / (1.0f + __expf(-ccv));
#pragma unroll
            for (int j = 0; j < 32; ++j) { const float sl = __builtin_bit_cast(float, __builtin_amdgcn_readlane(__builtin_bit_cast(int, slv), j)), sc = __builtin_bit_cast(float, __builtin_amdgcn_readlane(__builtin_bit_cast(int, scv), j));
                aL = aL + w[j] * sl; aC = aC + w[j] * sc; }
        }
        *(f32x4*)(modacc + (size_t)kp * MODPART + (size_t)(l * 2 + 0) * 6 * D + n) = aL;
        *(f32x4*)(modacc + (size_t)kp * MODPART + (size_t)(l * 2 + 1) * 6 * D + n) = aC;
    }
}
__device__ __forceinline__ void r1_block_task(const bf16_t* P, float* KVt, LAS unsigned char* lds, float lg2, int cidx, int head, int wave, int lane) {
    const int i = lane & 15, g = lane >> 4, dir = wave >> 2, quad = wave & 3;
    const int dk0 = 64 * (quad >> 1), dv0 = 64 * (quad & 1);
    const bf16_t* Prow = P + (size_t)chunk_row(cidx) * ABIN;
#pragma unroll
    for (int r = 0; r < 2; ++r)
#pragma unroll
        for (int j = 0; j < 4; ++j) {
            const int p = (j * 8 + wave) * 64 + lane, row = p >> 4, c = (p & 15) ^ (row & 15);
            const bf16_t* src = Prow + (size_t)row * ABIN + (r == 0 ? 4096 : 5120) + head * 128 + c * 8;
            __builtin_amdgcn_global_load_lds((const unsigned*)src, (LAS unsigned*)(lds + r * 32768 + (j * 8 + wave) * 1024), 16, 0, 0);
        }
    asm volatile("s_waitcnt vmcnt(0)" ::: "memory");
    asm volatile("s_waitcnt lgkmcnt(0)" ::: "memory"); __builtin_amdgcn_s_barrier(); asm volatile("" ::: "memory");
    int kbo[8], vbo[8];
#pragma unroll
    for (int jj = 0; jj < 8; ++jj) { const int tl = 8 * g + jj;
        kbo[jj] = tl * 256 + (((dk0 >> 3) + (i >> 1)) ^ (tl & 15)) * 16 + 8 * (i & 1);
        vbo[jj] = 32768 + tl * 256 + (((dv0 >> 3) + (i >> 1)) ^ (tl & 15)) * 16 + 8 * (i & 1); }
    f32x4 acc[4][4];
#pragma unroll
    for (int a = 0; a < 4; ++a)
#pragma unroll
        for (int b = 0; b < 4; ++b) acc[a][b] = (f32x4){0.f, 0.f, 0.f, 0.f};
#pragma unroll
    for (int s = 0; s < 4; ++s) {
        u32x2 kd[8], vd[8]; float w[8];
#pragma unroll
        for (int jj = 0; jj < 8; ++jj) {
            const int tj = 32 * s + 8 * g + jj;
            kd[jj] = *(LAS const u32x2*)(lds + kbo[jj] + 8192 * s); vd[jj] = *(LAS const u32x2*)(lds + vbo[jj] + 8192 * s);
            w[jj] = ex2(lg2 * (float)(dir == 0 ? 127 - tj : tj));
        }
        bf16x8 af[4], bfr[4];
#pragma unroll
        for (int mt = 0; mt < 4; ++mt) {
            u32x4 wd;
#pragma unroll
            for (int q = 0; q < 4; ++q) {
                const unsigned X = kd[2 * q][mt >> 1], Y = kd[2 * q + 1][mt >> 1];
                const float lo = ((mt & 1) ? bf_hi(X) : bf_lo(X)) * w[2 * q], hi = ((mt & 1) ? bf_hi(Y) : bf_lo(Y)) * w[2 * q + 1];
                wd[q] = cvt_pk_bf16(lo, hi);
            }
            af[mt] = __builtin_bit_cast(bf16x8, wd);
        }
#pragma unroll
        for (int nt = 0; nt < 4; ++nt) {
            u32x4 wd;
#pragma unroll
            for (int q = 0; q < 4; ++q) {
                const unsigned X = vd[2 * q][nt >> 1], Y = vd[2 * q + 1][nt >> 1];
                wd[q] = (nt & 1) ? ((X >> 16) | (Y & 0xffff0000u)) : ((X & 0xffffu) | (Y << 16));
            }
            bfr[nt] = __builtin_bit_cast(bf16x8, wd);
        }
#pragma unroll
        for (int mt = 0; mt < 4; ++mt)
#pragma unroll
            for (int nt = 0; nt < 4; ++nt) acc[mt][nt] = mfma16(af[mt], bfr[nt], acc[mt][nt]);
        SCHED_FENCE();
    }
    asm volatile("s_waitcnt lgkmcnt(0)" ::: "memory"); __builtin_amdgcn_s_barrier(); asm volatile("" ::: "memory");
    float* out = KVt + ((((size_t)cidx * 8 + head) * 2 + dir) * 128) * 128;
#pragma unroll
    for (int nt = 0; nt < 4; ++nt)
#pragma unroll
        for (int reg = 0; reg < 4; ++reg) {
            const int dv = dv0 + 4 * i + nt, dk = dk0 + 16 * g + 4 * reg;
            *(f32x4*)(out + (size_t)dv * 128 + dk) = (f32x4){acc[0][nt][reg], acc[1][nt][reg], acc[2][nt][reg], acc[3][nt][reg]};
        }
}

__device__ __forceinline__ void r1_issue_set(const bf16_t* Prow, LAS unsigned char* setp, const int head, const int wave, const int lane) {
#pragma unroll
    for (int r = 0; r < 2; ++r)
#pragma unroll
        for (int j = 0; j < 4; ++j) {
            const int p = (j * 8 + wave) * 64 + lane, row = p >> 4, c = (p & 15) ^ (row & 15);
            const bf16_t* src = Prow + (size_t)row * ABIN + (r == 0 ? 4096 : 5120) + head * 128 + c * 8;
            __builtin_amdgcn_global_load_lds((const unsigned*)src, (LAS unsigned*)(setp + r * 32768 + (j * 8 + wave) * 1024), 16, 0, 0);
        }
}
__device__ __forceinline__ void r1_phase_pipelined(const bf16_t* P, float* KVt, LAS unsigned char* lds, const float* decay_exp, const int iab, const int vcu, const int G, const int wave, const int lane) {
    const int i = lane & 15, g = lane >> 4, dir = wave >> 2, quad = wave & 3;
    const int dk0 = 64 * (quad >> 1), dv0 = 64 * (quad & 1);
    int bt = vcu; if (bt >= NCHUNK * 8) return;
    int kbo[8], vbo[8];
#pragma unroll
    for (int jj = 0; jj < 8; ++jj) { const int tl = 8 * g + jj;
        kbo[jj] = tl * 256 + (((dk0 >> 3) + (i >> 1)) ^ (tl & 15)) * 16 + 8 * (i & 1);
        vbo[jj] = 32768 + tl * 256 + (((dv0 >> 3) + (i >> 1)) ^ (tl & 15)) * 16 + 8 * (i & 1); }
    r1_issue_set(P + (size_t)chunk_row(bt >> 3) * ABIN, lds, bt & 7, wave, lane);
    for (int k = 0;; ++k) {
        const int cidx = bt >> 3, head = bt & 7, nbt = bt + G;
        const bool has_next = nbt < NCHUNK * 8;
        const float lg2 = lg2gamma(decay_exp, iab, dir, head);
        LAS const unsigned char* setp = lds + (k & 1) * 65536;
        if (has_next) { r1_issue_set(P + (size_t)chunk_row(nbt >> 3) * ABIN, lds + ((k + 1) & 1) * 65536, nbt & 7, wave, lane); asm volatile("s_waitcnt vmcnt(8)" ::: "memory"); }
        else asm volatile("s_waitcnt vmcnt(0)" ::: "memory");
        asm volatile("s_waitcnt lgkmcnt(0)" ::: "memory"); __builtin_amdgcn_s_barrier(); asm volatile("" ::: "memory");
        f32x4 acc[4][4];
#pragma unroll
        for (int a = 0; a < 4; ++a)
#pragma unroll
            for (int b = 0; b < 4; ++b) acc[a][b] = (f32x4){0.f, 0.f, 0.f, 0.f};
#pragma unroll
        for (int s = 0; s < 4; ++s) {
            u32x2 kd[8], vd[8]; float w[8];
#pragma unroll
            for (int jj = 0; jj < 8; ++jj) {
                const int tj = 32 * s + 8 * g + jj;
                kd[jj] = *(LAS const u32x2*)(setp + kbo[jj] + 8192 * s); vd[jj] = *(LAS const u32x2*)(setp + vbo[jj] + 8192 * s);
                w[jj] = ex2(lg2 * (float)(dir == 0 ? 127 - tj : tj));
            }
            bf16x8 af[4], bfr[4];
#pragma unroll
            for (int mt = 0; mt < 4; ++mt) {
                u32x4 wd;
#pragma unroll
                for (int q = 0; q < 4; ++q) {
                    const unsigned X = kd[2 * q][mt >> 1], Y = kd[2 * q + 1][mt >> 1];
                    const float lo = ((mt & 1) ? bf_hi(X) : bf_lo(X)) * w[2 * q], hi = ((mt & 1) ? bf_hi(Y) : bf_lo(Y)) * w[2 * q + 1];
                    wd[q] = cvt_pk_bf16(lo, hi);
                }
                af[mt] = __builtin_bit_cast(bf16x8, wd);
            }
#pragma unroll
            for (int nt = 0; nt < 4; ++nt) {
                u32x4 wd;
#pragma unroll
                for (int q = 0; q < 4; ++q) {
                    const unsigned X = vd[2 * q][nt >> 1], Y = vd[2 * q + 1][nt >> 1];
                    wd[q] = (nt & 1) ? ((X >> 16) | (Y & 0xffff0000u)) : ((X & 0xffffu) | (Y << 16));
                }
                bfr[nt] = __builtin_bit_cast(bf16x8, wd);
            }
#pragma unroll
            for (int mt = 0; mt < 4; ++mt)
#pragma unroll
                for (int nt = 0; nt < 4; ++nt) acc[mt][nt] = mfma16(af[mt], bfr[nt], acc[mt][nt]);
            SCHED_FENCE();
        }
        asm volatile("s_waitcnt lgkmcnt(0)" ::: "memory"); __builtin_amdgcn_s_barrier(); asm volatile("" ::: "memory");
        bf16_t* out = (bf16_t*)KVt + ((((size_t)cidx * 8 + head) * 2 + dir) * 128) * 128;
#pragma unroll
        for (int nt = 0; nt < 4; ++nt)
#pragma unroll
            for (int reg = 0; reg < 4; ++reg) {
                const int dv = dv0 + 4 * i + nt, dk = dk0 + 16 * g + 4 * reg;
                u32x2 w; w[0] = cvt_pk_bf16(acc[0][nt][reg], acc[1][nt][reg]); w[1] = cvt_pk_bf16(acc[2][nt][reg], acc[3][nt][reg]);
                *(u32x2*)(out + (size_t)dv * 128 + dk) = w;
            }
        if (!has_next) break;
        bt = nbt;
    }
}

__device__ __forceinline__ void r3_block_task(const bf16_t* P, const bf16_t* St, bf16_t* YAB, LAS unsigned char* lds, float lg2f, float lg2b, int cidx, int head, int wave, int lane) {
    const int i = lane & 15, g = lane >> 4, qi = 16 * wave + i, rowbase = chunk_row(cidx);
    const bf16_t* Prow = P + (size_t)rowbase * ABIN;
    bf16x8 qf[4];
#pragma unroll
    for (int s = 0; s < 4; ++s) qf[s] = *(const bf16x8*)(Prow + (size_t)qi * ABIN + 3072 + head * 128 + 32 * s + 8 * g);
#pragma unroll
    for (int r = 0; r < 4; ++r)
#pragma unroll
        for (int j = 0; j < 4; ++j) {
            const int p = (j * 8 + wave) * 64 + lane, row = p >> 4, c = (p & 15) ^ (r < 2 ? (row & 15) : ((row >> 3) & 15));
            const bf16_t* src = r == 0 ? Prow + (size_t)row * ABIN + 4096 + head * 128 + c * 8 : (r == 1 ? Prow + (size_t)row * ABIN + 5120 + head * 128 + c * 8
                                : St + ((((size_t)cidx * 8 + head) * 2 + (r - 2)) * 128 + row) * 128 + c * 8);
            __builtin_amdgcn_global_load_lds((const unsigned*)src, (LAS unsigned*)(lds + r * 32768 + (j * 8 + wave) * 1024), 16, 0, 0);
        }
    asm volatile("s_waitcnt vmcnt(0)" ::: "memory");
    asm volatile("s_waitcnt lgkmcnt(0)" ::: "memory"); __builtin_amdgcn_s_barrier(); asm volatile("" ::: "memory");
    int kb[4], sb[4], vb[8];
#pragma unroll
    for (int s = 0; s < 4; ++s) { kb[s] = i * 256 + ((4 * s + g) ^ i) * 16; sb[s] = 65536 + i * 2048 + ((4 * s + g) ^ i) * 16; }
#pragma unroll
    for (int jj = 0; jj < 8; ++jj) { const int kk = jj < 4 ? 4 * g + jj : 16 + 4 * g + jj - 4; vb[jj] = 32768 + kk * 256 + (i ^ (kk & 15)) * 16; }
    f32x4 sacc[8];
#pragma unroll
    for (int mt = 0; mt < 8; ++mt) {
        f32x4 a = (f32x4){0.f, 0.f, 0.f, 0.f};
#pragma unroll
        for (int s = 0; s < 4; ++s) { const bf16x8 kf = *(LAS const bf16x8*)(lds + kb[s] + 4096 * mt); a = mfma16(kf, qf[s], a); }
        sacc[mt] = a;
        if (mt & 1) SCHED_FENCE();
    }
#pragma unroll
    for (int mt = 0; mt < 8; ++mt)
#pragma unroll
        for (int reg = 0; reg < 4; ++reg) {
            const int diff = qi - (16 * mt + 4 * g + reg);
            const float d = diff > 0 ? ex2((float)diff * lg2f) : (diff < 0 ? ex2((float)(-diff) * lg2b) : 2.0f);
            sacc[mt][reg] *= d;
        }
    bf16x8 pf[4];
#pragma unroll
    for (int s = 0; s < 4; ++s) {
        u32x4 w; w[0] = cvt_pk_bf16(sacc[2 * s][0], sacc[2 * s][1]); w[1] = cvt_pk_bf16(sacc[2 * s][2], sacc[2 * s][3]);
        w[2] = cvt_pk_bf16(sacc[2 * s + 1][0], sacc[2 * s + 1][1]); w[3] = cvt_pk_bf16(sacc[2 * s + 1][2], sacc[2 * s + 1][3]);
        pf[s] = __builtin_bit_cast(bf16x8, w);
    }
    f32x4 oacc[8];
#pragma unroll
    for (int mt = 0; mt < 8; ++mt) oacc[mt] = (f32x4){0.f, 0.f, 0.f, 0.f};
#pragma unroll
    for (int s = 0; s < 4; ++s) {
        u32x4 vd[8];
#pragma unroll
        for (int jj = 0; jj < 8; ++jj) vd[jj] = *(LAS const u32x4*)(lds + vb[jj] + 8192 * s);
#pragma unroll
        for (int mt = 0; mt < 8; ++mt) oacc[mt] = mfma16(extract8(vd, mt), pf[s], oacc[mt]);
        SCHED_FENCE();
    }
#pragma unroll
    for (int dir = 0; dir < 2; ++dir) {
        f32x4 tacc[8];
#pragma unroll
        for (int mt = 0; mt < 8; ++mt) tacc[mt] = (f32x4){0.f, 0.f, 0.f, 0.f};
#pragma unroll
        for (int s = 0; s < 4; ++s) {
#pragma unroll
            for (int mt = 0; mt < 8; ++mt) { const bf16x8 sf = *(LAS const bf16x8*)(lds + sb[s] + 256 * mt + 32768 * dir); tacc[mt] = mfma16(sf, qf[s], tacc[mt]); }
            SCHED_FENCE();
        }
        const float qd = dir == 0 ? ex2((float)(qi + 1) * lg2f) : ex2((float)(128 - qi) * lg2b);
#pragma unroll
        for (int mt = 0; mt < 8; ++mt) oacc[mt] = oacc[mt] + tacc[mt] * qd;
    }
    asm volatile("s_waitcnt lgkmcnt(0)" ::: "memory"); __builtin_amdgcn_s_barrier(); asm volatile("" ::: "memory");
    float ss = 0.f;
#pragma unroll
    for (int mt = 0; mt < 8; ++mt) ss += (oacc[mt][0] * oacc[mt][0] + oacc[mt][1] * oacc[mt][1]) + (oacc[mt][2] * oacc[mt][2] + oacc[mt][3] * oacc[mt][3]);
    ss += shfl_xor_f(ss, 16); ss += shfl_xor_f(ss, 32);
    const float rinv = rsq_f(ss * (1.0f / 128.0f) + EPS);
#pragma unroll
    for (int reg = 0; reg < 4; ++reg) {
        const int dvb = 32 * g + 8 * reg;
        const u32x4 gt = *(const u32x4*)(Prow + (size_t)qi * ABIN + 6144 + head * 128 + dvb);
        float o[8];
#pragma unroll
        for (int mt = 0; mt < 8; ++mt) { const float gv = (mt & 1) ? bf_hi(gt[mt >> 1]) : bf_lo(gt[mt >> 1]); o[mt] = silu_f(gv) * (oacc[mt][reg] * rinv); }
        u32x4 w; w[0] = cvt_pk_bf16(o[0], o[1]); w[1] = cvt_pk_bf16(o[2], o[3]); w[2] = cvt_pk_bf16(o[4], o[5]); w[3] = cvt_pk_bf16(o[6], o[7]);
        *(u32x4*)(YAB + (size_t)(rowbase + qi) * D + 1024 + head * 128 + dvb) = w;
    }
}

__device__ __forceinline__ void r3_issue_regions(const bf16_t* Prow, const bf16_t* Stb, LAS unsigned char* lds, const int head, const int rlo, const int wave, const int lane) {
#pragma unroll
    for (int rr = 0; rr < 2; ++rr)
#pragma unroll
        for (int j = 0; j < 4; ++j) {
            const int r = rlo + rr;
            const int p = (j * 8 + wave) * 64 + lane, row = p >> 4, c = (p & 15) ^ (r < 2 ? (row & 15) : ((row >> 3) & 15));
            const bf16_t* src = r == 0 ? Prow + (size_t)row * ABIN + 4096 + head * 128 + c * 8 : (r == 1 ? Prow + (size_t)row * ABIN + 5120 + head * 128 + c * 8
                                : Stb + ((size_t)(r - 2) * 128 + row) * 128 + c * 8);
            __builtin_amdgcn_global_load_lds((const unsigned*)src, (LAS unsigned*)(lds + r * 32768 + (j * 8 + wave) * 1024), 16, 0, 0);
        }
}
__device__ __forceinline__ void r3_phase_pipelined(const bf16_t* P, const bf16_t* St, bf16_t* YAB, LAS unsigned char* lds, const float* decay_exp, const int iab, const int vcu, const int G, const int wave, const int lane) {
    const int i = lane & 15, g = lane >> 4;
    int bt = vcu; if (bt >= NCHUNK * 8) return;
    int kb[4], sb[4], vb[8];
#pragma unroll
    for (int s = 0; s < 4; ++s) { kb[s] = i * 256 + ((4 * s + g) ^ i) * 16; sb[s] = 65536 + i * 2048 + ((4 * s + g) ^ i) * 16; }
#pragma unroll
    for (int jj = 0; jj < 8; ++jj) { const int kk = jj < 4 ? 4 * g + jj : 16 + 4 * g + jj - 4; vb[jj] = 32768 + kk * 256 + (i ^ (kk & 15)) * 16; }
    bf16x8 qn[4];
    {   const int cidx = bt >> 3, head = bt & 7; const bf16_t* Prow = P + (size_t)chunk_row(cidx) * ABIN;
#pragma unroll
        for (int s = 0; s < 4; ++s) qn[s] = *(const bf16x8*)(Prow + (size_t)(16 * wave + i) * ABIN + 3072 + head * 128 + 32 * s + 8 * g);
        const bf16_t* Stb = St + (((size_t)cidx * 8 + head) * 2) * 16384;
        r3_issue_regions(Prow, Stb, lds, head, 0, wave, lane); r3_issue_regions(Prow, Stb, lds, head, 2, wave, lane); }
    for (;;) {
        const int cidx = bt >> 3, head = bt & 7, qi = 16 * wave + i, rowbase = chunk_row(cidx), nbt = bt + G;
        const bool has_next = nbt < NCHUNK * 8;
        const bf16_t* Prow = P + (size_t)rowbase * ABIN;
        const float lg2f = lg2gamma(decay_exp, iab, 0, head), lg2b = lg2gamma(decay_exp, iab, 1, head);
        bf16x8 qf[4];
#pragma unroll
        for (int s = 0; s < 4; ++s) qf[s] = qn[s];
        asm volatile("s_waitcnt vmcnt(8)" ::: "memory");
        asm volatile("s_waitcnt lgkmcnt(0)" ::: "memory"); __builtin_amdgcn_s_barrier(); asm volatile("" ::: "memory");
        f32x4 sacc[8];
#pragma unroll
        for (int mt = 0; mt < 8; ++mt) {
            f32x4 a = (f32x4){0.f, 0.f, 0.f, 0.f};
#pragma unroll
            for (int s = 0; s < 4; ++s) { const bf16x8 kf = *(LAS const bf16x8*)(lds + kb[s] + 4096 * mt); a = mfma16(kf, qf[s], a); }
            sacc[mt] = a;
            if (mt & 1) SCHED_FENCE();
        }
#pragma unroll
        for (int mt = 0; mt < 8; ++mt)
#pragma unroll
            for (int reg = 0; reg < 4; ++reg) {
                const int diff = qi - (16 * mt + 4 * g + reg);
                const float d = diff > 0 ? ex2((float)diff * lg2f) : (diff < 0 ? ex2((float)(-diff) * lg2b) : 2.0f);
                sacc[mt][reg] *= d;
            }
        bf16x8 pf[4];
#pragma unroll
        for (int s = 0; s < 4; ++s) {
            u32x4 w; w[0] = cvt_pk_bf16(sacc[2 * s][0], sacc[2 * s][1]); w[1] = cvt_pk_bf16(sacc[2 * s][2], sacc[2 * s][3]);
            w[2] = cvt_pk_bf16(sacc[2 * s + 1][0], sacc[2 * s + 1][1]); w[3] = cvt_pk_bf16(sacc[2 * s + 1][2], sacc[2 * s + 1][3]);
            pf[s] = __builtin_bit_cast(bf16x8, w);
        }
        f32x4 oacc[8];
#pragma unroll
        for (int mt = 0; mt < 8; ++mt) oacc[mt] = (f32x4){0.f, 0.f, 0.f, 0.f};
#pragma unroll
        for (int s = 0; s < 4; ++s) {
            u32x4 vd[8];
#pragma unroll
            for (int jj = 0; jj < 8; ++jj) vd[jj] = *(LAS const u32x4*)(lds + vb[jj] + 8192 * s);
#pragma unroll
            for (int mt = 0; mt < 8; ++mt) oacc[mt] = mfma16(extract8(vd, mt), pf[s], oacc[mt]);
            SCHED_FENCE();
        }
        asm volatile("s_waitcnt lgkmcnt(0)" ::: "memory"); __builtin_amdgcn_s_barrier(); asm volatile("" ::: "memory");
        if (has_next) {
            const int ncidx = nbt >> 3, nhead = nbt & 7; const bf16_t* nProw = P + (size_t)chunk_row(ncidx) * ABIN;
#pragma unroll
            for (int s = 0; s < 4; ++s) qn[s] = *(const bf16x8*)(nProw + (size_t)(16 * wave + i) * ABIN + 3072 + nhead * 128 + 32 * s + 8 * g);
            r3_issue_regions(nProw, St, lds, nhead, 0, wave, lane);
            asm volatile("s_waitcnt vmcnt(8)" ::: "memory");
        } else asm volatile("s_waitcnt vmcnt(0)" ::: "memory");
        asm volatile("s_waitcnt lgkmcnt(0)" ::: "memory"); __builtin_amdgcn_s_barrier(); asm volatile("" ::: "memory");
#pragma unroll
        for (int dir = 0; dir < 2; ++dir) {
            f32x4 tacc[8];
#pragma unroll
            for (int mt = 0; mt < 8; ++mt) tacc[mt] = (f32x4){0.f, 0.f, 0.f, 0.f};
#pragma unroll
            for (int s = 0; s < 4; ++s) {
#pragma unroll
                for (int mt = 0; mt < 8; ++mt) { const bf16x8 sf = *(LAS const bf16x8*)(lds + sb[s] + 256 * mt + 32768 * dir); tacc[mt] = mfma16(sf, qf[s], tacc[mt]); }
                SCHED_FENCE();
            }
            const float qd = dir == 0 ? ex2((float)(qi + 1) * lg2f) : ex2((float)(128 - qi) * lg2b);
#pragma unroll
            for (int mt = 0; mt < 8; ++mt) oacc[mt] = oacc[mt] + tacc[mt] * qd;
        }
        asm volatile("s_waitcnt lgkmcnt(0)" ::: "memory"); __builtin_amdgcn_s_barrier(); asm volatile("" ::: "memory");
        float ss = 0.f;
#pragma unroll
        for (int mt = 0; mt < 8; ++mt) ss += (oacc[mt][0] * oacc[mt][0] + oacc[mt][1] * oacc[mt][1]) + (oacc[mt][2] * oacc[mt][2] + oacc[mt][3] * oacc[mt][3]);
        ss += shfl_xor_f(ss, 16); ss += shfl_xor_f(ss, 32);
        const float rinv = rsq_f(ss * (1.0f / 128.0f) + EPS);
#pragma unroll
        for (int reg = 0; reg < 4; ++reg) {
            const int dvb = 32 * g + 8 * reg;
            const u32x4 gt = *(const u32x4*)(Prow + (size_t)qi * ABIN + 6144 + head * 128 + dvb);
            float o[8];
#pragma unroll
            for (int mt = 0; mt < 8; ++mt) { const float gv = (mt & 1) ? bf_hi(gt[mt >> 1]) : bf_lo(gt[mt >> 1]); o[mt] = silu_f(gv) * (oacc[mt][reg] * rinv); }
            u32x4 w; w[0] = cvt_pk_bf16(o[0], o[1]); w[1] = cvt_pk_bf16(o[2], o[3]); w[2] = cvt_pk_bf16(o[4], o[5]); w[3] = cvt_pk_bf16(o[6], o[7]);
            *(u32x4*)(YAB + (size_t)(rowbase + qi) * D + 1024 + head * 128 + dvb) = w;
        }
        if (!has_next) break;
        { const int ncidx = nbt >> 3, nhead = nbt & 7; const bf16_t* nProw = P + (size_t)chunk_row(ncidx) * ABIN;
          r3_issue_regions(nProw, St + (((size_t)ncidx * 8 + nhead) * 2) * 16384, lds, nhead, 2, wave, lane); }
        bt = nbt;
    }
}

__device__ __forceinline__ void na_stage_issue(const bf16_t* P, LAS unsigned char* slot, int tok0, int h, int wave, int lane) {
#pragma unroll
    for (int j = 0; j < 2; ++j) {
        const int p = (j * 8 + wave) * 64 + lane, key = p >> 4, c = (p & 15) ^ (key & 15);
        const bf16_t* src = P + (size_t)(tok0 + key) * QKV + 2048 + h * 128 + c * 8;
        __builtin_amdgcn_global_load_lds((const unsigned*)src, (LAS unsigned*)(slot + (j * 8 + wave) * 1024), 16, 0, 0);
        __builtin_amdgcn_global_load_lds((const unsigned*)(src + 2048), (LAS unsigned*)(slot + 16384 + (j * 8 + wave) * 1024), 16, 0, 0);
    }
}
__device__ __forceinline__ void na_half_step(AttnTile& ta, AttnTile& tb, LAS const unsigned char* slot, const int k0, const bool okA, const bool okB, const bool win,
                                             LAS const float* brA, LAS const float* brB, const int kc0, const int c, const int sc, const int i, const int g) {
    f32x4 saA[2], saB[2];
#pragma unroll
    for (int mt = 0; mt < 2; ++mt) {
        const int k = k0 + 16 * mt + i;
        bf16x8 kf[4];
#pragma unroll
        for (int s = 0; s < 4; ++s) kf[s] = *(LAS const bf16x8*)(slot + ((k << 4) + ((4 * s + g) ^ (k & 15))) * 16);
        f32x4 a = (f32x4){0.f, 0.f, 0.f, 0.f}, b = a;
#pragma unroll
        for (int s = 0; s < 4; ++s) { a = mfma16(kf[s], ta.qf[s], a); b = mfma16(kf[s], tb.qf[s], b); }
        saA[mt] = a; saB[mt] = b;
    }
    const bf16x8 pfA = attn_tile_soft(ta, saA, win, okA, brA, kc0, c, sc, g);
    const bf16x8 pfB = attn_tile_soft(tb, saB, win, okB, brB, kc0, c, sc, g);
    u32x4 vd[8];
#pragma unroll
    for (int jj = 0; jj < 8; ++jj) { const int k = k0 + (jj < 4 ? 4 * g + jj : 16 + 4 * g + jj - 4); vd[jj] = *(LAS const u32x4*)(slot + 16384 + ((k << 4) + (i ^ (k & 15))) * 16); }
#pragma unroll
    for (int mt = 0; mt < 8; ++mt) { const bf16x8 vf = extract8(vd, mt); ta.oacc[mt] = mfma16(vf, pfA, ta.oacc[mt]); tb.oacc[mt] = mfma16(vf, pfB, tb.oacc[mt]); }
}
__device__ __forceinline__ void na_block_task(const bf16_t* P, bf16_t* YAB, const float* rpbh, LAS unsigned char* lds, const int h, const int r0, const int tid, const int wave, const int lane) {
    const int i = lane & 15, g = lane >> 4, cgp = wave & 3, pair = wave >> 2;
    const int rA = r0 + 2 * pair, rB = rA + 1, c0 = 16 * cgp, kc0 = cgp == 0 ? 0 : (cgp == 1 ? 8 : (cgp == 2 ? 24 : 32));
    const int c = c0 + i, sc = c - 8 < 0 ? 0 : (c - 8 > 48 ? 48 : c - 8);
    const int srA = rA - 4 < 0 ? 0 : (rA - 4 > 120 ? 120 : rA - 4), srB = rB - 4 < 0 ? 0 : (rB - 4 > 120 ? 120 : rB - 4);
    const int srmin = r0 - 4 < 0 ? 0 : (r0 - 4 > 120 ? 120 : r0 - 4), srlast = r0 - 1 < 0 ? 0 : (r0 - 1 > 120 ? 120 : r0 - 1);
    const int nkr = srlast + 8 - srmin, nsw = (nkr + 1) >> 1, nst = nsw + 2;
    LAS float* bias = (LAS float*)(lds + LDSCTL_OFF + 2048);
    if (tid < 465) bias[tid] = rpbh[tid];
    AttnTile ta, tb;
    attn_tile_init(ta, P, rA * 64 + c0 + i, h, g); attn_tile_init(tb, P, rB * 64 + c0 + i, h, g);
    asm volatile("s_waitcnt vmcnt(0)" ::: "memory");
#define NA_ROWOFF(idx) (nkr == 11 ? ((idx) < 4 ? (((idx) & 1) ? 9 + ((idx) >> 1) : ((idx) >> 1)) : (idx) - 2) : (idx))
#define NA_ISSUE2(stg, slotp) do { const int s_ = (stg); \
        const int t0_ = s_ < nsw ? (srmin + NA_ROWOFF(2 * s_)) * 64 : S + 128 * (s_ - nsw); \
        const int t1_ = s_ < nsw ? (srmin + (2 * s_ + 1 < nkr ? NA_ROWOFF(2 * s_ + 1) : NA_ROWOFF(2 * s_))) * 64 : S + 128 * (s_ - nsw) + 64; \
        na_stage_issue(P, (slotp), t0_, h, wave, lane); na_stage_issue(P, (slotp) + 32768, t1_, h, wave, lane); } while (0)
    NA_ISSUE2(0, lds);
    for (int st = 0; st < nst; ++st) {
        if (st + 1 < nst) {
            NA_ISSUE2(st + 1, lds + ((st + 1) & 1) * 65536);
            asm volatile("s_waitcnt vmcnt(8)" ::: "memory");
        } else asm volatile("s_waitcnt vmcnt(0)" ::: "memory");
        asm volatile("s_waitcnt lgkmcnt(0)" ::: "memory"); __builtin_amdgcn_s_barrier(); asm volatile("" ::: "memory");
        const bool win = st < nsw;
#pragma unroll 1
        for (int sub = 0; sub < 2; ++sub) {
            LAS const unsigned char* slot = lds + (st & 1) * 65536 + sub * 32768;
            const int kr = srmin + NA_ROWOFF(2 * st + sub);
            if (win && 2 * st + sub >= nkr) break;
            const bool doA = !win || (kr >= srA && kr < srA + 8), doB = !win || (kr >= srB && kr < srB + 8);
            if (!doA && !doB) continue;
            const int nh = win ? 1 : 2;
#pragma unroll 1
            for (int hf = 0; hf < nh; ++hf)
                na_half_step(ta, tb, slot, win ? kc0 : 32 * hf, doA, doB, win, bias + (win && doA ? (kr - rA + 7) * 31 : 0), bias + (win && doB ? (kr - rB + 7) * 31 : 0), kc0, c, sc, i, g);
        }
        asm volatile("s_waitcnt lgkmcnt(0)" ::: "memory"); __builtin_amdgcn_s_barrier(); asm volatile("" ::: "memory");
    }
#undef NA_ISSUE2
#undef NA_ROWOFF
    attn_tile_store(ta, YAB, rA * 64 + c0 + i, h, g); attn_tile_store(tb, YAB, rB * 64 + c0 + i, h, g);
}

#ifndef MK_MODE
#define MK_MODE 1
#endif
__global__ void __launch_bounds__(512, 2) mega_fwd(Params p) {
    extern __shared__ __attribute__((aligned(16))) unsigned char lds_raw[];
    LAS unsigned char* lds = (LAS unsigned char*)lds_raw;
    const int G_k = gridDim.x, bx_k = blockIdx.x;
#define SITE_COORDS pt_t0_ = (PT_SITE >= 0) ? wall_clock64() : 0ull; int tid = threadIdx.x; asm volatile("" : "+v"(tid)); int Gl_ = G_k, bxl_ = bx_k; asm volatile("" : "+s"(Gl_), "+s"(bxl_)); const int G = Gl_, bx = bxl_, NGW = G * 8; (void)NGW; const int lane = tid & 63, wave = __builtin_amdgcn_readfirstlane(tid >> 6); \
    const int vcu = (bx & 7) * (G >> 3) + (bx >> 3); const int gw = vcu * 8 + wave;     (void)lane; (void)gw; (void)vcu; \
    LAS const unsigned* prm = (LAS const unsigned*)(lds + PRM_OFF); asm volatile("" : "+v"(prm)); unsigned char* ws = (unsigned char*)(GAS unsigned char*)ldptr(prm, 17); (void)ws; \
    float* modacc = (float*)(ws + WS_MODACC); f32x2* rope = (f32x2*)(ws + WS_ROPE); float* X = (float*)(ws + WS_X); bf16_t* H = (bf16_t*)(ws + WS_H); bf16_t* P = (bf16_t*)(ws + WS_P); bf16_t* YAB = (bf16_t*)(ws + WS_YAB); \
    float* Y = (float*)(ws + WS_Y); bf16_t* HID = (bf16_t*)(ws + WS_P)  ; float* KVT = (float*)(ws + WS_Y)  ; bf16_t* ST = (bf16_t*)(ws + WS_Y + (size_t)NCHUNK * 16 * 16384 * 2); float* YC = (float*)(ws + WS_YC); \
    (void)modacc; (void)rope; (void)X; (void)H; (void)P; (void)YAB; (void)Y; (void)HID; (void)KVT; (void)ST; (void)YC
#define INP(k) ((const float*)(GAS const float*)ldptr(prm, (k)))
    volatile LAS unsigned* MISC = (volatile LAS unsigned*)(lds + MISC_OFF);
    { const int tid = threadIdx.x; for (int u = tid; u < (LDS_BYTES - LDSCTL_OFF) / 4; u += 512) ((LAS unsigned*)(lds + LDSCTL_OFF))[u] = 0u; }
    __syncthreads();
    if (threadIdx.x == 0) { LAS unsigned long long* q = (LAS unsigned long long*)(lds + PRM_OFF);
        q[0] = (unsigned long long)p.in[0]; q[1] = (unsigned long long)p.in[1]; q[2] = (unsigned long long)p.in[2]; q[3] = (unsigned long long)p.in[3];
        q[4] = (unsigned long long)p.in[4]; q[5] = (unsigned long long)p.in[5]; q[6] = (unsigned long long)p.in[6]; q[7] = (unsigned long long)p.in[7];
        q[8] = (unsigned long long)p.in[8]; q[9] = (unsigned long long)p.in[9]; q[10] = (unsigned long long)p.in[10]; q[11] = (unsigned long long)p.in[11];
        q[12] = (unsigned long long)p.in[12]; q[13] = (unsigned long long)p.in[13]; q[14] = (unsigned long long)p.in[14]; q[15] = (unsigned long long)p.in[15];
        q[16] = (unsigned long long)p.out; q[17] = (unsigned long long)p.ws; }
    __syncthreads();
    const int lo = MK_MODE == 1 ? 0 : p.ph_lo, hi = MK_MODE == 1 ? NPHASE : p.ph_hi;
    const bool multi = (hi - lo) > 1;
    XcdBarrier bar; bar.bar = (unsigned*)(p.ws + WS_CTL) + p.li * 4096; bar.x = 0; bar.st = nullptr;
    if (multi) bar = xcd_barrier_post((unsigned*)(p.ws + WS_CTL) + p.li * 4096, MISC + 8);
#ifndef SITE_MASK
#define SITE_MASK 0xffff
#endif
#define EN(i) (((SITE_MASK) >> (i)) & 1)
#ifndef REPEAT_MASK
#define REPEAT_MASK 0
#endif
#if REPEAT_MASK != 0
    int rmask_ = REPEAT_MASK; asm volatile("" : "+s"(rmask_));
#define REP(i) ((rmask_ >> (i)) & 1)
#else
#define REP(i) 0
#endif
#define IN(k) (lo <= (k) && (k) < hi)
#ifndef DEFER_CVT
#define DEFER_CVT 1
#endif
#define DEFER_SLOT(rk_, nblk_, lo_, hi_) do { if (DEFER_CVT && G == 256) {     const int rk = (rk_); if (rk >= 0) { LAS float* scr_ = (LAS float*)(lds + wave * 16384); \
        for (int gi = (lo_) + rk * 8 + wave; gi < (hi_); gi += (nblk_) * 8) cvt_dl_item(prm, gi, scr_, lane); } __syncthreads(); } } while (0)
#define DEFER_ADA(rk_, lo_, hi_) do { if (DEFER_CVT && G == 256) { const int ai_ = (lo_) + (rk_); if ((rk_) >= 0 && ai_ < (hi_)) ada_item(prm, 1 + (ai_ >> 7), (ai_ >> 4) & 7, ai_ & 15, tid); } } while (0)
#define MODF_FINALIZE(l0_, l1_) do { for (int it = (vcu * 512 + tid); it < ((l1_) - (l0_)) * 2 * 6 * (D / 4); it += G * 512) { const int col = 4 * (it & 511), j6 = (it >> 9) % 6, ls = 2 * (l0_) + it / (512 * 6); \
        *(f32x4*)((float*)(ws + WS_MODF) + (size_t)(ls * 6 + j6) * D + col) = modvec_partials(modacc, INP(5), ls >> 1, ls & 1, j6, col); } } while (0)
#define ROWOP_RUN(a0) do { RowopArgs ra_ = (a0); if (rep_ + 1 < nrep_) { ra_.xout_lat = (float*)(ws + WS_END); ra_.xout_ctx = ra_.xout_lat + (size_t)S * D; ra_.h = (bf16_t*)(ws + WS_END + (size_t)MTOK * D * 4); } LAS float* cf0 = (LAS float*)lds; LAS float* cf1 = (LAS float*)(lds + 24576); \
        rowop_coefs(ra_, 0, cf0, tid); if (ra_.nctx) rowop_coefs(ra_, 1, cf1, tid); __syncthreads(); \
        if (ra_.nctx) rowop_ctx(ra_, cf1, (LAS float*)(lds + 49152), vcu, G, wave, lane); \
        rowop_stream(ra_, cf0, gw, NGW, lane); __syncthreads(); } while (0)
#ifndef DOUBLE_BAR
#define DOUBLE_BAR 0
#endif
#ifndef PT_SITE
#define PT_SITE -1
#endif
#ifndef PT_BLOCK
#define PT_BLOCK 0
#endif
#ifndef IDLE_Q
#define IDLE_Q 40.0f
#endif
#ifndef IDLE_PROBE
#define IDLE_PROBE 0
#endif
    unsigned long long idle_acc_ = 0ull, pt_t0_ = 0ull, pt_acc_ = 0ull; int pt_cur_ = -1; (void)pt_t0_; (void)pt_acc_; (void)pt_cur_;
#define SEAM(k, knext) do { if (PT_SITE >= 0) { if (pt_cur_ == PT_SITE) pt_acc_ += wall_clock64() - pt_t0_; pt_cur_ = -1; } if (IN(k) && IN(knext)) { unsigned long long t0_ = 0ull; if (IDLE_PROBE) t0_ = wall_clock64(); { XcdBarrier b_ = bar; asm volatile("" : "+s"(b_.x)); xcd_barrier(b_); if (DOUBLE_BAR) xcd_barrier(b_); } \
        if (IDLE_PROBE == 1 || (IDLE_PROBE >= 2 && IDLE_PROBE < 100 && (k) >= 2 && ((k) - 2) % 9 == IDLE_PROBE - 2) || (IDLE_PROBE >= 100 && (k) == IDLE_PROBE - 100)) idle_acc_ += wall_clock64() - t0_; } } while (0)

    for (int nrep_ = 1 + REP(0), rep_ = 0; rep_ < nrep_; ++rep_) if (EN(0) && IN(0) && ((pt_cur_ = 0), true)) {
        SITE_COORDS;
        LAS float* scr = (LAS float*)(lds + wave * 16384);
        if (DEFER_CVT && G == 256) {
            constexpr int L0_ADA_SHARE = 2048;
            if (vcu < 128) { ada_item(prm, 0, vcu >> 4, vcu & 15, tid); for (int it = L0_ITEMS - L0_ADA_SHARE + vcu * 8 + wave; it < L0_ITEMS; it += 1024) cvt_l0_item(prm, it, scr, lane); }
            else for (int it = (vcu - 128) * 8 + wave; it < L0_ITEMS - L0_ADA_SHARE; it += 1024) cvt_l0_item(prm, it, scr, lane);
        } else {
            for (int it = gw; it < L0_ITEMS; it += NGW) cvt_l0_item(prm, it, scr, lane);
            for (int it = gw; it < DL_END; it += NGW) cvt_dl_item(prm, it, scr, lane);
            for (int it = vcu; it < 4 * 128; it += G) ada_item(prm, it >> 7, (it >> 4) & 7, it & 15, tid);
        }
        for (int idx = bx * 512 + tid; idx < 192 * 32; idx += G * 512) {
            const int pi = idx >> 5, f = idx & 31; const float pos = (float)(pi < 128 ? pi : pi - 128);
            const float ang = pos * powf(10000.0f, -(float)f / 32.0f);
            rope[idx] = (f32x2){cosf(ang), sinf(ang)};
        }
    }
    SEAM(0, 1);
    for (int nrep_ = 1 + REP(1), rep_ = 0; rep_ < nrep_; ++rep_) if (EN(1) && IN(1) && ((pt_cur_ = 1), true)) {
        SITE_COORDS;
        RowopArgs a; a.y = nullptr; a.xin_lat = INP(0); a.xin_ctx = INP(2); a.xout_lat = nullptr; a.xout_ctx = nullptr; a.xin16 = 0; a.xout16 = 0;     a.h = H; a.modacc = modacc; a.ada_b = INP(5); a.norm_g = INP(6);
        a.ly = -1; a.jg_y = 0; a.jgate = 0; a.lh = 0; a.jg_h = 0; a.jshift = 0; a.jscale = 1; a.nctx = NCTX; a.ypart = nullptr; a.nypart = 0; a.modf = nullptr;
        if (DEFER_CVT && G == 256) MODF_FINALIZE(0, 1); else MODF_FINALIZE(0, 4);
        ROWOP_RUN(a);
    }
    SEAM(1, 2);
    for (int layer = 0; layer < DEPTH; ++layer) {
        const int pb = 2 + 9 * layer, iab = layer >> 1;
        const bool even = (layer & 1) == 0, last = layer == DEPTH - 1;
        const int Mrows = last ? S : MTOK;
        if (even) {
            for (int nrep_ = 1 + REP(2), rep_ = 0; rep_ < nrep_; ++rep_) if (EN(2) && IN(pb + 0) && ((pt_cur_ = 2), true)) {
                SITE_COORDS;
                pg8::Gemm g{H, (const bf16_t*)(ws + WS_WABIN + iab * SZ_WABIN), MTOK, ABIN, D}; pg8::StaticOrder So; So.init(MTOK, ABIN, D, G, bx);
                EpiInProj E{P, rope};
                pg8::gemm_phase<EpiInProj, pg8::StaticOrder, PG8_ALIGN, PG8_SP2>(lds, g, So, E, tid);
                if (rep_ == 0) {     if (layer == 0) { DEFER_ADA(bx - 156, 0, 100); DEFER_SLOT(bx - 156, 100, 0, 8000); } else { DEFER_ADA(bx - 156, 268, 368); DEFER_SLOT(bx - 156, 100, 46784, 54784); } }
            }
            SEAM(pb + 0, pb + 1);
            for (int nrep_ = 1 + REP(3), rep_ = 0; rep_ < nrep_; ++rep_) if (EN(3) && IN(pb + 1) && ((pt_cur_ = 3), true)) {
                SITE_COORDS;
                if (rep_ == 0) { if (layer == 0) DEFER_SLOT(vcu - 16, 240, 8000, 13760); else DEFER_SLOT(vcu - 16, 240, 54784, 60544); }
                r1_phase_pipelined(P, KVT, lds, INP(9), iab, vcu, G, wave, lane);
                { const int cw0 = G == 256 ? (vcu - 16) * 8 + wave : gw, cwn = G == 256 ? 240 * 8 : NGW;
                  if (cw0 >= 0) for (int t = cw0; t < (MTOK / 8) * 2; t += cwn) conv_task(P, YAB, INP(8) + (size_t)iab * 3 * 1024, t, lane); }
            }
            SEAM(pb + 1, pb + 2);
            for (int nrep_ = 1 + REP(4), rep_ = 0; rep_ < nrep_; ++rep_) if (EN(4) && IN(pb + 2) && ((pt_cur_ = 4), true)) {
                SITE_COORDS;
                for (int it = vcu * 512 + tid; it < 131072; it += G * 512) r2_item((const bf16_t*)KVT, ST, INP(9), iab, it);
            }
            SEAM(pb + 2, pb + 3);
            for (int nrep_ = 1 + REP(5), rep_ = 0; rep_ < nrep_; ++rep_) if (EN(5) && IN(pb + 3) && ((pt_cur_ = 5), true)) {
                SITE_COORDS;
                if (rep_ == 0) { if (layer == 0) DEFER_SLOT(vcu - 16, 240, 13760, 21440); else DEFER_SLOT(vcu - 16, 240, 60544, 68224); }
                r3_phase_pipelined(P, ST, YAB, lds, INP(9), iab, vcu, G, wave, lane);
            }
            SEAM(pb + 3, pb + 4);
        } else {
            for (int nrep_ = 1 + REP(6), rep_ = 0; rep_ < nrep_; ++rep_) if (EN(6) && IN(pb + 0) && ((pt_cur_ = 6), true)) {
                SITE_COORDS;
                pg8::Gemm g{H, (const bf16_t*)(ws + WS_WQKV + iab * SZ_WQKV), MTOK, QKV, D}; pg8::StaticOrder So; So.init(MTOK, QKV, D, G, bx);
                EpiBf16 E{P, QKV};
                pg8::gemm_phase<EpiBf16, pg8::StaticOrder, PG8_ALIGN, PG8_SP2>(lds, g, So, E, tid);
                if (rep_ == 0) { if (layer == 1) DEFER_SLOT(bx - 24, 232, 27488, 40736); else DEFER_SLOT(bx - 24, 232, 74272, 87520); }
            }
            SEAM(pb + 0, pb + 1);
            for (int nrep_ = 1 + REP(7), rep_ = 0; rep_ < nrep_; ++rep_) if (EN(7) && IN(pb + 1) && ((pt_cur_ = 7), true)) {
                SITE_COORDS;
                const float* rpb = INP(12) + (size_t)iab * 16 * 15 * 31;
                for (int bt = vcu; bt < 512; bt += G) {
                    const int h = bt >> 5, rq = bt & 31;
                    na_block_task(P, YAB, rpb + h * 465, lds, h, 4 * rq, tid, wave, lane);
                }
                if (!last) for (int t = gw; t < 128; t += NGW) attn_task2<false>(P, YAB, rpb, t >> 3, S + 32 * (t & 7), S + 32 * (t & 7) + 16, 0, 0, 0, lane);
            }
            SEAM(pb + 1, pb + 4);
        }
        for (int nrep_ = 1 + REP(8), rep_ = 0; rep_ < nrep_; ++rep_) if (EN(8) && IN(pb + 4) && ((pt_cur_ = 8), true)) {
            SITE_COORDS;
            const bf16_t* wt = even ? (const bf16_t*)(ws + WS_WABOUT + iab * SZ_WSQ) : (const bf16_t*)(ws + WS_WNAOUT + iab * SZ_WSQ);
            pg8::Gemm g{YAB, wt, MTOK, D, D}; pg8::MixedOrder So; So.init(S, D, D, G, bx, 32, last ? 0 : NSPLIT_OUT);
            EpiY E{(bf16_t*)Y, D, (bf16_t*)YC};
            pg8::gemm_phase<EpiY, pg8::MixedOrder, PG8_ALIGN, PG8_SP2>(lds, g, So, E, tid);
        }
        SEAM(pb + 4, pb + 5);
        for (int nrep_ = 1 + REP(9), rep_ = 0; rep_ < nrep_; ++rep_) if (EN(9) && IN(pb + 5) && ((pt_cur_ = 9), true)) {
            SITE_COORDS;
            RowopArgs a; a.y = (const bf16_t*)Y; a.xin_lat = layer == 0 ? INP(0) : X; a.xin_ctx = layer == 0 ? INP(2) : (const float*)((const bf16_t*)X + (size_t)S * D); a.xout_lat = X; a.xout_ctx = (float*)((bf16_t*)X + (size_t)S * D); a.xin16 = layer == 0 ? 0 : 1; a.xout16 = 1;     a.h = H; a.modacc = modacc; a.ada_b = INP(5); a.norm_g = INP(6);
            a.ly = layer; a.jg_y = 1; a.jgate = 2; a.lh = layer; a.jg_h = 2; a.jshift = 3; a.jscale = 4; a.nctx = last ? 0 : NCTX; a.ypart = (const bf16_t*)YC; a.nypart = NSPLIT_OUT; a.modf = (const float*)(ws + WS_MODF);
            ROWOP_RUN(a);
        }
        SEAM(pb + 5, pb + 6);
        for (int nrep_ = 1 + REP(10), rep_ = 0; rep_ < nrep_; ++rep_) if (EN(10) && IN(pb + 6) && ((pt_cur_ = 10), true)) {
            SITE_COORDS;
            pg8::Gemm g{H, (const bf16_t*)(ws + WS_WFFIN + layer * SZ_WFFIN), Mrows, FF2, D}; pg8::StaticOrder So; So.init(Mrows, FF2, D, G, bx);
            EpiSwiglu E{HID};
            pg8::gemm_phase<EpiSwiglu, pg8::StaticOrder, PG8_ALIGN, PG8_SP2>(lds, g, So, E, tid);
            if (rep_ == 0) { if (layer == 0) { DEFER_ADA(bx - 172, 100, 184); DEFER_SLOT(bx - 172, 84, 21440, 27488); } else if (layer == 1) { DEFER_ADA(bx - 172, 184, 268); DEFER_SLOT(bx - 172, 84, 40736, 46784); } else if (layer == 2) { DEFER_ADA(bx - 172, 368, 384); DEFER_SLOT(bx - 172, 84, 68224, 74272); } else DEFER_SLOT(bx - 128, 128, 87520, DL_END); }
        }
        SEAM(pb + 6, pb + 7);
        for (int nrep_ = 1 + REP(11), rep_ = 0; rep_ < nrep_; ++rep_) if (EN(11) && IN(pb + 7) && ((pt_cur_ = 11), true)) {
            SITE_COORDS;
            if (rep_ == 0 && !last && DEFER_CVT && G == 256) MODF_FINALIZE(layer + 1, layer + 2);
            pg8::Gemm g{HID, (const bf16_t*)(ws + WS_WFFOUT + layer * SZ_WFFOUT), MTOK, D, FFH}; pg8::MixedOrder So; So.init(S, D, FFH, G, bx, 32, last ? 0 : NSPLIT_FFO);
            EpiY E{(bf16_t*)Y, D, (bf16_t*)YC};
            pg8::gemm_phase<EpiY, pg8::MixedOrder, PG8_ALIGN, PG8_SP2>(lds, g, So, E, tid);
        }
        SEAM(pb + 7, pb + 8);
        for (int nrep_ = 1 + REP(12), rep_ = 0; rep_ < nrep_; ++rep_) if (EN(12) && IN(pb + 8) && ((pt_cur_ = 12), true)) {
            SITE_COORDS;
            RowopArgs a; a.y = (const bf16_t*)Y; a.xin_lat = X; a.xin_ctx = (const float*)((const bf16_t*)X + (size_t)S * D); a.xout_lat = last ? (float*)(GAS float*)ldptr(prm, 16) : X; a.xout_ctx = last ? nullptr : (float*)((bf16_t*)X + (size_t)S * D); a.xin16 = 1; a.xout16 = last ? 0 : 1; a.h = H; a.modacc = modacc; a.ada_b = INP(5); a.norm_g = INP(6);
            a.ly = layer; a.jg_y = 3; a.jgate = 5; a.lh = last ? -1 : layer + 1; a.jg_h = 0; a.jshift = 0; a.jscale = 1; a.nctx = last ? 0 : NCTX; a.ypart = (const bf16_t*)YC; a.nypart = NSPLIT_FFO; a.modf = (const float*)(ws + WS_MODF);
            ROWOP_RUN(a);
        }
        if (!last) SEAM(pb + 8, pb + 9);
    }
    if (PT_SITE >= 0) { if (blockIdx.x == PT_BLOCK && threadIdx.x == 0) { const float us = (float)((double)pt_acc_ * 0.01); p.out[0] = 1000.0f * IDLE_Q * floorf(us / IDLE_Q + 0.5f); } }
    if (IDLE_PROBE) {
        unsigned long long* acc = (unsigned long long*)(p.ws + WS_CTL + 32768);
        if (threadIdx.x == 0) atomicAdd(acc, idle_acc_);
        xcd_barrier(bar);
        if (blockIdx.x == 0 && threadIdx.x == 0) { const unsigned long long tot = __hip_atomic_load(acc, __ATOMIC_RELAXED, __HIP_MEMORY_SCOPE_AGENT); const float us = (float)((double)tot / (double)G_k * 0.01); p.out[0] = 1000.0f * IDLE_Q * floorf(us / IDLE_Q + 0.5f); }
    }
#undef IN
#undef SEAM
}

extern "C" void kernel_launch(void* const* d_in, const int* in_sizes, int n_in, void* d_out, int out_size, void* d_ws, size_t ws_size, hipStream_t stream) {
    static int grid = 0;
    if (grid == 0) {
        if (n_in != 16 || out_size != S * D || ws_size < WS_END) { fprintf(stderr, "kernel_launch: unexpected shapes (n_in %d out %d ws %zu need %zu)\n", n_in, out_size, ws_size, (size_t)WS_END); grid = -1; return; }
        int dev = 0, cus = 0, per_cu = 0;
        if (hipGetDevice(&dev) != hipSuccess || hipDeviceGetAttribute(&cus, hipDeviceAttributeMultiprocessorCount, dev) != hipSuccess) { grid = -1; return; }
        if (hipFuncSetAttribute((const void*)mega_fwd, hipFuncAttributeMaxDynamicSharedMemorySize, LDS_BYTES) != hipSuccess) { fprintf(stderr, "kernel_launch: hipFuncSetAttribute failed\n"); grid = -1; return; }
        if (hipOccupancyMaxActiveBlocksPerMultiprocessor(&per_cu, (const void*)mega_fwd, 512, LDS_BYTES) != hipSuccess || per_cu < 1) fprintf(stderr, "kernel_launch: occupancy query says %d\n", per_cu);
        (void)hipGetLastError();
        grid = cus;
    }
    if (grid < 0) return;
    if (hipMemsetAsync((char*)d_ws + WS_CTL, 0, CTL_ZERO_BYTES, stream) != hipSuccess) { fprintf(stderr, "kernel_launch: memset failed\n"); return; }
    Params a{};
    for (int i = 0; i < 16; ++i) a.in[i] = (const float*)d_in[i];
    a.out = (float*)d_out; a.ws = (unsigned char*)d_ws; a.pad = 0;
#if MK_MODE == 1
    a.ph_lo = 0; a.ph_hi = NPHASE; a.li = 0;
    hipLaunchKernelGGL(mega_fwd, dim3(grid), dim3(512), LDS_BYTES, stream, a);
#else
    for (int ph = 0; ph < NPHASE; ++ph) {
        if (ph >= 2) { const int layer = (ph - 2) / 9, slot = (ph - 2) % 9; if ((layer & 1) && (slot == 2 || slot == 3)) continue; }
        a.ph_lo = ph; a.ph_hi = ph + 1; a.li = 0;
        hipLaunchKernelGGL(mega_fwd, dim3(grid), dim3(512), LDS_BYTES, stream, a);
    }
#endif
    const hipError_t le = hipPeekAtLastError();
    if (le != hipSuccess) fprintf(stderr, "kernel_launch: launch failed: %s\n", hipGetErrorName(le));
}
#endif
```
